# Optimizing an MI355X kernel written in HIP

```python
import math
import jax, jax.numpy as jnp
from jax import lax
import numpy as np

D_MODEL = 1024
BATCH = 8
SEQ = 4096
DEPTH = 2

CHUNK = 64
MEM_LEN = 256
EPS = 1e-6
A_WIDTH = 512
A_GROUPS = 4
A_GROUP_DIM = A_WIDTH // A_GROUPS
GMLP_BLOCK = 128
B_WIDTH = 512
CONV_WIDTH = 31
MIX_WIDTH = A_WIDTH + B_WIDTH
IN_WIDTH = 2 * A_WIDTH + 2 * B_WIDTH
C_WIDTH = 512
C_GROUP_CH = 16
C_GROUPS = C_WIDTH // C_GROUP_CH
C_STATE = 64
DT_MIN = 1e-3
DT_MAX = 1e-1
CA_HEADS = 4
CA_HEAD_DIM = D_MODEL // CA_HEADS
FFN_HIDDEN = -(-8 * D_MODEL // (3 * 256)) * 256
N_EVEN = (DEPTH + 1) // 2
N_ODD = DEPTH // 2

kernel_name = "chunk_causal_hybrid_gmlp_conformer_s5_trunk"


def rmsnorm(x, g):
    xf = x.astype(jnp.float32)
    y = xf * lax.rsqrt(jnp.mean(xf * xf, axis=-1, keepdims=True) + EPS)
    return (y * g.astype(jnp.float32)).astype(x.dtype)


def layernorm(x, g=None, b=None):
    xf = x.astype(jnp.float32)
    mu = jnp.mean(xf, axis=-1, keepdims=True)
    xc = xf - mu
    y = xc * lax.rsqrt(jnp.mean(xc * xc, axis=-1, keepdims=True) + EPS)
    if g is not None:
        y = y * g.astype(jnp.float32) + b.astype(jnp.float32)
    return y.astype(x.dtype)


def gmlp_spatial_gate(u, v, w_s, b_s):
    bn, s, _ = v.shape
    v = layernorm(v)
    v = v.reshape(bn, s // GMLP_BLOCK, GMLP_BLOCK, A_GROUPS, A_GROUP_DIM)
    chunk_id = jnp.arange(GMLP_BLOCK) // CHUNK
    mask = chunk_id[None, :] <= chunk_id[:, None]
    w = jnp.where(mask[None], w_s, jnp.zeros_like(w_s))
    sg = jnp.einsum('gij,bnjgc->bnigc', w, v) + b_s.T[None, None, :, :, None]
    return u * sg.reshape(bn, s, A_WIDTH)


def conformer_conv(a, g, conv_w, conv_b, ln_g, ln_b):
    h = a * jax.nn.sigmoid(g)
    h = lax.conv_general_dilated(
        h, conv_w[:, None, :].astype(h.dtype), window_strides=(1,),
        padding=[(CONV_WIDTH - 1, 0)], dimension_numbers=('NWC', 'WIO', 'NWC'),
        feature_group_count=B_WIDTH) + conv_b
    h = layernorm(h, ln_g, ln_b)
    return jax.nn.silu(h)


def _complex_affine_combine(e1, e2):
    a1r, a1i, b1r, b1i = e1
    a2r, a2i, b2r, b2i = e2
    ar = a1r * a2r - a1i * a2i
    ai = a1r * a2i + a1i * a2r
    br = a2r * b1r - a2i * b1i + b2r
    bi = a2r * b1i + a2i * b1r + b2i
    return (ar, ai, br, bi)


def s5_layer(u, lam_re, lam_im, log_dt, b_re, b_im, c_re, c_im, d_skip):
    bn, s, _ = u.shape
    f32 = jnp.float32
    uf = u.astype(f32)
    dt = jnp.exp(log_dt.astype(f32))[:, None]
    lr = lam_re.astype(f32)
    li = lam_im.astype(f32)
    mag = jnp.exp(lr * dt)
    ar = mag * jnp.cos(li * dt)
    ai = mag * jnp.sin(li * dt)
    den = lr * lr + li * li
    qr = ((ar - 1.0) * lr + ai * li) / den
    qi = (ai * lr - (ar - 1.0) * li) / den
    br_ = b_re.astype(f32)
    bi_ = b_im.astype(f32)
    bbr = qr[..., None] * br_ - qi[..., None] * bi_
    bbi = qr[..., None] * bi_ + qi[..., None] * br_
    ug = uf.reshape(bn, s, C_GROUPS, C_GROUP_CH).transpose(1, 0, 2, 3)
    bu_r = jnp.einsum('sbgc,gpc->sbgp', ug, bbr)
    bu_i = jnp.einsum('sbgc,gpc->sbgp', ug, bbi)
    a_r = jnp.broadcast_to(ar[None, None], (s, 1, C_GROUPS, C_STATE))
    a_i = jnp.broadcast_to(ai[None, None], (s, 1, C_GROUPS, C_STATE))
    _, _, xr, xi = lax.associative_scan(_complex_affine_combine, (a_r, a_i, bu_r, bu_i), axis=0)
    y = (jnp.einsum('sbgp,gcp->sbgc', xr, c_re.astype(f32))
         - jnp.einsum('sbgp,gcp->sbgc', xi, c_im.astype(f32)))
    y = y.transpose(1, 0, 2, 3).reshape(bn, s, C_WIDTH) + d_skip.astype(f32) * uf
    return y.astype(u.dtype)


def cross_attention(xn, memn, wq, wk, wv, wo):
    bn, s, _ = xn.shape
    m = memn.shape[1]
    q = (xn @ wq).reshape(bn, s, CA_HEADS, CA_HEAD_DIM)
    k = (memn @ wk).reshape(bn, m, CA_HEADS, CA_HEAD_DIM)
    v = (memn @ wv).reshape(bn, m, CA_HEADS, CA_HEAD_DIM)
    sc = jnp.einsum('bshd,bmhd->bhsm', q, k).astype(jnp.float32) * (CA_HEAD_DIM ** -0.5)
    p = jax.nn.softmax(sc, axis=-1).astype(v.dtype)
    o = jnp.einsum('bhsm,bmhd->bshd', p, v).reshape(bn, s, D_MODEL)
    return o @ wo


def swiglu(xn, wg, wu, wd):
    return (jax.nn.silu(xn @ wg) * (xn @ wu)) @ wd


def setup_inputs(seed: int = 0) -> dict:
    key = jax.random.key(seed)
    ks = iter(jax.random.split(key, 48))

    def nrm(shape, scale):
        return jax.random.normal(next(ks), shape, jnp.float32) * scale

    def gain(shape):
        return 1.0 + nrm(shape, 0.02)

    d, h = D_MODEL, FFN_HIDDEN
    inp = {}
    inp['x'] = nrm((BATCH, SEQ, d), 1.0)
    inp['mem'] = nrm((BATCH, MEM_LEN, d), 1.0)
    inp['e_norm'] = gain((N_EVEN, d))
    inp['e_w_in'] = nrm((N_EVEN, d, IN_WIDTH), d ** -0.5)
    inp['e_gmlp_w'] = nrm((N_EVEN, A_GROUPS, GMLP_BLOCK, GMLP_BLOCK), 0.5 * GMLP_BLOCK ** -0.5)
    inp['e_gmlp_b'] = gain((N_EVEN, A_GROUPS, GMLP_BLOCK))
    inp['e_conv_w'] = nrm((N_EVEN, CONV_WIDTH, B_WIDTH), CONV_WIDTH ** -0.5)
    inp['e_conv_b'] = nrm((N_EVEN, B_WIDTH), 0.02)
    inp['e_conv_ln_g'] = gain((N_EVEN, B_WIDTH))
    inp['e_conv_ln_b'] = nrm((N_EVEN, B_WIDTH), 0.02)
    inp['e_w_out'] = nrm((N_EVEN, MIX_WIDTH, d), MIX_WIDTH ** -0.5)
    inp['o_norm'] = gain((N_ODD, d))
    inp['o_w_in'] = nrm((N_ODD, d, C_WIDTH), d ** -0.5)
    inp['o_lam_re'] = -0.5 + nrm((N_ODD, C_GROUPS, C_STATE), 0.01)
    inp['o_lam_im'] = (math.pi * jnp.arange(C_STATE, dtype=jnp.float32))[None, None, :] + nrm((N_ODD, C_GROUPS, C_STATE), 0.01)
    inp['o_log_dt'] = jax.random.uniform(next(ks), (N_ODD, C_GROUPS), jnp.float32, math.log(DT_MIN), math.log(DT_MAX))
    inp['o_b_re'] = nrm((N_ODD, C_GROUPS, C_STATE, C_GROUP_CH), (2 * C_GROUP_CH) ** -0.5)
    inp['o_b_im'] = nrm((N_ODD, C_GROUPS, C_STATE, C_GROUP_CH), (2 * C_GROUP_CH) ** -0.5)
    inp['o_c_re'] = nrm((N_ODD, C_GROUPS, C_GROUP_CH, C_STATE), (2 * C_STATE) ** -0.5)
    inp['o_c_im'] = nrm((N_ODD, C_GROUPS, C_GROUP_CH, C_STATE), (2 * C_STATE) ** -0.5)
    inp['o_d'] = gain((N_ODD, C_WIDTH))
    inp['o_w_out'] = nrm((N_ODD, C_WIDTH, 2 * d), C_WIDTH ** -0.5)
    inp['ca_norm'] = gain((DEPTH, d))
    inp['ca_mem_norm'] = gain((DEPTH, d))
    inp['ca_wq'] = nrm((DEPTH, d, d), d ** -0.5)
    inp['ca_wk'] = nrm((DEPTH, d, d), d ** -0.5)
    inp['ca_wv'] = nrm((DEPTH, d, d), d ** -0.5)
    inp['ca_wo'] = nrm((DEPTH, d, d), d ** -0.5)
    inp['ffn_norm'] = gain((DEPTH, d))
    inp['ffn_w_gate'] = nrm((DEPTH, d, h), d ** -0.5)
    inp['ffn_w_up'] = nrm((DEPTH, d, h), d ** -0.5)
    inp['ffn_w_down'] = nrm((DEPTH, h, d), h ** -0.5)
    inp['final_norm'] = gain((d,))
    return inp


def reference(x, mem, e_norm, e_w_in, e_gmlp_w, e_gmlp_b, e_conv_w, e_conv_b, e_conv_ln_g,
              e_conv_ln_b, e_w_out, o_norm, o_w_in, o_lam_re, o_lam_im, o_log_dt, o_b_re,
              o_b_im, o_c_re, o_c_im, o_d, o_w_out, ca_norm, ca_mem_norm, ca_wq, ca_wk, ca_wv,
              ca_wo, ffn_norm, ffn_w_gate, ffn_w_up, ffn_w_down, final_norm):
    for i in range(DEPTH):
        j = i // 2
        if i % 2 == 0:
            hn = rmsnorm(x, e_norm[j])
            proj = hn @ e_w_in[j]
            a_u, a_v, b_a, b_g = jnp.split(proj, [A_WIDTH, 2 * A_WIDTH, 2 * A_WIDTH + B_WIDTH], axis=-1)
            out_a = gmlp_spatial_gate(jax.nn.gelu(a_u), jax.nn.gelu(a_v), e_gmlp_w[j], e_gmlp_b[j])
            out_b = conformer_conv(b_a, b_g, e_conv_w[j], e_conv_b[j], e_conv_ln_g[j], e_conv_ln_b[j])
            mix = jnp.concatenate([out_a, out_b], axis=-1) @ e_w_out[j]
        else:
            hn = rmsnorm(x, o_norm[j])
            u = hn @ o_w_in[j]
            y = s5_layer(u, o_lam_re[j], o_lam_im[j], o_log_dt[j], o_b_re[j], o_b_im[j],
                         o_c_re[j], o_c_im[j], o_d[j])
            o = jax.nn.gelu(y) @ o_w_out[j]
            mix = o[..., :D_MODEL] * jax.nn.sigmoid(o[..., D_MODEL:])
        x = x + mix
        x = x + cross_attention(rmsnorm(x, ca_norm[i]), rmsnorm(mem, ca_mem_norm[i]),
                                ca_wq[i], ca_wk[i], ca_wv[i], ca_wo[i])
        x = x + swiglu(rmsnorm(x, ffn_norm[i]), ffn_w_gate[i], ffn_w_up[i], ffn_w_down[i])
    return rmsnorm(x, final_norm)
```

```cpp
#include <hip/hip_runtime.h>
#include <hip/hip_cooperative_groups.h>
#include <cstdio>
#include <cstdint>
namespace cg = cooperative_groups;

#ifndef MK_MULTI
#define MK_MULTI 0
#endif
#ifndef MK_CGSYNC
#define MK_CGSYNC 1
#endif

#define LAS __attribute__((address_space(3)))
typedef unsigned short bf16_t;
typedef short bf16x8 __attribute__((ext_vector_type(8)));
typedef float f32x4 __attribute__((ext_vector_type(4)));
typedef float f32x2 __attribute__((ext_vector_type(2)));
typedef unsigned u32x4 __attribute__((ext_vector_type(4)));
typedef unsigned u32x2 __attribute__((ext_vector_type(2)));

constexpr int T = 32768, D = 1024, SEQ = 4096, NB = 8, MT = 2048, FH = 2816;
constexpr float EPS = 1e-6f;
constexpr int SL = 32;
constexpr int NCH = T / SL;
constexpr int AK = SL * 16 + 128;

constexpr size_t MiB = 1u << 20;
constexpr size_t WS_WIN0 = 0, WS_WOUT0 = 4 * MiB, WS_WOIN = 6 * MiB, WS_WOOUT = 7 * MiB, WS_WQ = 9 * MiB, WS_WK = 13 * MiB, WS_WV = 17 * MiB, WS_WO = 21 * MiB;
constexpr size_t WS_WGU = 25 * MiB, WS_WD = 47 * MiB, WS_GW = 58 * MiB, WS_AL = 59 * MiB, WS_BT3 = 60 * MiB, WS_GM = 80 * MiB, WS_MEMN = 88 * MiB, WS_KL = 92 * MiB, WS_VT = 100 * MiB;
constexpr size_t WS_SS = 108 * MiB, WS_VST = 109 * MiB, WS_BAR = 109 * MiB + 512 * 1024, WS_XB = 110 * MiB, WS_QO = 174 * MiB, WS_P = 238 * MiB, WS_R0 = 302 * MiB;
constexpr size_t WS_HM = WS_R0, WS_U = WS_R0, WS_V = WS_R0 + 32 * MiB, WS_H = WS_R0 + 64 * MiB, WS_MIX = WS_R0 + 96 * MiB;
constexpr size_t WS_ACOMB = WS_R0, WS_XLOC = WS_R0 + 40 * MiB, WS_Y = WS_R0 + 56 * MiB;
constexpr size_t WS_END = WS_R0 + 176 * MiB;
constexpr size_t WGU_L = (size_t)2 * FH * D * 2, WD_L = (size_t)D * FH * 2, WSQ_L = (size_t)D * D * 2;

constexpr int RING_BYTES = 131072, XCH_OFF = RING_BYTES, MISC_OFF = RING_BYTES + 8192, LDS_BYTES = 147456;

__device__ __forceinline__ unsigned cvt_pk_bf16(float lo, float hi) { unsigned r; asm volatile("v_cvt_pk_bf16_f32 %0, %1, %2" : "=v"(r) : "v"(lo), "v"(hi)); return r; }
__device__ __forceinline__ float bf2f(unsigned short b) { return __builtin_bit_cast(float, (unsigned)b << 16); }
__device__ __forceinline__ float bflo(unsigned w) { return __builtin_bit_cast(float, w << 16); }
__device__ __forceinline__ float bfhi(unsigned w) { return __builtin_bit_cast(float, w & 0xffff0000u); }
__device__ __forceinline__ float sigmoid_f(float x) { return __builtin_amdgcn_rcpf(1.0f + __expf(-x)); }
__device__ __forceinline__ float silu_f(float x) { return x * sigmoid_f(x); }
__device__ __forceinline__ float gelu_f(float x) { return x * sigmoid_f(1.5957691216f * (x + 0.044715f * x * x * x)); }
__device__ __forceinline__ float wave_sum(float v) {
#pragma unroll
    for (int o = 1; o < 64; o <<= 1) v += __shfl_xor(v, o);
    return v;
}
__device__ __forceinline__ u32x4 pack8(f32x4 a, f32x4 b) { u32x4 w; w.x = cvt_pk_bf16(a[0], a[1]); w.y = cvt_pk_bf16(a[2], a[3]); w.z = cvt_pk_bf16(b[0], b[1]); w.w = cvt_pk_bf16(b[2], b[3]); return w; }

namespace pg8 {
constexpr int BM = 256, BK = 64, HALF = 128, HTB = HALF * BK * 2, NXCD = 8, WGM = 8;
__device__ __forceinline__ int lds_byte(int r, int c) { const int st = (r >> 4) * 2 + (c >> 5), rr = r & 15, cc = c & 31, ob = rr * 64 + cc * 2; return st * 1024 + (ob ^ (((ob >> 9) & 1) << 5)); }
__device__ __forceinline__ void stage_rc(int b, int& R, int& C) { const int st = b / 1024, sb = b % 1024, swz = sb ^ (((sb >> 9) & 1) << 5); R = (st >> 1) * 16 + swz / 64; C = (st & 1) * 32 + (swz % 64) / 2; }
__device__ __forceinline__ int perm32(int rho) { const int n = rho >> 4, i = rho & 15; return 8 * (i >> 2) + 4 * n + (i & 3); }

struct Unit { int pm, pn, z; };
struct Gemm { const bf16_t* A; const bf16_t* Bt; int lda, ldb, K, nz0; long sAz0, sAz1, sBz0, sBz1; };
struct Sched {
    int nM, nN, per, total, G, c;
    __device__ __forceinline__ void init(int nM_, int nN_, int nz, int G_, int c_) { nM = nM_; nN = nN_; per = nM_ * nN_; total = per * nz; G = G_; c = c_; }
    __device__ __forceinline__ bool next(int i, Unit& u) const {
        const long L = (long)i * G + c; if (L >= total) return false;
        const int z = (int)(L / per); int wgid = (int)(L % per);
        { const int q = per / NXCD, r = per % NXCD, xcd = wgid % NXCD, off = wgid / NXCD; wgid = (xcd < r ? xcd * (q + 1) : r * (q + 1) + (xcd - r) * q) + off; }
        const int nig = WGM * nN, gid = wgid / nig, fm = gid * WGM, gsz = (nM - fm) < WGM ? (nM - fm) : WGM;
        u.pm = fm + ((wgid % nig) % gsz); u.pn = (wgid % nig) / gsz; u.z = z; return true;
    }
};

template <class Epi>
__device__ __forceinline__ void gemm_phase(LAS unsigned char* lds, const Gemm g, const Sched& S, const Epi& E, const int tid) {
    const int wid = __builtin_amdgcn_readfirstlane(tid >> 6), lane = tid & 63, wr = wid >> 2, wc = wid & 3, fr = lane & 15, fq = lane >> 4;
    const int nt = g.K / BK;
    unsigned voffA[2], voffB[2];
#pragma unroll
    for (int i = 0; i < 2; ++i) { int R, C; stage_rc(tid * 16 + i * 8192, R, C); const int Rb = (R & ~31) + perm32(R & 31);
        voffA[i] = (unsigned)(R * g.lda + C) * 2u; voffB[i] = (unsigned)(Rb * g.ldb + C) * 2u; }
    const size_t kstep = (size_t)(BK * 2);
    const size_t hsA = (size_t)HALF * g.lda * 2, hsB = (size_t)HALF * g.ldb * 2;
    const unsigned ldsw = (unsigned)wid * 1024u;
    const int aoff = lds_byte(wr * 64 + fr, fq * 8), boff = lds_byte(wc * 32 + fr, fq * 8);
#define PG8_SA(b, h) (((b) * 2 + (h)) * HTB)
#define PG8_SB(b, h) ((4 + (b) * 2 + (h)) * HTB)
#define PG8_STAGE(bufoff, gbase, voff) do { _Pragma("unroll") for (int _i = 0; _i < 2; ++_i) \
        __builtin_amdgcn_global_load_lds((const unsigned*)((const char*)(gbase) + (voff)[_i]), (LAS unsigned*)(lds + (bufoff) + ldsw + _i * 8192), 16, 0, 0); } while (0)
#define PG8_LDA(dst, b, h) do { _Pragma("unroll") for (int m = 0; m < 4; ++m) _Pragma("unroll") for (int k = 0; k < 2; ++k) dst[m][k] = *(const LAS bf16x8*)(lds + PG8_SA(b, h) + aoff + m * 2048 + k * 1024); } while (0)
#define PG8_LDB(dst, b, h) do { _Pragma("unroll") for (int n = 0; n < 2; ++n) _Pragma("unroll") for (int k = 0; k < 2; ++k) dst[n][k] = *(const LAS bf16x8*)(lds + PG8_SB(b, h) + boff + n * 2048 + k * 1024); } while (0)
#define PG8_MMA(ai, bj, At, Bt) do { __builtin_amdgcn_s_setprio(1); _Pragma("unroll") for (int m = 0; m < 4; ++m) _Pragma("unroll") for (int n = 0; n < 2; ++n) _Pragma("unroll") for (int k = 0; k < 2; ++k) \
        acc[ai][bj][m][n] = __builtin_amdgcn_mfma_f32_16x16x32_bf16(Bt[n][k], At[m][k], acc[ai][bj][m][n], 0, 0, 0); __builtin_amdgcn_s_setprio(0); } while (0)
#define PG8_WAIT_V(n) asm volatile("s_waitcnt vmcnt(" #n ")" ::: "memory")
#define PG8_WAIT_L(n) asm volatile("s_waitcnt lgkmcnt(" #n ")" ::: "memory")
#define PG8_BAR __builtin_amdgcn_s_barrier()
#define PG8_SCHED __builtin_amdgcn_sched_barrier(0)
#define PG8_UA(u) ((const char*)g.A + 2 * ((size_t)((u).z % g.nz0) * g.sAz0 + (size_t)((u).z / g.nz0) * g.sAz1 + (size_t)(u).pm * BM * g.lda))
#define PG8_UB(u) ((const char*)g.Bt + 2 * ((size_t)((u).z % g.nz0) * g.sBz0 + (size_t)((u).z / g.nz0) * g.sBz1 + (size_t)(u).pn * BM * g.ldb))
    Unit cur, nxt; int ui = 0;
    if (!S.next(0, cur)) return;
    f32x4 acc[2][2][4][2];
#pragma unroll
    for (int a = 0; a < 2; ++a)
#pragma unroll
        for (int b = 0; b < 2; ++b)
#pragma unroll
            for (int m = 0; m < 4; ++m)
#pragma unroll
                for (int n = 0; n < 2; ++n) acc[a][b][m][n] = (f32x4){0.f, 0.f, 0.f, 0.f};
    bf16x8 At[4][2], B0[2][2], B1[2][2];
    const char* cA = PG8_UA(cur); const char* cB = PG8_UB(cur);
    PG8_STAGE(PG8_SB(0, 0), cB, voffB); PG8_STAGE(PG8_SB(0, 1), cB + hsB, voffB); PG8_STAGE(PG8_SA(0, 0), cA, voffA); PG8_STAGE(PG8_SA(0, 1), cA + hsA, voffA);
    if (wr == 1) PG8_BAR;
    PG8_WAIT_V(2); PG8_BAR;
    PG8_STAGE(PG8_SB(1, 0), cB + kstep, voffB); PG8_STAGE(PG8_SA(1, 0), cA + kstep, voffA); PG8_STAGE(PG8_SB(1, 1), cB + hsB + kstep, voffB);
    PG8_WAIT_V(6); PG8_BAR;
    for (;;) {
        const bool has_next = S.next(ui + 1, nxt);
        const char* nA = has_next ? PG8_UA(nxt) : cA; const char* nB = has_next ? PG8_UB(nxt) : cB;
        for (int t = 0; t < nt; t += 2) {
            const bool last = (t == nt - 2);
            const char* a1 = cA + (size_t)(t + 1) * kstep;
            const char* a2 = last ? nA : cA + (size_t)(t + 2) * kstep; const char* b2 = last ? nB : cB + (size_t)(t + 2) * kstep;
            const char* a3 = a2 + kstep; const char* b3 = b2 + kstep;
            PG8_LDB(B0, 0, 0); PG8_LDB(B1, 0, 1); PG8_SCHED; PG8_LDA(At, 0, 0); PG8_STAGE(PG8_SA(1, 1), a1 + hsA, voffA);
            PG8_WAIT_V(8); PG8_WAIT_L(0); PG8_BAR; PG8_MMA(0, 0, At, B0); PG8_MMA(0, 1, At, B1); PG8_BAR; PG8_SCHED;
            PG8_LDA(At, 0, 1); PG8_STAGE(PG8_SB(0, 0), b2, voffB); PG8_STAGE(PG8_SB(0, 1), b2 + hsB, voffB); PG8_STAGE(PG8_SA(0, 0), a2, voffA);
            PG8_WAIT_V(8); PG8_WAIT_L(0); PG8_BAR; PG8_MMA(1, 0, At, B0); PG8_MMA(1, 1, At, B1); PG8_BAR; PG8_SCHED;
            PG8_LDB(B0, 1, 0); PG8_LDB(B1, 1, 1); PG8_SCHED; PG8_LDA(At, 1, 0); PG8_STAGE(PG8_SA(0, 1), a2 + hsA, voffA);
            PG8_WAIT_V(8); PG8_WAIT_L(0); PG8_BAR; PG8_MMA(0, 0, At, B0); PG8_MMA(0, 1, At, B1); PG8_BAR; PG8_SCHED;
            PG8_LDA(At, 1, 1); PG8_STAGE(PG8_SB(1, 0), b3, voffB); PG8_STAGE(PG8_SB(1, 1), b3 + hsB, voffB); PG8_STAGE(PG8_SA(1, 0), a3, voffA);
            PG8_WAIT_V(8); PG8_WAIT_L(0); PG8_BAR; PG8_MMA(1, 0, At, B0); PG8_MMA(1, 1, At, B1); PG8_BAR; PG8_SCHED;
        }
        if (wr == 0) PG8_BAR;
        E(acc, cur, wr, wc, fr, fq, lds);
        if (!has_next) break;
#pragma unroll
        for (int a = 0; a < 2; ++a)
#pragma unroll
            for (int b = 0; b < 2; ++b)
#pragma unroll
                for (int m = 0; m < 4; ++m)
#pragma unroll
                    for (int n = 0; n < 2; ++n) acc[a][b][m][n] = (f32x4){0.f, 0.f, 0.f, 0.f};
        cur = nxt; cA = nA; cB = nB; ++ui;
        if (wr == 1) PG8_BAR;
    }
    PG8_WAIT_V(0);
    PG8_BAR;
#undef PG8_SA
#undef PG8_SB
#undef PG8_STAGE
#undef PG8_LDA
#undef PG8_LDB
#undef PG8_MMA
#undef PG8_UA
#undef PG8_UB
}

typedef f32x4 Acc[2][2][4][2];
#define EPI_ARGS Acc& acc, const Unit& u, int wr, int wc, int fr, int fq, LAS unsigned char* lds
__device__ __forceinline__ int efence() { asm volatile("" ::: "memory"); return 1; }
#define ROWLOOP _Pragma("unroll") for (int ai = 0; ai < 2; ++ai) _Pragma("unroll") for (int m = 0; m < 4; ++m) for (int once_ = efence(); once_; once_ = 0)

struct EpiIn0 {
    const float* ss; bf16_t* U; bf16_t* V; bf16_t* H; float* vst;
    __device__ __forceinline__ void operator()(EPI_ARGS) const {
        const int row0 = u.pm * 256 + wr * 64 + fr;
        if (u.pn < 4) {
            bf16_t* dst = (u.pn < 2) ? U : V; const int col0 = (u.pn & 1) * 256 + wc * 32 + 8 * fq; const bool st = u.pn >= 2;
            ROWLOOP { const int row = row0 + ai * 128 + m * 16; const float rs = rsqrtf(ss[row] * (1.0f / D) + EPS); float s = 0.f, q = 0.f;
#pragma unroll
                for (int bj = 0; bj < 2; ++bj) { f32x4 v0 = acc[ai][bj][m][0] * rs, v1 = acc[ai][bj][m][1] * rs;
#pragma unroll
                    for (int e = 0; e < 4; ++e) { v0[e] = gelu_f(v0[e]); v1[e] = gelu_f(v1[e]); s += v0[e] + v1[e]; q += v0[e] * v0[e] + v1[e] * v1[e]; }
                    *(u32x4*)(dst + (size_t)row * 512 + col0 + bj * 128) = pack8(v0, v1); }
                if (st) { s += __shfl_xor(s, 16); s += __shfl_xor(s, 32); q += __shfl_xor(q, 16); q += __shfl_xor(q, 32);
                    if (fq == 0) { unsafeAtomicAdd(vst + 2 * row, s); unsafeAtomicAdd(vst + 2 * row + 1, q); } }
            }
        } else {
            const int col0 = (u.pn - 4) * 128 + wc * 32 + 8 * fq;
            ROWLOOP { const int row = row0 + ai * 128 + m * 16; const float rs = rsqrtf(ss[row] * (1.0f / D) + EPS); f32x4 h0, h1;
#pragma unroll
                for (int e = 0; e < 4; ++e) { h0[e] = acc[ai][0][m][0][e] * rs * sigmoid_f(acc[ai][1][m][0][e] * rs); h1[e] = acc[ai][0][m][1][e] * rs * sigmoid_f(acc[ai][1][m][1][e] * rs); }
                *(u32x4*)(H + (size_t)row * 512 + col0) = pack8(h0, h1); }
        }
    }
};
template <bool GLU> struct EpiRes {
    const float* base; float* out; bf16_t* xb; float* ss;
    __device__ __forceinline__ void operator()(EPI_ARGS) const {
        const int row0 = u.pm * 256 + wr * 64 + fr;
        ROWLOOP { const int row = row0 + ai * 128 + m * 16; float q = 0.f;
            if (GLU) { const size_t off = (size_t)row * D + u.pn * 128 + wc * 32 + 8 * fq;
                f32x4 o0 = *(const f32x4*)(base + off), o1 = *(const f32x4*)(base + off + 4);
#pragma unroll
                for (int e = 0; e < 4; ++e) { o0[e] += acc[ai][0][m][0][e] * sigmoid_f(acc[ai][1][m][0][e]); o1[e] += acc[ai][0][m][1][e] * sigmoid_f(acc[ai][1][m][1][e]);
                    q += o0[e] * o0[e] + o1[e] * o1[e]; }
                *(f32x4*)(out + off) = o0; *(f32x4*)(out + off + 4) = o1; *(u32x4*)(xb + off) = pack8(o0, o1);
            } else {
#pragma unroll
                for (int bj = 0; bj < 2; ++bj) { const size_t off = (size_t)row * D + u.pn * 256 + bj * 128 + wc * 32 + 8 * fq;
                    f32x4 o0 = *(const f32x4*)(base + off) + acc[ai][bj][m][0], o1 = *(const f32x4*)(base + off + 4) + acc[ai][bj][m][1];
#pragma unroll
                    for (int e = 0; e < 4; ++e) q += o0[e] * o0[e] + o1[e] * o1[e];
                    *(f32x4*)(out + off) = o0; *(f32x4*)(out + off + 4) = o1; *(u32x4*)(xb + off) = pack8(o0, o1); }
            }
            q += __shfl_xor(q, 16); q += __shfl_xor(q, 32);
            if (fq == 0) unsafeAtomicAdd(ss + row, q);
            if (m & 1) asm volatile("" ::: "memory");
        }
    }
};
struct EpiStore {
    bf16_t* O; int ldc, nz0; long sz0, sz1; const float* ss; float scale;
    __device__ __forceinline__ void operator()(EPI_ARGS) const {
        bf16_t* base = O + (size_t)(u.z % nz0) * sz0 + (size_t)(u.z / nz0) * sz1; const int row0 = u.pm * 256 + wr * 64 + fr, col0 = u.pn * 256 + wc * 32 + 8 * fq;
        ROWLOOP { const int row = row0 + ai * 128 + m * 16; const float rs = ss ? rsqrtf(ss[row] * (1.0f / D) + EPS) * scale : scale;
#pragma unroll
            for (int bj = 0; bj < 2; ++bj) *(u32x4*)(base + (size_t)row * ldc + col0 + bj * 128) = pack8(acc[ai][bj][m][0] * rs, acc[ai][bj][m][1] * rs); }
    }
};
struct EpiSoftmax {
    bf16_t* P;
    __device__ __forceinline__ void operator()(EPI_ARGS) const {
        LAS float* X = (LAS float*)(lds + XCH_OFF); LAS float* Y = X + 1024;
        ROWLOOP { const int r = ai * 128 + wr * 64 + m * 16 + fr; float mx = -3.0e38f;
#pragma unroll
            for (int bj = 0; bj < 2; ++bj)
#pragma unroll
                for (int n = 0; n < 2; ++n)
#pragma unroll
                    for (int e = 0; e < 4; ++e) mx = fmaxf(mx, acc[ai][bj][m][n][e]);
            mx = fmaxf(mx, __shfl_xor(mx, 16)); mx = fmaxf(mx, __shfl_xor(mx, 32));
            if (fq == 0) X[r * 4 + wc] = mx; }
        asm volatile("s_waitcnt lgkmcnt(0)" ::: "memory"); __builtin_amdgcn_s_barrier(); asm volatile("" ::: "memory");
        ROWLOOP { const int r = ai * 128 + wr * 64 + m * 16 + fr; const f32x4 xm = *(const LAS f32x4*)(X + r * 4); const float mx = fmaxf(fmaxf(xm[0], xm[1]), fmaxf(xm[2], xm[3])); float s = 0.f;
#pragma unroll
            for (int bj = 0; bj < 2; ++bj)
#pragma unroll
                for (int n = 0; n < 2; ++n)
#pragma unroll
                    for (int e = 0; e < 4; ++e) { const float p = __expf(acc[ai][bj][m][n][e] - mx); acc[ai][bj][m][n][e] = p; s += p; }
            s += __shfl_xor(s, 16); s += __shfl_xor(s, 32);
            if (fq == 0) Y[r * 4 + wc] = s; }
        asm volatile("s_waitcnt lgkmcnt(0)" ::: "memory"); __builtin_amdgcn_s_barrier(); asm volatile("" ::: "memory");
        bf16_t* base = P + (size_t)u.z * SEQ * 256;
        ROWLOOP { const int r = ai * 128 + wr * 64 + m * 16 + fr; const f32x4 ys = *(const LAS f32x4*)(Y + r * 4); const float inv = 1.0f / ((ys[0] + ys[1]) + (ys[2] + ys[3]));
#pragma unroll
            for (int bj = 0; bj < 2; ++bj) *(u32x4*)(base + (size_t)(u.pm * 256 + r) * 256 + bj * 128 + wc * 32 + 8 * fq) = pack8(acc[ai][bj][m][0] * inv, acc[ai][bj][m][1] * inv); }
    }
};
struct EpiFfn1 {
    const float* ss; bf16_t* HM;
    __device__ __forceinline__ void operator()(EPI_ARGS) const {
        const int row0 = u.pm * 256 + wr * 64 + fr, col0 = u.pn * 128 + wc * 32 + 8 * fq;
        ROWLOOP { const int row = row0 + ai * 128 + m * 16; const float rs = rsqrtf(ss[row] * (1.0f / D) + EPS); f32x4 h0, h1;
#pragma unroll
            for (int e = 0; e < 4; ++e) { h0[e] = silu_f(acc[ai][0][m][0][e] * rs) * (acc[ai][1][m][0][e] * rs); h1[e] = silu_f(acc[ai][0][m][1][e] * rs) * (acc[ai][1][m][1][e] * rs); }
            *(u32x4*)(HM + (size_t)row * FH + col0) = pack8(h0, h1); }
    }
};
struct EpiOin {
    const float* ss; bf16_t* AC;
    __device__ __forceinline__ void operator()(EPI_ARGS) const {
        const int row0 = u.pm * 256 + wr * 64 + fr;
        ROWLOOP { const int row = row0 + ai * 128 + m * 16; const float rs = rsqrtf(ss[row] * (1.0f / D) + EPS);
#pragma unroll
            for (int bj = 0; bj < 2; ++bj) { const int col = u.pn * 256 + bj * 128 + wc * 32 + 8 * fq;
                *(u32x4*)(AC + (size_t)(col >> 4) * NCH * AK + (size_t)(row / SL) * AK + (row % SL) * 16 + (col & 8)) = pack8(acc[ai][bj][m][0] * rs, acc[ai][bj][m][1] * rs); } }
    }
};
struct EpiS5State {
    float* XL;
    __device__ __forceinline__ void operator()(EPI_ARGS) const {
        const int row0 = u.pm * 256 + wr * 64 + fr, col0 = wc * 32 + 8 * fq;
        ROWLOOP { const int row = row0 + ai * 128 + m * 16; float* p = XL + (size_t)u.z * NCH * 128 + (size_t)row * 128 + col0;
            *(f32x4*)p = acc[ai][0][m][0]; *(f32x4*)(p + 4) = acc[ai][0][m][1]; }
    }
};
struct EpiS5Out {
    const bf16_t* AC; const float* dsk; bf16_t* Y;
    __device__ __forceinline__ void operator()(EPI_ARGS) const {
        const int g = u.z, row0 = u.pm * 256 + wr * 64 + fr;
        ROWLOOP { const int row = row0 + ai * 128 + m * 16;
#pragma unroll
            for (int bj = 0; bj < 2; ++bj) { const int col = u.pn * 256 + bj * 128 + wc * 32 + 8 * fq, k = col >> 4, ch = g * 16 + (col & 8);
                const u32x4 uu = *(const u32x4*)(AC + (size_t)g * NCH * AK + (size_t)row * AK + col);
                const f32x4 d0 = *(const f32x4*)(dsk + ch), d1 = *(const f32x4*)(dsk + ch + 4);
                f32x4 y0 = acc[ai][bj][m][0], y1 = acc[ai][bj][m][1];
                y0[0] += d0[0] * bflo(uu.x); y0[1] += d0[1] * bfhi(uu.x); y0[2] += d0[2] * bflo(uu.y); y0[3] += d0[3] * bfhi(uu.y);
                y1[0] += d1[0] * bflo(uu.z); y1[1] += d1[1] * bfhi(uu.z); y1[2] += d1[2] * bflo(uu.w); y1[3] += d1[3] * bfhi(uu.w);
#pragma unroll
                for (int e = 0; e < 4; ++e) { y0[e] = gelu_f(y0[e]); y1[e] = gelu_f(y1[e]); }
                *(u32x4*)(Y + (size_t)(row * SL + k) * 512 + ch) = pack8(y0, y1); } }
    }
};
}

#define XB_TMO      128
#define XB_XCNT(j)  (256  + 64 * (j))
#define XB_XSUB(j)  (1280 + 64 * (j))
#define XB_XGEN(j)  (2304 + 64 * (j))
#define XB_TOP      3328
#define XB_TOPGEN   3392
#define XCD_BAR_WORDS 3456
#define XB_SPIN_CAP (1u << 22)
__device__ __forceinline__ unsigned xb_ld(unsigned* p)              { return __hip_atomic_load(p, __ATOMIC_RELAXED, __HIP_MEMORY_SCOPE_AGENT); }
__device__ __forceinline__ unsigned xb_add(unsigned* p, unsigned v) { return __hip_atomic_fetch_add(p, v, __ATOMIC_RELAXED, __HIP_MEMORY_SCOPE_AGENT); }
__device__ __forceinline__ unsigned xb_xcc_id() { return (unsigned)__builtin_amdgcn_s_getreg((3 << 11) | 20) & 0xFu; }
#define XB_SPIN(cond, bar) do { unsigned _sp = 0; while (cond) { __builtin_amdgcn_s_sleep(1); \
    if ((++_sp & 255u) == 0u) { if (xb_ld(&(bar)[XB_TMO])) break; if (_sp > XB_SPIN_CAP) { atomicAdd(&(bar)[XB_TMO], 1u); break; } } } } while (0)
struct XcdBarrier { unsigned* bar; unsigned x; volatile LAS unsigned* st; };
__device__ __forceinline__ XcdBarrier xcd_barrier_post(unsigned* bar, volatile LAS unsigned* st) {
    XcdBarrier b; b.bar = bar; b.x = xb_xcc_id(); b.st = st;
    if (threadIdx.x == 0) (void)xb_add(&bar[XB_XCNT(b.x)], 1u);
    return b;
}
__device__ __forceinline__ void xcd_barrier_complete(unsigned* bar, unsigned x, unsigned& nloc, unsigned& nx) {
    const unsigned G = gridDim.x * gridDim.y * gridDim.z;
    unsigned sum, cnt, mine, sp = 0u;
    for (;;) {
        sum = 0u; cnt = 0u; mine = 0u;
#pragma unroll
        for (unsigned j = 0; j < 16; ++j) { const unsigned c = xb_ld(&bar[XB_XCNT(j)]); sum += c; cnt += (c > 0u) ? 1u : 0u; mine = (j == x) ? c : mine; }
        if (sum == G) break;
        __builtin_amdgcn_s_sleep(1);
        if ((++sp & 255u) == 0u) { if (xb_ld(&bar[XB_TMO])) break; if (sp > XB_SPIN_CAP) { atomicAdd(&bar[XB_TMO], 1u); break; } }
    }
    nloc = mine > 0u ? mine : 1u; nx = cnt > 0u ? cnt : 1u;
}
__device__ __forceinline__ void xcd_barrier(const XcdBarrier& b) {
    asm volatile("s_waitcnt vmcnt(0)" ::: "memory");
    __syncthreads();
    if (threadIdx.x == 0) {
        unsigned* bar = b.bar;
        __builtin_amdgcn_s_waitcnt(0);
        unsigned nloc = b.st[0], nx = b.st[1];
        if (nloc == 0u) { xcd_barrier_complete(bar, b.x, nloc, nx); b.st[0] = nloc; b.st[1] = nx; }
        const unsigned old = xb_add(&bar[XB_XSUB(b.x)], 1u);
        const unsigned gen = old / nloc;
        if (old + 1u == (gen + 1u) * nloc) {
            __builtin_amdgcn_fence(__ATOMIC_RELEASE, "agent");
            asm volatile("s_waitcnt vmcnt(0)" ::: "memory");
            const unsigned og = xb_add(&bar[XB_TOP], 1u);
            const unsigned tg = og / nx;
            if (og + 1u == (tg + 1u) * nx) xb_add(&bar[XB_TOPGEN], 1u);
            else XB_SPIN(xb_ld(&bar[XB_TOPGEN]) == tg, bar);
            __builtin_amdgcn_fence(__ATOMIC_ACQUIRE, "agent");
            xb_add(&bar[XB_XGEN(b.x)], 1u);
            asm volatile("s_waitcnt vmcnt(0)" ::: "memory");
        } else {
            XB_SPIN(xb_ld(&bar[XB_XGEN(b.x)]) == gen, bar);
            __builtin_amdgcn_fence(__ATOMIC_ACQUIRE, "agent");
            asm volatile("s_waitcnt vmcnt(0)" ::: "memory");
        }
    }
    __syncthreads();
}

__device__ __forceinline__ void conv_item(const float* W, int K, int ldn, int cs, int nblk, bf16_t* WT, int mode, int roff, const float* gain, LAS float* scr, int item, int lane) {
    const int kb = item / nblk, nb = item % nblk, k0 = 64 * kb, c0 = 32 * nb;
#pragma unroll 8
    for (int i = 0; i < 32; ++i) { const int kk = 2 * i + (lane >> 5); const float gk = gain ? gain[k0 + kk] : 1.0f; scr[kk * 33 + (lane & 31)] = W[(size_t)(k0 + kk) * ldn + cs + c0 + (lane & 31)] * gk; }
    asm volatile("s_waitcnt lgkmcnt(0)" ::: "memory");
    const int c = lane & 7; const int drow = roff + (mode == 0 ? c0 : ((c0 >> 7) * 256 + (mode - 1) * 128 + (c0 & 127)));
#pragma unroll
    for (int j = 0; j < 4; ++j) { const int n = (lane >> 3) + 8 * j; const LAS float* s = scr + (8 * c) * 33 + n;
        u32x4 o; o.x = cvt_pk_bf16(s[0 * 33], s[1 * 33]); o.y = cvt_pk_bf16(s[2 * 33], s[3 * 33]); o.z = cvt_pk_bf16(s[4 * 33], s[5 * 33]); o.w = cvt_pk_bf16(s[6 * 33], s[7 * 33]);
        *(u32x4*)(WT + (size_t)(drow + n) * K + k0 + 8 * c) = o; }
    asm volatile("s_waitcnt lgkmcnt(0)" ::: "memory");
}
template <bool NORM> __device__ __forceinline__ float row_to_bf16(const float* xrow, bf16_t* orow, int lane) {
    const f32x4* xr = (const f32x4*)xrow + lane; f32x4 v[4]; float s = 0.f;
#pragma unroll
    for (int j = 0; j < 4; ++j) { v[j] = xr[64 * j]; s += (v[j][0] * v[j][0] + v[j][1] * v[j][1]) + (v[j][2] * v[j][2] + v[j][3] * v[j][3]); }
    s = wave_sum(s); const float rs = NORM ? rsqrtf(s * (1.0f / D) + EPS) : 1.0f;
    u32x2* o = (u32x2*)orow + lane;
#pragma unroll
    for (int j = 0; j < 4; ++j) { u32x2 w; w.x = cvt_pk_bf16(v[j][0] * rs, v[j][1] * rs); w.y = cvt_pk_bf16(v[j][2] * rs, v[j][3] * rs); o[64 * j] = w; }
    return s;
}
__device__ __forceinline__ void cis_f(float ang, float& c, float& s) {
    float rev = ang * 0.15915494309189535f; rev = rev - rintf(rev);
    const float x = rev * 6.283185307179586f;
    const float h = x * 0.25f, h2 = h * h;
    float sh = h * (1.0f + h2 * (-1.6666667e-1f + h2 * (8.3333333e-3f + h2 * (-1.9841270e-4f + h2 * 2.7557319e-6f))));
    float ch = 1.0f + h2 * (-0.5f + h2 * (4.1666667e-2f + h2 * (-1.3888889e-3f + h2 * (2.4801587e-5f + h2 * -2.7557319e-7f))));
    float s2 = 2.f * sh * ch, c2 = 1.f - 2.f * sh * sh;
    s = 2.f * s2 * c2; c = 1.f - 2.f * s2 * s2;
}
__device__ __forceinline__ void s5_setup(int g, LAS unsigned char* lds, const float* lam_re, const float* lam_im, const float* log_dt, const float* b_re, const float* b_im, const float* c_re, const float* c_im,
                                         bf16_t* BT3, bf16_t* GM, float* AL, int tid) {
    LAS float* pwr = (LAS float*)lds; LAS float* pwi = pwr + 33 * 64; LAS float* Bbr = pwi + 33 * 64; LAS float* Bbi = Bbr + 1024; LAS float* Cr = Bbi + 1024; LAS float* Ci = Cr + 1024; LAS float* Kd = Ci + 1024;
    const float dt = __expf(log_dt[g]);
    for (int idx = tid; idx < 33 * 64; idx += 512) { const int d = idx >> 6, p = idx & 63; const float lr = lam_re[g * 64 + p], li = lam_im[g * 64 + p];
        const float mag = __expf(lr * dt * (float)d); float c, s; cis_f(li * dt * (float)d, c, s); pwr[idx] = mag * c; pwi[idx] = mag * s; }
    for (int idx = tid; idx < 1024; idx += 512) { const int p = idx >> 4; const float lr = lam_re[g * 64 + p], li = lam_im[g * 64 + p];
        const float mag = __expf(lr * dt); float c, s; cis_f(li * dt, c, s); const float ar = mag * c, ai = mag * s, den = lr * lr + li * li;
        const float qr = ((ar - 1.0f) * lr + ai * li) / den, qi = (ai * lr - (ar - 1.0f) * li) / den;
        const float br = b_re[g * 1024 + idx], bi = b_im[g * 1024 + idx];
        Bbr[idx] = qr * br - qi * bi; Bbi[idx] = qr * bi + qi * br;
        Cr[idx] = c_re[g * 1024 + idx]; Ci[idx] = c_im[g * 1024 + idx]; }
    __syncthreads();
    for (int idx = tid; idx < 32 * 256; idx += 512) { const int d = idx >> 8, co = (idx >> 4) & 15, ci = idx & 15; float a = 0.f;
        for (int p = 0; p < 64; ++p) { const float cr = Cr[co * 64 + p], cim = Ci[co * 64 + p], pr = pwr[d * 64 + p], pi = pwi[d * 64 + p];
            const float tr = cr * pr - cim * pi, ti = cr * pi + cim * pr; a += tr * Bbr[p * 16 + ci] - ti * Bbi[p * 16 + ci]; }
        Kd[idx] = a; }
    __syncthreads();
    bf16_t* bt = BT3 + (size_t)g * 512 * AK;
    for (int idx = tid; idx < 512 * (AK / 8); idx += 512) { const int n = idx / (AK / 8), q = idx % (AK / 8), kk0 = q * 8, k = n >> 4, co = n & 15; float v[8];
        if (kk0 < 512) { const int j = kk0 >> 4, ci0 = kk0 & 15;
#pragma unroll
            for (int e = 0; e < 8; ++e) v[e] = (j <= k) ? Kd[(k - j) * 256 + co * 16 + ci0 + e] : 0.f;
        } else { const int p0 = kk0 - 512;
#pragma unroll
            for (int e = 0; e < 8; ++e) { const int p = (p0 & 63) + e; const float cr = Cr[co * 64 + p], cim = Ci[co * 64 + p], pr = pwr[(k + 1) * 64 + p], pi = pwi[(k + 1) * 64 + p];
                v[e] = (p0 < 64) ? (cr * pr - cim * pi) : -(cr * pi + cim * pr); } }
        u32x4 w; w.x = cvt_pk_bf16(v[0], v[1]); w.y = cvt_pk_bf16(v[2], v[3]); w.z = cvt_pk_bf16(v[4], v[5]); w.w = cvt_pk_bf16(v[6], v[7]);
        *(u32x4*)(bt + (size_t)n * AK + kk0) = w; }
    bf16_t* gm = GM + (size_t)g * 256 * 512;
    for (int idx = tid; idx < 256 * 64; idx += 512) { const int n = idx >> 6, q = idx & 63, kk0 = q * 8; float v[8];
        if (n < 128) { const int p = n & 63, j = kk0 >> 4, ci0 = kk0 & 15; const float pr = pwr[(SL - 1 - j) * 64 + p], pi = pwi[(SL - 1 - j) * 64 + p];
#pragma unroll
            for (int e = 0; e < 8; ++e) { const float br = Bbr[p * 16 + ci0 + e], bi = Bbi[p * 16 + ci0 + e]; v[e] = (n < 64) ? (pr * br - pi * bi) : (pr * bi + pi * br); }
        } else {
#pragma unroll
            for (int e = 0; e < 8; ++e) v[e] = 0.f; }
        u32x4 w; w.x = cvt_pk_bf16(v[0], v[1]); w.y = cvt_pk_bf16(v[2], v[3]); w.z = cvt_pk_bf16(v[4], v[5]); w.w = cvt_pk_bf16(v[6], v[7]);
        *(u32x4*)(gm + (size_t)n * 512 + kk0) = w; }
    if (tid < 64) { AL[(g * 64 + tid) * 2] = pwr[SL * 64 + tid]; AL[(g * 64 + tid) * 2 + 1] = pwi[SL * 64 + tid]; }
    __syncthreads();
}

__device__ __forceinline__ void gmlp_unit(int unit, LAS unsigned char* lds, const bf16_t* U, const bf16_t* V, const float* vst, const bf16_t* GW, const float* gb, bf16_t* MIX, int tid) {
    const int g = unit & 3, t0 = (unit >> 2) * 128, lane = tid & 63, wid = tid >> 6;
    LAS bf16_t* vT = (LAS bf16_t*)lds;
#pragma unroll
    for (int e = 0; e < 4; ++e) { const int q = tid + 512 * e, j = q >> 4, c8 = (q & 15) * 8;
        const u32x4 raw = *(const u32x4*)(V + (size_t)(t0 + j) * 512 + g * 128 + c8);
        const float s = vst[2 * (t0 + j)], ss = vst[2 * (t0 + j) + 1], mean = s * (1.0f / 512.0f), var = ss * (1.0f / 512.0f) - mean * mean, rstd = rsqrtf(fmaxf(var, 0.f) + EPS);
        float v[8] = {bflo(raw.x), bfhi(raw.x), bflo(raw.y), bfhi(raw.y), bflo(raw.z), bfhi(raw.z), bflo(raw.w), bfhi(raw.w)};
#pragma unroll
        for (int i = 0; i < 8; i += 2) { const unsigned pk = cvt_pk_bf16((v[i] - mean) * rstd, (v[i + 1] - mean) * rstd); vT[(c8 + i) * 136 + j] = (bf16_t)(pk & 0xffffu); vT[(c8 + i + 1) * 136 + j] = (bf16_t)(pk >> 16); } }
    __syncthreads();
    const int il = lane & 15, kq = lane >> 4, i = wid * 16 + il;
    bf16x8 wf[4];
#pragma unroll
    for (int ks = 0; ks < 4; ++ks) wf[ks] = *(const bf16x8*)(GW + (size_t)g * 16384 + (size_t)i * 128 + ks * 32 + kq * 8);
    const float bias = gb[g * 128 + i];
#pragma unroll 2
    for (int nt = 0; nt < 8; ++nt) { f32x4 a = {0.f, 0.f, 0.f, 0.f};
#pragma unroll
        for (int ks = 0; ks < 4; ++ks) { const bf16x8 vf = *(const LAS bf16x8*)(vT + (nt * 16 + il) * 136 + ks * 32 + kq * 8); a = __builtin_amdgcn_mfma_f32_16x16x32_bf16(vf, wf[ks], a, 0, 0, 0); }
        const size_t tok = (size_t)(t0 + i); const int c = g * 128 + nt * 16 + kq * 4;
        const u32x2 uu = *(const u32x2*)(U + tok * 512 + c);
        u32x2 o; o.x = cvt_pk_bf16(bflo(uu.x) * (a[0] + bias), bfhi(uu.x) * (a[1] + bias)); o.y = cvt_pk_bf16(bflo(uu.y) * (a[2] + bias), bfhi(uu.y) * (a[3] + bias));
        *(u32x2*)(MIX + tok * 1024 + c) = o; }
    __syncthreads();
}
__device__ __forceinline__ void conv_unit(int unit, LAS unsigned char* lds, const bf16_t* H, const float* cw, const float* cb, const float* lng, const float* lnb, bf16_t* MIX, int tid) {
    const int t0 = unit * 32, s0 = t0 % SEQ, lane = tid & 63, wid = tid >> 6;
    LAS bf16_t* hin = (LAS bf16_t*)lds;
    LAS float* cout = (LAS float*)(lds + 62 * 1024);
    for (int q = tid; q < 62 * 64; q += 512) { const int r = q >> 6, c8 = (q & 63) * 8; u32x4 v = {0u, 0u, 0u, 0u};
        if (s0 - 30 + r >= 0) v = *(const u32x4*)(H + (size_t)(t0 - 30 + r) * 512 + c8);
        *(LAS u32x4*)(hin + r * 512 + c8) = v; }
    float w[31];
#pragma unroll
    for (int k = 0; k < 31; ++k) w[k] = cw[k * 512 + tid];
    const float bias = cb[tid];
    __syncthreads();
#pragma unroll 1
    for (int tg = 0; tg < 4; ++tg) { float x[38];
#pragma unroll
        for (int r = 0; r < 38; ++r) x[r] = bf2f(hin[(tg * 8 + r) * 512 + tid]);
#pragma unroll
        for (int o = 0; o < 8; ++o) { float a = bias;
#pragma unroll
            for (int k = 0; k < 31; ++k) a += w[k] * x[o + k];
            cout[(tg * 8 + o) * 516 + tid] = a; } }
    __syncthreads();
#pragma unroll 1
    for (int tt = 0; tt < 4; ++tt) { const int row = wid * 4 + tt; const f32x4 v0 = *(const LAS f32x4*)(cout + row * 516 + lane * 8), v1 = *(const LAS f32x4*)(cout + row * 516 + lane * 8 + 4);
        const float mean = wave_sum((v0[0] + v0[1]) + (v0[2] + v0[3]) + (v1[0] + v1[1]) + (v1[2] + v1[3])) * (1.0f / 512.0f);
        const f32x4 d0 = v0 - mean, d1 = v1 - mean;
        const float var = wave_sum((d0[0] * d0[0] + d0[1] * d0[1]) + (d0[2] * d0[2] + d0[3] * d0[3]) + (d1[0] * d1[0] + d1[1] * d1[1]) + (d1[2] * d1[2] + d1[3] * d1[3])) * (1.0f / 512.0f);
        const float rstd = rsqrtf(var + EPS);
        const f32x4 g0 = *(const f32x4*)(lng + lane * 8), g1 = *(const f32x4*)(lng + lane * 8 + 4), b0 = *(const f32x4*)(lnb + lane * 8), b1 = *(const f32x4*)(lnb + lane * 8 + 4);
        f32x4 y0 = d0 * rstd * g0 + b0, y1 = d1 * rstd * g1 + b1;
#pragma unroll
        for (int e = 0; e < 4; ++e) { y0[e] = silu_f(y0[e]); y1[e] = silu_f(y1[e]); }
        *(u32x4*)(MIX + (size_t)(t0 + row) * 1024 + 512 + lane * 8) = pack8(y0, y1); }
    __syncthreads();
}

struct Args { const float* in[33]; float* out; unsigned char* ws; int ph_lo, ph_hi; };
constexpr int NPHASE = 27;

typedef const __attribute__((address_space(4))) Args* KArgP;
__device__ __forceinline__ KArgP fresh_args() { KArgP p = (KArgP)__builtin_amdgcn_kernarg_segment_ptr(); asm volatile("" : "+s"(p)); return p; }

__global__ void __launch_bounds__(512, 2) trunk_fwd(Args args_unused) {
    extern __shared__ __attribute__((aligned(16))) unsigned char lds_raw[];
    LAS unsigned char* lds = (LAS unsigned char*)lds_raw;
    cg::grid_group grid = cg::this_grid();
    { volatile LAS unsigned* MISC0 = (volatile LAS unsigned*)(lds + MISC_OFF); if (threadIdx.x < 32) MISC0[threadIdx.x] = 0u; }
    __syncthreads();
    int lo, hi;
    { KArgP ap = fresh_args(); lo = ap->ph_lo; hi = ap->ph_hi; }
#if !MK_MULTI && !MK_CGSYNC
    { KArgP ap = fresh_args(); (void)xcd_barrier_post((unsigned*)(ap->ws + WS_BAR), (volatile LAS unsigned*)(lds + MISC_OFF) + 8); }
#endif
    int nsync = 0;
#if MK_MULTI
#define SEAM(k) do { } while (0)
#elif MK_CGSYNC
#define SEAM(k) do { if ((k) + 1 < hi) grid.sync(); } while (0)
#else
#define SEAM(k) do { if ((k) + 1 < hi) { if (nsync == 0) grid.sync(); else { KArgP ap_ = fresh_args(); XcdBarrier xb_; xb_.bar = (unsigned*)(ap_->ws + WS_BAR); xb_.x = xb_xcc_id(); xb_.st = (volatile LAS unsigned*)(lds + MISC_OFF) + 8; xcd_barrier(xb_); } ++nsync; } } while (0)
#endif
#ifndef ONLY
#define ONLY -1
#endif
#define PHASE(id, k) if ((ONLY < 0 || ONLY == (id)) && lo <= (k) && (k) < hi)
    (void)nsync;
#define LOCALS KArgP ap = fresh_args(); unsigned char* ws = ap->ws; float* out = ap->out; const float* x_in = ap->in[0]; \
    int tid_ = threadIdx.x, G_ = gridDim.x, bx_ = blockIdx.x; asm volatile("" : "+v"(tid_), "+s"(G_), "+s"(bx_)); \
    const int tid = tid_, lane = tid & 63, wave = __builtin_amdgcn_readfirstlane(tid >> 6), G = G_, bx = bx_, gw = bx * 8 + wave, NGW = G * 8; \
    bf16_t* XB = (bf16_t*)(ws + WS_XB); float* SS = (float*)(ws + WS_SS); float* VST = (float*)(ws + WS_VST); bf16_t* QO = (bf16_t*)(ws + WS_QO); bf16_t* Pb = (bf16_t*)(ws + WS_P); \
    bf16_t* HM = (bf16_t*)(ws + WS_HM); bf16_t* MEMN = (bf16_t*)(ws + WS_MEMN); bf16_t* KL = (bf16_t*)(ws + WS_KL); bf16_t* VT = (bf16_t*)(ws + WS_VT); \
    bf16_t* U = (bf16_t*)(ws + WS_U); bf16_t* V = (bf16_t*)(ws + WS_V); bf16_t* H = (bf16_t*)(ws + WS_H); bf16_t* MIX = (bf16_t*)(ws + WS_MIX); \
    bf16_t* AC = (bf16_t*)(ws + WS_ACOMB); float* XL = (float*)(ws + WS_XLOC); bf16_t* Y = (bf16_t*)(ws + WS_Y); float* SSa = SS + (size_t)(3 * l) * T; \
    (void)out; (void)x_in; (void)lane; (void)gw; (void)NGW; (void)XB; (void)VST; (void)QO; (void)Pb; (void)HM; (void)MEMN; (void)KL; (void)VT; (void)U; (void)V; (void)H; (void)MIX; (void)AC; (void)XL; (void)Y; (void)SSa; (void)wave;

    PHASE(0, 0) { const int l = 0; LOCALS
        { f32x4* z = (f32x4*)(SS + T); const int n4 = 7 * T / 4; for (int i = bx * 512 + tid; i < n4; i += G * 512) z[i] = (f32x4){0.f, 0.f, 0.f, 0.f};
          f32x4* z2 = (f32x4*)VST; const int m4 = 2 * T / 4; for (int i = bx * 512 + tid; i < m4; i += G * 512) z2[i] = (f32x4){0.f, 0.f, 0.f, 0.f}; }
        LAS float* scr = (LAS float*)(lds + wave * 16384);
#define CONVJOB(Wp, K_, ldn_, cs_, nc_, WTp, mode_, roff_, gain_) { const int nblk_ = (nc_) / 32, cnt_ = ((K_) / 64) * nblk_; \
            if (r >= 0 && r < cnt_) conv_item((Wp), (K_), (ldn_), (cs_), nblk_, (bf16_t*)(WTp), (mode_), (roff_), (gain_), scr, r, lane); r -= cnt_; }
        constexpr int NITEMS = 512 + 256 + 256 + 512 + 256 + 256 + 256 + 2 * (4 * 512 + 3 * 1408);
        for (int it = gw; it < NITEMS; it += NGW) {
            int r = it;
            CONVJOB(ap->in[3], 1024, 2048, 0, 1024, ws + WS_WIN0, 0, 0, ap->in[2]);
            CONVJOB(ap->in[3], 1024, 2048, 1024, 512, ws + WS_WIN0, 1, 1024, ap->in[2]);
            CONVJOB(ap->in[3], 1024, 2048, 1536, 512, ws + WS_WIN0, 2, 1024, ap->in[2]);
            CONVJOB(ap->in[10], 1024, 1024, 0, 1024, ws + WS_WOUT0, 0, 0, nullptr);
            CONVJOB(ap->in[12], 1024, 512, 0, 512, ws + WS_WOIN, 0, 0, ap->in[11]);
            CONVJOB(ap->in[21], 512, 2048, 0, 1024, ws + WS_WOOUT, 1, 0, nullptr);
            CONVJOB(ap->in[21], 512, 2048, 1024, 1024, ws + WS_WOOUT, 2, 0, nullptr);
#pragma unroll
            for (int l = 0; l < 2; ++l) {
                CONVJOB(ap->in[24] + (size_t)l * D * D, 1024, 1024, 0, 1024, ws + WS_WQ + l * WSQ_L, 0, 0, ap->in[22] + l * D);
                CONVJOB(ap->in[25] + (size_t)l * D * D, 1024, 1024, 0, 1024, ws + WS_WK + l * WSQ_L, 0, 0, ap->in[23] + l * D);
                CONVJOB(ap->in[26] + (size_t)l * D * D, 1024, 1024, 0, 1024, ws + WS_WV + l * WSQ_L, 0, 0, ap->in[23] + l * D);
                CONVJOB(ap->in[27] + (size_t)l * D * D, 1024, 1024, 0, 1024, ws + WS_WO + l * WSQ_L, 0, 0, nullptr);
                CONVJOB(ap->in[29] + (size_t)l * D * FH, 1024, FH, 0, FH, ws + WS_WGU + l * WGU_L, 1, 0, ap->in[28] + l * D);
                CONVJOB(ap->in[30] + (size_t)l * D * FH, 1024, FH, 0, FH, ws + WS_WGU + l * WGU_L, 2, 0, ap->in[28] + l * D);
                CONVJOB(ap->in[31] + (size_t)l * FH * D, FH, 1024, 0, 1024, ws + WS_WD + l * WD_L, 0, 0, nullptr);
            }
        }
        for (int m = gw; m < T; m += NGW) { const float s = row_to_bf16<false>(x_in + (size_t)m * D, XB + (size_t)m * D, lane); if (lane == 0) SS[m] = s; }
        for (int m = gw; m < MT; m += NGW) (void)row_to_bf16<true>(ap->in[1] + (size_t)m * D, MEMN + (size_t)m * D, lane);
        { bf16_t* GW = (bf16_t*)(ws + WS_GW); const float* w = ap->in[4];
          for (int i = bx * 512 + tid; i < 4 * 128 * 128 / 2; i += G * 512) { const int e = 2 * i, ii = (e >> 7) & 127, jj = e & 127; const bool keep = (jj >> 6) <= (ii >> 6);
              ((unsigned*)GW)[i] = keep ? cvt_pk_bf16(w[e], w[e + 1]) : 0u; } }
        __syncthreads();
        for (int g = G - 1 - bx; g < 32; g += G)
            s5_setup(g, lds, ap->in[13], ap->in[14], ap->in[15], ap->in[16], ap->in[17], ap->in[18], ap->in[19], (bf16_t*)(ws + WS_BT3), (bf16_t*)(ws + WS_GM), (float*)(ws + WS_AL), tid);
        SEAM(0);
    }
    PHASE(1, 1) { const int l = 0; LOCALS
        { pg8::Gemm g{MEMN, (const bf16_t*)(ws + WS_WK), D, D, D, 2, 0, 0, (long)D * D, 0}; pg8::Sched S; S.init(MT / 256, D / 256, 2, G, bx);
          pg8::EpiStore E{KL, D, 2, (long)MT * D, 0, nullptr, 1.0f}; pg8::gemm_phase(lds, g, S, E, tid); }
        { pg8::Gemm g{(const bf16_t*)(ws + WS_WV), MEMN, D, D, D, 2, (long)D * D, 0, 0, 0}; pg8::Sched S; S.init(D / 256, MT / 256, 2, G, (bx + G / 2) % G);
          pg8::EpiStore E{VT, MT, 2, (long)D * MT, 0, nullptr, 1.0f}; pg8::gemm_phase(lds, g, S, E, tid); }
        SEAM(1);
    }
#pragma unroll 1
    for (int l = 0; l < 2; ++l) {
        const int pb = 2 + 12 * l;
        if (l == 0) {
            PHASE(2, pb + 0) { LOCALS
                pg8::Gemm g{XB, (const bf16_t*)(ws + WS_WIN0), D, D, D, 1, 0, 0, 0, 0}; pg8::Sched S; S.init(T / 256, 2048 / 256, 1, G, bx);
                pg8::EpiIn0 E{SSa, U, V, H, VST}; pg8::gemm_phase(lds, g, S, E, tid);
                SEAM(pb + 0);
            }
            PHASE(3, pb + 1) { LOCALS
                for (int i = bx; i < 2048; i += G) {
                    if (i < 1024) gmlp_unit(i, lds, U, V, VST, (const bf16_t*)(ws + WS_GW), ap->in[5], MIX, tid);
                    else conv_unit(i - 1024, lds, H, ap->in[6], ap->in[7], ap->in[8], ap->in[9], MIX, tid);
                }
                SEAM(pb + 1);
            }
            PHASE(4, pb + 2) { LOCALS
                pg8::Gemm g{MIX, (const bf16_t*)(ws + WS_WOUT0), D, D, D, 1, 0, 0, 0, 0}; pg8::Sched S; S.init(T / 256, D / 256, 1, G, bx);
                pg8::EpiRes<false> E{x_in, out, XB, SSa + T}; pg8::gemm_phase(lds, g, S, E, tid);
                SEAM(pb + 2);
            }
        } else {
            PHASE(5, pb + 0) { LOCALS
                pg8::Gemm g{XB, (const bf16_t*)(ws + WS_WOIN), D, D, D, 1, 0, 0, 0, 0}; pg8::Sched S; S.init(T / 256, 512 / 256, 1, G, bx);
                pg8::EpiOin E{SSa, AC}; pg8::gemm_phase(lds, g, S, E, tid);
                SEAM(pb + 0);
            }
            PHASE(6, pb + 1) { LOCALS
                pg8::Gemm g{AC, (const bf16_t*)(ws + WS_GM), AK, 512, 512, 32, (long)NCH * AK, 0, 256L * 512, 0}; pg8::Sched S; S.init(NCH / 256, 1, 32, G, bx);
                pg8::EpiS5State E{XL}; pg8::gemm_phase(lds, g, S, E, tid);
                SEAM(pb + 1);
            }
            PHASE(7, pb + 2) { LOCALS
                if (wave == 0) {
                    const int idx = bx * 64 + lane;
                    if (idx < NB * 32 * 64) { const int p = idx & 63, g = (idx >> 6) & 31, b = idx >> 11;
                        const float* AL = (const float*)(ws + WS_AL); const float ar = AL[(g * 64 + p) * 2], ai = AL[(g * 64 + p) * 2 + 1];
                        const float* xl = XL + (size_t)g * NCH * 128 + (size_t)(b * (SEQ / SL)) * 128; bf16_t* ac = AC + (size_t)g * NCH * AK + (size_t)(b * (SEQ / SL)) * AK + 512;
                        float xr = 0.f, xi = 0.f;
#pragma unroll 1
                        for (int c0 = 0; c0 < SEQ / SL; c0 += 16) { float lr[16], li[16];
#pragma unroll
                            for (int i = 0; i < 16; ++i) { lr[i] = xl[(size_t)(c0 + i) * 128 + p]; li[i] = xl[(size_t)(c0 + i) * 128 + 64 + p]; }
#pragma unroll
                            for (int i = 0; i < 16; ++i) { const unsigned pk = cvt_pk_bf16(xr, xi); ac[(size_t)(c0 + i) * AK + p] = (bf16_t)(pk & 0xffffu); ac[(size_t)(c0 + i) * AK + 64 + p] = (bf16_t)(pk >> 16);
                                const float nr = ar * xr - ai * xi + lr[i], ni = ar * xi + ai * xr + li[i]; xr = nr; xi = ni; } }
                    }
                }
                SEAM(pb + 2);
            }
            PHASE(8, pb + 3) { LOCALS
                pg8::Gemm g{AC, (const bf16_t*)(ws + WS_BT3), AK, AK, AK, 32, (long)NCH * AK, 0, 512L * AK, 0}; pg8::Sched S; S.init(NCH / 256, 2, 32, G, bx);
                pg8::EpiS5Out E{AC, ap->in[20], Y}; pg8::gemm_phase(lds, g, S, E, tid);
                SEAM(pb + 3);
            }
            PHASE(9, pb + 4) { LOCALS
                pg8::Gemm g{Y, (const bf16_t*)(ws + WS_WOOUT), 512, 512, 512, 1, 0, 0, 0, 0}; pg8::Sched S; S.init(T / 256, 2048 / 256, 1, G, bx);
                pg8::EpiRes<true> E{out, out, XB, SSa + T}; pg8::gemm_phase(lds, g, S, E, tid);
                SEAM(pb + 4);
            }
        }
        PHASE(10, pb + 5) { LOCALS
            pg8::Gemm g{XB, (const bf16_t*)(ws + WS_WQ + l * WSQ_L), D, D, D, 1, 0, 0, 0, 0}; pg8::Sched S; S.init(T / 256, D / 256, 1, G, bx);
            pg8::EpiStore E{QO, D, 1, 0, 0, SSa + T, 0.0625f}; pg8::gemm_phase(lds, g, S, E, tid);
            SEAM(pb + 5);
        }
        PHASE(11, pb + 6) { LOCALS
            pg8::Gemm g{QO, KL + (size_t)l * MT * D, D, D, 256, 4, 256, (long)SEQ * D, 256, 256L * D}; pg8::Sched S; S.init(SEQ / 256, 1, 32, G, bx);
            pg8::EpiSoftmax E{Pb}; pg8::gemm_phase(lds, g, S, E, tid);
            SEAM(pb + 6);
        }
        PHASE(12, pb + 7) { LOCALS
            pg8::Gemm g{Pb, VT + (size_t)l * D * MT, 256, MT, 256, 4, (long)SEQ * 256, 4L * SEQ * 256, 256L * MT, 256}; pg8::Sched S; S.init(SEQ / 256, 1, 32, G, bx);
            pg8::EpiStore E{QO, D, 4, 256, (long)SEQ * D, nullptr, 1.0f}; pg8::gemm_phase(lds, g, S, E, tid);
            SEAM(pb + 7);
        }
        PHASE(13, pb + 8) { LOCALS
            pg8::Gemm g{QO, (const bf16_t*)(ws + WS_WO + l * WSQ_L), D, D, D, 1, 0, 0, 0, 0}; pg8::Sched S; S.init(T / 256, D / 256, 1, G, bx);
            pg8::EpiRes<false> E{out, out, XB, SSa + 2 * T}; pg8::gemm_phase(lds, g, S, E, tid);
            SEAM(pb + 8);
        }
        PHASE(14, pb + 9) { LOCALS
            pg8::Gemm g{XB, (const bf16_t*)(ws + WS_WGU + l * WGU_L), D, D, D, 1, 0, 0, 0, 0}; pg8::Sched S; S.init(T / 256, 2 * FH / 256, 1, G, bx);
            pg8::EpiFfn1 E{SSa + 2 * T, HM}; pg8::gemm_phase(lds, g, S, E, tid);
            SEAM(pb + 9);
        }
        PHASE(15, pb + 10) { LOCALS
            pg8::Gemm g{HM, (const bf16_t*)(ws + WS_WD + l * WD_L), FH, FH, FH, 1, 0, 0, 0, 0}; pg8::Sched S; S.init(T / 256, D / 256, 1, G, bx);
            pg8::EpiRes<false> E{out, out, XB, SSa + 3 * T}; pg8::gemm_phase(lds, g, S, E, tid);
            SEAM(pb + 10);
        }
    }
    PHASE(16, 26) { const int l = 0; LOCALS
        const float* ssf = SS + (size_t)6 * T; const f32x4* gf = (const f32x4*)ap->in[32] + lane;
        f32x4 gv[4];
#pragma unroll
        for (int j = 0; j < 4; ++j) gv[j] = gf[64 * j];
        for (int m = gw; m < T; m += NGW) { const float rs = rsqrtf(ssf[m] * (1.0f / D) + EPS); f32x4* xr = (f32x4*)(out + (size_t)m * D) + lane;
#pragma unroll
            for (int j = 0; j < 4; ++j) xr[64 * j] = xr[64 * j] * rs * gv[j]; }
    }
}

extern "C" void kernel_launch(void* const* d_in, const int* in_sizes, int n_in, void* d_out, int out_size, void* d_ws, size_t ws_size, hipStream_t stream) {
    static int grid = 0;
    if (grid == 0) {
        if (n_in != 33 || in_sizes[0] != T * D || out_size != T * D || ws_size < WS_END) { fprintf(stderr, "kernel_launch: unexpected shapes (n_in %d, in0 %d, out %d, ws %zu < %zu)\n", n_in, n_in > 0 ? in_sizes[0] : -1, out_size, ws_size, (size_t)WS_END); grid = -1; return; }
        int dev = 0, cus = 0, per_cu = 0;
        hipGetDevice(&dev); hipDeviceGetAttribute(&cus, hipDeviceAttributeMultiprocessorCount, dev);
        if (hipFuncSetAttribute((const void*)trunk_fwd, hipFuncAttributeMaxDynamicSharedMemorySize, LDS_BYTES) != hipSuccess) { fprintf(stderr, "kernel_launch: hipFuncSetAttribute failed\n"); grid = -1; return; }
        if (hipOccupancyMaxActiveBlocksPerMultiprocessor(&per_cu, (const void*)trunk_fwd, 512, LDS_BYTES) != hipSuccess || per_cu < 1) { fprintf(stderr, "kernel_launch: occupancy query says %d\n", per_cu); per_cu = 1; }
        (void)hipGetLastError();
        grid = cus * 1;
        if (grid <= 0) grid = 256;
    }
    if (grid < 0) return;
    Args a{};
    for (int i = 0; i < 33; ++i) a.in[i] = (const float*)d_in[i];
    a.out = (float*)d_out; a.ws = (unsigned char*)d_ws;
#if !MK_MULTI && !MK_CGSYNC
    (void)hipMemsetAsync((char*)d_ws + WS_BAR, 0, XCD_BAR_WORDS * 4, stream);
#endif
#if MK_MULTI
    for (int p = 0; p < NPHASE; ++p) {
        if (p == 5 || p == 6 || p == 13 || p == 25) continue;
        a.ph_lo = p; a.ph_hi = p + 1; void* kargs[] = {&a};
        hipError_t e = hipLaunchCooperativeKernel((const void*)trunk_fwd, dim3(grid), dim3(512), kargs, LDS_BYTES, stream);
        if (e != hipSuccess) { fprintf(stderr, "kernel_launch: launch of phase %d failed: %s\n", p, hipGetErrorString(e)); break; }
    }
#else
    a.ph_lo = 0; a.ph_hi = NPHASE; void* kargs[] = {&a};
    hipError_t e = hipLaunchCooperativeKernel((const void*)trunk_fwd, dim3(grid), dim3(512), kargs, LDS_BYTES, stream);
    if (e != hipSuccess) fprintf(stderr, "kernel_launch: cooperative launch failed: %s (grid %d)\n", hipGetErrorString(e), grid);
#endif
}
```

```cpp
#include <hip/hip_runtime.h>
#include <hip/hip_cooperative_groups.h>
#include <cstdio>
#include <cstdint>
namespace cg = cooperative_groups;

#ifndef MK_MULTI
#define MK_MULTI 0
#endif
#ifndef MK_CGSYNC
#define MK_CGSYNC 0
#endif

#define LAS __attribute__((address_space(3)))
typedef unsigned short bf16_t;
typedef short bf16x8 __attribute__((ext_vector_type(8)));
typedef float f32x4 __attribute__((ext_vector_type(4)));
typedef float f32x2 __attribute__((ext_vector_type(2)));
typedef unsigned u32x4 __attribute__((ext_vector_type(4)));
typedef unsigned u32x2 __attribute__((ext_vector_type(2)));

constexpr int T = 32768, D = 1024, SEQ = 4096, NB = 8, MT = 2048, FH = 2816;
constexpr float EPS = 1e-6f;
constexpr int SL = 32;
constexpr int NCH = T / SL;
constexpr int AK = SL * 16 + 128;

constexpr size_t MiB = 1u << 20;
constexpr size_t WS_WIN0 = 0, WS_WOUT0 = 4 * MiB, WS_WOIN = 6 * MiB, WS_WOOUT = 7 * MiB, WS_WQ = 9 * MiB, WS_WK = 13 * MiB, WS_WV = 17 * MiB, WS_WO = 21 * MiB;
constexpr size_t WS_WGU = 25 * MiB, WS_WD = 47 * MiB, WS_GW = 58 * MiB, WS_AL = 59 * MiB, WS_BT3 = 60 * MiB, WS_GM = 80 * MiB, WS_MEMN = 88 * MiB, WS_KL = 92 * MiB, WS_VT = 100 * MiB;
constexpr size_t WS_SS = 108 * MiB, WS_VST = 109 * MiB, WS_BAR = 109 * MiB + 512 * 1024, WS_XB = 110 * MiB, WS_QO = 174 * MiB, WS_P = 238 * MiB, WS_R0 = 302 * MiB;
constexpr size_t WS_HM = WS_R0, WS_U = WS_R0, WS_V = WS_R0 + 32 * MiB, WS_H = WS_R0 + 64 * MiB, WS_MIX = WS_R0 + 96 * MiB;
constexpr size_t WS_ACOMB = WS_R0, WS_XLOC = WS_R0 + 40 * MiB, WS_Y = WS_R0 + 56 * MiB;
constexpr size_t WS_END = WS_R0 + 176 * MiB;
constexpr size_t WGU_L = (size_t)2 * FH * D * 2, WD_L = (size_t)D * FH * 2, WSQ_L = (size_t)D * D * 2;

constexpr int RING_BYTES = 131072, XCH_OFF = RING_BYTES, MISC_OFF = RING_BYTES + 8192, LDS_BYTES = 147456;

__device__ __forceinline__ unsigned cvt_pk_bf16(float lo, float hi) { unsigned r; asm volatile("v_cvt_pk_bf16_f32 %0, %1, %2" : "=v"(r) : "v"(lo), "v"(hi)); return r; }
__device__ __forceinline__ float bf2f(unsigned short b) { return __builtin_bit_cast(float, (unsigned)b << 16); }
__device__ __forceinline__ float bflo(unsigned w) { return __builtin_bit_cast(float, w << 16); }
__device__ __forceinline__ float bfhi(unsigned w) { return __builtin_bit_cast(float, w & 0xffff0000u); }
__device__ __forceinline__ float sigmoid_f(float x) { return __builtin_amdgcn_rcpf(1.0f + __expf(-x)); }
__device__ __forceinline__ float silu_f(float x) { return x * sigmoid_f(x); }
__device__ __forceinline__ float gelu_f(float x) { return x * sigmoid_f(1.5957691216f * (x + 0.044715f * x * x * x)); }
__device__ __forceinline__ float wave_sum(float v) {
#pragma unroll
    for (int o = 1; o < 64; o <<= 1) v += __shfl_xor(v, o);
    return v;
}
__device__ __forceinline__ u32x4 pack8(f32x4 a, f32x4 b) { u32x4 w; w.x = cvt_pk_bf16(a[0], a[1]); w.y = cvt_pk_bf16(a[2], a[3]); w.z = cvt_pk_bf16(b[0], b[1]); w.w = cvt_pk_bf16(b[2], b[3]); return w; }

namespace pg8 {
constexpr int BM = 256, BK = 64, HALF = 128, HTB = HALF * BK * 2, NXCD = 8, WGM = 8;
__device__ __forceinline__ int lds_byte(int r, int c) { const int st = (r >> 4) * 2 + (c >> 5), rr = r & 15, cc = c & 31, ob = rr * 64 + cc * 2; return st * 1024 + (ob ^ (((ob >> 9) & 1) << 5)); }
__device__ __forceinline__ void stage_rc(int b, int& R, int& C) { const int st = b / 1024, sb = b % 1024, swz = sb ^ (((sb >> 9) & 1) << 5); R = (st >> 1) * 16 + swz / 64; C = (st & 1) * 32 + (swz % 64) / 2; }
__device__ __forceinline__ int perm32(int rho) { const int n = rho >> 4, i = rho & 15; return 8 * (i >> 2) + 4 * n + (i & 3); }

struct Unit { int pm, pn, z; };
struct Gemm { const bf16_t* A; const bf16_t* Bt; int lda, ldb, K, nz0; long sAz0, sAz1, sBz0, sBz1; };
struct Sched {
    int nM, nN, per, total, G, c;
    __device__ __forceinline__ void init(int nM_, int nN_, int nz, int G_, int c_) { nM = nM_; nN = nN_; per = nM_ * nN_; total = per * nz; G = G_; c = c_; }
    __device__ __forceinline__ bool next(int i, Unit& u) const {
        const long L = (long)i * G + c; if (L >= total) return false;
        const int z = (int)(L / per); int wgid = (int)(L % per);
        { const int q = per / NXCD, r = per % NXCD, xcd = wgid % NXCD, off = wgid / NXCD; wgid = (xcd < r ? xcd * (q + 1) : r * (q + 1) + (xcd - r) * q) + off; }
        const int nig = WGM * nN, gid = wgid / nig, fm = gid * WGM, gsz = (nM - fm) < WGM ? (nM - fm) : WGM;
        u.pm = fm + ((wgid % nig) % gsz); u.pn = (wgid % nig) / gsz; u.z = z; return true;
    }
};

template <class Epi>
__device__ __forceinline__ void gemm_phase(LAS unsigned char* lds, const Gemm g, const Sched& S, const Epi& E, const int tid) {
    const int wid = __builtin_amdgcn_readfirstlane(tid >> 6), lane = tid & 63, wr = wid >> 2, wc = wid & 3, fr = lane & 15, fq = lane >> 4;
    const int nt = g.K / BK;
    unsigned voffA[2], voffB[2];
#pragma unroll
    for (int i = 0; i < 2; ++i) { int R, C; stage_rc(tid * 16 + i * 8192, R, C); const int Rb = (R & ~31) + perm32(R & 31);
        voffA[i] = (unsigned)(R * g.lda + C) * 2u; voffB[i] = (unsigned)(Rb * g.ldb + C) * 2u; }
    const size_t kstep = (size_t)(BK * 2);
    const size_t hsA = (size_t)HALF * g.lda * 2, hsB = (size_t)HALF * g.ldb * 2;
    const unsigned ldsw = (unsigned)wid * 1024u;
    const int aoff = lds_byte(wr * 64 + fr, fq * 8), boff = lds_byte(wc * 32 + fr, fq * 8);
#define PG8_SA(b, h) (((b) * 2 + (h)) * HTB)
#define PG8_SB(b, h) ((4 + (b) * 2 + (h)) * HTB)
#define PG8_STAGE(bufoff, gbase, voff) do { _Pragma("unroll") for (int _i = 0; _i < 2; ++_i) \
        __builtin_amdgcn_global_load_lds((const unsigned*)((const char*)(gbase) + (voff)[_i]), (LAS unsigned*)(lds + (bufoff) + ldsw + _i * 8192), 16, 0, 0); } while (0)
#define PG8_LDA(dst, b, h) do { _Pragma("unroll") for (int m = 0; m < 4; ++m) _Pragma("unroll") for (int k = 0; k < 2; ++k) dst[m][k] = *(const LAS bf16x8*)(lds + PG8_SA(b, h) + aoff + m * 2048 + k * 1024); } while (0)
#define PG8_LDB(dst, b, h) do { _Pragma("unroll") for (int n = 0; n < 2; ++n) _Pragma("unroll") for (int k = 0; k < 2; ++k) dst[n][k] = *(const LAS bf16x8*)(lds + PG8_SB(b, h) + boff + n * 2048 + k * 1024); } while (0)
#define PG8_MMA(ai, bj, At, Bt) do { __builtin_amdgcn_s_setprio(1); _Pragma("unroll") for (int m = 0; m < 4; ++m) _Pragma("unroll") for (int n = 0; n < 2; ++n) _Pragma("unroll") for (int k = 0; k < 2; ++k) \
        acc[ai][bj][m][n] = __builtin_amdgcn_mfma_f32_16x16x32_bf16(Bt[n][k], At[m][k], acc[ai][bj][m][n], 0, 0, 0); __builtin_amdgcn_s_setprio(0); } while (0)
#define PG8_WAIT_V(n) asm volatile("s_waitcnt vmcnt(" #n ")" ::: "memory")
#define PG8_WAIT_L(n) asm volatile("s_waitcnt lgkmcnt(" #n ")" ::: "memory")
#define PG8_BAR __builtin_amdgcn_s_barrier()
#define PG8_SCHED __builtin_amdgcn_sched_barrier(0)
#define PG8_UA(u) ((const char*)g.A + 2 * ((size_t)((u).z % g.nz0) * g.sAz0 + (size_t)((u).z / g.nz0) * g.sAz1 + (size_t)(u).pm * BM * g.lda))
#define PG8_UB(u) ((const char*)g.Bt + 2 * ((size_t)((u).z % g.nz0) * g.sBz0 + (size_t)((u).z / g.nz0) * g.sBz1 + (size_t)(u).pn * BM * g.ldb))
    Unit cur, nxt; int ui = 0;
    if (!S.next(0, cur)) return;
    f32x4 acc[2][2][4][2];
#pragma unroll
    for (int a = 0; a < 2; ++a)
#pragma unroll
        for (int b = 0; b < 2; ++b)
#pragma unroll
            for (int m = 0; m < 4; ++m)
#pragma unroll
                for (int n = 0; n < 2; ++n) acc[a][b][m][n] = (f32x4){0.f, 0.f, 0.f, 0.f};
    bf16x8 At[4][2], B0[2][2], B1[2][2];
    const char* cA = PG8_UA(cur); const char* cB = PG8_UB(cur);
    PG8_STAGE(PG8_SB(0, 0), cB, voffB); PG8_STAGE(PG8_SB(0, 1), cB + hsB, voffB); PG8_STAGE(PG8_SA(0, 0), cA, voffA); PG8_STAGE(PG8_SA(0, 1), cA + hsA, voffA);
    if (wr == 1) PG8_BAR;
    PG8_WAIT_V(2); PG8_BAR;
    PG8_STAGE(PG8_SB(1, 0), cB + kstep, voffB); PG8_STAGE(PG8_SA(1, 0), cA + kstep, voffA); PG8_STAGE(PG8_SB(1, 1), cB + hsB + kstep, voffB);
    PG8_WAIT_V(6); PG8_BAR;
    for (;;) {
        const bool has_next = S.next(ui + 1, nxt);
        const char* nA = has_next ? PG8_UA(nxt) : cA; const char* nB = has_next ? PG8_UB(nxt) : cB;
        for (int t = 0; t < nt; t += 2) {
            const bool last = (t == nt - 2);
            const char* a1 = cA + (size_t)(t + 1) * kstep;
            const char* a2 = last ? nA : cA + (size_t)(t + 2) * kstep; const char* b2 = last ? nB : cB + (size_t)(t + 2) * kstep;
            const char* a3 = a2 + kstep; const char* b3 = b2 + kstep;
            PG8_LDB(B0, 0, 0); PG8_LDB(B1, 0, 1); PG8_SCHED; PG8_LDA(At, 0, 0); PG8_STAGE(PG8_SA(1, 1), a1 + hsA, voffA);
            PG8_WAIT_V(8); PG8_WAIT_L(0); PG8_BAR; PG8_MMA(0, 0, At, B0); PG8_MMA(0, 1, At, B1); PG8_BAR; PG8_SCHED;
            PG8_LDA(At, 0, 1); PG8_STAGE(PG8_SB(0, 0), b2, voffB); PG8_STAGE(PG8_SB(0, 1), b2 + hsB, voffB); PG8_STAGE(PG8_SA(0, 0), a2, voffA);
            PG8_WAIT_V(8); PG8_WAIT_L(0); PG8_BAR; PG8_MMA(1, 0, At, B0); PG8_MMA(1, 1, At, B1); PG8_BAR; PG8_SCHED;
            PG8_LDB(B0, 1, 0); PG8_LDB(B1, 1, 1); PG8_SCHED; PG8_LDA(At, 1, 0); PG8_STAGE(PG8_SA(0, 1), a2 + hsA, voffA);
            PG8_WAIT_V(8); PG8_WAIT_L(0); PG8_BAR; PG8_MMA(0, 0, At, B0); PG8_MMA(0, 1, At, B1); PG8_BAR; PG8_SCHED;
            PG8_LDA(At, 1, 1); PG8_STAGE(PG8_SB(1, 0), b3, voffB); PG8_STAGE(PG8_SB(1, 1), b3 + hsB, voffB); PG8_STAGE(PG8_SA(1, 0), a3, voffA);
            PG8_WAIT_V(8); PG8_WAIT_L(0); PG8_BAR; PG8_MMA(1, 0, At, B0); PG8_MMA(1, 1, At, B1); PG8_BAR; PG8_SCHED;
        }
        if (wr == 0) PG8_BAR;
        E(acc, cur, wr, wc, fr, fq, lds);
        if (!has_next) break;
#pragma unroll
        for (int a = 0; a < 2; ++a)
#pragma unroll
            for (int b = 0; b < 2; ++b)
#pragma unroll
                for (int m = 0; m < 4; ++m)
#pragma unroll
                    for (int n = 0; n < 2; ++n) acc[a][b][m][n] = (f32x4){0.f, 0.f, 0.f, 0.f};
        cur = nxt; cA = nA; cB = nB; ++ui;
        if (wr == 1) PG8_BAR;
    }
    PG8_WAIT_V(0);
    PG8_BAR;
#undef PG8_SA
#undef PG8_SB
#undef PG8_STAGE
#undef PG8_LDA
#undef PG8_LDB
#undef PG8_MMA
#undef PG8_UA
#undef PG8_UB
}

typedef f32x4 Acc[2][2][4][2];
#define EPI_ARGS Acc& acc, const Unit& u, int wr, int wc, int fr, int fq, LAS unsigned char* lds
__device__ __forceinline__ int efence() { asm volatile("" ::: "memory"); return 1; }
#define ROWLOOP _Pragma("unroll") for (int ai = 0; ai < 2; ++ai) _Pragma("unroll") for (int m = 0; m < 4; ++m) for (int once_ = efence(); once_; once_ = 0)

struct EpiIn0 {
    const float* ss; bf16_t* U; bf16_t* V; bf16_t* H; float* vst;
    __device__ __forceinline__ void operator()(EPI_ARGS) const {
        const int row0 = u.pm * 256 + wr * 64 + fr;
        if (u.pn < 4) {
            bf16_t* dst = (u.pn < 2) ? U : V; const int col0 = (u.pn & 1) * 256 + wc * 32 + 8 * fq; const bool st = u.pn >= 2;
            ROWLOOP { const int row = row0 + ai * 128 + m * 16; const float rs = rsqrtf(ss[row] * (1.0f / D) + EPS); float s = 0.f, q = 0.f;
#pragma unroll
                for (int bj = 0; bj < 2; ++bj) { f32x4 v0 = acc[ai][bj][m][0] * rs, v1 = acc[ai][bj][m][1] * rs;
#pragma unroll
                    for (int e = 0; e < 4; ++e) { v0[e] = gelu_f(v0[e]); v1[e] = gelu_f(v1[e]); s += v0[e] + v1[e]; q += v0[e] * v0[e] + v1[e] * v1[e]; }
                    *(u32x4*)(dst + (size_t)row * 512 + col0 + bj * 128) = pack8(v0, v1); }
                if (st) { s += __shfl_xor(s, 16); s += __shfl_xor(s, 32); q += __shfl_xor(q, 16); q += __shfl_xor(q, 32);
                    if (fq == 0) { unsafeAtomicAdd(vst + 2 * row, s); unsafeAtomicAdd(vst + 2 * row + 1, q); } }
            }
        } else {
            const int col0 = (u.pn - 4) * 128 + wc * 32 + 8 * fq;
            ROWLOOP { const int row = row0 + ai * 128 + m * 16; const float rs = rsqrtf(ss[row] * (1.0f / D) + EPS); f32x4 h0, h1;
#pragma unroll
                for (int e = 0; e < 4; ++e) { h0[e] = acc[ai][0][m][0][e] * rs * sigmoid_f(acc[ai][1][m][0][e] * rs); h1[e] = acc[ai][0][m][1][e] * rs * sigmoid_f(acc[ai][1][m][1][e] * rs); }
                *(u32x4*)(H + (size_t)row * 512 + col0) = pack8(h0, h1); }
        }
    }
};
template <bool GLU> struct EpiRes {
    const float* base; float* out; bf16_t* xb; float* ss;
    __device__ __forceinline__ void operator()(EPI_ARGS) const {
        const int row0 = u.pm * 256 + wr * 64 + fr;
        ROWLOOP { const int row = row0 + ai * 128 + m * 16; float q = 0.f;
            if (GLU) { const size_t off = (size_t)row * D + u.pn * 128 + wc * 32 + 8 * fq;
                f32x4 o0 = *(const f32x4*)(base + off), o1 = *(const f32x4*)(base + off + 4);
#pragma unroll
                for (int e = 0; e < 4; ++e) { o0[e] += acc[ai][0][m][0][e] * sigmoid_f(acc[ai][1][m][0][e]); o1[e] += acc[ai][0][m][1][e] * sigmoid_f(acc[ai][1][m][1][e]);
                    q += o0[e] * o0[e] + o1[e] * o1[e]; }
                *(f32x4*)(out + off) = o0; *(f32x4*)(out + off + 4) = o1; *(u32x4*)(xb + off) = pack8(o0, o1);
            } else {
#pragma unroll
                for (int bj = 0; bj < 2; ++bj) { const size_t off = (size_t)row * D + u.pn * 256 + bj * 128 + wc * 32 + 8 * fq;
                    f32x4 o0 = *(const f32x4*)(base + off) + acc[ai][bj][m][0], o1 = *(const f32x4*)(base + off + 4) + acc[ai][bj][m][1];
#pragma unroll
                    for (int e = 0; e < 4; ++e) q += o0[e] * o0[e] + o1[e] * o1[e];
                    *(f32x4*)(out + off) = o0; *(f32x4*)(out + off + 4) = o1; *(u32x4*)(xb + off) = pack8(o0, o1); }
            }
            q += __shfl_xor(q, 16); q += __shfl_xor(q, 32);
            if (fq == 0) unsafeAtomicAdd(ss + row, q);
            if (m & 1) asm volatile("" ::: "memory");
        }
    }
};
struct EpiStore {
    bf16_t* O; int ldc, nz0; long sz0, sz1; const float* ss; float scale;
    __device__ __forceinline__ void operator()(EPI_ARGS) const {
        bf16_t* base = O + (size_t)(u.z % nz0) * sz0 + (size_t)(u.z / nz0) * sz1; const int row0 = u.pm * 256 + wr * 64 + fr, col0 = u.pn * 256 + wc * 32 + 8 * fq;
        ROWLOOP { const int row = row0 + ai * 128 + m * 16; const float rs = ss ? rsqrtf(ss[row] * (1.0f / D) + EPS) * scale : scale;
#pragma unroll
            for (int bj = 0; bj < 2; ++bj) *(u32x4*)(base + (size_t)row * ldc + col0 + bj * 128) = pack8(acc[ai][bj][m][0] * rs, acc[ai][bj][m][1] * rs); }
    }
};
struct EpiSoftmax {
    bf16_t* P;
    __device__ __forceinline__ void operator()(EPI_ARGS) const {
        LAS float* X = (LAS float*)(lds + XCH_OFF); LAS float* Y = X + 1024;
        ROWLOOP { const int r = ai * 128 + wr * 64 + m * 16 + fr; float mx = -3.0e38f;
#pragma unroll
            for (int bj = 0; bj < 2; ++bj)
#pragma unroll
                for (int n = 0; n < 2; ++n)
#pragma unroll
                    for (int e = 0; e < 4; ++e) mx = fmaxf(mx, acc[ai][bj][m][n][e]);
            mx = fmaxf(mx, __shfl_xor(mx, 16)); mx = fmaxf(mx, __shfl_xor(mx, 32));
            if (fq == 0) X[r * 4 + wc] = mx; }
        asm volatile("s_waitcnt lgkmcnt(0)" ::: "memory"); __builtin_amdgcn_s_barrier(); asm volatile("" ::: "memory");
        ROWLOOP { const int r = ai * 128 + wr * 64 + m * 16 + fr; const f32x4 xm = *(const LAS f32x4*)(X + r * 4); const float mx = fmaxf(fmaxf(xm[0], xm[1]), fmaxf(xm[2], xm[3])); float s = 0.f;
#pragma unroll
            for (int bj = 0; bj < 2; ++bj)
#pragma unroll
                for (int n = 0; n < 2; ++n)
#pragma unroll
                    for (int e = 0; e < 4; ++e) { const float p = __expf(acc[ai][bj][m][n][e] - mx); acc[ai][bj][m][n][e] = p; s += p; }
            s += __shfl_xor(s, 16); s += __shfl_xor(s, 32);
            if (fq == 0) Y[r * 4 + wc] = s; }
        asm volatile("s_waitcnt lgkmcnt(0)" ::: "memory"); __builtin_amdgcn_s_barrier(); asm volatile("" ::: "memory");
        bf16_t* base = P + (size_t)u.z * SEQ * 256;
        ROWLOOP { const int r = ai * 128 + wr * 64 + m * 16 + fr; const f32x4 ys = *(const LAS f32x4*)(Y + r * 4); const float inv = 1.0f / ((ys[0] + ys[1]) + (ys[2] + ys[3]));
#pragma unroll
            for (int bj = 0; bj < 2; ++bj) *(u32x4*)(base + (size_t)(u.pm * 256 + r) * 256 + bj * 128 + wc * 32 + 8 * fq) = pack8(acc[ai][bj][m][0] * inv, acc[ai][bj][m][1] * inv); }
    }
};
struct EpiFfn1 {
    const float* ss; bf16_t* HM;
    __device__ __forceinline__ void operator()(EPI_ARGS) const {
        const int row0 = u.pm * 256 + wr * 64 + fr, col0 = u.pn * 128 + wc * 32 + 8 * fq;
        ROWLOOP { const int row = row0 + ai * 128 + m * 16; const float rs = rsqrtf(ss[row] * (1.0f / D) + EPS); f32x4 h0, h1;
#pragma unroll
            for (int e = 0; e < 4; ++e) { h0[e] = silu_f(acc[ai][0][m][0][e] * rs) * (acc[ai][1][m][0][e] * rs); h1[e] = silu_f(acc[ai][0][m][1][e] * rs) * (acc[ai][1][m][1][e] * rs); }
            *(u32x4*)(HM + (size_t)row * FH + col0) = pack8(h0, h1); }
    }
};
struct EpiOin {
    const float* ss; bf16_t* AC;
    __device__ __forceinline__ void operator()(EPI_ARGS) const {
        const int row0 = u.pm * 256 + wr * 64 + fr;
        ROWLOOP { const int row = row0 + ai * 128 + m * 16; const float rs = rsqrtf(ss[row] * (1.0f / D) + EPS);
#pragma unroll
            for (int bj = 0; bj < 2; ++bj) { const int col = u.pn * 256 + bj * 128 + wc * 32 + 8 * fq;
                *(u32x4*)(AC + (size_t)(col >> 4) * NCH * AK + (size_t)(row / SL) * AK + (row % SL) * 16 + (col & 8)) = pack8(acc[ai][bj][m][0] * rs, acc[ai][bj][m][1] * rs); } }
    }
};
struct EpiS5State {
    float* XL;
    __device__ __forceinline__ void operator()(EPI_ARGS) const {
        const int row0 = u.pm * 256 + wr * 64 + fr, col0 = wc * 32 + 8 * fq;
        ROWLOOP { const int row = row0 + ai * 128 + m * 16; float* p = XL + (size_t)u.z * NCH * 128 + (size_t)row * 128 + col0;
            *(f32x4*)p = acc[ai][0][m][0]; *(f32x4*)(p + 4) = acc[ai][0][m][1]; }
    }
};
struct EpiS5Out {
    const bf16_t* AC; const float* dsk; bf16_t* Y;
    __device__ __forceinline__ void operator()(EPI_ARGS) const {
        const int g = u.z, row0 = u.pm * 256 + wr * 64 + fr;
        ROWLOOP { const int row = row0 + ai * 128 + m * 16;
#pragma unroll
            for (int bj = 0; bj < 2; ++bj) { const int col = u.pn * 256 + bj * 128 + wc * 32 + 8 * fq, k = col >> 4, ch = g * 16 + (col & 8);
                const u32x4 uu = *(const u32x4*)(AC + (size_t)g * NCH * AK + (size_t)row * AK + col);
                const f32x4 d0 = *(const f32x4*)(dsk + ch), d1 = *(const f32x4*)(dsk + ch + 4);
                f32x4 y0 = acc[ai][bj][m][0], y1 = acc[ai][bj][m][1];
                y0[0] += d0[0] * bflo(uu.x); y0[1] += d0[1] * bfhi(uu.x); y0[2] += d0[2] * bflo(uu.y); y0[3] += d0[3] * bfhi(uu.y);
                y1[0] += d1[0] * bflo(uu.z); y1[1] += d1[1] * bfhi(uu.z); y1[2] += d1[2] * bflo(uu.w); y1[3] += d1[3] * bfhi(uu.w);
#pragma unroll
                for (int e = 0; e < 4; ++e) { y0[e] = gelu_f(y0[e]); y1[e] = gelu_f(y1[e]); }
                *(u32x4*)(Y + (size_t)(row * SL + k) * 512 + ch) = pack8(y0, y1); } }
    }
};
}

#define XB_TMO      128
#define XB_XCNT(j)  (256  + 64 * (j))
#define XB_XSUB(j)  (1280 + 64 * (j))
#define XB_XGEN(j)  (2304 + 64 * (j))
#define XB_TOP      3328
#define XB_TOPGEN   3392
#define XCD_BAR_WORDS 3456
#define XB_SPIN_CAP (1u << 22)
__device__ __forceinline__ unsigned xb_ld(unsigned* p)              { return __hip_atomic_load(p, __ATOMIC_RELAXED, __HIP_MEMORY_SCOPE_AGENT); }
__device__ __forceinline__ unsigned xb_add(unsigned* p, unsigned v) { return __hip_atomic_fetch_add(p, v, __ATOMIC_RELAXED, __HIP_MEMORY_SCOPE_AGENT); }
__device__ __forceinline__ unsigned xb_xcc_id() { return (unsigned)__builtin_amdgcn_s_getreg((3 << 11) | 20) & 0xFu; }
#define XB_SPIN(cond, bar) do { unsigned _sp = 0; while (cond) { __builtin_amdgcn_s_sleep(1); \
    if ((++_sp & 255u) == 0u) { if (xb_ld(&(bar)[XB_TMO])) break; if (_sp > XB_SPIN_CAP) { atomicAdd(&(bar)[XB_TMO], 1u); break; } } } } while (0)
struct XcdBarrier { unsigned* bar; unsigned x; volatile LAS unsigned* st; };
__device__ __forceinline__ XcdBarrier xcd_barrier_post(unsigned* bar, volatile LAS unsigned* st) {
    XcdBarrier b; b.bar = bar; b.x = xb_xcc_id(); b.st = st;
    if (threadIdx.x == 0) (void)xb_add(&bar[XB_XCNT(b.x)], 1u);
    return b;
}
__device__ __forceinline__ void xcd_barrier_complete(unsigned* bar, unsigned x, unsigned& nloc, unsigned& nx) {
    const unsigned G = gridDim.x * gridDim.y * gridDim.z;
    unsigned sum, cnt, mine, sp = 0u;
    for (;;) {
        sum = 0u; cnt = 0u; mine = 0u;
#pragma unroll
        for (unsigned j = 0; j < 16; ++j) { const unsigned c = xb_ld(&bar[XB_XCNT(j)]); sum += c; cnt += (c > 0u) ? 1u : 0u; mine = (j == x) ? c : mine; }
        if (sum == G) break;
        __builtin_amdgcn_s_sleep(1);
        if ((++sp & 255u) == 0u) { if (xb_ld(&bar[XB_TMO])) break; if (sp > XB_SPIN_CAP) { atomicAdd(&bar[XB_TMO], 1u); break; } }
    }
    nloc = mine > 0u ? mine : 1u; nx = cnt > 0u ? cnt : 1u;
}
__device__ __forceinline__ void xcd_barrier(const XcdBarrier& b) {
    asm volatile("s_waitcnt vmcnt(0)" ::: "memory");
    __syncthreads();
    if (threadIdx.x == 0) {
        unsigned* bar = b.bar;
        __builtin_amdgcn_s_waitcnt(0);
        unsigned nloc = b.st[0], nx = b.st[1];
        if (nloc == 0u) { xcd_barrier_complete(bar, b.x, nloc, nx); b.st[0] = nloc; b.st[1] = nx; }
        const unsigned old = xb_add(&bar[XB_XSUB(b.x)], 1u);
        const unsigned gen = old / nloc;
        if (old + 1u == (gen + 1u) * nloc) {
            __builtin_amdgcn_fence(__ATOMIC_RELEASE, "agent");
            asm volatile("s_waitcnt vmcnt(0)" ::: "memory");
            const unsigned og = xb_add(&bar[XB_TOP], 1u);
            const unsigned tg = og / nx;
            if (og + 1u == (tg + 1u) * nx) xb_add(&bar[XB_TOPGEN], 1u);
            else XB_SPIN(xb_ld(&bar[XB_TOPGEN]) == tg, bar);
            __builtin_amdgcn_fence(__ATOMIC_ACQUIRE, "agent");
            xb_add(&bar[XB_XGEN(b.x)], 1u);
            asm volatile("s_waitcnt vmcnt(0)" ::: "memory");
        } else {
            XB_SPIN(xb_ld(&bar[XB_XGEN(b.x)]) == gen, bar);
            __builtin_amdgcn_fence(__ATOMIC_ACQUIRE, "agent");
            asm volatile("s_waitcnt vmcnt(0)" ::: "memory");
        }
    }
    __syncthreads();
}

__device__ __forceinline__ void conv_item(const float* W, int K, int ldn, int cs, int nblk, bf16_t* WT, int mode, int roff, const float* gain, LAS float* scr, int item, int lane) {
    const int kb = item / nblk, nb = item % nblk, k0 = 64 * kb, c0 = 32 * nb;
#pragma unroll 8
    for (int i = 0; i < 32; ++i) { const int kk = 2 * i + (lane >> 5); const float gk = gain ? gain[k0 + kk] : 1.0f; scr[kk * 33 + (lane & 31)] = W[(size_t)(k0 + kk) * ldn + cs + c0 + (lane & 31)] * gk; }
    asm volatile("s_waitcnt lgkmcnt(0)" ::: "memory");
    const int c = lane & 7; const int drow = roff + (mode == 0 ? c0 : ((c0 >> 7) * 256 + (mode - 1) * 128 + (c0 & 127)));
#pragma unroll
    for (int j = 0; j < 4; ++j) { const int n = (lane >> 3) + 8 * j; const LAS float* s = scr + (8 * c) * 33 + n;
        u32x4 o; o.x = cvt_pk_bf16(s[0 * 33], s[1 * 33]); o.y = cvt_pk_bf16(s[2 * 33], s[3 * 33]); o.z = cvt_pk_bf16(s[4 * 33], s[5 * 33]); o.w = cvt_pk_bf16(s[6 * 33], s[7 * 33]);
        *(u32x4*)(WT + (size_t)(drow + n) * K + k0 + 8 * c) = o; }
    asm volatile("s_waitcnt lgkmcnt(0)" ::: "memory");
}
template <bool NORM> __device__ __forceinline__ float row_to_bf16(const float* xrow, bf16_t* orow, int lane) {
    const f32x4* xr = (const f32x4*)xrow + lane; f32x4 v[4]; float s = 0.f;
#pragma unroll
    for (int j = 0; j < 4; ++j) { v[j] = xr[64 * j]; s += (v[j][0] * v[j][0] + v[j][1] * v[j][1]) + (v[j][2] * v[j][2] + v[j][3] * v[j][3]); }
    s = wave_sum(s); const float rs = NORM ? rsqrtf(s * (1.0f / D) + EPS) : 1.0f;
    u32x2* o = (u32x2*)orow + lane;
#pragma unroll
    for (int j = 0; j < 4; ++j) { u32x2 w; w.x = cvt_pk_bf16(v[j][0] * rs, v[j][1] * rs); w.y = cvt_pk_bf16(v[j][2] * rs, v[j][3] * rs); o[64 * j] = w; }
    return s;
}
__device__ __forceinline__ void cis_f(float ang, float& c, float& s) {
    float rev = ang * 0.15915494309189535f; rev = rev - rintf(rev);
    const float x = rev * 6.283185307179586f;
    const float h = x * 0.25f, h2 = h * h;
    float sh = h * (1.0f + h2 * (-1.6666667e-1f + h2 * (8.3333333e-3f + h2 * (-1.9841270e-4f + h2 * 2.7557319e-6f))));
    float ch = 1.0f + h2 * (-0.5f + h2 * (4.1666667e-2f + h2 * (-1.3888889e-3f + h2 * (2.4801587e-5f + h2 * -2.7557319e-7f))));
    float s2 = 2.f * sh * ch, c2 = 1.f - 2.f * sh * sh;
    s = 2.f * s2 * c2; c = 1.f - 2.f * s2 * s2;
}
__device__ __forceinline__ void s5_setup(int g, LAS unsigned char* lds, const float* lam_re, const float* lam_im, const float* log_dt, const float* b_re, const float* b_im, const float* c_re, const float* c_im,
                                         bf16_t* BT3, bf16_t* GM, float* AL, int tid) {
    LAS float* pwr = (LAS float*)lds; LAS float* pwi = pwr + 33 * 64; LAS float* Bbr = pwi + 33 * 64; LAS float* Bbi = Bbr + 1024; LAS float* Cr = Bbi + 1024; LAS float* Ci = Cr + 1024; LAS float* Kd = Ci + 1024;
    const float dt = __expf(log_dt[g]);
    for (int idx = tid; idx < 33 * 64; idx += 512) { const int d = idx >> 6, p = idx & 63; const float lr = lam_re[g * 64 + p], li = lam_im[g * 64 + p];
        const float mag = __expf(lr * dt * (float)d); float c, s; cis_f(li * dt * (float)d, c, s); pwr[idx] = mag * c; pwi[idx] = mag * s; }
    for (int idx = tid; idx < 1024; idx += 512) { const int p = idx >> 4; const float lr = lam_re[g * 64 + p], li = lam_im[g * 64 + p];
        const float mag = __expf(lr * dt); float c, s; cis_f(li * dt, c, s); const float ar = mag * c, ai = mag * s, den = lr * lr + li * li;
        const float qr = ((ar - 1.0f) * lr + ai * li) / den, qi = (ai * lr - (ar - 1.0f) * li) / den;
        const float br = b_re[g * 1024 + idx], bi = b_im[g * 1024 + idx];
        Bbr[idx] = qr * br - qi * bi; Bbi[idx] = qr * bi + qi * br;
        Cr[idx] = c_re[g * 1024 + idx]; Ci[idx] = c_im[g * 1024 + idx]; }
    __syncthreads();
    for (int idx = tid; idx < 32 * 256; idx += 512) { const int d = idx >> 8, co = (idx >> 4) & 15, ci = idx & 15; float a = 0.f;
        for (int p = 0; p < 64; ++p) { const float cr = Cr[co * 64 + p], cim = Ci[co * 64 + p], pr = pwr[d * 64 + p], pi = pwi[d * 64 + p];
            const float tr = cr * pr - cim * pi, ti = cr * pi + cim * pr; a += tr * Bbr[p * 16 + ci] - ti * Bbi[p * 16 + ci]; }
        Kd[idx] = a; }
    __syncthreads();
    bf16_t* bt = BT3 + (size_t)g * 512 * AK;
    for (int idx = tid; idx < 512 * (AK / 8); idx += 512) { const int n = idx / (AK / 8), q = idx % (AK / 8), kk0 = q * 8, k = n >> 4, co = n & 15; float v[8];
        if (kk0 < 512) { const int j = kk0 >> 4, ci0 = kk0 & 15;
#pragma unroll
            for (int e = 0; e < 8; ++e) v[e] = (j <= k) ? Kd[(k - j) * 256 + co * 16 + ci0 + e] : 0.f;
        } else { const int p0 = kk0 - 512;
#pragma unroll
            for (int e = 0; e < 8; ++e) { const int p = (p0 & 63) + e; const float cr = Cr[co * 64 + p], cim = Ci[co * 64 + p], pr = pwr[(k + 1) * 64 + p], pi = pwi[(k + 1) * 64 + p];
                v[e] = (p0 < 64) ? (cr * pr - cim * pi) : -(cr * pi + cim * pr); } }
        u32x4 w; w.x = cvt_pk_bf16(v[0], v[1]); w.y = cvt_pk_bf16(v[2], v[3]); w.z = cvt_pk_bf16(v[4], v[5]); w.w = cvt_pk_bf16(v[6], v[7]);
        *(u32x4*)(bt + (size_t)n * AK + kk0) = w; }
    bf16_t* gm = GM + (size_t)g * 256 * 512;
    for (int idx = tid; idx < 256 * 64; idx += 512) { const int n = idx >> 6, q = idx & 63, kk0 = q * 8; float v[8];
        if (n < 128) { const int p = n & 63, j = kk0 >> 4, ci0 = kk0 & 15; const float pr = pwr[(SL - 1 - j) * 64 + p], pi = pwi[(SL - 1 - j) * 64 + p];
#pragma unroll
            for (int e = 0; e < 8; ++e) { const float br = Bbr[p * 16 + ci0 + e], bi = Bbi[p * 16 + ci0 + e]; v[e] = (n < 64) ? (pr * br - pi * bi) : (pr * bi + pi * br); }
        } else {
#pragma unroll
            for (int e = 0; e < 8; ++e) v[e] = 0.f; }
        u32x4 w; w.x = cvt_pk_bf16(v[0], v[1]); w.y = cvt_pk_bf16(v[2], v[3]); w.z = cvt_pk_bf16(v[4], v[5]); w.w = cvt_pk_bf16(v[6], v[7]);
        *(u32x4*)(gm + (size_t)n * 512 + kk0) = w; }
    if (tid < 64) { AL[(g * 64 + tid) * 2] = pwr[SL * 64 + tid]; AL[(g * 64 + tid) * 2 + 1] = pwi[SL * 64 + tid]; }
    __syncthreads();
}

__device__ __forceinline__ void gmlp_unit(int unit, LAS unsigned char* lds, const bf16_t* U, const bf16_t* V, const float* vst, const bf16_t* GW, const float* gb, bf16_t* MIX, int tid) {
    const int g = unit & 3, t0 = (unit >> 2) * 128, lane = tid & 63, wid = tid >> 6;
    LAS bf16_t* vT = (LAS bf16_t*)lds;
#pragma unroll
    for (int e = 0; e < 4; ++e) { const int q = tid + 512 * e, j = q >> 4, c8 = (q & 15) * 8;
        const u32x4 raw = *(const u32x4*)(V + (size_t)(t0 + j) * 512 + g * 128 + c8);
        const float s = vst[2 * (t0 + j)], ss = vst[2 * (t0 + j) + 1], mean = s * (1.0f / 512.0f), var = ss * (1.0f / 512.0f) - mean * mean, rstd = rsqrtf(fmaxf(var, 0.f) + EPS);
        float v[8] = {bflo(raw.x), bfhi(raw.x), bflo(raw.y), bfhi(raw.y), bflo(raw.z), bfhi(raw.z), bflo(raw.w), bfhi(raw.w)};
#pragma unroll
        for (int i = 0; i < 8; i += 2) { const unsigned pk = cvt_pk_bf16((v[i] - mean) * rstd, (v[i + 1] - mean) * rstd); vT[(c8 + i) * 136 + j] = (bf16_t)(pk & 0xffffu); vT[(c8 + i + 1) * 136 + j] = (bf16_t)(pk >> 16); } }
    __syncthreads();
    const int il = lane & 15, kq = lane >> 4, i = wid * 16 + il;
    bf16x8 wf[4];
#pragma unroll
    for (int ks = 0; ks < 4; ++ks) wf[ks] = *(const bf16x8*)(GW + (size_t)g * 16384 + (size_t)i * 128 + ks * 32 + kq * 8);
    const float bias = gb[g * 128 + i];
#pragma unroll 2
    for (int nt = 0; nt < 8; ++nt) { f32x4 a = {0.f, 0.f, 0.f, 0.f};
#pragma unroll
        for (int ks = 0; ks < 4; ++ks) { const bf16x8 vf = *(const LAS bf16x8*)(vT + (nt * 16 + il) * 136 + ks * 32 + kq * 8); a = __builtin_amdgcn_mfma_f32_16x16x32_bf16(vf, wf[ks], a, 0, 0, 0); }
        const size_t tok = (size_t)(t0 + i); const int c = g * 128 + nt * 16 + kq * 4;
        const u32x2 uu = *(const u32x2*)(U + tok * 512 + c);
        u32x2 o; o.x = cvt_pk_bf16(bflo(uu.x) * (a[0] + bias), bfhi(uu.x) * (a[1] + bias)); o.y = cvt_pk_bf16(bflo(uu.y) * (a[2] + bias), bfhi(uu.y) * (a[3] + bias));
        *(u32x2*)(MIX + tok * 1024 + c) = o; }
    __syncthreads();
}
__device__ __forceinline__ void conv_unit(int unit, LAS unsigned char* lds, const bf16_t* H, const float* cw, const float* cb, const float* lng, const float* lnb, bf16_t* MIX, int tid) {
    const int t0 = unit * 32, s0 = t0 % SEQ, lane = tid & 63, wid = tid >> 6;
    LAS bf16_t* hin = (LAS bf16_t*)lds;
    LAS float* cout = (LAS float*)(lds + 62 * 1024);
    for (int q = tid; q < 62 * 64; q += 512) { const int r = q >> 6, c8 = (q & 63) * 8; u32x4 v = {0u, 0u, 0u, 0u};
        if (s0 - 30 + r >= 0) v = *(const u32x4*)(H + (size_t)(t0 - 30 + r) * 512 + c8);
        *(LAS u32x4*)(hin + r * 512 + c8) = v; }
    float w[31];
#pragma unroll
    for (int k = 0; k < 31; ++k) w[k] = cw[k * 512 + tid];
    const float bias = cb[tid];
    __syncthreads();
#pragma unroll 1
    for (int tg = 0; tg < 4; ++tg) { float x[38];
#pragma unroll
        for (int r = 0; r < 38; ++r) x[r] = bf2f(hin[(tg * 8 + r) * 512 + tid]);
#pragma unroll
        for (int o = 0; o < 8; ++o) { float a = bias;
#pragma unroll
            for (int k = 0; k < 31; ++k) a += w[k] * x[o + k];
            cout[(tg * 8 + o) * 516 + tid] = a; } }
    __syncthreads();
#pragma unroll 1
    for (int tt = 0; tt < 4; ++tt) { const int row = wid * 4 + tt; const f32x4 v0 = *(const LAS f32x4*)(cout + row * 516 + lane * 8), v1 = *(const LAS f32x4*)(cout + row * 516 + lane * 8 + 4);
        const float mean = wave_sum((v0[0] + v0[1]) + (v0[2] + v0[3]) + (v1[0] + v1[1]) + (v1[2] + v1[3])) * (1.0f / 512.0f);
        const f32x4 d0 = v0 - mean, d1 = v1 - mean;
        const float var = wave_sum((d0[0] * d0[0] + d0[1] * d0[1]) + (d0[2] * d0[2] + d0[3] * d0[3]) + (d1[0] * d1[0] + d1[1] * d1[1]) + (d1[2] * d1[2] + d1[3] * d1[3])) * (1.0f / 512.0f);
        const float rstd = rsqrtf(var + EPS);
        const f32x4 g0 = *(const f32x4*)(lng + lane * 8), g1 = *(const f32x4*)(lng + lane * 8 + 4), b0 = *(const f32x4*)(lnb + lane * 8), b1 = *(const f32x4*)(lnb + lane * 8 + 4);
        f32x4 y0 = d0 * rstd * g0 + b0, y1 = d1 * rstd * g1 + b1;
#pragma unroll
        for (int e = 0; e < 4; ++e) { y0[e] = silu_f(y0[e]); y1[e] = silu_f(y1[e]); }
        *(u32x4*)(MIX + (size_t)(t0 + row) * 1024 + 512 + lane * 8) = pack8(y0, y1); }
    __syncthreads();
}

struct Args { const float* in[33]; float* out; unsigned char* ws; int ph_lo, ph_hi; };
constexpr int NPHASE = 27;

typedef const __attribute__((address_space(4))) Args* KArgP;
__device__ __forceinline__ KArgP fresh_args() { KArgP p = (KArgP)__builtin_amdgcn_kernarg_segment_ptr(); asm volatile("" : "+s"(p)); return p; }

__global__ void __launch_bounds__(512, 2) trunk_fwd(Args args_unused) {
    extern __shared__ __attribute__((aligned(16))) unsigned char lds_raw[];
    LAS unsigned char* lds = (LAS unsigned char*)lds_raw;
    cg::grid_group grid = cg::this_grid();
    { volatile LAS unsigned* MISC0 = (volatile LAS unsigned*)(lds + MISC_OFF); if (threadIdx.x < 32) MISC0[threadIdx.x] = 0u; }
    __syncthreads();
    int lo, hi;
    { KArgP ap = fresh_args(); lo = ap->ph_lo; hi = ap->ph_hi; }
#if !MK_MULTI && !MK_CGSYNC
    { KArgP ap = fresh_args(); (void)xcd_barrier_post((unsigned*)(ap->ws + WS_BAR), (volatile LAS unsigned*)(lds + MISC_OFF) + 8); }
#endif
    int nsync = 0;
#if MK_MULTI
#define SEAM(k) do { } while (0)
#elif MK_CGSYNC
#define SEAM(k) do { if ((k) + 1 < hi) grid.sync(); } while (0)
#else
#define SEAM(k) do { if ((k) + 1 < hi) { if (nsync == 0) grid.sync(); else { KArgP ap_ = fresh_args(); XcdBarrier xb_; xb_.bar = (unsigned*)(ap_->ws + WS_BAR); xb_.x = xb_xcc_id(); xb_.st = (volatile LAS unsigned*)(lds + MISC_OFF) + 8; xcd_barrier(xb_); } ++nsync; } } while (0)
#endif
#ifndef ONLY
#define ONLY -1
#endif
#define PHASE(id, k) if ((ONLY < 0 || ONLY == (id)) && lo <= (k) && (k) < hi)
    (void)nsync;
#define LOCALS KArgP ap = fresh_args(); unsigned char* ws = ap->ws; float* out = ap->out; const float* x_in = ap->in[0]; \
    int tid_ = threadIdx.x, G_ = gridDim.x, bx_ = blockIdx.x; asm volatile("" : "+v"(tid_), "+s"(G_), "+s"(bx_)); \
    const int tid = tid_, lane = tid & 63, wave = __builtin_amdgcn_readfirstlane(tid >> 6), G = G_, bx = bx_, gw = bx * 8 + wave, NGW = G * 8; \
    bf16_t* XB = (bf16_t*)(ws + WS_XB); float* SS = (float*)(ws + WS_SS); float* VST = (float*)(ws + WS_VST); bf16_t* QO = (bf16_t*)(ws + WS_QO); bf16_t* Pb = (bf16_t*)(ws + WS_P); \
    bf16_t* HM = (bf16_t*)(ws + WS_HM); bf16_t* MEMN = (bf16_t*)(ws + WS_MEMN); bf16_t* KL = (bf16_t*)(ws + WS_KL); bf16_t* VT = (bf16_t*)(ws + WS_VT); \
    bf16_t* U = (bf16_t*)(ws + WS_U); bf16_t* V = (bf16_t*)(ws + WS_V); bf16_t* H = (bf16_t*)(ws + WS_H); bf16_t* MIX = (bf16_t*)(ws + WS_MIX); \
    bf16_t* AC = (bf16_t*)(ws + WS_ACOMB); float* XL = (float*)(ws + WS_XLOC); bf16_t* Y = (bf16_t*)(ws + WS_Y); float* SSa = SS + (size_t)(3 * l) * T; \
    (void)out; (void)x_in; (void)lane; (void)gw; (void)NGW; (void)XB; (void)VST; (void)QO; (void)Pb; (void)HM; (void)MEMN; (void)KL; (void)VT; (void)U; (void)V; (void)H; (void)MIX; (void)AC; (void)XL; (void)Y; (void)SSa; (void)wave;

    PHASE(0, 0) { const int l = 0; LOCALS
        { f32x4* z = (f32x4*)(SS + T); const int n4 = 7 * T / 4; for (int i = bx * 512 + tid; i < n4; i += G * 512) z[i] = (f32x4){0.f, 0.f, 0.f, 0.f};
          f32x4* z2 = (f32x4*)VST; const int m4 = 2 * T / 4; for (int i = bx * 512 + tid; i < m4; i += G * 512) z2[i] = (f32x4){0.f, 0.f, 0.f, 0.f}; }
        LAS float* scr = (LAS float*)(lds + wave * 16384);
#define CONVJOB(Wp, K_, ldn_, cs_, nc_, WTp, mode_, roff_, gain_) { const int nblk_ = (nc_) / 32, cnt_ = ((K_) / 64) * nblk_; \
            if (r >= 0 && r < cnt_) conv_item((Wp), (K_), (ldn_), (cs_), nblk_, (bf16_t*)(WTp), (mode_), (roff_), (gain_), scr, r, lane); r -= cnt_; }
        constexpr int NITEMS = 512 + 256 + 256 + 512 + 256 + 256 + 256 + 2 * (4 * 512 + 3 * 1408);
        for (int it = gw; it < NITEMS; it += NGW) {
            int r = it;
            CONVJOB(ap->in[3], 1024, 2048, 0, 1024, ws + WS_WIN0, 0, 0, ap->in[2]);
            CONVJOB(ap->in[3], 1024, 2048, 1024, 512, ws + WS_WIN0, 1, 1024, ap->in[2]);
            CONVJOB(ap->in[3], 1024, 2048, 1536, 512, ws + WS_WIN0, 2, 1024, ap->in[2]);
            CONVJOB(ap->in[10], 1024, 1024, 0, 1024, ws + WS_WOUT0, 0, 0, nullptr);
            CONVJOB(ap->in[12], 1024, 512, 0, 512, ws + WS_WOIN, 0, 0, ap->in[11]);
            CONVJOB(ap->in[21], 512, 2048, 0, 1024, ws + WS_WOOUT, 1, 0, nullptr);
            CONVJOB(ap->in[21], 512, 2048, 1024, 1024, ws + WS_WOOUT, 2, 0, nullptr);
#pragma unroll
            for (int l = 0; l < 2; ++l) {
                CONVJOB(ap->in[24] + (size_t)l * D * D, 1024, 1024, 0, 1024, ws + WS_WQ + l * WSQ_L, 0, 0, ap->in[22] + l * D);
                CONVJOB(ap->in[25] + (size_t)l * D * D, 1024, 1024, 0, 1024, ws + WS_WK + l * WSQ_L, 0, 0, ap->in[23] + l * D);
                CONVJOB(ap->in[26] + (size_t)l * D * D, 1024, 1024, 0, 1024, ws + WS_WV + l * WSQ_L, 0, 0, ap->in[23] + l * D);
                CONVJOB(ap->in[27] + (size_t)l * D * D, 1024, 1024, 0, 1024, ws + WS_WO + l * WSQ_L, 0, 0, nullptr);
                CONVJOB(ap->in[29] + (size_t)l * D * FH, 1024, FH, 0, FH, ws + WS_WGU + l * WGU_L, 1, 0, ap->in[28] + l * D);
                CONVJOB(ap->in[30] + (size_t)l * D * FH, 1024, FH, 0, FH, ws + WS_WGU + l * WGU_L, 2, 0, ap->in[28] + l * D);
                CONVJOB(ap->in[31] + (size_t)l * FH * D, FH, 1024, 0, 1024, ws + WS_WD + l * WD_L, 0, 0, nullptr);
            }
        }
        for (int m = gw; m < T; m += NGW) { const float s = row_to_bf16<false>(x_in + (size_t)m * D, XB + (size_t)m * D, lane); if (lane == 0) SS[m] = s; }
        for (int m = gw; m < MT; m += NGW) (void)row_to_bf16<true>(ap->in[1] + (size_t)m * D, MEMN + (size_t)m * D, lane);
        { bf16_t* GW = (bf16_t*)(ws + WS_GW); const float* w = ap->in[4];
          for (int i = bx * 512 + tid; i < 4 * 128 * 128 / 2; i += G * 512) { const int e = 2 * i, ii = (e >> 7) & 127, jj = e & 127; const bool keep = (jj >> 6) <= (ii >> 6);
              ((unsigned*)GW)[i] = keep ? cvt_pk_bf16(w[e], w[e + 1]) : 0u; } }
        __syncthreads();
        for (int g = G - 1 - bx; g < 32; g += G)
            s5_setup(g, lds, ap->in[13], ap->in[14], ap->in[15], ap->in[16], ap->in[17], ap->in[18], ap->in[19], (bf16_t*)(ws + WS_BT3), (bf16_t*)(ws + WS_GM), (float*)(ws + WS_AL), tid);
        SEAM(0);
    }
    PHASE(1, 1) { const int l = 0; LOCALS
        { pg8::Gemm g{MEMN, (const bf16_t*)(ws + WS_WK), D, D, D, 2, 0, 0, (long)D * D, 0}; pg8::Sched S; S.init(MT / 256, D / 256, 2, G, bx);
          pg8::EpiStore E{KL, D, 2, (long)MT * D, 0, nullptr, 1.0f}; pg8::gemm_phase(lds, g, S, E, tid); }
        { pg8::Gemm g{(const bf16_t*)(ws + WS_WV), MEMN, D, D, D, 2, (long)D * D, 0, 0, 0}; pg8::Sched S; S.init(D / 256, MT / 256, 2, G, (bx + G / 2) % G);
          pg8::EpiStore E{VT, MT, 2, (long)D * MT, 0, nullptr, 1.0f}; pg8::gemm_phase(lds, g, S, E, tid); }
        SEAM(1);
    }
#pragma unroll 1
    for (int l = 0; l < 2; ++l) {
        const int pb = 2 + 12 * l;
        if (l == 0) {
            PHASE(2, pb + 0) { LOCALS
                pg8::Gemm g{XB, (const bf16_t*)(ws + WS_WIN0), D, D, D, 1, 0, 0, 0, 0}; pg8::Sched S; S.init(T / 256, 2048 / 256, 1, G, bx);
                pg8::EpiIn0 E{SSa, U, V, H, VST}; pg8::gemm_phase(lds, g, S, E, tid);
                SEAM(pb + 0);
            }
            PHASE(3, pb + 1) { LOCALS
                for (int i = bx; i < 2048; i += G) {
                    if (i < 1024) gmlp_unit(i, lds, U, V, VST, (const bf16_t*)(ws + WS_GW), ap->in[5], MIX, tid);
                    else conv_unit(i - 1024, lds, H, ap->in[6], ap->in[7], ap->in[8], ap->in[9], MIX, tid);
                }
                SEAM(pb + 1);
            }
            PHASE(4, pb + 2) { LOCALS
                pg8::Gemm g{MIX, (const bf16_t*)(ws + WS_WOUT0), D, D, D, 1, 0, 0, 0, 0}; pg8::Sched S; S.init(T / 256, D / 256, 1, G, bx);
                pg8::EpiRes<false> E{x_in, out, XB, SSa + T}; pg8::gemm_phase(lds, g, S, E, tid);
                SEAM(pb + 2);
            }
        } else {
            PHASE(5, pb + 0) { LOCALS
                pg8::Gemm g{XB, (const bf16_t*)(ws + WS_WOIN), D, D, D, 1, 0, 0, 0, 0}; pg8::Sched S; S.init(T / 256, 512 / 256, 1, G, bx);
                pg8::EpiOin E{SSa, AC}; pg8::gemm_phase(lds, g, S, E, tid);
                SEAM(pb + 0);
            }
            PHASE(6, pb + 1) { LOCALS
                pg8::Gemm g{AC, (const bf16_t*)(ws + WS_GM), AK, 512, 512, 32, (long)NCH * AK, 0, 256L * 512, 0}; pg8::Sched S; S.init(NCH / 256, 1, 32, G, bx);
                pg8::EpiS5State E{XL}; pg8::gemm_phase(lds, g, S, E, tid);
                SEAM(pb + 1);
            }
            PHASE(7, pb + 2) { LOCALS
                if (wave == 0) {
                    const int idx = bx * 64 + lane;
                    if (idx < NB * 32 * 64) { const int p = idx & 63, g = (idx >> 6) & 31, b = idx >> 11;
                        const float* AL = (const float*)(ws + WS_AL); const float ar = AL[(g * 64 + p) * 2], ai = AL[(g * 64 + p) * 2 + 1];
                        const float* xl = XL + (size_t)g * NCH * 128 + (size_t)(b * (SEQ / SL)) * 128; bf16_t* ac = AC + (size_t)g * NCH * AK + (size_t)(b * (SEQ / SL)) * AK + 512;
                        float xr = 0.f, xi = 0.f;
#pragma unroll 1
                        for (int c0 = 0; c0 < SEQ / SL; c0 += 16) { float lr[16], li[16];
#pragma unroll
                            for (int i = 0; i < 16; ++i) { lr[i] = xl[(size_t)(c0 + i) * 128 + p]; li[i] = xl[(size_t)(c0 + i) * 128 + 64 + p]; }
#pragma unroll
                            for (int i = 0; i < 16; ++i) { const unsigned pk = cvt_pk_bf16(xr, xi); ac[(size_t)(c0 + i) * AK + p] = (bf16_t)(pk & 0xffffu); ac[(size_t)(c0 + i) * AK + 64 + p] = (bf16_t)(pk >> 16);
                                const float nr = ar * xr - ai * xi + lr[i], ni = ar * xi + ai * xr + li[i]; xr = nr; xi = ni; } }
                    }
                }
                SEAM(pb + 2);
            }
            PHASE(8, pb + 3) { LOCALS
                pg8::Gemm g{AC, (const bf16_t*)(ws + WS_BT3), AK, AK, AK, 32, (long)NCH * AK, 0, 512L * AK, 0}; pg8::Sched S; S.init(NCH / 256, 2, 32, G, bx);
                pg8::EpiS5Out E{AC, ap->in[20], Y}; pg8::gemm_phase(lds, g, S, E, tid);
                SEAM(pb + 3);
            }
            PHASE(9, pb + 4) { LOCALS
                pg8::Gemm g{Y, (const bf16_t*)(ws + WS_WOOUT), 512, 512, 512, 1, 0, 0, 0, 0}; pg8::Sched S; S.init(T / 256, 2048 / 256, 1, G, bx);
                pg8::EpiRes<true> E{out, out, XB, SSa + T}; pg8::gemm_phase(lds, g, S, E, tid);
                SEAM(pb + 4);
            }
        }
        PHASE(10, pb + 5) { LOCALS
            pg8::Gemm g{XB, (const bf16_t*)(ws + WS_WQ + l * WSQ_L), D, D, D, 1, 0, 0, 0, 0}; pg8::Sched S; S.init(T / 256, D / 256, 1, G, bx);
            pg8::EpiStore E{QO, D, 1, 0, 0, SSa + T, 0.0625f}; pg8::gemm_phase(lds, g, S, E, tid);
            SEAM(pb + 5);
        }
        PHASE(11, pb + 6) { LOCALS
            pg8::Gemm g{QO, KL + (size_t)l * MT * D, D, D, 256, 4, 256, (long)SEQ * D, 256, 256L * D}; pg8::Sched S; S.init(SEQ / 256, 1, 32, G, bx);
            pg8::EpiSoftmax E{Pb}; pg8::gemm_phase(lds, g, S, E, tid);
            SEAM(pb + 6);
        }
        PHASE(12, pb + 7) { LOCALS
            pg8::Gemm g{Pb, VT + (size_t)l * D * MT, 256, MT, 256, 4, (long)SEQ * 256, 4L * SEQ * 256, 256L * MT, 256}; pg8::Sched S; S.init(SEQ / 256, 1, 32, G, bx);
            pg8::EpiStore E{QO, D, 4, 256, (long)SEQ * D, nullptr, 1.0f}; pg8::gemm_phase(lds, g, S, E, tid);
            SEAM(pb + 7);
        }
        PHASE(13, pb + 8) { LOCALS
            pg8::Gemm g{QO, (const bf16_t*)(ws + WS_WO + l * WSQ_L), D, D, D, 1, 0, 0, 0, 0}; pg8::Sched S; S.init(T / 256, D / 256, 1, G, bx);
            pg8::EpiRes<false> E{out, out, XB, SSa + 2 * T}; pg8::gemm_phase(lds, g, S, E, tid);
            SEAM(pb + 8);
        }
        PHASE(14, pb + 9) { LOCALS
            pg8::Gemm g{XB, (const bf16_t*)(ws + WS_WGU + l * WGU_L), D, D, D, 1, 0, 0, 0, 0}; pg8::Sched S; S.init(T / 256, 2 * FH / 256, 1, G, bx);
            pg8::EpiFfn1 E{SSa + 2 * T, HM}; pg8::gemm_phase(lds, g, S, E, tid);
            SEAM(pb + 9);
        }
        PHASE(15, pb + 10) { LOCALS
            pg8::Gemm g{HM, (const bf16_t*)(ws + WS_WD + l * WD_L), FH, FH, FH, 1, 0, 0, 0, 0}; pg8::Sched S; S.init(T / 256, D / 256, 1, G, bx);
            pg8::EpiRes<false> E{out, out, XB, SSa + 3 * T}; pg8::gemm_phase(lds, g, S, E, tid);
            SEAM(pb + 10);
        }
    }
    PHASE(16, 26) { const int l = 0; LOCALS
        const float* ssf = SS + (size_t)6 * T; const f32x4* gf = (const f32x4*)ap->in[32] + lane;
        f32x4 gv[4];
#pragma unroll
        for (int j = 0; j < 4; ++j) gv[j] = gf[64 * j];
        for (int m = gw; m < T; m += NGW) { const float rs = rsqrtf(ssf[m] * (1.0f / D) + EPS); f32x4* xr = (f32x4*)(out + (size_t)m * D) + lane;
#pragma unroll
            for (int j = 0; j < 4; ++j) xr[64 * j] = xr[64 * j] * rs * gv[j]; }
    }
}

extern "C" void kernel_launch(void* const* d_in, const int* in_sizes, int n_in, void* d_out, int out_size, void* d_ws, size_t ws_size, hipStream_t stream) {
    static int grid = 0;
    if (grid == 0) {
        if (n_in != 33 || in_sizes[0] != T * D || out_size != T * D || ws_size < WS_END) { fprintf(stderr, "kernel_launch: unexpected shapes (n_in %d, in0 %d, out %d, ws %zu < %zu)\n", n_in, n_in > 0 ? in_sizes[0] : -1, out_size, ws_size, (size_t)WS_END); grid = -1; return; }
        int dev = 0, cus = 0, per_cu = 0;
        hipGetDevice(&dev); hipDeviceGetAttribute(&cus, hipDeviceAttributeMultiprocessorCount, dev);
        if (hipFuncSetAttribute((const void*)trunk_fwd, hipFuncAttributeMaxDynamicSharedMemorySize, LDS_BYTES) != hipSuccess) { fprintf(stderr, "kernel_launch: hipFuncSetAttribute failed\n"); grid = -1; return; }
        if (hipOccupancyMaxActiveBlocksPerMultiprocessor(&per_cu, (const void*)trunk_fwd, 512, LDS_BYTES) != hipSuccess || per_cu < 1) { fprintf(stderr, "kernel_launch: occupancy query says %d\n", per_cu); per_cu = 1; }
        (void)hipGetLastError();
        grid = cus * 1;
        if (grid <= 0) grid = 256;
    }
    if (grid < 0) return;
    Args a{};
    for (int i = 0; i < 33; ++i) a.in[i] = (const float*)d_in[i];
    a.out = (float*)d_out; a.ws = (unsigned char*)d_ws;
#if !MK_MULTI && !MK_CGSYNC
    (void)hipMemsetAsync((char*)d_ws + WS_BAR, 0, XCD_BAR_WORDS * 4, stream);
#endif
#if MK_MULTI
    for (int p = 0; p < NPHASE; ++p) {
        if (p == 5 || p == 6 || p == 13 || p == 25) continue;
        a.ph_lo = p; a.ph_hi = p + 1; void* kargs[] = {&a};
        hipError_t e = hipLaunchCooperativeKernel((const void*)trunk_fwd, dim3(grid), dim3(512), kargs, LDS_BYTES, stream);
        if (e != hipSuccess) { fprintf(stderr, "kernel_launch: launch of phase %d failed: %s\n", p, hipGetErrorString(e)); break; }
    }
#else
    a.ph_lo = 0; a.ph_hi = NPHASE; void* kargs[] = {&a};
    hipError_t e = hipLaunchCooperativeKernel((const void*)trunk_fwd, dim3(grid), dim3(512), kargs, LDS_BYTES, stream);
    if (e != hipSuccess) fprintf(stderr, "kernel_launch: cooperative launch failed: %s (grid %d)\n", hipGetErrorString(e), grid);
#endif
}
```

```cpp
#include <hip/hip_runtime.h>
#include <hip/hip_cooperative_groups.h>
#include <cstdio>
#include <cstdint>
namespace cg = cooperative_groups;

#ifndef MK_MULTI
#define MK_MULTI 0
#endif
#ifndef MK_ALIGN
#define MK_ALIGN true
#endif
#ifndef MK_CGSYNC
#define MK_CGSYNC 0
#endif

#define LAS __attribute__((address_space(3)))
typedef unsigned short bf16_t;
typedef short bf16x8 __attribute__((ext_vector_type(8)));
typedef float f32x4 __attribute__((ext_vector_type(4)));
typedef float f32x2 __attribute__((ext_vector_type(2)));
typedef unsigned u32x4 __attribute__((ext_vector_type(4)));
typedef unsigned u32x2 __attribute__((ext_vector_type(2)));

constexpr int T = 32768, D = 1024, SEQ = 4096, NB = 8, MT = 2048, FH = 2816;
constexpr float EPS = 1e-6f;
constexpr int SL = 32;
constexpr int NCH = T / SL;
constexpr int AK = SL * 16 + 128;

constexpr size_t MiB = 1u << 20;
constexpr size_t WS_WIN0 = 0, WS_WOUT0 = 4 * MiB, WS_WOIN = 6 * MiB, WS_WOOUT = 7 * MiB, WS_WQ = 9 * MiB, WS_WK = 13 * MiB, WS_WV = 17 * MiB, WS_WO = 21 * MiB;
constexpr size_t WS_WGU = 25 * MiB, WS_WD = 47 * MiB, WS_GW = 58 * MiB, WS_AL = 59 * MiB, WS_BT3 = 60 * MiB, WS_GM = 80 * MiB, WS_MEMN = 88 * MiB, WS_KL = 92 * MiB, WS_VT = 100 * MiB;
constexpr size_t WS_SS = 108 * MiB, WS_VST = 109 * MiB, WS_BAR = 109 * MiB + 512 * 1024, WS_XB = 110 * MiB, WS_QO = 174 * MiB, WS_P = 238 * MiB, WS_R0 = 302 * MiB;
constexpr size_t WS_HM = WS_R0, WS_U = WS_R0, WS_V = WS_R0 + 32 * MiB, WS_H = WS_R0 + 64 * MiB, WS_MIX = WS_R0 + 96 * MiB;
constexpr size_t WS_ACOMB = WS_R0, WS_XLOC = WS_R0 + 40 * MiB, WS_Y = WS_R0 + 56 * MiB;
constexpr size_t WS_END = WS_R0 + 176 * MiB;
constexpr size_t WGU_L = (size_t)2 * FH * D * 2, WD_L = (size_t)D * FH * 2, WSQ_L = (size_t)D * D * 2;

constexpr int RING_BYTES = 131072, XCH_OFF = RING_BYTES, MISC_OFF = RING_BYTES + 8192, LDS_BYTES = 147456;

__device__ __forceinline__ unsigned cvt_pk_bf16(float lo, float hi) { unsigned r; asm volatile("v_cvt_pk_bf16_f32 %0, %1, %2" : "=v"(r) : "v"(lo), "v"(hi)); return r; }
__device__ __forceinline__ float bf2f(unsigned short b) { return __builtin_bit_cast(float, (unsigned)b << 16); }
__device__ __forceinline__ float bflo(unsigned w) { return __builtin_bit_cast(float, w << 16); }
__device__ __forceinline__ float bfhi(unsigned w) { return __builtin_bit_cast(float, w & 0xffff0000u); }
__device__ __forceinline__ float sigmoid_f(float x) { return __builtin_amdgcn_rcpf(1.0f + __expf(-x)); }
__device__ __forceinline__ float silu_f(float x) { return x * sigmoid_f(x); }
__device__ __forceinline__ float gelu_f(float x) { return x * sigmoid_f(1.5957691216f * (x + 0.044715f * x * x * x)); }
__device__ __forceinline__ float wave_sum(float v) {
#pragma unroll
    for (int o = 1; o < 64; o <<= 1) v += __shfl_xor(v, o);
    return v;
}
__device__ __forceinline__ u32x4 pack8(f32x4 a, f32x4 b) { u32x4 w; w.x = cvt_pk_bf16(a[0], a[1]); w.y = cvt_pk_bf16(a[2], a[3]); w.z = cvt_pk_bf16(b[0], b[1]); w.w = cvt_pk_bf16(b[2], b[3]); return w; }

namespace pg8 {
constexpr int BM = 256, BK = 64, HALF = 128, HTB = HALF * BK * 2, NXCD = 8, WGM = 8;
__device__ __forceinline__ int lds_byte(int r, int c) { const int st = (r >> 4) * 2 + (c >> 5), rr = r & 15, cc = c & 31, ob = rr * 64 + cc * 2; return st * 1024 + (ob ^ (((ob >> 9) & 1) << 5)); }
__device__ __forceinline__ void stage_rc(int b, int& R, int& C) { const int st = b / 1024, sb = b % 1024, swz = sb ^ (((sb >> 9) & 1) << 5); R = (st >> 1) * 16 + swz / 64; C = (st & 1) * 32 + (swz % 64) / 2; }
__device__ __forceinline__ int perm32(int rho) { const int n = rho >> 4, i = rho & 15; return 8 * (i >> 2) + 4 * n + (i & 3); }

struct Unit { int pm, pn, z; };
struct Gemm { const bf16_t* A; const bf16_t* Bt; int lda, ldb, K, nz0; long sAz0, sAz1, sBz0, sBz1; };
struct Sched {
    int nM, nN, per, total, G, c;
    __device__ __forceinline__ void init(int nM_, int nN_, int nz, int G_, int c_) { nM = nM_; nN = nN_; per = nM_ * nN_; total = per * nz; G = G_; c = c_; }
    __device__ __forceinline__ bool next(int i, Unit& u) const {
        const long L = (long)i * G + c; if (L >= total) return false;
        const int z = (int)(L / per); int wgid = (int)(L % per);
        { const int q = per / NXCD, r = per % NXCD, xcd = wgid % NXCD, off = wgid / NXCD; wgid = (xcd < r ? xcd * (q + 1) : r * (q + 1) + (xcd - r) * q) + off; }
        const int nig = WGM * nN, gid = wgid / nig, fm = gid * WGM, gsz = (nM - fm) < WGM ? (nM - fm) : WGM;
        u.pm = fm + ((wgid % nig) % gsz); u.pn = (wgid % nig) / gsz; u.z = z; return true;
    }
};

template <bool ALIGN, class Epi>
__device__ __forceinline__ void gemm_phase(LAS unsigned char* lds, const Gemm g, const Sched& S, const Epi& E, const int tid) {
    const int wid = __builtin_amdgcn_readfirstlane(tid >> 6), lane = tid & 63, wr = wid >> 2, wc = wid & 3, fr = lane & 15, fq = lane >> 4;
    const int nt = g.K / BK;
    unsigned voffA[2], voffB[2];
#pragma unroll
    for (int i = 0; i < 2; ++i) { int R, C; stage_rc(tid * 16 + i * 8192, R, C); const int Rb = (R & ~31) + perm32(R & 31);
        voffA[i] = (unsigned)(R * g.lda + C) * 2u; voffB[i] = (unsigned)(Rb * g.ldb + C) * 2u; }
    const size_t kstep = (size_t)(BK * 2);
    const size_t hsA = (size_t)HALF * g.lda * 2, hsB = (size_t)HALF * g.ldb * 2;
    const unsigned ldsw = (unsigned)wid * 1024u;
    const int aoff = lds_byte(wr * 64 + fr, fq * 8), boff = lds_byte(wc * 32 + fr, fq * 8);
#define PG8_SA(b, h) (((b) * 2 + (h)) * HTB)
#define PG8_SB(b, h) ((4 + (b) * 2 + (h)) * HTB)
#define PG8_STAGE(bufoff, gbase, voff) do { _Pragma("unroll") for (int _i = 0; _i < 2; ++_i) \
        __builtin_amdgcn_global_load_lds((const unsigned*)((const char*)(gbase) + (voff)[_i]), (LAS unsigned*)(lds + (bufoff) + ldsw + _i * 8192), 16, 0, 0); } while (0)
#define PG8_LDA(dst, b, h) do { _Pragma("unroll") for (int m = 0; m < 4; ++m) _Pragma("unroll") for (int k = 0; k < 2; ++k) dst[m][k] = *(const LAS bf16x8*)(lds + PG8_SA(b, h) + aoff + m * 2048 + k * 1024); } while (0)
#define PG8_LDB(dst, b, h) do { _Pragma("unroll") for (int n = 0; n < 2; ++n) _Pragma("unroll") for (int k = 0; k < 2; ++k) dst[n][k] = *(const LAS bf16x8*)(lds + PG8_SB(b, h) + boff + n * 2048 + k * 1024); } while (0)
#define PG8_MMA(ai, bj, At, Bt) do { __builtin_amdgcn_s_setprio(1); _Pragma("unroll") for (int m = 0; m < 4; ++m) _Pragma("unroll") for (int n = 0; n < 2; ++n) _Pragma("unroll") for (int k = 0; k < 2; ++k) \
        acc[ai][bj][m][n] = __builtin_amdgcn_mfma_f32_16x16x32_bf16(Bt[n][k], At[m][k], acc[ai][bj][m][n], 0, 0, 0); __builtin_amdgcn_s_setprio(0); } while (0)
#define PG8_WAIT_V(n) asm volatile("s_waitcnt vmcnt(" #n ")" ::: "memory")
#define PG8_WAIT_L(n) asm volatile("s_waitcnt lgkmcnt(" #n ")" ::: "memory")
#define PG8_BAR __builtin_amdgcn_s_barrier()
#define PG8_SCHED __builtin_amdgcn_sched_barrier(0)
#define PG8_UA(u) ((const char*)g.A + 2 * ((size_t)((u).z % g.nz0) * g.sAz0 + (size_t)((u).z / g.nz0) * g.sAz1 + (size_t)(u).pm * BM * g.lda))
#define PG8_UB(u) ((const char*)g.Bt + 2 * ((size_t)((u).z % g.nz0) * g.sBz0 + (size_t)((u).z / g.nz0) * g.sBz1 + (size_t)(u).pn * BM * g.ldb))
    Unit cur, nxt; int ui = 0;
    if (!S.next(0, cur)) return;
    f32x4 acc[2][2][4][2];
#pragma unroll
    for (int a = 0; a < 2; ++a)
#pragma unroll
        for (int b = 0; b < 2; ++b)
#pragma unroll
            for (int m = 0; m < 4; ++m)
#pragma unroll
                for (int n = 0; n < 2; ++n) acc[a][b][m][n] = (f32x4){0.f, 0.f, 0.f, 0.f};
    bf16x8 At[4][2], B0[2][2], B1[2][2];
    const char* cA = PG8_UA(cur); const char* cB = PG8_UB(cur);
    PG8_STAGE(PG8_SB(0, 0), cB, voffB); PG8_STAGE(PG8_SB(0, 1), cB + hsB, voffB); PG8_STAGE(PG8_SA(0, 0), cA, voffA); PG8_STAGE(PG8_SA(0, 1), cA + hsA, voffA);
    if (wr == 1) PG8_BAR;
    PG8_WAIT_V(2); PG8_BAR;
    PG8_STAGE(PG8_SB(1, 0), cB + kstep, voffB); PG8_STAGE(PG8_SA(1, 0), cA + kstep, voffA); PG8_STAGE(PG8_SB(1, 1), cB + hsB + kstep, voffB);
    PG8_WAIT_V(6); PG8_BAR;
    for (;;) {
        const bool has_next = S.next(ui + 1, nxt);
        const char* nA = has_next ? PG8_UA(nxt) : cA; const char* nB = has_next ? PG8_UB(nxt) : cB;
        for (int t = 0; t < nt; t += 2) {
            const bool last = (t == nt - 2);
            const char* a1 = cA + (size_t)(t + 1) * kstep;
            const char* a2 = last ? nA : cA + (size_t)(t + 2) * kstep; const char* b2 = last ? nB : cB + (size_t)(t + 2) * kstep;
            const char* a3 = a2 + kstep; const char* b3 = b2 + kstep;
            PG8_LDB(B0, 0, 0); PG8_LDB(B1, 0, 1); PG8_SCHED; PG8_LDA(At, 0, 0); PG8_STAGE(PG8_SA(1, 1), a1 + hsA, voffA);
            PG8_WAIT_V(8); PG8_WAIT_L(0); PG8_BAR; PG8_MMA(0, 0, At, B0); PG8_MMA(0, 1, At, B1); PG8_BAR; PG8_SCHED;
            PG8_LDA(At, 0, 1); PG8_STAGE(PG8_SB(0, 0), b2, voffB); PG8_STAGE(PG8_SB(0, 1), b2 + hsB, voffB); PG8_STAGE(PG8_SA(0, 0), a2, voffA);
            PG8_WAIT_V(8); PG8_WAIT_L(0); PG8_BAR; PG8_MMA(1, 0, At, B0); PG8_MMA(1, 1, At, B1); PG8_BAR; PG8_SCHED;
            PG8_LDB(B0, 1, 0); PG8_LDB(B1, 1, 1); PG8_SCHED; PG8_LDA(At, 1, 0); PG8_STAGE(PG8_SA(0, 1), a2 + hsA, voffA);
            PG8_WAIT_V(8); PG8_WAIT_L(0); PG8_BAR; PG8_MMA(0, 0, At, B0); PG8_MMA(0, 1, At, B1); PG8_BAR; PG8_SCHED;
            PG8_LDA(At, 1, 1); PG8_STAGE(PG8_SB(1, 0), b3, voffB); PG8_STAGE(PG8_SB(1, 1), b3 + hsB, voffB); PG8_STAGE(PG8_SA(1, 0), a3, voffA);
            PG8_WAIT_V(8); PG8_WAIT_L(0); PG8_BAR; PG8_MMA(1, 0, At, B0); PG8_MMA(1, 1, At, B1); PG8_BAR; PG8_SCHED;
        }
        if (ALIGN) { if (wr == 0) PG8_BAR; }
        E(acc, cur, wr, wc, fr, fq, lds);
        if (!has_next) break;
#pragma unroll
        for (int a = 0; a < 2; ++a)
#pragma unroll
            for (int b = 0; b < 2; ++b)
#pragma unroll
                for (int m = 0; m < 4; ++m)
#pragma unroll
                    for (int n = 0; n < 2; ++n) acc[a][b][m][n] = (f32x4){0.f, 0.f, 0.f, 0.f};
        cur = nxt; cA = nA; cB = nB; ++ui;
        if (ALIGN) { if (wr == 1) PG8_BAR; }
    }
    PG8_WAIT_V(0);
    if (!ALIGN) { if (wr == 0) PG8_BAR; }
    PG8_BAR;
#undef PG8_SA
#undef PG8_SB
#undef PG8_STAGE
#undef PG8_LDA
#undef PG8_LDB
#undef PG8_MMA
#undef PG8_UA
#undef PG8_UB
}

typedef f32x4 Acc[2][2][4][2];
#define EPI_ARGS Acc& acc, const Unit& u, int wr, int wc, int fr, int fq, LAS unsigned char* lds
__device__ __forceinline__ int efence() { asm volatile("" ::: "memory"); return 1; }
#define ROWLOOP _Pragma("unroll") for (int ai = 0; ai < 2; ++ai) _Pragma("unroll") for (int m = 0; m < 4; ++m) for (int once_ = efence(); once_; once_ = 0)

struct EpiIn0 {
    const float* ss; bf16_t* U; bf16_t* V; bf16_t* H; float* vst;
    __device__ __forceinline__ void operator()(EPI_ARGS) const {
        const int row0 = u.pm * 256 + wr * 64 + fr;
        if (u.pn < 4) {
            bf16_t* dst = (u.pn < 2) ? U : V; const int col0 = (u.pn & 1) * 256 + wc * 32 + 8 * fq; const bool st = u.pn >= 2;
            ROWLOOP { const int row = row0 + ai * 128 + m * 16; const float rs = rsqrtf(ss[row] * (1.0f / D) + EPS); float s = 0.f, q = 0.f;
#pragma unroll
                for (int bj = 0; bj < 2; ++bj) { f32x4 v0 = acc[ai][bj][m][0] * rs, v1 = acc[ai][bj][m][1] * rs;
#pragma unroll
                    for (int e = 0; e < 4; ++e) { v0[e] = gelu_f(v0[e]); v1[e] = gelu_f(v1[e]); s += v0[e] + v1[e]; q += v0[e] * v0[e] + v1[e] * v1[e]; }
                    *(u32x4*)(dst + (size_t)row * 512 + col0 + bj * 128) = pack8(v0, v1); }
                if (st) { s += __shfl_xor(s, 16); s += __shfl_xor(s, 32); q += __shfl_xor(q, 16); q += __shfl_xor(q, 32);
                    if (fq == 0) { unsafeAtomicAdd(vst + 2 * row, s); unsafeAtomicAdd(vst + 2 * row + 1, q); } }
            }
        } else {
            const int col0 = (u.pn - 4) * 128 + wc * 32 + 8 * fq;
            ROWLOOP { const int row = row0 + ai * 128 + m * 16; const float rs = rsqrtf(ss[row] * (1.0f / D) + EPS); f32x4 h0, h1;
#pragma unroll
                for (int e = 0; e < 4; ++e) { h0[e] = acc[ai][0][m][0][e] * rs * sigmoid_f(acc[ai][1][m][0][e] * rs); h1[e] = acc[ai][0][m][1][e] * rs * sigmoid_f(acc[ai][1][m][1][e] * rs); }
                *(u32x4*)(H + (size_t)row * 512 + col0) = pack8(h0, h1); }
        }
    }
};
template <bool GLU> struct EpiRes {
    const float* base; float* out; bf16_t* xb; float* ss;
    __device__ __forceinline__ void operator()(EPI_ARGS) const {
        const int row0 = u.pm * 256 + wr * 64 + fr;
        ROWLOOP { const int row = row0 + ai * 128 + m * 16; float q = 0.f;
            if (GLU) { const size_t off = (size_t)row * D + u.pn * 128 + wc * 32 + 8 * fq;
                f32x4 o0 = *(const f32x4*)(base + off), o1 = *(const f32x4*)(base + off + 4);
#pragma unroll
                for (int e = 0; e < 4; ++e) { o0[e] += acc[ai][0][m][0][e] * sigmoid_f(acc[ai][1][m][0][e]); o1[e] += acc[ai][0][m][1][e] * sigmoid_f(acc[ai][1][m][1][e]);
                    q += o0[e] * o0[e] + o1[e] * o1[e]; }
                *(f32x4*)(out + off) = o0; *(f32x4*)(out + off + 4) = o1; *(u32x4*)(xb + off) = pack8(o0, o1);
            } else {
#pragma unroll
                for (int bj = 0; bj < 2; ++bj) { const size_t off = (size_t)row * D + u.pn * 256 + bj * 128 + wc * 32 + 8 * fq;
                    f32x4 o0 = *(const f32x4*)(base + off) + acc[ai][bj][m][0], o1 = *(const f32x4*)(base + off + 4) + acc[ai][bj][m][1];
#pragma unroll
                    for (int e = 0; e < 4; ++e) q += o0[e] * o0[e] + o1[e] * o1[e];
                    *(f32x4*)(out + off) = o0; *(f32x4*)(out + off + 4) = o1; *(u32x4*)(xb + off) = pack8(o0, o1); }
            }
            q += __shfl_xor(q, 16); q += __shfl_xor(q, 32);
            if (fq == 0) unsafeAtomicAdd(ss + row, q);
            if (m & 1) asm volatile("" ::: "memory");
        }
    }
};
struct EpiStore {
    bf16_t* O; int ldc, nz0; long sz0, sz1; const float* ss; float scale;
    __device__ __forceinline__ void operator()(EPI_ARGS) const {
        bf16_t* base = O + (size_t)(u.z % nz0) * sz0 + (size_t)(u.z / nz0) * sz1; const int row0 = u.pm * 256 + wr * 64 + fr, col0 = u.pn * 256 + wc * 32 + 8 * fq;
        ROWLOOP { const int row = row0 + ai * 128 + m * 16; const float rs = ss ? rsqrtf(ss[row] * (1.0f / D) + EPS) * scale : scale;
#pragma unroll
            for (int bj = 0; bj < 2; ++bj) *(u32x4*)(base + (size_t)row * ldc + col0 + bj * 128) = pack8(acc[ai][bj][m][0] * rs, acc[ai][bj][m][1] * rs); }
    }
};
struct EpiSoftmax {
    bf16_t* P;
    __device__ __forceinline__ void operator()(EPI_ARGS) const {
        LAS float* X = (LAS float*)(lds + XCH_OFF); LAS float* Y = X + 1024;
        ROWLOOP { const int r = ai * 128 + wr * 64 + m * 16 + fr; float mx = -3.0e38f;
#pragma unroll
            for (int bj = 0; bj < 2; ++bj)
#pragma unroll
                for (int n = 0; n < 2; ++n)
#pragma unroll
                    for (int e = 0; e < 4; ++e) mx = fmaxf(mx, acc[ai][bj][m][n][e]);
            mx = fmaxf(mx, __shfl_xor(mx, 16)); mx = fmaxf(mx, __shfl_xor(mx, 32));
            if (fq == 0) X[r * 4 + wc] = mx; }
        asm volatile("s_waitcnt lgkmcnt(0)" ::: "memory"); __builtin_amdgcn_s_barrier(); asm volatile("" ::: "memory");
        ROWLOOP { const int r = ai * 128 + wr * 64 + m * 16 + fr; const f32x4 xm = *(const LAS f32x4*)(X + r * 4); const float mx = fmaxf(fmaxf(xm[0], xm[1]), fmaxf(xm[2], xm[3])); float s = 0.f;
#pragma unroll
            for (int bj = 0; bj < 2; ++bj)
#pragma unroll
                for (int n = 0; n < 2; ++n)
#pragma unroll
                    for (int e = 0; e < 4; ++e) { const float p = __expf(acc[ai][bj][m][n][e] - mx); acc[ai][bj][m][n][e] = p; s += p; }
            s += __shfl_xor(s, 16); s += __shfl_xor(s, 32);
            if (fq == 0) Y[r * 4 + wc] = s; }
        asm volatile("s_waitcnt lgkmcnt(0)" ::: "memory"); __builtin_amdgcn_s_barrier(); asm volatile("" ::: "memory");
        bf16_t* base = P + (size_t)u.z * SEQ * 256;
        ROWLOOP { const int r = ai * 128 + wr * 64 + m * 16 + fr; const f32x4 ys = *(const LAS f32x4*)(Y + r * 4); const float inv = 1.0f / ((ys[0] + ys[1]) + (ys[2] + ys[3]));
#pragma unroll
            for (int bj = 0; bj < 2; ++bj) *(u32x4*)(base + (size_t)(u.pm * 256 + r) * 256 + bj * 128 + wc * 32 + 8 * fq) = pack8(acc[ai][bj][m][0] * inv, acc[ai][bj][m][1] * inv); }
    }
};
struct EpiFfn1 {
    const float* ss; bf16_t* HM;
    __device__ __forceinline__ void operator()(EPI_ARGS) const {
        const int row0 = u.pm * 256 + wr * 64 + fr, col0 = u.pn * 128 + wc * 32 + 8 * fq;
        ROWLOOP { const int row = row0 + ai * 128 + m * 16; const float rs = rsqrtf(ss[row] * (1.0f / D) + EPS); f32x4 h0, h1;
#pragma unroll
            for (int e = 0; e < 4; ++e) { h0[e] = silu_f(acc[ai][0][m][0][e] * rs) * (acc[ai][1][m][0][e] * rs); h1[e] = silu_f(acc[ai][0][m][1][e] * rs) * (acc[ai][1][m][1][e] * rs); }
            *(u32x4*)(HM + (size_t)row * FH + col0) = pack8(h0, h1); }
    }
};
struct EpiOin {
    const float* ss; bf16_t* AC;
    __device__ __forceinline__ void operator()(EPI_ARGS) const {
        const int row0 = u.pm * 256 + wr * 64 + fr;
        ROWLOOP { const int row = row0 + ai * 128 + m * 16; const float rs = rsqrtf(ss[row] * (1.0f / D) + EPS);
#pragma unroll
            for (int bj = 0; bj < 2; ++bj) { const int col = u.pn * 256 + bj * 128 + wc * 32 + 8 * fq;
                *(u32x4*)(AC + (size_t)(col >> 4) * NCH * AK + (size_t)(row / SL) * AK + (row % SL) * 16 + (col & 8)) = pack8(acc[ai][bj][m][0] * rs, acc[ai][bj][m][1] * rs); } }
    }
};
struct EpiS5State {
    float* XL;
    __device__ __forceinline__ void operator()(EPI_ARGS) const {
        const int row0 = u.pm * 256 + wr * 64 + fr, col0 = wc * 32 + 8 * fq;
        ROWLOOP { const int row = row0 + ai * 128 + m * 16; float* p = XL + (size_t)u.z * NCH * 128 + (size_t)row * 128 + col0;
            *(f32x4*)p = acc[ai][0][m][0]; *(f32x4*)(p + 4) = acc[ai][0][m][1]; }
    }
};
struct EpiS5Out {
    const bf16_t* AC; const float* dsk; bf16_t* Y;
    __device__ __forceinline__ void operator()(EPI_ARGS) const {
        const int g = u.z, row0 = u.pm * 256 + wr * 64 + fr;
        ROWLOOP { const int row = row0 + ai * 128 + m * 16;
#pragma unroll
            for (int bj = 0; bj < 2; ++bj) { const int col = u.pn * 256 + bj * 128 + wc * 32 + 8 * fq, k = col >> 4, ch = g * 16 + (col & 8);
                const u32x4 uu = *(const u32x4*)(AC + (size_t)g * NCH * AK + (size_t)row * AK + col);
                const f32x4 d0 = *(const f32x4*)(dsk + ch), d1 = *(const f32x4*)(dsk + ch + 4);
                f32x4 y0 = acc[ai][bj][m][0], y1 = acc[ai][bj][m][1];
                y0[0] += d0[0] * bflo(uu.x); y0[1] += d0[1] * bfhi(uu.x); y0[2] += d0[2] * bflo(uu.y); y0[3] += d0[3] * bfhi(uu.y);
                y1[0] += d1[0] * bflo(uu.z); y1[1] += d1[1] * bfhi(uu.z); y1[2] += d1[2] * bflo(uu.w); y1[3] += d1[3] * bfhi(uu.w);
#pragma unroll
                for (int e = 0; e < 4; ++e) { y0[e] = gelu_f(y0[e]); y1[e] = gelu_f(y1[e]); }
                *(u32x4*)(Y + (size_t)(row * SL + k) * 512 + ch) = pack8(y0, y1); } }
    }
};
}

#define XB_TMO      128
#define XB_XCNT(j)  (256  + 64 * (j))
#define XB_XSUB(j)  (1280 + 64 * (j))
#define XB_XGEN(j)  (2304 + 64 * (j))
#define XB_TOP      3328
#define XB_TOPGEN   3392
#define XCD_BAR_WORDS 3456
#define XB_SPIN_CAP (1u << 22)
__device__ __forceinline__ unsigned xb_ld(unsigned* p)              { return __hip_atomic_load(p, __ATOMIC_RELAXED, __HIP_MEMORY_SCOPE_AGENT); }
__device__ __forceinline__ unsigned xb_add(unsigned* p, unsigned v) { return __hip_atomic_fetch_add(p, v, __ATOMIC_RELAXED, __HIP_MEMORY_SCOPE_AGENT); }
__device__ __forceinline__ unsigned xb_xcc_id() { return (unsigned)__builtin_amdgcn_s_getreg((3 << 11) | 20) & 0xFu; }
#define XB_SPIN(cond, bar) do { unsigned _sp = 0; while (cond) { __builtin_amdgcn_s_sleep(1); \
    if ((++_sp & 255u) == 0u) { if (xb_ld(&(bar)[XB_TMO])) break; if (_sp > XB_SPIN_CAP) { atomicAdd(&(bar)[XB_TMO], 1u); break; } } } } while (0)
struct XcdBarrier { unsigned* bar; unsigned x; volatile LAS unsigned* st; };
__device__ __forceinline__ XcdBarrier xcd_barrier_post(unsigned* bar, volatile LAS unsigned* st) {
    XcdBarrier b; b.bar = bar; b.x = xb_xcc_id(); b.st = st;
    if (threadIdx.x == 0) (void)xb_add(&bar[XB_XCNT(b.x)], 1u);
    return b;
}
__device__ __forceinline__ void xcd_barrier_complete(unsigned* bar, unsigned x, unsigned& nloc, unsigned& nx) {
    const unsigned G = gridDim.x * gridDim.y * gridDim.z;
    unsigned sum, cnt, mine, sp = 0u;
    for (;;) {
        sum = 0u; cnt = 0u; mine = 0u;
#pragma unroll
        for (unsigned j = 0; j < 16; ++j) { const unsigned c = xb_ld(&bar[XB_XCNT(j)]); sum += c; cnt += (c > 0u) ? 1u : 0u; mine = (j == x) ? c : mine; }
        if (sum == G) break;
        __builtin_amdgcn_s_sleep(1);
        if ((++sp & 255u) == 0u) { if (xb_ld(&bar[XB_TMO])) break; if (sp > XB_SPIN_CAP) { atomicAdd(&bar[XB_TMO], 1u); break; } }
    }
    nloc = mine > 0u ? mine : 1u; nx = cnt > 0u ? cnt : 1u;
}
__device__ __forceinline__ void xcd_barrier(const XcdBarrier& b) {
    asm volatile("s_waitcnt vmcnt(0)" ::: "memory");
    __syncthreads();
    if (threadIdx.x == 0) {
        unsigned* bar = b.bar;
        __builtin_amdgcn_s_waitcnt(0);
        unsigned nloc = b.st[0], nx = b.st[1];
        if (nloc == 0u) { xcd_barrier_complete(bar, b.x, nloc, nx); b.st[0] = nloc; b.st[1] = nx; }
        const unsigned old = xb_add(&bar[XB_XSUB(b.x)], 1u);
        const unsigned gen = old / nloc;
        if (old + 1u == (gen + 1u) * nloc) {
            __builtin_amdgcn_fence(__ATOMIC_RELEASE, "agent");
            asm volatile("s_waitcnt vmcnt(0)" ::: "memory");
            const unsigned og = xb_add(&bar[XB_TOP], 1u);
            const unsigned tg = og / nx;
            if (og + 1u == (tg + 1u) * nx) xb_add(&bar[XB_TOPGEN], 1u);
            else XB_SPIN(xb_ld(&bar[XB_TOPGEN]) == tg, bar);
            __builtin_amdgcn_fence(__ATOMIC_ACQUIRE, "agent");
            xb_add(&bar[XB_XGEN(b.x)], 1u);
            asm volatile("s_waitcnt vmcnt(0)" ::: "memory");
        } else {
            XB_SPIN(xb_ld(&bar[XB_XGEN(b.x)]) == gen, bar);
            __builtin_amdgcn_fence(__ATOMIC_ACQUIRE, "agent");
            asm volatile("s_waitcnt vmcnt(0)" ::: "memory");
        }
    }
    __syncthreads();
}

__device__ __forceinline__ void conv_item(const float* W, int K, int ldn, int cs, int nblk, bf16_t* WT, int mode, int roff, const float* gain, LAS float* scr, int item, int lane) {
    const int kb = item / nblk, nb = item % nblk, k0 = 64 * kb, c0 = 32 * nb;
#pragma unroll
    for (int i = 0; i < 32; ++i) { const int kk = 2 * i + (lane >> 5); const float gk = gain ? gain[k0 + kk] : 1.0f; scr[kk * 33 + (lane & 31)] = W[(size_t)(k0 + kk) * ldn + cs + c0 + (lane & 31)] * gk; }
    asm volatile("s_waitcnt lgkmcnt(0)" ::: "memory");
    const int c = lane & 7; const int drow = roff + (mode == 0 ? c0 : ((c0 >> 7) * 256 + (mode - 1) * 128 + (c0 & 127)));
#pragma unroll
    for (int j = 0; j < 4; ++j) { const int n = (lane >> 3) + 8 * j; const LAS float* s = scr + (8 * c) * 33 + n;
        u32x4 o; o.x = cvt_pk_bf16(s[0 * 33], s[1 * 33]); o.y = cvt_pk_bf16(s[2 * 33], s[3 * 33]); o.z = cvt_pk_bf16(s[4 * 33], s[5 * 33]); o.w = cvt_pk_bf16(s[6 * 33], s[7 * 33]);
        *(u32x4*)(WT + (size_t)(drow + n) * K + k0 + 8 * c) = o; }
    asm volatile("s_waitcnt lgkmcnt(0)" ::: "memory");
}
template <bool NORM, int R> __device__ __forceinline__ void rows_to_bf16(const float* x0, bf16_t* o0, float* ssq, int lane) {
    f32x4 v[R][4]; float s[R];
#pragma unroll
    for (int r = 0; r < R; ++r) { const f32x4* xr = (const f32x4*)(x0 + (size_t)r * D) + lane;
#pragma unroll
        for (int j = 0; j < 4; ++j) v[r][j] = xr[64 * j]; }
#pragma unroll
    for (int r = 0; r < R; ++r) { float a = 0.f;
#pragma unroll
        for (int j = 0; j < 4; ++j) a += (v[r][j][0] * v[r][j][0] + v[r][j][1] * v[r][j][1]) + (v[r][j][2] * v[r][j][2] + v[r][j][3] * v[r][j][3]);
        s[r] = wave_sum(a); }
#pragma unroll
    for (int r = 0; r < R; ++r) { const float rs = NORM ? rsqrtf(s[r] * (1.0f / D) + EPS) : 1.0f; u32x2* o = (u32x2*)(o0 + (size_t)r * D) + lane;
#pragma unroll
        for (int j = 0; j < 4; ++j) { u32x2 w; w.x = cvt_pk_bf16(v[r][j][0] * rs, v[r][j][1] * rs); w.y = cvt_pk_bf16(v[r][j][2] * rs, v[r][j][3] * rs); o[64 * j] = w; }
        if (ssq && lane == 0) ssq[r] = s[r]; }
}
__device__ __forceinline__ void cis_f(float ang, float& c, float& s) {
    float rev = ang * 0.15915494309189535f; rev = rev - rintf(rev);
    const float x = rev * 6.283185307179586f;
    const float h = x * 0.25f, h2 = h * h;
    float sh = h * (1.0f + h2 * (-1.6666667e-1f + h2 * (8.3333333e-3f + h2 * (-1.9841270e-4f + h2 * 2.7557319e-6f))));
    float ch = 1.0f + h2 * (-0.5f + h2 * (4.1666667e-2f + h2 * (-1.3888889e-3f + h2 * (2.4801587e-5f + h2 * -2.7557319e-7f))));
    float s2 = 2.f * sh * ch, c2 = 1.f - 2.f * sh * sh;
    s = 2.f * s2 * c2; c = 1.f - 2.f * s2 * s2;
}
__device__ __forceinline__ void s5_setup(int g, LAS unsigned char* lds, const float* lam_re, const float* lam_im, const float* log_dt, const float* b_re, const float* b_im, const float* c_re, const float* c_im,
                                         bf16_t* BT3, bf16_t* GM, float* AL, int tid) {
    LAS float* pwr = (LAS float*)lds; LAS float* pwi = pwr + 33 * 64; LAS float* Bbr = pwi + 33 * 64; LAS float* Bbi = Bbr + 1024; LAS float* Cr = Bbi + 1024; LAS float* Ci = Cr + 1024; LAS float* Kd = Ci + 1024;
    const float dt = __expf(log_dt[g]);
    for (int idx = tid; idx < 33 * 64; idx += 512) { const int d = idx >> 6, p = idx & 63; const float lr = lam_re[g * 64 + p], li = lam_im[g * 64 + p];
        const float mag = __expf(lr * dt * (float)d); float c, s; cis_f(li * dt * (float)d, c, s); pwr[idx] = mag * c; pwi[idx] = mag * s; }
    for (int idx = tid; idx < 1024; idx += 512) { const int p = idx >> 4; const float lr = lam_re[g * 64 + p], li = lam_im[g * 64 + p];
        const float mag = __expf(lr * dt); float c, s; cis_f(li * dt, c, s); const float ar = mag * c, ai = mag * s, den = lr * lr + li * li;
        const float qr = ((ar - 1.0f) * lr + ai * li) / den, qi = (ai * lr - (ar - 1.0f) * li) / den;
        const float br = b_re[g * 1024 + idx], bi = b_im[g * 1024 + idx];
        Bbr[idx] = qr * br - qi * bi; Bbi[idx] = qr * bi + qi * br;
        Cr[idx] = c_re[g * 1024 + idx]; Ci[idx] = c_im[g * 1024 + idx]; }
    __syncthreads();
    for (int idx = tid; idx < 32 * 256; idx += 512) { const int d = idx >> 8, co = (idx >> 4) & 15, ci = idx & 15; float a = 0.f;
        for (int p = 0; p < 64; ++p) { const float cr = Cr[co * 64 + p], cim = Ci[co * 64 + p], pr = pwr[d * 64 + p], pi = pwi[d * 64 + p];
            const float tr = cr * pr - cim * pi, ti = cr * pi + cim * pr; a += tr * Bbr[p * 16 + ci] - ti * Bbi[p * 16 + ci]; }
        Kd[idx] = a; }
    __syncthreads();
    bf16_t* bt = BT3 + (size_t)g * 512 * AK;
    for (int idx = tid; idx < 512 * (AK / 8); idx += 512) { const int n = idx / (AK / 8), q = idx % (AK / 8), kk0 = q * 8, k = n >> 4, co = n & 15; float v[8];
        if (kk0 < 512) { const int j = kk0 >> 4, ci0 = kk0 & 15;
#pragma unroll
            for (int e = 0; e < 8; ++e) v[e] = (j <= k) ? Kd[(k - j) * 256 + co * 16 + ci0 + e] : 0.f;
        } else { const int p0 = kk0 - 512;
#pragma unroll
            for (int e = 0; e < 8; ++e) { const int p = (p0 & 63) + e; const float cr = Cr[co * 64 + p], cim = Ci[co * 64 + p], pr = pwr[(k + 1) * 64 + p], pi = pwi[(k + 1) * 64 + p];
                v[e] = (p0 < 64) ? (cr * pr - cim * pi) : -(cr * pi + cim * pr); } }
        u32x4 w; w.x = cvt_pk_bf16(v[0], v[1]); w.y = cvt_pk_bf16(v[2], v[3]); w.z = cvt_pk_bf16(v[4], v[5]); w.w = cvt_pk_bf16(v[6], v[7]);
        *(u32x4*)(bt + (size_t)n * AK + kk0) = w; }
    bf16_t* gm = GM + (size_t)g * 256 * 512;
    for (int idx = tid; idx < 256 * 64; idx += 512) { const int n = idx >> 6, q = idx & 63, kk0 = q * 8; float v[8];
        if (n < 128) { const int p = n & 63, j = kk0 >> 4, ci0 = kk0 & 15; const float pr = pwr[(SL - 1 - j) * 64 + p], pi = pwi[(SL - 1 - j) * 64 + p];
#pragma unroll
            for (int e = 0; e < 8; ++e) { const float br = Bbr[p * 16 + ci0 + e], bi = Bbi[p * 16 + ci0 + e]; v[e] = (n < 64) ? (pr * br - pi * bi) : (pr * bi + pi * br); }
        } else {
#pragma unroll
            for (int e = 0; e < 8; ++e) v[e] = 0.f; }
        u32x4 w; w.x = cvt_pk_bf16(v[0], v[1]); w.y = cvt_pk_bf16(v[2], v[3]); w.z = cvt_pk_bf16(v[4], v[5]); w.w = cvt_pk_bf16(v[6], v[7]);
        *(u32x4*)(gm + (size_t)n * 512 + kk0) = w; }
    if (tid < 64) { AL[(g * 64 + tid) * 2] = pwr[SL * 64 + tid]; AL[(g * 64 + tid) * 2 + 1] = pwi[SL * 64 + tid]; }
    __syncthreads();
}

__device__ __forceinline__ void gmlp_unit(int unit, LAS unsigned char* lds, const bf16_t* U, const bf16_t* V, const float* vst, const bf16_t* GW, const float* gb, bf16_t* MIX, int tid) {
    const int g = unit & 3, t0 = (unit >> 2) * 128, lane = tid & 63, wid = tid >> 6;
    LAS bf16_t* vT = (LAS bf16_t*)lds;
#pragma unroll
    for (int e = 0; e < 4; ++e) { const int q = tid + 512 * e, j = q >> 4, c8 = (q & 15) * 8;
        const u32x4 raw = *(const u32x4*)(V + (size_t)(t0 + j) * 512 + g * 128 + c8);
        const float s = vst[2 * (t0 + j)], ss = vst[2 * (t0 + j) + 1], mean = s * (1.0f / 512.0f), var = ss * (1.0f / 512.0f) - mean * mean, rstd = rsqrtf(fmaxf(var, 0.f) + EPS);
        float v[8] = {bflo(raw.x), bfhi(raw.x), bflo(raw.y), bfhi(raw.y), bflo(raw.z), bfhi(raw.z), bflo(raw.w), bfhi(raw.w)};
#pragma unroll
        for (int i = 0; i < 8; i += 2) { const unsigned pk = cvt_pk_bf16((v[i] - mean) * rstd, (v[i + 1] - mean) * rstd); vT[(c8 + i) * 136 + j] = (bf16_t)(pk & 0xffffu); vT[(c8 + i + 1) * 136 + j] = (bf16_t)(pk >> 16); } }
    __syncthreads();
    const int il = lane & 15, kq = lane >> 4, i = wid * 16 + il;
    bf16x8 wf[4];
#pragma unroll
    for (int ks = 0; ks < 4; ++ks) wf[ks] = *(const bf16x8*)(GW + (size_t)g * 16384 + (size_t)i * 128 + ks * 32 + kq * 8);
    const float bias = gb[g * 128 + i];
#pragma unroll 2
    for (int nt = 0; nt < 8; ++nt) { f32x4 a = {0.f, 0.f, 0.f, 0.f};
#pragma unroll
        for (int ks = 0; ks < 4; ++ks) { const bf16x8 vf = *(const LAS bf16x8*)(vT + (nt * 16 + il) * 136 + ks * 32 + kq * 8); a = __builtin_amdgcn_mfma_f32_16x16x32_bf16(vf, wf[ks], a, 0, 0, 0); }
        const size_t tok = (size_t)(t0 + i); const int c = g * 128 + nt * 16 + kq * 4;
        const u32x2 uu = *(const u32x2*)(U + tok * 512 + c);
        u32x2 o; o.x = cvt_pk_bf16(bflo(uu.x) * (a[0] + bias), bfhi(uu.x) * (a[1] + bias)); o.y = cvt_pk_bf16(bflo(uu.y) * (a[2] + bias), bfhi(uu.y) * (a[3] + bias));
        *(u32x2*)(MIX + tok * 1024 + c) = o; }
    __syncthreads();
}
__device__ __forceinline__ void conv_unit(int unit, LAS unsigned char* lds, const bf16_t* H, const float* cw, const float* cb, const float* lng, const float* lnb, bf16_t* MIX, int tid) {
    const int t0 = unit * 32, s0 = t0 % SEQ, lane = tid & 63, wid = tid >> 6;
    LAS bf16_t* hin = (LAS bf16_t*)lds;
    LAS float* cout = (LAS float*)(lds + 62 * 1024);
    for (int q = tid; q < 62 * 64; q += 512) { const int r = q >> 6, c8 = (q & 63) * 8; u32x4 v = {0u, 0u, 0u, 0u};
        if (s0 - 30 + r >= 0) v = *(const u32x4*)(H + (size_t)(t0 - 30 + r) * 512 + c8);
        *(LAS u32x4*)(hin + r * 512 + c8) = v; }
    float w[31];
#pragma unroll
    for (int k = 0; k < 31; ++k) w[k] = cw[k * 512 + tid];
    const float bias = cb[tid];
    __syncthreads();
#pragma unroll 1
    for (int tg = 0; tg < 4; ++tg) { float x[38];
#pragma unroll
        for (int r = 0; r < 38; ++r) x[r] = bf2f(hin[(tg * 8 + r) * 512 + tid]);
#pragma unroll
        for (int o = 0; o < 8; ++o) { float a = bias;
#pragma unroll
            for (int k = 0; k < 31; ++k) a += w[k] * x[o + k];
            cout[(tg * 8 + o) * 516 + tid] = a; } }
    __syncthreads();
#pragma unroll 1
    for (int tt = 0; tt < 4; ++tt) { const int row = wid * 4 + tt; const f32x4 v0 = *(const LAS f32x4*)(cout + row * 516 + lane * 8), v1 = *(const LAS f32x4*)(cout + row * 516 + lane * 8 + 4);
        const float mean = wave_sum((v0[0] + v0[1]) + (v0[2] + v0[3]) + (v1[0] + v1[1]) + (v1[2] + v1[3])) * (1.0f / 512.0f);
        const f32x4 d0 = v0 - mean, d1 = v1 - mean;
        const float var = wave_sum((d0[0] * d0[0] + d0[1] * d0[1]) + (d0[2] * d0[2] + d0[3] * d0[3]) + (d1[0] * d1[0] + d1[1] * d1[1]) + (d1[2] * d1[2] + d1[3] * d1[3])) * (1.0f / 512.0f);
        const float rstd = rsqrtf(var + EPS);
        const f32x4 g0 = *(const f32x4*)(lng + lane * 8), g1 = *(const f32x4*)(lng + lane * 8 + 4), b0 = *(const f32x4*)(lnb + lane * 8), b1 = *(const f32x4*)(lnb + lane * 8 + 4);
        f32x4 y0 = d0 * rstd * g0 + b0, y1 = d1 * rstd * g1 + b1;
#pragma unroll
        for (int e = 0; e < 4; ++e) { y0[e] = silu_f(y0[e]); y1[e] = silu_f(y1[e]); }
        *(u32x4*)(MIX + (size_t)(t0 + row) * 1024 + 512 + lane * 8) = pack8(y0, y1); }
    __syncthreads();
}

struct Args { const float* in[33]; float* out; unsigned char* ws; int ph_lo, ph_hi; };
constexpr int NPHASE = 27;

typedef const __attribute__((address_space(4))) Args* KArgP;
__device__ __forceinline__ KArgP fresh_args() { KArgP p = (KArgP)__builtin_amdgcn_kernarg_segment_ptr(); asm volatile("" : "+s"(p)); return p; }

__global__ void __launch_bounds__(512, 2) trunk_fwd(Args args_unused) {
    extern __shared__ __attribute__((aligned(16))) unsigned char lds_raw[];
    LAS unsigned char* lds = (LAS unsigned char*)lds_raw;
    cg::grid_group grid = cg::this_grid();
    { volatile LAS unsigned* MISC0 = (volatile LAS unsigned*)(lds + MISC_OFF); if (threadIdx.x < 32) MISC0[threadIdx.x] = 0u; }
    __syncthreads();
    int lo, hi;
    { KArgP ap = fresh_args(); lo = ap->ph_lo; hi = ap->ph_hi; }
#if !MK_MULTI && !MK_CGSYNC
    { KArgP ap = fresh_args(); (void)xcd_barrier_post((unsigned*)(ap->ws + WS_BAR), (volatile LAS unsigned*)(lds + MISC_OFF) + 8); }
#endif
    int nsync = 0;
#if MK_MULTI
#define SEAM(k) do { } while (0)
#elif MK_CGSYNC
#define SEAM(k) do { if (rep_ + 1 == nrep_ && (k) + 1 < hi) grid.sync(); } while (0)
#else
#define SEAM(k) do { if (rep_ + 1 == nrep_ && (k) + 1 < hi) { if (hi > 1000) grid.sync(); else { KArgP ap_ = fresh_args(); XcdBarrier xb_; xb_.bar = (unsigned*)(ap_->ws + WS_BAR); xb_.x = xb_xcc_id(); xb_.st = (volatile LAS unsigned*)(lds + MISC_OFF) + 8; xcd_barrier(xb_); } ++nsync; } } while (0)
#endif
#ifndef ONLY
#define ONLY -1
#endif
#ifndef REPMASK
#define REPMASK 0
#endif
#define PHASE(id, k) if ((ONLY < 0 || ONLY == (id)) && lo <= (k) && (k) < hi) for (int rep_ = 0, nrep_ = (((REPMASK) >> (id)) & 1) ? 2 : 1; rep_ < nrep_; ++rep_)
    (void)nsync;
#define LOCALS KArgP ap = fresh_args(); unsigned char* ws = ap->ws; float* out = ap->out; const float* x_in = ap->in[0]; \
    int tid_ = threadIdx.x, G_ = gridDim.x, bx_ = blockIdx.x; asm volatile("" : "+v"(tid_), "+s"(G_), "+s"(bx_)); \
    const int tid = tid_, lane = tid & 63, wave = __builtin_amdgcn_readfirstlane(tid >> 6), G = G_, bx = bx_, gw = bx * 8 + wave, NGW = G * 8; \
    bf16_t* XB = (bf16_t*)(ws + WS_XB); float* SS = (float*)(ws + WS_SS); float* VST = (float*)(ws + WS_VST); bf16_t* QO = (bf16_t*)(ws + WS_QO); bf16_t* Pb = (bf16_t*)(ws + WS_P); \
    bf16_t* HM = (bf16_t*)(ws + WS_HM); bf16_t* MEMN = (bf16_t*)(ws + WS_MEMN); bf16_t* KL = (bf16_t*)(ws + WS_KL); bf16_t* VT = (bf16_t*)(ws + WS_VT); \
    bf16_t* U = (bf16_t*)(ws + WS_U); bf16_t* V = (bf16_t*)(ws + WS_V); bf16_t* H = (bf16_t*)(ws + WS_H); bf16_t* MIX = (bf16_t*)(ws + WS_MIX); \
    bf16_t* AC = (bf16_t*)(ws + WS_ACOMB); float* XL = (float*)(ws + WS_XLOC); bf16_t* Y = (bf16_t*)(ws + WS_Y); float* SSa = SS + (size_t)(3 * l) * T; \
    (void)out; (void)x_in; (void)lane; (void)gw; (void)NGW; (void)XB; (void)VST; (void)QO; (void)Pb; (void)HM; (void)MEMN; (void)KL; (void)VT; (void)U; (void)V; (void)H; (void)MIX; (void)AC; (void)XL; (void)Y; (void)SSa; (void)wave;

    PHASE(0, 0) { const int l = 0; LOCALS
        { f32x4* z = (f32x4*)(SS + T); const int n4 = 7 * T / 4; for (int i = bx * 512 + tid; i < n4; i += G * 512) z[i] = (f32x4){0.f, 0.f, 0.f, 0.f};
          f32x4* z2 = (f32x4*)VST; const int m4 = 2 * T / 4; for (int i = bx * 512 + tid; i < m4; i += G * 512) z2[i] = (f32x4){0.f, 0.f, 0.f, 0.f}; }
        LAS float* scr = (LAS float*)(lds + wave * 16384);
#define CONVJOB(Wp, K_, ldn_, cs_, nc_, WTp, mode_, roff_, gain_) { const int nblk_ = (nc_) / 32, cnt_ = ((K_) / 64) * nblk_; \
            if (r >= 0 && r < cnt_) conv_item((Wp), (K_), (ldn_), (cs_), nblk_, (bf16_t*)(WTp), (mode_), (roff_), (gain_), scr, r, lane); r -= cnt_; }
        constexpr int NITEMS = 512 + 256 + 256 + 512 + 256 + 256 + 256 + 2 * (4 * 512 + 3 * 1408);
        for (int it = gw; it < NITEMS; it += NGW) {
            int r = it;
            CONVJOB(ap->in[3], 1024, 2048, 0, 1024, ws + WS_WIN0, 0, 0, ap->in[2]);
            CONVJOB(ap->in[3], 1024, 2048, 1024, 512, ws + WS_WIN0, 1, 1024, ap->in[2]);
            CONVJOB(ap->in[3], 1024, 2048, 1536, 512, ws + WS_WIN0, 2, 1024, ap->in[2]);
            CONVJOB(ap->in[10], 1024, 1024, 0, 1024, ws + WS_WOUT0, 0, 0, nullptr);
            CONVJOB(ap->in[12], 1024, 512, 0, 512, ws + WS_WOIN, 0, 0, ap->in[11]);
            CONVJOB(ap->in[21], 512, 2048, 0, 1024, ws + WS_WOOUT, 1, 0, nullptr);
            CONVJOB(ap->in[21], 512, 2048, 1024, 1024, ws + WS_WOOUT, 2, 0, nullptr);
#pragma unroll
            for (int l = 0; l < 2; ++l) {
                CONVJOB(ap->in[24] + (size_t)l * D * D, 1024, 1024, 0, 1024, ws + WS_WQ + l * WSQ_L, 0, 0, ap->in[22] + l * D);
                CONVJOB(ap->in[25] + (size_t)l * D * D, 1024, 1024, 0, 1024, ws + WS_WK + l * WSQ_L, 0, 0, ap->in[23] + l * D);
                CONVJOB(ap->in[26] + (size_t)l * D * D, 1024, 1024, 0, 1024, ws + WS_WV + l * WSQ_L, 0, 0, ap->in[23] + l * D);
                CONVJOB(ap->in[27] + (size_t)l * D * D, 1024, 1024, 0, 1024, ws + WS_WO + l * WSQ_L, 0, 0, nullptr);
                CONVJOB(ap->in[29] + (size_t)l * D * FH, 1024, FH, 0, FH, ws + WS_WGU + l * WGU_L, 1, 0, ap->in[28] + l * D);
                CONVJOB(ap->in[30] + (size_t)l * D * FH, 1024, FH, 0, FH, ws + WS_WGU + l * WGU_L, 2, 0, ap->in[28] + l * D);
                CONVJOB(ap->in[31] + (size_t)l * FH * D, FH, 1024, 0, 1024, ws + WS_WD + l * WD_L, 0, 0, nullptr);
            }
        }
        { const int nb5 = (G > 64) ? G - 32 : G;
          if (bx < nb5) { const int NW5 = nb5 * 8;
              for (int m = gw * 4; m < T; m += NW5 * 4) rows_to_bf16<false, 4>(x_in + (size_t)m * D, XB + (size_t)m * D, SS + m, lane);
              for (int m = gw * 4; m < MT; m += NW5 * 4) rows_to_bf16<true, 4>(ap->in[1] + (size_t)m * D, MEMN + (size_t)m * D, nullptr, lane); } }
        { bf16_t* GW = (bf16_t*)(ws + WS_GW); const float* w = ap->in[4];
          for (int i = bx * 512 + tid; i < 4 * 128 * 128 / 2; i += G * 512) { const int e = 2 * i, ii = (e >> 7) & 127, jj = e & 127; const bool keep = (jj >> 6) <= (ii >> 6);
              ((unsigned*)GW)[i] = keep ? cvt_pk_bf16(w[e], w[e + 1]) : 0u; } }
        __syncthreads();
        for (int g = G - 1 - bx; g < 32; g += G)
            s5_setup(g, lds, ap->in[13], ap->in[14], ap->in[15], ap->in[16], ap->in[17], ap->in[18], ap->in[19], (bf16_t*)(ws + WS_BT3), (bf16_t*)(ws + WS_GM), (float*)(ws + WS_AL), tid);
        SEAM(0);
    }
    PHASE(1, 1) { const int l = 0; LOCALS
        { pg8::Gemm g{MEMN, (const bf16_t*)(ws + WS_WK), D, D, D, 2, 0, 0, (long)D * D, 0}; pg8::Sched S; S.init(MT / 256, D / 256, 2, G, bx);
          pg8::EpiStore E{KL, D, 2, (long)MT * D, 0, nullptr, 1.0f}; pg8::gemm_phase<MK_ALIGN>(lds, g, S, E, tid); }
        { pg8::Gemm g{(const bf16_t*)(ws + WS_WV), MEMN, D, D, D, 2, (long)D * D, 0, 0, 0}; pg8::Sched S; S.init(D / 256, MT / 256, 2, G, (bx + G / 2) % G);
          pg8::EpiStore E{VT, MT, 2, (long)D * MT, 0, nullptr, 1.0f}; pg8::gemm_phase<MK_ALIGN>(lds, g, S, E, tid); }
        SEAM(1);
    }
#pragma unroll 1
    for (int l = 0; l < 2; ++l) {
        const int pb = 2 + 12 * l;
        if (l == 0) {
            PHASE(2, pb + 0) { LOCALS
                pg8::Gemm g{XB, (const bf16_t*)(ws + WS_WIN0), D, D, D, 1, 0, 0, 0, 0}; pg8::Sched S; S.init(T / 256, 2048 / 256, 1, G, bx);
                pg8::EpiIn0 E{SSa, U, V, H, VST}; pg8::gemm_phase<MK_ALIGN>(lds, g, S, E, tid);
                SEAM(pb + 0);
            }
            PHASE(3, pb + 1) { LOCALS
                for (int i = bx; i < 2048; i += G) {
                    if (i < 1024) gmlp_unit(i, lds, U, V, VST, (const bf16_t*)(ws + WS_GW), ap->in[5], MIX, tid);
                    else conv_unit(i - 1024, lds, H, ap->in[6], ap->in[7], ap->in[8], ap->in[9], MIX, tid);
                }
                SEAM(pb + 1);
            }
            PHASE(4, pb + 2) { LOCALS
                pg8::Gemm g{MIX, (const bf16_t*)(ws + WS_WOUT0), D, D, D, 1, 0, 0, 0, 0}; pg8::Sched S; S.init(T / 256, D / 256, 1, G, bx);
                pg8::EpiRes<false> E{x_in, out, XB, SSa + T}; pg8::gemm_phase<MK_ALIGN>(lds, g, S, E, tid);
                SEAM(pb + 2);
            }
        } else {
            PHASE(5, pb + 0) { LOCALS
                pg8::Gemm g{XB, (const bf16_t*)(ws + WS_WOIN), D, D, D, 1, 0, 0, 0, 0}; pg8::Sched S; S.init(T / 256, 512 / 256, 1, G, bx);
                pg8::EpiOin E{SSa, AC}; pg8::gemm_phase<MK_ALIGN>(lds, g, S, E, tid);
                SEAM(pb + 0);
            }
            PHASE(6, pb + 1) { LOCALS
                pg8::Gemm g{AC, (const bf16_t*)(ws + WS_GM), AK, 512, 512, 32, (long)NCH * AK, 0, 256L * 512, 0}; pg8::Sched S; S.init(NCH / 256, 1, 32, G, bx);
                pg8::EpiS5State E{XL}; pg8::gemm_phase<MK_ALIGN>(lds, g, S, E, tid);
                SEAM(pb + 1);
            }
            PHASE(7, pb + 2) { LOCALS
                if (wave == 0) {
                    const int idx = bx * 64 + lane;
                    if (idx < NB * 32 * 64) { const int p = idx & 63, g = (idx >> 6) & 31, b = idx >> 11;
                        const float* AL = (const float*)(ws + WS_AL); const float ar = AL[(g * 64 + p) * 2], ai = AL[(g * 64 + p) * 2 + 1];
                        const float* xl = XL + (size_t)g * NCH * 128 + (size_t)(b * (SEQ / SL)) * 128; bf16_t* ac = AC + (size_t)g * NCH * AK + (size_t)(b * (SEQ / SL)) * AK + 512;
                        float xr = 0.f, xi = 0.f;
#pragma unroll 1
                        for (int c0 = 0; c0 < SEQ / SL; c0 += 32) { float lr[32], li[32];
#pragma unroll
                            for (int i = 0; i < 32; ++i) { lr[i] = xl[(size_t)(c0 + i) * 128 + p]; li[i] = xl[(size_t)(c0 + i) * 128 + 64 + p]; }
#pragma unroll
                            for (int i = 0; i < 32; ++i) { const unsigned pk = cvt_pk_bf16(xr, xi); ac[(size_t)(c0 + i) * AK + p] = (bf16_t)(pk & 0xffffu); ac[(size_t)(c0 + i) * AK + 64 + p] = (bf16_t)(pk >> 16);
                                const float nr = ar * xr - ai * xi + lr[i], ni = ar * xi + ai * xr + li[i]; xr = nr; xi = ni; } }
                    }
                }
                SEAM(pb + 2);
            }
            PHASE(8, pb + 3) { LOCALS
                pg8::Gemm g{AC, (const bf16_t*)(ws + WS_BT3), AK, AK, AK, 32, (long)NCH * AK, 0, 512L * AK, 0}; pg8::Sched S; S.init(NCH / 256, 2, 32, G, bx);
                pg8::EpiS5Out E{AC, ap->in[20], Y}; pg8::gemm_phase<MK_ALIGN>(lds, g, S, E, tid);
                SEAM(pb + 3);
            }
            PHASE(9, pb + 4) { LOCALS
                pg8::Gemm g{Y, (const bf16_t*)(ws + WS_WOOUT), 512, 512, 512, 1, 0, 0, 0, 0}; pg8::Sched S; S.init(T / 256, 2048 / 256, 1, G, bx);
                pg8::EpiRes<true> E{out, out, XB, SSa + T}; pg8::gemm_phase<MK_ALIGN>(lds, g, S, E, tid);
                SEAM(pb + 4);
            }
        }
        PHASE(10, pb + 5) { LOCALS
            pg8::Gemm g{XB, (const bf16_t*)(ws + WS_WQ + l * WSQ_L), D, D, D, 1, 0, 0, 0, 0}; pg8::Sched S; S.init(T / 256, D / 256, 1, G, bx);
            pg8::EpiStore E{QO, D, 1, 0, 0, SSa + T, 0.0625f}; pg8::gemm_phase<MK_ALIGN>(lds, g, S, E, tid);
            SEAM(pb + 5);
        }
        PHASE(11, pb + 6) { LOCALS
            pg8::Gemm g{QO, KL + (size_t)l * MT * D, D, D, 256, 4, 256, (long)SEQ * D, 256, 256L * D}; pg8::Sched S; S.init(SEQ / 256, 1, 32, G, bx);
            pg8::EpiSoftmax E{Pb}; pg8::gemm_phase<true>(lds, g, S, E, tid);
            SEAM(pb + 6);
        }
        PHASE(12, pb + 7) { LOCALS
            pg8::Gemm g{Pb, VT + (size_t)l * D * MT, 256, MT, 256, 4, (long)SEQ * 256, 4L * SEQ * 256, 256L * MT, 256}; pg8::Sched S; S.init(SEQ / 256, 1, 32, G, bx);
            pg8::EpiStore E{QO, D, 4, 256, (long)SEQ * D, nullptr, 1.0f}; pg8::gemm_phase<MK_ALIGN>(lds, g, S, E, tid);
            SEAM(pb + 7);
        }
        PHASE(13, pb + 8) { LOCALS
            pg8::Gemm g{QO, (const bf16_t*)(ws + WS_WO + l * WSQ_L), D, D, D, 1, 0, 0, 0, 0}; pg8::Sched S; S.init(T / 256, D / 256, 1, G, bx);
            pg8::EpiRes<false> E{out, out, XB, SSa + 2 * T}; pg8::gemm_phase<MK_ALIGN>(lds, g, S, E, tid);
            SEAM(pb + 8);
        }
        PHASE(14, pb + 9) { LOCALS
            pg8::Gemm g{XB, (const bf16_t*)(ws + WS_WGU + l * WGU_L), D, D, D, 1, 0, 0, 0, 0}; pg8::Sched S; S.init(T / 256, 2 * FH / 256, 1, G, bx);
            pg8::EpiFfn1 E{SSa + 2 * T, HM}; pg8::gemm_phase<MK_ALIGN>(lds, g, S, E, tid);
            SEAM(pb + 9);
        }
        PHASE(15, pb + 10) { LOCALS
            pg8::Gemm g{HM, (const bf16_t*)(ws + WS_WD + l * WD_L), FH, FH, FH, 1, 0, 0, 0, 0}; pg8::Sched S; S.init(T / 256, D / 256, 1, G, bx);
            pg8::EpiRes<false> E{out, out, XB, SSa + 3 * T}; pg8::gemm_phase<MK_ALIGN>(lds, g, S, E, tid);
            SEAM(pb + 10);
        }
    }
    PHASE(16, 26) { const int l = 0; LOCALS
        const float* ssf = SS + (size_t)6 * T; const f32x4* gf = (const f32x4*)ap->in[32] + lane;
        f32x4 gv[4];
#pragma unroll
        for (int j = 0; j < 4; ++j) gv[j] = gf[64 * j];
        for (int m = gw * 4; m < T; m += NGW * 4) { f32x4 v[4][4]; float rs[4];
#pragma unroll
            for (int r = 0; r < 4; ++r) { rs[r] = rsqrtf(ssf[m + r] * (1.0f / D) + EPS); const f32x4* xr = (const f32x4*)(out + (size_t)(m + r) * D) + lane;
#pragma unroll
                for (int j = 0; j < 4; ++j) v[r][j] = xr[64 * j]; }
#pragma unroll
            for (int r = 0; r < 4; ++r) { f32x4* xr = (f32x4*)(out + (size_t)(m + r) * D) + lane;
#pragma unroll
                for (int j = 0; j < 4; ++j) xr[64 * j] = v[r][j] * rs[r] * gv[j]; } }
    }
}

extern "C" void kernel_launch(void* const* d_in, const int* in_sizes, int n_in, void* d_out, int out_size, void* d_ws, size_t ws_size, hipStream_t stream) {
    static int grid = 0;
    if (grid == 0) {
        if (n_in != 33 || in_sizes[0] != T * D || out_size != T * D || ws_size < WS_END) { fprintf(stderr, "kernel_launch: unexpected shapes (n_in %d, in0 %d, out %d, ws %zu < %zu)\n", n_in, n_in > 0 ? in_sizes[0] : -1, out_size, ws_size, (size_t)WS_END); grid = -1; return; }
        int dev = 0, cus = 0, per_cu = 0;
        hipGetDevice(&dev); hipDeviceGetAttribute(&cus, hipDeviceAttributeMultiprocessorCount, dev);
        if (hipFuncSetAttribute((const void*)trunk_fwd, hipFuncAttributeMaxDynamicSharedMemorySize, LDS_BYTES) != hipSuccess) { fprintf(stderr, "kernel_launch: hipFuncSetAttribute failed\n"); grid = -1; return; }
        if (hipOccupancyMaxActiveBlocksPerMultiprocessor(&per_cu, (const void*)trunk_fwd, 512, LDS_BYTES) != hipSuccess || per_cu < 1) { fprintf(stderr, "kernel_launch: occupancy query says %d\n", per_cu); per_cu = 1; }
        (void)hipGetLastError();
        grid = cus * 1;
        if (grid <= 0) grid = 256;
    }
    if (grid < 0) return;
    Args a{};
    for (int i = 0; i < 33; ++i) a.in[i] = (const float*)d_in[i];
    a.out = (float*)d_out; a.ws = (unsigned char*)d_ws;
#if !MK_MULTI && !MK_CGSYNC
    (void)hipMemsetAsync((char*)d_ws + WS_BAR, 0, XCD_BAR_WORDS * 4, stream);
#endif
#if MK_MULTI
    for (int p = 0; p < NPHASE; ++p) {
        if (p == 5 || p == 6 || p == 13 || p == 25) continue;
        a.ph_lo = p; a.ph_hi = p + 1; void* kargs[] = {&a};
        hipError_t e = hipLaunchCooperativeKernel((const void*)trunk_fwd, dim3(grid), dim3(512), kargs, LDS_BYTES, stream);
        if (e != hipSuccess) { fprintf(stderr, "kernel_launch: launch of phase %d failed: %s\n", p, hipGetErrorString(e)); break; }
    }
#else
    a.ph_lo = 0; a.ph_hi = NPHASE; void* kargs[] = {&a};
    hipError_t e = hipLaunchCooperativeKernel((const void*)trunk_fwd, dim3(grid), dim3(512), kargs, LDS_BYTES, stream);
    if (e != hipSuccess) fprintf(stderr, "kernel_launch: cooperative launch failed: %s (grid %d)\n", hipGetErrorString(e), grid);
#endif
}
```

```cpp
#include <hip/hip_runtime.h>
#include <hip/hip_cooperative_groups.h>
#include <cstdio>
#include <cstdint>
namespace cg = cooperative_groups;

#ifndef MK_MULTI
#define MK_MULTI 0
#endif
#ifndef MK_ALIGN
#define MK_ALIGN true
#endif
#ifndef MK_CGSYNC
#define MK_CGSYNC 0
#endif

#define LAS __attribute__((address_space(3)))
typedef unsigned short bf16_t;
typedef short bf16x8 __attribute__((ext_vector_type(8)));
typedef float f32x4 __attribute__((ext_vector_type(4)));
typedef float f32x2 __attribute__((ext_vector_type(2)));
typedef unsigned u32x4 __attribute__((ext_vector_type(4)));
typedef unsigned u32x2 __attribute__((ext_vector_type(2)));

constexpr int T = 32768, D = 1024, SEQ = 4096, NB = 8, MT = 2048, FH = 2816;
constexpr float EPS = 1e-6f;
constexpr int SL = 32;
constexpr int NCH = T / SL;
constexpr int AK = SL * 16 + 128;

constexpr size_t MiB = 1u << 20;
constexpr size_t WS_WIN0 = 0, WS_WOUT0 = 4 * MiB, WS_WOIN = 6 * MiB, WS_WOOUT = 7 * MiB, WS_WQ = 9 * MiB, WS_WK = 13 * MiB, WS_WV = 17 * MiB, WS_WO = 21 * MiB;
constexpr size_t WS_WGU = 25 * MiB, WS_WD = 47 * MiB, WS_GW = 58 * MiB, WS_AL = 59 * MiB, WS_BT3 = 60 * MiB, WS_GM = 80 * MiB, WS_MEMN = 88 * MiB, WS_KL = 92 * MiB, WS_VT = 100 * MiB;
constexpr size_t WS_XB = 110 * MiB, WS_QO = 174 * MiB, WS_P = 238 * MiB, WS_R0 = 302 * MiB;
constexpr size_t WS_HM = WS_R0, WS_U = WS_R0, WS_V = WS_R0 + 32 * MiB, WS_H = WS_R0 + 64 * MiB, WS_MIX = WS_R0 + 96 * MiB;
constexpr size_t WS_ACOMB = WS_R0, WS_XLOC = WS_R0 + 40 * MiB, WS_Y = WS_R0 + 56 * MiB;
constexpr size_t WS_SS = WS_R0 + 176 * MiB, WS_VST = WS_SS + 2 * MiB, WS_BAR = WS_VST + 1 * MiB, WS_END = WS_BAR + 1 * MiB;
constexpr size_t WGU_L = (size_t)2 * FH * D * 2, WD_L = (size_t)D * FH * 2, WSQ_L = (size_t)D * D * 2;

constexpr int RING_BYTES = 131072, XCH_OFF = RING_BYTES, MISC_OFF = RING_BYTES + 8192, LDS_BYTES = 147456;

__device__ __forceinline__ unsigned cvt_pk_bf16(float lo, float hi) { unsigned r; asm volatile("v_cvt_pk_bf16_f32 %0, %1, %2" : "=v"(r) : "v"(lo), "v"(hi)); return r; }
__device__ __forceinline__ float bf2f(unsigned short b) { return __builtin_bit_cast(float, (unsigned)b << 16); }
__device__ __forceinline__ float bflo(unsigned w) { return __builtin_bit_cast(float, w << 16); }
__device__ __forceinline__ float bfhi(unsigned w) { return __builtin_bit_cast(float, w & 0xffff0000u); }
__device__ __forceinline__ float sigmoid_f(float x) { return __builtin_amdgcn_rcpf(1.0f + __expf(-x)); }
__device__ __forceinline__ float silu_f(float x) { return x * sigmoid_f(x); }
__device__ __forceinline__ float gelu_f(float x) { return x * sigmoid_f(1.5957691216f * (x + 0.044715f * x * x * x)); }
typedef unsigned long long u64;
__device__ __forceinline__ void fx_add(u64* p, float q) { atomicAdd(p, (u64)(long long)(q * 16777216.0f)); }
__device__ __forceinline__ float fx_get(const u64* p) { return (float)(long long)(*p) * (1.0f / 16777216.0f); }
__device__ __forceinline__ float wave_sum(float v) {
#pragma unroll
    for (int o = 1; o < 64; o <<= 1) v += __shfl_xor(v, o);
    return v;
}
__device__ __forceinline__ u32x4 pack8(f32x4 a, f32x4 b) { u32x4 w; w.x = cvt_pk_bf16(a[0], a[1]); w.y = cvt_pk_bf16(a[2], a[3]); w.z = cvt_pk_bf16(b[0], b[1]); w.w = cvt_pk_bf16(b[2], b[3]); return w; }

namespace pg8 {
constexpr int BM = 256, BK = 64, HALF = 128, HTB = HALF * BK * 2, NXCD = 8, WGM = 8;
__device__ __forceinline__ int lds_byte(int r, int c) { const int st = (r >> 4) * 2 + (c >> 5), rr = r & 15, cc = c & 31, ob = rr * 64 + cc * 2; return st * 1024 + (ob ^ (((ob >> 9) & 1) << 5)); }
__device__ __forceinline__ void stage_rc(int b, int& R, int& C) { const int st = b / 1024, sb = b % 1024, swz = sb ^ (((sb >> 9) & 1) << 5); R = (st >> 1) * 16 + swz / 64; C = (st & 1) * 32 + (swz % 64) / 2; }
__device__ __forceinline__ int perm32(int rho) { const int n = rho >> 4, i = rho & 15; return 8 * (i >> 2) + 4 * n + (i & 3); }

struct Unit { int pm, pn, z; };
struct Gemm { const bf16_t* A; const bf16_t* Bt; int lda, ldb, K, nz0; long sAz0, sAz1, sBz0, sBz1; };
struct Sched {
    int nM, nN, per, total, G, c;
    __device__ __forceinline__ void init(int nM_, int nN_, int nz, int G_, int c_) { nM = nM_; nN = nN_; per = nM_ * nN_; total = per * nz; G = G_; c = c_; }
    __device__ __forceinline__ bool next(int i, Unit& u) const {
        const long L = (long)i * G + c; if (L >= total) return false;
        const int z = (int)(L / per); int wgid = (int)(L % per);
        { const int q = per / NXCD, r = per % NXCD, xcd = wgid % NXCD, off = wgid / NXCD; wgid = (xcd < r ? xcd * (q + 1) : r * (q + 1) + (xcd - r) * q) + off; }
        const int nig = WGM * nN, gid = wgid / nig, fm = gid * WGM, gsz = (nM - fm) < WGM ? (nM - fm) : WGM;
        u.pm = fm + ((wgid % nig) % gsz); u.pn = (wgid % nig) / gsz; u.z = z; return true;
    }
};

template <bool ALIGN, class Epi>
__device__ __forceinline__ void gemm_phase(LAS unsigned char* lds, const Gemm g, const Sched& S, const Epi& E, const int tid) {
    const int wid = __builtin_amdgcn_readfirstlane(tid >> 6), lane = tid & 63, wr = wid >> 2, wc = wid & 3, fr = lane & 15, fq = lane >> 4;
    const int nt = g.K / BK;
    unsigned voffA[2], voffB[2];
#pragma unroll
    for (int i = 0; i < 2; ++i) { int R, C; stage_rc(tid * 16 + i * 8192, R, C); const int Rb = (R & ~31) + perm32(R & 31);
        voffA[i] = (unsigned)(R * g.lda + C) * 2u; voffB[i] = (unsigned)(Rb * g.ldb + C) * 2u; }
    const size_t kstep = (size_t)(BK * 2);
    const size_t hsA = (size_t)HALF * g.lda * 2, hsB = (size_t)HALF * g.ldb * 2;
    const unsigned ldsw = (unsigned)wid * 1024u;
    const int aoff = lds_byte(wr * 64 + fr, fq * 8), boff = lds_byte(wc * 32 + fr, fq * 8);
#define PG8_SA(b, h) (((b) * 2 + (h)) * HTB)
#define PG8_SB(b, h) ((4 + (b) * 2 + (h)) * HTB)
#define PG8_STAGE(bufoff, gbase, voff) do { _Pragma("unroll") for (int _i = 0; _i < 2; ++_i) \
        __builtin_amdgcn_global_load_lds((const unsigned*)((const char*)(gbase) + (voff)[_i]), (LAS unsigned*)(lds + (bufoff) + ldsw + _i * 8192), 16, 0, 0); } while (0)
#define PG8_LDA(dst, b, h) do { _Pragma("unroll") for (int m = 0; m < 4; ++m) _Pragma("unroll") for (int k = 0; k < 2; ++k) dst[m][k] = *(const LAS bf16x8*)(lds + PG8_SA(b, h) + aoff + m * 2048 + k * 1024); } while (0)
#define PG8_LDB(dst, b, h) do { _Pragma("unroll") for (int n = 0; n < 2; ++n) _Pragma("unroll") for (int k = 0; k < 2; ++k) dst[n][k] = *(const LAS bf16x8*)(lds + PG8_SB(b, h) + boff + n * 2048 + k * 1024); } while (0)
#define PG8_MMA(ai, bj, At, Bt) do { __builtin_amdgcn_s_setprio(1); _Pragma("unroll") for (int m = 0; m < 4; ++m) _Pragma("unroll") for (int n = 0; n < 2; ++n) _Pragma("unroll") for (int k = 0; k < 2; ++k) \
        acc[ai][bj][m][n] = __builtin_amdgcn_mfma_f32_16x16x32_bf16(Bt[n][k], At[m][k], acc[ai][bj][m][n], 0, 0, 0); __builtin_amdgcn_s_setprio(0); } while (0)
#define PG8_WAIT_V(n) asm volatile("s_waitcnt vmcnt(" #n ")" ::: "memory")
#define PG8_WAIT_L(n) asm volatile("s_waitcnt lgkmcnt(" #n ")" ::: "memory")
#define PG8_BAR __builtin_amdgcn_s_barrier()
#define PG8_SCHED __builtin_amdgcn_sched_barrier(0)
#define PG8_UA(u) ((const char*)g.A + 2 * ((size_t)((u).z % g.nz0) * g.sAz0 + (size_t)((u).z / g.nz0) * g.sAz1 + (size_t)(u).pm * BM * g.lda))
#define PG8_UB(u) ((const char*)g.Bt + 2 * ((size_t)((u).z % g.nz0) * g.sBz0 + (size_t)((u).z / g.nz0) * g.sBz1 + (size_t)(u).pn * BM * g.ldb))
    Unit cur, nxt; int ui = 0;
    if (!S.next(0, cur)) return;
    f32x4 acc[2][2][4][2];
#pragma unroll
    for (int a = 0; a < 2; ++a)
#pragma unroll
        for (int b = 0; b < 2; ++b)
#pragma unroll
            for (int m = 0; m < 4; ++m)
#pragma unroll
                for (int n = 0; n < 2; ++n) acc[a][b][m][n] = (f32x4){0.f, 0.f, 0.f, 0.f};
    bf16x8 At[4][2], B0[2][2], B1[2][2];
    const char* cA = PG8_UA(cur); const char* cB = PG8_UB(cur);
    PG8_STAGE(PG8_SB(0, 0), cB, voffB); PG8_STAGE(PG8_SB(0, 1), cB + hsB, voffB); PG8_STAGE(PG8_SA(0, 0), cA, voffA); PG8_STAGE(PG8_SA(0, 1), cA + hsA, voffA);
    if (wr == 1) PG8_BAR;
    PG8_WAIT_V(2); PG8_BAR;
    PG8_STAGE(PG8_SB(1, 0), cB + kstep, voffB); PG8_STAGE(PG8_SA(1, 0), cA + kstep, voffA); PG8_STAGE(PG8_SB(1, 1), cB + hsB + kstep, voffB);
    PG8_WAIT_V(6); PG8_BAR;
    for (;;) {
        const bool has_next = S.next(ui + 1, nxt);
        const char* nA = has_next ? PG8_UA(nxt) : cA; const char* nB = has_next ? PG8_UB(nxt) : cB;
        for (int t = 0; t < nt; t += 2) {
            const bool last = (t == nt - 2);
            const char* a1 = cA + (size_t)(t + 1) * kstep;
            const char* a2 = last ? nA : cA + (size_t)(t + 2) * kstep; const char* b2 = last ? nB : cB + (size_t)(t + 2) * kstep;
            const char* a3 = a2 + kstep; const char* b3 = b2 + kstep;
            PG8_LDB(B0, 0, 0); PG8_LDB(B1, 0, 1); PG8_SCHED; PG8_LDA(At, 0, 0); PG8_STAGE(PG8_SA(1, 1), a1 + hsA, voffA);
            PG8_WAIT_V(8); PG8_WAIT_L(0); PG8_BAR; PG8_MMA(0, 0, At, B0); PG8_MMA(0, 1, At, B1); PG8_BAR; PG8_SCHED;
            PG8_LDA(At, 0, 1); PG8_STAGE(PG8_SB(0, 0), b2, voffB); PG8_STAGE(PG8_SB(0, 1), b2 + hsB, voffB); PG8_STAGE(PG8_SA(0, 0), a2, voffA);
            PG8_WAIT_V(8); PG8_WAIT_L(0); PG8_BAR; PG8_MMA(1, 0, At, B0); PG8_MMA(1, 1, At, B1); PG8_BAR; PG8_SCHED;
            PG8_LDB(B0, 1, 0); PG8_LDB(B1, 1, 1); PG8_SCHED; PG8_LDA(At, 1, 0); PG8_STAGE(PG8_SA(0, 1), a2 + hsA, voffA);
            PG8_WAIT_V(8); PG8_WAIT_L(0); PG8_BAR; PG8_MMA(0, 0, At, B0); PG8_MMA(0, 1, At, B1); PG8_BAR; PG8_SCHED;
            PG8_LDA(At, 1, 1); PG8_STAGE(PG8_SB(1, 0), b3, voffB); PG8_STAGE(PG8_SB(1, 1), b3 + hsB, voffB); PG8_STAGE(PG8_SA(1, 0), a3, voffA);
            PG8_WAIT_V(8); PG8_WAIT_L(0); PG8_BAR; PG8_MMA(1, 0, At, B0); PG8_MMA(1, 1, At, B1); PG8_BAR; PG8_SCHED;
        }
        if (ALIGN) { if (wr == 0) PG8_BAR; }
        E(acc, cur, wr, wc, fr, fq, lds);
        if (!has_next) break;
#pragma unroll
        for (int a = 0; a < 2; ++a)
#pragma unroll
            for (int b = 0; b < 2; ++b)
#pragma unroll
                for (int m = 0; m < 4; ++m)
#pragma unroll
                    for (int n = 0; n < 2; ++n) acc[a][b][m][n] = (f32x4){0.f, 0.f, 0.f, 0.f};
        cur = nxt; cA = nA; cB = nB; ++ui;
        if (ALIGN) { if (wr == 1) PG8_BAR; }
    }
    PG8_WAIT_V(0);
    if (!ALIGN) { if (wr == 0) PG8_BAR; }
    PG8_BAR;
#undef PG8_SA
#undef PG8_SB
#undef PG8_STAGE
#undef PG8_LDA
#undef PG8_LDB
#undef PG8_MMA
#undef PG8_UA
#undef PG8_UB
}

typedef f32x4 Acc[2][2][4][2];
#define EPI_ARGS Acc& acc, const Unit& u, int wr, int wc, int fr, int fq, LAS unsigned char* lds
__device__ __forceinline__ int efence() { asm volatile("" ::: "memory"); return 1; }
#define ROWLOOP _Pragma("unroll") for (int ai = 0; ai < 2; ++ai) _Pragma("unroll") for (int m = 0; m < 4; ++m) for (int once_ = efence(); once_; once_ = 0)

struct EpiIn0 {
    const u64* ss; bf16_t* U; bf16_t* V; bf16_t* H; u64* vst;
    __device__ __forceinline__ void operator()(EPI_ARGS) const {
        const int row0 = u.pm * 256 + wr * 64 + fr;
        if (u.pn < 4) {
            bf16_t* dst = (u.pn < 2) ? U : V; const int col0 = (u.pn & 1) * 256 + wc * 32 + 8 * fq; const bool st = u.pn >= 2;
            ROWLOOP { const int row = row0 + ai * 128 + m * 16; const float rs = rsqrtf(fx_get(ss + row) * (1.0f / D) + EPS); float s = 0.f, q = 0.f;
#pragma unroll
                for (int bj = 0; bj < 2; ++bj) { f32x4 v0 = acc[ai][bj][m][0] * rs, v1 = acc[ai][bj][m][1] * rs;
#pragma unroll
                    for (int e = 0; e < 4; ++e) { v0[e] = gelu_f(v0[e]); v1[e] = gelu_f(v1[e]); s += v0[e] + v1[e]; q += v0[e] * v0[e] + v1[e] * v1[e]; }
                    *(u32x4*)(dst + (size_t)row * 512 + col0 + bj * 128) = pack8(v0, v1); }
                if (st) { s += __shfl_xor(s, 16); s += __shfl_xor(s, 32); q += __shfl_xor(q, 16); q += __shfl_xor(q, 32);
                    if (fq == 0) { fx_add(vst + 2 * row, s); fx_add(vst + 2 * row + 1, q); } }
            }
        } else {
            const int col0 = (u.pn - 4) * 128 + wc * 32 + 8 * fq;
            ROWLOOP { const int row = row0 + ai * 128 + m * 16; const float rs = rsqrtf(fx_get(ss + row) * (1.0f / D) + EPS); f32x4 h0, h1;
#pragma unroll
                for (int e = 0; e < 4; ++e) { h0[e] = acc[ai][0][m][0][e] * rs * sigmoid_f(acc[ai][1][m][0][e] * rs); h1[e] = acc[ai][0][m][1][e] * rs * sigmoid_f(acc[ai][1][m][1][e] * rs); }
                *(u32x4*)(H + (size_t)row * 512 + col0) = pack8(h0, h1); }
        }
    }
};
__device__ __forceinline__ void unpack8(u32x4 b, f32x4& o0, f32x4& o1) { o0 = (f32x4){bflo(b.x), bfhi(b.x), bflo(b.y), bfhi(b.y)}; o1 = (f32x4){bflo(b.z), bfhi(b.z), bflo(b.w), bfhi(b.w)}; }
template <bool GLU> struct EpiRes {
    bf16_t* xb; u64* ss;
    __device__ __forceinline__ void operator()(EPI_ARGS) const {
        const int row0 = u.pm * 256 + wr * 64 + fr;
        ROWLOOP { const int row = row0 + ai * 128 + m * 16; float q = 0.f;
            if (GLU) { const size_t off = (size_t)row * D + u.pn * 128 + wc * 32 + 8 * fq;
                f32x4 o0, o1; unpack8(*(const u32x4*)(xb + off), o0, o1);
#pragma unroll
                for (int e = 0; e < 4; ++e) { o0[e] += acc[ai][0][m][0][e] * sigmoid_f(acc[ai][1][m][0][e]); o1[e] += acc[ai][0][m][1][e] * sigmoid_f(acc[ai][1][m][1][e]);
                    q += o0[e] * o0[e] + o1[e] * o1[e]; }
                *(u32x4*)(xb + off) = pack8(o0, o1);
            } else {
#pragma unroll
                for (int bj = 0; bj < 2; ++bj) { const size_t off = (size_t)row * D + u.pn * 256 + bj * 128 + wc * 32 + 8 * fq;
                    f32x4 o0, o1; unpack8(*(const u32x4*)(xb + off), o0, o1); o0 += acc[ai][bj][m][0]; o1 += acc[ai][bj][m][1];
#pragma unroll
                    for (int e = 0; e < 4; ++e) q += o0[e] * o0[e] + o1[e] * o1[e];
                    *(u32x4*)(xb + off) = pack8(o0, o1); }
            }
            q += __shfl_xor(q, 16); q += __shfl_xor(q, 32);
            if (fq == 0) fx_add(ss + row, q);
        }
    }
};
struct EpiStore {
    bf16_t* O; int ldc, nz0; long sz0, sz1; const u64* ss; float scale;
    __device__ __forceinline__ void operator()(EPI_ARGS) const {
        bf16_t* base = O + (size_t)(u.z % nz0) * sz0 + (size_t)(u.z / nz0) * sz1; const int row0 = u.pm * 256 + wr * 64 + fr, col0 = u.pn * 256 + wc * 32 + 8 * fq;
        ROWLOOP { const int row = row0 + ai * 128 + m * 16; const float rs = ss ? rsqrtf(fx_get(ss + row) * (1.0f / D) + EPS) * scale : scale;
#pragma unroll
            for (int bj = 0; bj < 2; ++bj) *(u32x4*)(base + (size_t)row * ldc + col0 + bj * 128) = pack8(acc[ai][bj][m][0] * rs, acc[ai][bj][m][1] * rs); }
    }
};
struct EpiSoftmax {
    bf16_t* P;
    __device__ __forceinline__ void operator()(EPI_ARGS) const {
        LAS float* X = (LAS float*)(lds + XCH_OFF); LAS float* Y = X + 1024;
        ROWLOOP { const int r = ai * 128 + wr * 64 + m * 16 + fr; float mx = -3.0e38f;
#pragma unroll
            for (int bj = 0; bj < 2; ++bj)
#pragma unroll
                for (int n = 0; n < 2; ++n)
#pragma unroll
                    for (int e = 0; e < 4; ++e) mx = fmaxf(mx, acc[ai][bj][m][n][e]);
            mx = fmaxf(mx, __shfl_xor(mx, 16)); mx = fmaxf(mx, __shfl_xor(mx, 32));
            if (fq == 0) X[r * 4 + wc] = mx; }
        asm volatile("s_waitcnt lgkmcnt(0)" ::: "memory"); __builtin_amdgcn_s_barrier(); asm volatile("" ::: "memory");
        ROWLOOP { const int r = ai * 128 + wr * 64 + m * 16 + fr; const f32x4 xm = *(const LAS f32x4*)(X + r * 4); const float mx = fmaxf(fmaxf(xm[0], xm[1]), fmaxf(xm[2], xm[3])); float s = 0.f;
#pragma unroll
            for (int bj = 0; bj < 2; ++bj)
#pragma unroll
                for (int n = 0; n < 2; ++n)
#pragma unroll
                    for (int e = 0; e < 4; ++e) { const float p = __expf(acc[ai][bj][m][n][e] - mx); acc[ai][bj][m][n][e] = p; s += p; }
            s += __shfl_xor(s, 16); s += __shfl_xor(s, 32);
            if (fq == 0) Y[r * 4 + wc] = s; }
        asm volatile("s_waitcnt lgkmcnt(0)" ::: "memory"); __builtin_amdgcn_s_barrier(); asm volatile("" ::: "memory");
        bf16_t* base = P + (size_t)u.z * SEQ * 256;
        ROWLOOP { const int r = ai * 128 + wr * 64 + m * 16 + fr; const f32x4 ys = *(const LAS f32x4*)(Y + r * 4); const float inv = 1.0f / ((ys[0] + ys[1]) + (ys[2] + ys[3]));
#pragma unroll
            for (int bj = 0; bj < 2; ++bj) *(u32x4*)(base + (size_t)(u.pm * 256 + r) * 256 + bj * 128 + wc * 32 + 8 * fq) = pack8(acc[ai][bj][m][0] * inv, acc[ai][bj][m][1] * inv); }
    }
};
struct EpiFfn1 {
    const u64* ss; bf16_t* HM;
    __device__ __forceinline__ void operator()(EPI_ARGS) const {
        const int row0 = u.pm * 256 + wr * 64 + fr, col0 = u.pn * 128 + wc * 32 + 8 * fq;
        ROWLOOP { const int row = row0 + ai * 128 + m * 16; const float rs = rsqrtf(fx_get(ss + row) * (1.0f / D) + EPS); f32x4 h0, h1;
#pragma unroll
            for (int e = 0; e < 4; ++e) { h0[e] = silu_f(acc[ai][0][m][0][e] * rs) * (acc[ai][1][m][0][e] * rs); h1[e] = silu_f(acc[ai][0][m][1][e] * rs) * (acc[ai][1][m][1][e] * rs); }
            *(u32x4*)(HM + (size_t)row * FH + col0) = pack8(h0, h1); }
    }
};
struct EpiOin {
    const u64* ss; bf16_t* AC;
    __device__ __forceinline__ void operator()(EPI_ARGS) const {
        const int row0 = u.pm * 256 + wr * 64 + fr;
        ROWLOOP { const int row = row0 + ai * 128 + m * 16; const float rs = rsqrtf(fx_get(ss + row) * (1.0f / D) + EPS);
#pragma unroll
            for (int bj = 0; bj < 2; ++bj) { const int col = u.pn * 256 + bj * 128 + wc * 32 + 8 * fq;
                *(u32x4*)(AC + (size_t)(col >> 4) * NCH * AK + (size_t)(row / SL) * AK + (row % SL) * 16 + (col & 8)) = pack8(acc[ai][bj][m][0] * rs, acc[ai][bj][m][1] * rs); } }
    }
};
struct EpiS5State {
    float* XL;
    __device__ __forceinline__ void operator()(EPI_ARGS) const {
        const int row0 = u.pm * 256 + wr * 64 + fr, col0 = wc * 32 + 8 * fq;
        ROWLOOP { const int row = row0 + ai * 128 + m * 16; float* p = XL + (size_t)u.z * NCH * 128 + (size_t)row * 128 + col0;
            *(f32x4*)p = acc[ai][0][m][0]; *(f32x4*)(p + 4) = acc[ai][0][m][1]; }
    }
};
struct EpiS5Out {
    const bf16_t* AC; const float* dsk; bf16_t* Y;
    __device__ __forceinline__ void operator()(EPI_ARGS) const {
        const int g = u.z, row0 = u.pm * 256 + wr * 64 + fr;
        ROWLOOP { const int row = row0 + ai * 128 + m * 16;
#pragma unroll
            for (int bj = 0; bj < 2; ++bj) { const int col = u.pn * 256 + bj * 128 + wc * 32 + 8 * fq, k = col >> 4, ch = g * 16 + (col & 8);
                const u32x4 uu = *(const u32x4*)(AC + (size_t)g * NCH * AK + (size_t)row * AK + col);
                const f32x4 d0 = *(const f32x4*)(dsk + ch), d1 = *(const f32x4*)(dsk + ch + 4);
                f32x4 y0 = acc[ai][bj][m][0], y1 = acc[ai][bj][m][1];
                y0[0] += d0[0] * bflo(uu.x); y0[1] += d0[1] * bfhi(uu.x); y0[2] += d0[2] * bflo(uu.y); y0[3] += d0[3] * bfhi(uu.y);
                y1[0] += d1[0] * bflo(uu.z); y1[1] += d1[1] * bfhi(uu.z); y1[2] += d1[2] * bflo(uu.w); y1[3] += d1[3] * bfhi(uu.w);
#pragma unroll
                for (int e = 0; e < 4; ++e) { y0[e] = gelu_f(y0[e]); y1[e] = gelu_f(y1[e]); }
                *(u32x4*)(Y + (size_t)(row * SL + k) * 512 + ch) = pack8(y0, y1); } }
    }
};
}

#define XB_TMO      128
#define XB_XCNT(j)  (256  + 64 * (j))
#define XB_XSUB(j)  (1280 + 64 * (j))
#define XB_XGEN(j)  (2304 + 64 * (j))
#define XB_TOP      3328
#define XB_TOPGEN   3392
#define XCD_BAR_WORDS 3456
#define XB_SPIN_CAP (1u << 22)
__device__ __forceinline__ unsigned xb_ld(unsigned* p)              { return __hip_atomic_load(p, __ATOMIC_RELAXED, __HIP_MEMORY_SCOPE_AGENT); }
__device__ __forceinline__ unsigned xb_add(unsigned* p, unsigned v) { return __hip_atomic_fetch_add(p, v, __ATOMIC_RELAXED, __HIP_MEMORY_SCOPE_AGENT); }
__device__ __forceinline__ unsigned xb_xcc_id() { return (unsigned)__builtin_amdgcn_s_getreg((3 << 11) | 20) & 0xFu; }
#define XB_SPIN(cond, bar) do { unsigned _sp = 0; while (cond) { __builtin_amdgcn_s_sleep(1); \
    if ((++_sp & 255u) == 0u) { if (xb_ld(&(bar)[XB_TMO])) break; if (_sp > XB_SPIN_CAP) { atomicAdd(&(bar)[XB_TMO], 1u); break; } } } } while (0)
struct XcdBarrier { unsigned* bar; unsigned x; volatile LAS unsigned* st; };
__device__ __forceinline__ XcdBarrier xcd_barrier_post(unsigned* bar, volatile LAS unsigned* st) {
    XcdBarrier b; b.bar = bar; b.x = xb_xcc_id(); b.st = st;
    if (threadIdx.x == 0) (void)xb_add(&bar[XB_XCNT(b.x)], 1u);
    return b;
}
__device__ __forceinline__ void xcd_barrier_complete(unsigned* bar, unsigned x, unsigned& nloc, unsigned& nx) {
    const unsigned G = gridDim.x * gridDim.y * gridDim.z;
    unsigned sum, cnt, mine, sp = 0u;
    for (;;) {
        sum = 0u; cnt = 0u; mine = 0u;
#pragma unroll
        for (unsigned j = 0; j < 16; ++j) { const unsigned c = xb_ld(&bar[XB_XCNT(j)]); sum += c; cnt += (c > 0u) ? 1u : 0u; mine = (j == x) ? c : mine; }
        if (sum == G) break;
        __builtin_amdgcn_s_sleep(1);
        if ((++sp & 255u) == 0u) { if (xb_ld(&bar[XB_TMO])) break; if (sp > XB_SPIN_CAP) { atomicAdd(&bar[XB_TMO], 1u); break; } }
    }
    nloc = mine > 0u ? mine : 1u; nx = cnt > 0u ? cnt : 1u;
}
__device__ __forceinline__ void xcd_barrier(const XcdBarrier& b) {
    asm volatile("s_waitcnt vmcnt(0)" ::: "memory");
    __syncthreads();
    if (threadIdx.x == 0) {
        unsigned* bar = b.bar;
        __builtin_amdgcn_s_waitcnt(0);
        unsigned nloc = b.st[0], nx = b.st[1];
        if (nloc == 0u) { xcd_barrier_complete(bar, b.x, nloc, nx); b.st[0] = nloc; b.st[1] = nx; }
        const unsigned old = xb_add(&bar[XB_XSUB(b.x)], 1u);
        const unsigned gen = old / nloc;
        if (old + 1u == (gen + 1u) * nloc) {
            __builtin_amdgcn_fence(__ATOMIC_RELEASE, "agent");
            asm volatile("s_waitcnt vmcnt(0)" ::: "memory");
            const unsigned og = xb_add(&bar[XB_TOP], 1u);
            const unsigned tg = og / nx;
            if (og + 1u == (tg + 1u) * nx) xb_add(&bar[XB_TOPGEN], 1u);
            else XB_SPIN(xb_ld(&bar[XB_TOPGEN]) == tg, bar);
            __builtin_amdgcn_fence(__ATOMIC_ACQUIRE, "agent");
            xb_add(&bar[XB_XGEN(b.x)], 1u);
            asm volatile("s_waitcnt vmcnt(0)" ::: "memory");
        } else {
            XB_SPIN(xb_ld(&bar[XB_XGEN(b.x)]) == gen, bar);
            __builtin_amdgcn_fence(__ATOMIC_ACQUIRE, "agent");
            asm volatile("s_waitcnt vmcnt(0)" ::: "memory");
        }
    }
    __syncthreads();
}

struct ConvP { const float* W; bf16_t* WT; const float* gain; int K, ldn, cs, nblk, mode, roff, r; };
__device__ __forceinline__ void conv_load(const ConvP& p, float (&v)[32], int lane) {
    const int kb = p.r / p.nblk, nb = p.r % p.nblk; const float* src = p.W + (size_t)(64 * kb + (lane >> 5)) * p.ldn + p.cs + 32 * nb + (lane & 31);
#pragma unroll
    for (int i = 0; i < 32; ++i) v[i] = src[(size_t)(2 * i) * p.ldn];
}
__device__ __forceinline__ void conv_store(const ConvP& p, const float (&v)[32], LAS float* scr, int lane) {
    const int kb = p.r / p.nblk, nb = p.r % p.nblk, k0 = 64 * kb, c0 = 32 * nb, c = lane & 7;
    f32x4 g0 = {1.f, 1.f, 1.f, 1.f}, g1 = g0;
    if (p.gain) { g0 = *(const f32x4*)(p.gain + k0 + 8 * c); g1 = *(const f32x4*)(p.gain + k0 + 8 * c + 4); }
#pragma unroll
    for (int i = 0; i < 32; ++i) scr[(2 * i + (lane >> 5)) * 33 + (lane & 31)] = v[i];
    asm volatile("s_waitcnt lgkmcnt(0)" ::: "memory");
    const int drow = p.roff + (p.mode == 0 ? c0 : ((c0 >> 7) * 256 + (p.mode - 1) * 128 + (c0 & 127)));
#pragma unroll
    for (int j = 0; j < 4; ++j) { const int n = (lane >> 3) + 8 * j; const LAS float* s = scr + (8 * c) * 33 + n;
        u32x4 o; o.x = cvt_pk_bf16(s[0 * 33] * g0[0], s[1 * 33] * g0[1]); o.y = cvt_pk_bf16(s[2 * 33] * g0[2], s[3 * 33] * g0[3]); o.z = cvt_pk_bf16(s[4 * 33] * g1[0], s[5 * 33] * g1[1]); o.w = cvt_pk_bf16(s[6 * 33] * g1[2], s[7 * 33] * g1[3]);
        *(u32x4*)(p.WT + (size_t)(drow + n) * p.K + k0 + 8 * c) = o; }
    asm volatile("s_waitcnt lgkmcnt(0)" ::: "memory");
}
template <bool NORM, int R> __device__ __forceinline__ void rows_to_bf16(const float* x0, bf16_t* o0, u64* ssq, int lane) {
    f32x4 v[R][4]; float s[R];
#pragma unroll
    for (int r = 0; r < R; ++r) { const f32x4* xr = (const f32x4*)(x0 + (size_t)r * D) + lane;
#pragma unroll
        for (int j = 0; j < 4; ++j) v[r][j] = xr[64 * j]; }
#pragma unroll
    for (int r = 0; r < R; ++r) { float a = 0.f;
#pragma unroll
        for (int j = 0; j < 4; ++j) a += (v[r][j][0] * v[r][j][0] + v[r][j][1] * v[r][j][1]) + (v[r][j][2] * v[r][j][2] + v[r][j][3] * v[r][j][3]);
        s[r] = wave_sum(a); }
#pragma unroll
    for (int r = 0; r < R; ++r) { const float rs = NORM ? rsqrtf(s[r] * (1.0f / D) + EPS) : 1.0f; u32x2* o = (u32x2*)(o0 + (size_t)r * D) + lane;
#pragma unroll
        for (int j = 0; j < 4; ++j) { u32x2 w; w.x = cvt_pk_bf16(v[r][j][0] * rs, v[r][j][1] * rs); w.y = cvt_pk_bf16(v[r][j][2] * rs, v[r][j][3] * rs); o[64 * j] = w; }
        if (ssq && lane == 0) ssq[r] = (u64)(long long)(s[r] * 16777216.0f); }
}
__device__ __forceinline__ void cis_f(float ang, float& c, float& s) {
    float rev = ang * 0.15915494309189535f; rev = rev - rintf(rev);
    const float x = rev * 6.283185307179586f;
    const float h = x * 0.25f, h2 = h * h;
    float sh = h * (1.0f + h2 * (-1.6666667e-1f + h2 * (8.3333333e-3f + h2 * (-1.9841270e-4f + h2 * 2.7557319e-6f))));
    float ch = 1.0f + h2 * (-0.5f + h2 * (4.1666667e-2f + h2 * (-1.3888889e-3f + h2 * (2.4801587e-5f + h2 * -2.7557319e-7f))));
    float s2 = 2.f * sh * ch, c2 = 1.f - 2.f * sh * sh;
    s = 2.f * s2 * c2; c = 1.f - 2.f * s2 * s2;
}
__device__ __forceinline__ void s5_setup(int g, LAS unsigned char* lds, const float* lam_re, const float* lam_im, const float* log_dt, const float* b_re, const float* b_im, const float* c_re, const float* c_im,
                                         bf16_t* BT3, bf16_t* GM, float* AL, int tid) {
    LAS float* pwr = (LAS float*)lds; LAS float* pwi = pwr + 33 * 64; LAS float* Bbr = pwi + 33 * 64; LAS float* Bbi = Bbr + 1024; LAS float* Cr = Bbi + 1024; LAS float* Ci = Cr + 1024; LAS float* Kd = Ci + 1024;
    const float dt = __expf(log_dt[g]);
    for (int idx = tid; idx < 33 * 64; idx += 512) { const int d = idx >> 6, p = idx & 63; const float lr = lam_re[g * 64 + p], li = lam_im[g * 64 + p];
        const float mag = __expf(lr * dt * (float)d); float c, s; cis_f(li * dt * (float)d, c, s); pwr[idx] = mag * c; pwi[idx] = mag * s; }
    for (int idx = tid; idx < 1024; idx += 512) { const int p = idx >> 4; const float lr = lam_re[g * 64 + p], li = lam_im[g * 64 + p];
        const float mag = __expf(lr * dt); float c, s; cis_f(li * dt, c, s); const float ar = mag * c, ai = mag * s, den = lr * lr + li * li;
        const float qr = ((ar - 1.0f) * lr + ai * li) / den, qi = (ai * lr - (ar - 1.0f) * li) / den;
        const float br = b_re[g * 1024 + idx], bi = b_im[g * 1024 + idx];
        Bbr[idx] = qr * br - qi * bi; Bbi[idx] = qr * bi + qi * br;
        Cr[idx] = c_re[g * 1024 + idx]; Ci[idx] = c_im[g * 1024 + idx]; }
    __syncthreads();
    for (int idx = tid; idx < 32 * 256; idx += 512) { const int d = idx >> 8, co = (idx >> 4) & 15, ci = idx & 15; float a = 0.f;
        for (int p = 0; p < 64; ++p) { const float cr = Cr[co * 64 + p], cim = Ci[co * 64 + p], pr = pwr[d * 64 + p], pi = pwi[d * 64 + p];
            const float tr = cr * pr - cim * pi, ti = cr * pi + cim * pr; a += tr * Bbr[p * 16 + ci] - ti * Bbi[p * 16 + ci]; }
        Kd[idx] = a; }
    __syncthreads();
    bf16_t* bt = BT3 + (size_t)g * 512 * AK;
    for (int idx = tid; idx < 512 * (AK / 8); idx += 512) { const int n = idx / (AK / 8), q = idx % (AK / 8), kk0 = q * 8, k = n >> 4, co = n & 15; float v[8];
        if (kk0 < 512) { const int j = kk0 >> 4, ci0 = kk0 & 15;
#pragma unroll
            for (int e = 0; e < 8; ++e) v[e] = (j <= k) ? Kd[(k - j) * 256 + co * 16 + ci0 + e] : 0.f;
        } else { const int p0 = kk0 - 512;
#pragma unroll
            for (int e = 0; e < 8; ++e) { const int p = (p0 & 63) + e; const float cr = Cr[co * 64 + p], cim = Ci[co * 64 + p], pr = pwr[(k + 1) * 64 + p], pi = pwi[(k + 1) * 64 + p];
                v[e] = (p0 < 64) ? (cr * pr - cim * pi) : -(cr * pi + cim * pr); } }
        u32x4 w; w.x = cvt_pk_bf16(v[0], v[1]); w.y = cvt_pk_bf16(v[2], v[3]); w.z = cvt_pk_bf16(v[4], v[5]); w.w = cvt_pk_bf16(v[6], v[7]);
        *(u32x4*)(bt + (size_t)n * AK + kk0) = w; }
    bf16_t* gm = GM + (size_t)g * 256 * 512;
    for (int idx = tid; idx < 256 * 64; idx += 512) { const int n = idx >> 6, q = idx & 63, kk0 = q * 8; float v[8];
        if (n < 128) { const int p = n & 63, j = kk0 >> 4, ci0 = kk0 & 15; const float pr = pwr[(SL - 1 - j) * 64 + p], pi = pwi[(SL - 1 - j) * 64 + p];
#pragma unroll
            for (int e = 0; e < 8; ++e) { const float br = Bbr[p * 16 + ci0 + e], bi = Bbi[p * 16 + ci0 + e]; v[e] = (n < 64) ? (pr * br - pi * bi) : (pr * bi + pi * br); }
        } else {
#pragma unroll
            for (int e = 0; e < 8; ++e) v[e] = 0.f; }
        u32x4 w; w.x = cvt_pk_bf16(v[0], v[1]); w.y = cvt_pk_bf16(v[2], v[3]); w.z = cvt_pk_bf16(v[4], v[5]); w.w = cvt_pk_bf16(v[6], v[7]);
        *(u32x4*)(gm + (size_t)n * 512 + kk0) = w; }
    if (tid < 64) { AL[(g * 64 + tid) * 2] = pwr[SL * 64 + tid]; AL[(g * 64 + tid) * 2 + 1] = pwi[SL * 64 + tid]; }
    __syncthreads();
}

__device__ __forceinline__ void gmlp_unit(int unit, LAS unsigned char* lds, const bf16_t* U, const bf16_t* V, const u64* vst, const bf16_t* GW, const float* gb, bf16_t* MIX, int tid) {
    const int g = unit & 3, t0 = (unit >> 2) * 128, lane = tid & 63, wid = tid >> 6;
    LAS bf16_t* vT = (LAS bf16_t*)lds;
#pragma unroll
    for (int e = 0; e < 4; ++e) { const int q = tid + 512 * e, j = q >> 4, c8 = (q & 15) * 8;
        const u32x4 raw = *(const u32x4*)(V + (size_t)(t0 + j) * 512 + g * 128 + c8);
        const float s = fx_get(vst + 2 * (t0 + j)), ss = fx_get(vst + 2 * (t0 + j) + 1), mean = s * (1.0f / 512.0f), var = ss * (1.0f / 512.0f) - mean * mean, rstd = rsqrtf(fmaxf(var, 0.f) + EPS);
        float v[8] = {bflo(raw.x), bfhi(raw.x), bflo(raw.y), bfhi(raw.y), bflo(raw.z), bfhi(raw.z), bflo(raw.w), bfhi(raw.w)};
#pragma unroll
        for (int i = 0; i < 8; i += 2) { const unsigned pk = cvt_pk_bf16((v[i] - mean) * rstd, (v[i + 1] - mean) * rstd); vT[(c8 + i) * 136 + j] = (bf16_t)(pk & 0xffffu); vT[(c8 + i + 1) * 136 + j] = (bf16_t)(pk >> 16); } }
    __syncthreads();
    const int il = lane & 15, kq = lane >> 4, i = wid * 16 + il;
    bf16x8 wf[4];
#pragma unroll
    for (int ks = 0; ks < 4; ++ks) wf[ks] = *(const bf16x8*)(GW + (size_t)g * 16384 + (size_t)i * 128 + ks * 32 + kq * 8);
    const float bias = gb[g * 128 + i];
#pragma unroll 2
    for (int nt = 0; nt < 8; ++nt) { f32x4 a = {0.f, 0.f, 0.f, 0.f};
#pragma unroll
        for (int ks = 0; ks < 4; ++ks) { const bf16x8 vf = *(const LAS bf16x8*)(vT + (nt * 16 + il) * 136 + ks * 32 + kq * 8); a = __builtin_amdgcn_mfma_f32_16x16x32_bf16(vf, wf[ks], a, 0, 0, 0); }
        const size_t tok = (size_t)(t0 + i); const int c = g * 128 + nt * 16 + kq * 4;
        const u32x2 uu = *(const u32x2*)(U + tok * 512 + c);
        u32x2 o; o.x = cvt_pk_bf16(bflo(uu.x) * (a[0] + bias), bfhi(uu.x) * (a[1] + bias)); o.y = cvt_pk_bf16(bflo(uu.y) * (a[2] + bias), bfhi(uu.y) * (a[3] + bias));
        *(u32x2*)(MIX + tok * 1024 + c) = o; }
    __syncthreads();
}
__device__ __forceinline__ void conv_unit(int unit, LAS unsigned char* lds, const bf16_t* H, const float* cw, const float* cb, const float* lng, const float* lnb, bf16_t* MIX, int tid) {
    const int t0 = unit * 32, s0 = t0 % SEQ, lane = tid & 63, wid = tid >> 6;
    LAS bf16_t* hin = (LAS bf16_t*)lds;
    LAS float* cout = (LAS float*)(lds + 62 * 1024);
    for (int q = tid; q < 62 * 64; q += 512) { const int r = q >> 6, c8 = (q & 63) * 8; u32x4 v = {0u, 0u, 0u, 0u};
        if (s0 - 30 + r >= 0) v = *(const u32x4*)(H + (size_t)(t0 - 30 + r) * 512 + c8);
        *(LAS u32x4*)(hin + r * 512 + c8) = v; }
    float w[31];
#pragma unroll
    for (int k = 0; k < 31; ++k) w[k] = cw[k * 512 + tid];
    const float bias = cb[tid];
    __syncthreads();
#pragma unroll 1
    for (int tg = 0; tg < 4; ++tg) { float x[38];
#pragma unroll
        for (int r = 0; r < 38; ++r) x[r] = bf2f(hin[(tg * 8 + r) * 512 + tid]);
#pragma unroll
        for (int o = 0; o < 8; ++o) { float a = bias;
#pragma unroll
            for (int k = 0; k < 31; ++k) a += w[k] * x[o + k];
            cout[(tg * 8 + o) * 516 + tid] = a; } }
    __syncthreads();
#pragma unroll 1
    for (int tt = 0; tt < 4; ++tt) { const int row = wid * 4 + tt; const f32x4 v0 = *(const LAS f32x4*)(cout + row * 516 + lane * 8), v1 = *(const LAS f32x4*)(cout + row * 516 + lane * 8 + 4);
        const float mean = wave_sum((v0[0] + v0[1]) + (v0[2] + v0[3]) + (v1[0] + v1[1]) + (v1[2] + v1[3])) * (1.0f / 512.0f);
        const f32x4 d0 = v0 - mean, d1 = v1 - mean;
        const float var = wave_sum((d0[0] * d0[0] + d0[1] * d0[1]) + (d0[2] * d0[2] + d0[3] * d0[3]) + (d1[0] * d1[0] + d1[1] * d1[1]) + (d1[2] * d1[2] + d1[3] * d1[3])) * (1.0f / 512.0f);
        const float rstd = rsqrtf(var + EPS);
        const f32x4 g0 = *(const f32x4*)(lng + lane * 8), g1 = *(const f32x4*)(lng + lane * 8 + 4), b0 = *(const f32x4*)(lnb + lane * 8), b1 = *(const f32x4*)(lnb + lane * 8 + 4);
        f32x4 y0 = d0 * rstd * g0 + b0, y1 = d1 * rstd * g1 + b1;
#pragma unroll
        for (int e = 0; e < 4; ++e) { y0[e] = silu_f(y0[e]); y1[e] = silu_f(y1[e]); }
        *(u32x4*)(MIX + (size_t)(t0 + row) * 1024 + 512 + lane * 8) = pack8(y0, y1); }
    __syncthreads();
}

struct Args { const float* in[33]; float* out; unsigned char* ws; int ph_lo, ph_hi; };
constexpr int NPHASE = 27;

typedef const __attribute__((address_space(4))) Args* KArgP;
__device__ __forceinline__ KArgP fresh_args() { KArgP p = (KArgP)__builtin_amdgcn_kernarg_segment_ptr(); asm volatile("" : "+s"(p)); return p; }

__global__ void __launch_bounds__(512, 2) trunk_fwd(Args args_unused) {
    extern __shared__ __attribute__((aligned(16))) unsigned char lds_raw[];
    LAS unsigned char* lds = (LAS unsigned char*)lds_raw;
    cg::grid_group grid = cg::this_grid();
    { volatile LAS unsigned* MISC0 = (volatile LAS unsigned*)(lds + MISC_OFF); if (threadIdx.x < 32) MISC0[threadIdx.x] = 0u; }
    __syncthreads();
    int lo, hi;
    { KArgP ap = fresh_args(); lo = ap->ph_lo; hi = ap->ph_hi; }
#if !MK_MULTI && !MK_CGSYNC
    { KArgP ap = fresh_args(); (void)xcd_barrier_post((unsigned*)(ap->ws + WS_BAR), (volatile LAS unsigned*)(lds + MISC_OFF) + 8); }
#endif
    int nsync = 0;
#if MK_MULTI
#define SEAM(k) do { } while (0)
#elif MK_CGSYNC
#define SEAM(k) do { if (rep_ + 1 == nrep_ && (k) + 1 < hi) grid.sync(); } while (0)
#else
#define SEAM(k) do { if (rep_ + 1 == nrep_ && (k) + 1 < hi) { if (hi > 1000) grid.sync(); else { KArgP ap_ = fresh_args(); XcdBarrier xb_; xb_.bar = (unsigned*)(ap_->ws + WS_BAR); xb_.x = xb_xcc_id(); xb_.st = (volatile LAS unsigned*)(lds + MISC_OFF) + 8; xcd_barrier(xb_); } ++nsync; } } while (0)
#endif
#ifndef ONLY
#define ONLY -1
#endif
#ifndef REPMASK
#define REPMASK 0
#endif
#define PHASE(id, k) if ((ONLY < 0 || ONLY == (id)) && lo <= (k) && (k) < hi) for (int rep_ = 0, nrep_ = (((REPMASK) >> (id)) & 1) ? 2 : 1; rep_ < nrep_; ++rep_)
    (void)nsync;
#define LOCALS KArgP ap = fresh_args(); unsigned char* ws = ap->ws; float* out = ap->out; const float* x_in = ap->in[0]; \
    int tid_ = threadIdx.x, G_ = gridDim.x, bx_ = blockIdx.x; asm volatile("" : "+v"(tid_), "+s"(G_), "+s"(bx_)); \
    const int tid = tid_, lane = tid & 63, wave = __builtin_amdgcn_readfirstlane(tid >> 6), G = G_, bx = bx_, gw = bx * 8 + wave, NGW = G * 8; \
    bf16_t* XB = (bf16_t*)(ws + WS_XB); u64* SS = (u64*)(ws + WS_SS); u64* VST = (u64*)(ws + WS_VST); bf16_t* QO = (bf16_t*)(ws + WS_QO); bf16_t* Pb = (bf16_t*)(ws + WS_P); \
    bf16_t* HM = (bf16_t*)(ws + WS_HM); bf16_t* MEMN = (bf16_t*)(ws + WS_MEMN); bf16_t* KL = (bf16_t*)(ws + WS_KL); bf16_t* VT = (bf16_t*)(ws + WS_VT); \
    bf16_t* U = (bf16_t*)(ws + WS_U); bf16_t* V = (bf16_t*)(ws + WS_V); bf16_t* H = (bf16_t*)(ws + WS_H); bf16_t* MIX = (bf16_t*)(ws + WS_MIX); \
    bf16_t* AC = (bf16_t*)(ws + WS_ACOMB); float* XL = (float*)(ws + WS_XLOC); bf16_t* Y = (bf16_t*)(ws + WS_Y); u64* SSa = SS + (size_t)(3 * l) * T; \
    (void)out; (void)x_in; (void)lane; (void)gw; (void)NGW; (void)XB; (void)VST; (void)QO; (void)Pb; (void)HM; (void)MEMN; (void)KL; (void)VT; (void)U; (void)V; (void)H; (void)MIX; (void)AC; (void)XL; (void)Y; (void)SSa; (void)wave;

    PHASE(0, 0) { const int l = 0; LOCALS
        { f32x4* z = (f32x4*)(SS + T); const int n4 = 7 * T * 2 / 4; for (int i = bx * 512 + tid; i < n4; i += G * 512) z[i] = (f32x4){0.f, 0.f, 0.f, 0.f};
          f32x4* z2 = (f32x4*)VST; const int m4 = 2 * T * 2 / 4; for (int i = bx * 512 + tid; i < m4; i += G * 512) z2[i] = (f32x4){0.f, 0.f, 0.f, 0.f}; }
        LAS float* scr = (LAS float*)(lds + wave * 16384);
#define CONVJOB(Wp, K_, ldn_, cs_, nc_, WTp, mode_, roff_, gain_) { const int nblk_ = (nc_) / 32, cnt_ = ((K_) / 64) * nblk_; \
            if (r >= 0 && r < cnt_) { cp.W = (Wp); cp.WT = (bf16_t*)(WTp); cp.gain = (gain_); cp.K = (K_); cp.ldn = (ldn_); cp.cs = (cs_); cp.nblk = nblk_; cp.mode = (mode_); cp.roff = (roff_); cp.r = r; } r -= cnt_; }
#define CONVLOOKUP(cp, it_) { int r = (it_); \
            CONVJOB(ap->in[3], 1024, 2048, 0, 1024, ws + WS_WIN0, 0, 0, ap->in[2]); \
            CONVJOB(ap->in[3], 1024, 2048, 1024, 512, ws + WS_WIN0, 1, 1024, ap->in[2]); \
            CONVJOB(ap->in[3], 1024, 2048, 1536, 512, ws + WS_WIN0, 2, 1024, ap->in[2]); \
            CONVJOB(ap->in[10], 1024, 1024, 0, 1024, ws + WS_WOUT0, 0, 0, nullptr); \
            CONVJOB(ap->in[12], 1024, 512, 0, 512, ws + WS_WOIN, 0, 0, ap->in[11]); \
            CONVJOB(ap->in[21], 512, 2048, 0, 1024, ws + WS_WOOUT, 1, 0, nullptr); \
            CONVJOB(ap->in[21], 512, 2048, 1024, 1024, ws + WS_WOOUT, 2, 0, nullptr); \
            _Pragma("unroll") for (int l2 = 0; l2 < 2; ++l2) { \
                CONVJOB(ap->in[24] + (size_t)l2 * D * D, 1024, 1024, 0, 1024, ws + WS_WQ + l2 * WSQ_L, 0, 0, ap->in[22] + l2 * D); \
                CONVJOB(ap->in[25] + (size_t)l2 * D * D, 1024, 1024, 0, 1024, ws + WS_WK + l2 * WSQ_L, 0, 0, ap->in[23] + l2 * D); \
                CONVJOB(ap->in[26] + (size_t)l2 * D * D, 1024, 1024, 0, 1024, ws + WS_WV + l2 * WSQ_L, 0, 0, ap->in[23] + l2 * D); \
                CONVJOB(ap->in[27] + (size_t)l2 * D * D, 1024, 1024, 0, 1024, ws + WS_WO + l2 * WSQ_L, 0, 0, nullptr); \
                CONVJOB(ap->in[29] + (size_t)l2 * D * FH, 1024, FH, 0, FH, ws + WS_WGU + l2 * WGU_L, 1, 0, ap->in[28] + l2 * D); \
                CONVJOB(ap->in[30] + (size_t)l2 * D * FH, 1024, FH, 0, FH, ws + WS_WGU + l2 * WGU_L, 2, 0, ap->in[28] + l2 * D); \
                CONVJOB(ap->in[31] + (size_t)l2 * FH * D, FH, 1024, 0, 1024, ws + WS_WD + l2 * WD_L, 0, 0, nullptr); } }
        constexpr int NITEMS = 512 + 256 + 256 + 512 + 256 + 256 + 256 + 2 * (4 * 512 + 3 * 1408);
        for (int it = gw; it < NITEMS; it += 4 * NGW) {
            ConvP c0{}, c1{}, c2{}, c3{}; float v0[32], v1[32], v2[32], v3[32];
            const bool h1 = it + NGW < NITEMS, h2 = it + 2 * NGW < NITEMS, h3 = it + 3 * NGW < NITEMS;
            { ConvP cp{}; CONVLOOKUP(cp, it); c0 = cp; } conv_load(c0, v0, lane);
            if (h1) { ConvP cp{}; CONVLOOKUP(cp, it + NGW); c1 = cp; conv_load(c1, v1, lane); }
            if (h2) { ConvP cp{}; CONVLOOKUP(cp, it + 2 * NGW); c2 = cp; conv_load(c2, v2, lane); }
            if (h3) { ConvP cp{}; CONVLOOKUP(cp, it + 3 * NGW); c3 = cp; conv_load(c3, v3, lane); }
            conv_store(c0, v0, scr, lane);
            if (h1) conv_store(c1, v1, scr, lane);
            if (h2) conv_store(c2, v2, scr, lane);
            if (h3) conv_store(c3, v3, scr, lane);
        }
        { const int nb5 = (G > 64) ? G - 32 : G;
          if (bx < nb5) { const int NW5 = nb5 * 8;
              for (int m = gw * 4; m < T; m += NW5 * 4) rows_to_bf16<false, 4>(x_in + (size_t)m * D, XB + (size_t)m * D, SS + m, lane);
              for (int m = gw * 4; m < MT; m += NW5 * 4) rows_to_bf16<true, 4>(ap->in[1] + (size_t)m * D, MEMN + (size_t)m * D, nullptr, lane); } }
        { bf16_t* GW = (bf16_t*)(ws + WS_GW); const float* w = ap->in[4];
          for (int i = bx * 512 + tid; i < 4 * 128 * 128 / 2; i += G * 512) { const int e = 2 * i, ii = (e >> 7) & 127, jj = e & 127; const bool keep = (jj >> 6) <= (ii >> 6);
              ((unsigned*)GW)[i] = keep ? cvt_pk_bf16(w[e], w[e + 1]) : 0u; } }
        __syncthreads();
        for (int g = G - 1 - bx; g < 32; g += G)
            s5_setup(g, lds, ap->in[13], ap->in[14], ap->in[15], ap->in[16], ap->in[17], ap->in[18], ap->in[19], (bf16_t*)(ws + WS_BT3), (bf16_t*)(ws + WS_GM), (float*)(ws + WS_AL), tid);
        SEAM(0);
    }
    PHASE(1, 1) { const int l = 0; LOCALS
        { pg8::Gemm g{MEMN, (const bf16_t*)(ws + WS_WK), D, D, D, 2, 0, 0, (long)D * D, 0}; pg8::Sched S; S.init(MT / 256, D / 256, 2, G, bx);
          pg8::EpiStore E{KL, D, 2, (long)MT * D, 0, nullptr, 1.0f}; pg8::gemm_phase<MK_ALIGN>(lds, g, S, E, tid); }
        { pg8::Gemm g{(const bf16_t*)(ws + WS_WV), MEMN, D, D, D, 2, (long)D * D, 0, 0, 0}; pg8::Sched S; S.init(D / 256, MT / 256, 2, G, (bx + G / 2) % G);
          pg8::EpiStore E{VT, MT, 2, (long)D * MT, 0, nullptr, 1.0f}; pg8::gemm_phase<MK_ALIGN>(lds, g, S, E, tid); }
        SEAM(1);
    }
#pragma unroll 1
    for (int l = 0; l < 2; ++l) {
        const int pb = 2 + 12 * l;
        if (l == 0) {
            PHASE(2, pb + 0) { LOCALS
                pg8::Gemm g{XB, (const bf16_t*)(ws + WS_WIN0), D, D, D, 1, 0, 0, 0, 0}; pg8::Sched S; S.init(T / 256, 2048 / 256, 1, G, bx);
                pg8::EpiIn0 E{SSa, U, V, H, VST}; pg8::gemm_phase<MK_ALIGN>(lds, g, S, E, tid);
                SEAM(pb + 0);
            }
            PHASE(3, pb + 1) { LOCALS
                for (int i = bx; i < 2048; i += G) {
                    if (i < 1024) gmlp_unit(i, lds, U, V, VST, (const bf16_t*)(ws + WS_GW), ap->in[5], MIX, tid);
                    else conv_unit(i - 1024, lds, H, ap->in[6], ap->in[7], ap->in[8], ap->in[9], MIX, tid);
                }
                SEAM(pb + 1);
            }
            PHASE(4, pb + 2) { LOCALS
                pg8::Gemm g{MIX, (const bf16_t*)(ws + WS_WOUT0), D, D, D, 1, 0, 0, 0, 0}; pg8::Sched S; S.init(T / 256, D / 256, 1, G, bx);
                pg8::EpiRes<false> E{XB, SSa + T}; pg8::gemm_phase<MK_ALIGN>(lds, g, S, E, tid);
                SEAM(pb + 2);
            }
        } else {
            PHASE(5, pb + 0) { LOCALS
                pg8::Gemm g{XB, (const bf16_t*)(ws + WS_WOIN), D, D, D, 1, 0, 0, 0, 0}; pg8::Sched S; S.init(T / 256, 512 / 256, 1, G, bx);
                pg8::EpiOin E{SSa, AC}; pg8::gemm_phase<MK_ALIGN>(lds, g, S, E, tid);
                SEAM(pb + 0);
            }
            PHASE(6, pb + 1) { LOCALS
                pg8::Gemm g{AC, (const bf16_t*)(ws + WS_GM), AK, 512, 512, 32, (long)NCH * AK, 0, 256L * 512, 0}; pg8::Sched S; S.init(NCH / 256, 1, 32, G, bx);
                pg8::EpiS5State E{XL}; pg8::gemm_phase<MK_ALIGN>(lds, g, S, E, tid);
                SEAM(pb + 1);
            }
            PHASE(7, pb + 2) { LOCALS
                if (wave == 0) {
                    const int idx = bx * 64 + lane;
                    if (idx < NB * 32 * 64) { const int p = idx & 63, g = (idx >> 6) & 31, b = idx >> 11;
                        const float* AL = (const float*)(ws + WS_AL); const float ar = AL[(g * 64 + p) * 2], ai = AL[(g * 64 + p) * 2 + 1];
                        const float* xl = XL + (size_t)g * NCH * 128 + (size_t)(b * (SEQ / SL)) * 128; bf16_t* ac = AC + (size_t)g * NCH * AK + (size_t)(b * (SEQ / SL)) * AK + 512;
                        float xr = 0.f, xi = 0.f;
#pragma unroll 1
                        for (int c0 = 0; c0 < SEQ / SL; c0 += 32) { float lr[32], li[32];
#pragma unroll
                            for (int i = 0; i < 32; ++i) { lr[i] = xl[(size_t)(c0 + i) * 128 + p]; li[i] = xl[(size_t)(c0 + i) * 128 + 64 + p]; }
#pragma unroll
                            for (int i = 0; i < 32; ++i) { const unsigned pk = cvt_pk_bf16(xr, xi); ac[(size_t)(c0 + i) * AK + p] = (bf16_t)(pk & 0xffffu); ac[(size_t)(c0 + i) * AK + 64 + p] = (bf16_t)(pk >> 16);
                                const float nr = ar * xr - ai * xi + lr[i], ni = ar * xi + ai * xr + li[i]; xr = nr; xi = ni; } }
                    }
                }
                SEAM(pb + 2);
            }
            PHASE(8, pb + 3) { LOCALS
                pg8::Gemm g{AC, (const bf16_t*)(ws + WS_BT3), AK, AK, AK, 32, (long)NCH * AK, 0, 512L * AK, 0}; pg8::Sched S; S.init(NCH / 256, 2, 32, G, bx);
                pg8::EpiS5Out E{AC, ap->in[20], Y}; pg8::gemm_phase<MK_ALIGN>(lds, g, S, E, tid);
                SEAM(pb + 3);
            }
            PHASE(9, pb + 4) { LOCALS
                pg8::Gemm g{Y, (const bf16_t*)(ws + WS_WOOUT), 512, 512, 512, 1, 0, 0, 0, 0}; pg8::Sched S; S.init(T / 256, 2048 / 256, 1, G, bx);
                pg8::EpiRes<true> E{XB, SSa + T}; pg8::gemm_phase<MK_ALIGN>(lds, g, S, E, tid);
                SEAM(pb + 4);
            }
        }
        PHASE(10, pb + 5) { LOCALS
            pg8::Gemm g{XB, (const bf16_t*)(ws + WS_WQ + l * WSQ_L), D, D, D, 1, 0, 0, 0, 0}; pg8::Sched S; S.init(T / 256, D / 256, 1, G, bx);
            pg8::EpiStore E{QO, D, 1, 0, 0, SSa + T, 0.0625f}; pg8::gemm_phase<MK_ALIGN>(lds, g, S, E, tid);
            SEAM(pb + 5);
        }
        PHASE(11, pb + 6) { LOCALS
            pg8::Gemm g{QO, KL + (size_t)l * MT * D, D, D, 256, 4, 256, (long)SEQ * D, 256, 256L * D}; pg8::Sched S; S.init(SEQ / 256, 1, 32, G, bx);
            pg8::EpiSoftmax E{Pb}; pg8::gemm_phase<true>(lds, g, S, E, tid);
            SEAM(pb + 6);
        }
        PHASE(12, pb + 7) { LOCALS
            pg8::Gemm g{Pb, VT + (size_t)l * D * MT, 256, MT, 256, 4, (long)SEQ * 256, 4L * SEQ * 256, 256L * MT, 256}; pg8::Sched S; S.init(SEQ / 256, 1, 32, G, bx);
            pg8::EpiStore E{QO, D, 4, 256, (long)SEQ * D, nullptr, 1.0f}; pg8::gemm_phase<MK_ALIGN>(lds, g, S, E, tid);
            SEAM(pb + 7);
        }
        PHASE(13, pb + 8) { LOCALS
            pg8::Gemm g{QO, (const bf16_t*)(ws + WS_WO + l * WSQ_L), D, D, D, 1, 0, 0, 0, 0}; pg8::Sched S; S.init(T / 256, D / 256, 1, G, bx);
            pg8::EpiRes<false> E{XB, SSa + 2 * T}; pg8::gemm_phase<MK_ALIGN>(lds, g, S, E, tid);
            SEAM(pb + 8);
        }
        PHASE(14, pb + 9) { LOCALS
            pg8::Gemm g{XB, (const bf16_t*)(ws + WS_WGU + l * WGU_L), D, D, D, 1, 0, 0, 0, 0}; pg8::Sched S; S.init(T / 256, 2 * FH / 256, 1, G, bx);
            pg8::EpiFfn1 E{SSa + 2 * T, HM}; pg8::gemm_phase<MK_ALIGN>(lds, g, S, E, tid);
            SEAM(pb + 9);
        }
        PHASE(15, pb + 10) { LOCALS
            pg8::Gemm g{HM, (const bf16_t*)(ws + WS_WD + l * WD_L), FH, FH, FH, 1, 0, 0, 0, 0}; pg8::Sched S; S.init(T / 256, D / 256, 1, G, bx);
            pg8::EpiRes<false> E{XB, SSa + 3 * T}; pg8::gemm_phase<MK_ALIGN>(lds, g, S, E, tid);
            SEAM(pb + 10);
        }
    }
    PHASE(16, 26) { const int l = 0; LOCALS
        const u64* ssf = SS + (size_t)6 * T; const float* gf = ap->in[32];
        const f32x4 ga = *(const f32x4*)(gf + 8 * lane), gb = *(const f32x4*)(gf + 8 * lane + 4), gc = *(const f32x4*)(gf + 512 + 8 * lane), gd = *(const f32x4*)(gf + 512 + 8 * lane + 4);
        for (int m = gw * 4; m < T; m += NGW * 4) { u32x4 v[4][2]; float rs[4];
#pragma unroll
            for (int r = 0; r < 4; ++r) { rs[r] = rsqrtf(fx_get(ssf + m + r) * (1.0f / D) + EPS); const bf16_t* xr = XB + (size_t)(m + r) * D + 8 * lane; v[r][0] = *(const u32x4*)xr; v[r][1] = *(const u32x4*)(xr + 512); }
#pragma unroll
            for (int r = 0; r < 4; ++r) { float* orow = out + (size_t)(m + r) * D + 8 * lane; f32x4 a0, a1, b0, b1; pg8::unpack8(v[r][0], a0, a1); pg8::unpack8(v[r][1], b0, b1);
                *(f32x4*)orow = a0 * rs[r] * ga; *(f32x4*)(orow + 4) = a1 * rs[r] * gb; *(f32x4*)(orow + 512) = b0 * rs[r] * gc; *(f32x4*)(orow + 516) = b1 * rs[r] * gd; } }
    }
}

extern "C" void kernel_launch(void* const* d_in, const int* in_sizes, int n_in, void* d_out, int out_size, void* d_ws, size_t ws_size, hipStream_t stream) {
    static int grid = 0;
    if (grid == 0) {
        if (n_in != 33 || in_sizes[0] != T * D || out_size != T * D || ws_size < WS_END) { fprintf(stderr, "kernel_launch: unexpected shapes (n_in %d, in0 %d, out %d, ws %zu < %zu)\n", n_in, n_in > 0 ? in_sizes[0] : -1, out_size, ws_size, (size_t)WS_END); grid = -1; return; }
        int dev = 0, cus = 0, per_cu = 0;
        hipGetDevice(&dev); hipDeviceGetAttribute(&cus, hipDeviceAttributeMultiprocessorCount, dev);
        if (hipFuncSetAttribute((const void*)trunk_fwd, hipFuncAttributeMaxDynamicSharedMemorySize, LDS_BYTES) != hipSuccess) { fprintf(stderr, "kernel_launch: hipFuncSetAttribute failed\n"); grid = -1; return; }
        if (hipOccupancyMaxActiveBlocksPerMultiprocessor(&per_cu, (const void*)trunk_fwd, 512, LDS_BYTES) != hipSuccess || per_cu < 1) { fprintf(stderr, "kernel_launch: occupancy query says %d\n", per_cu); per_cu = 1; }
        (void)hipGetLastError();
        grid = cus * 1;
        if (grid <= 0) grid = 256;
    }
    if (grid < 0) return;
    Args a{};
    for (int i = 0; i < 33; ++i) a.in[i] = (const float*)d_in[i];
    a.out = (float*)d_out; a.ws = (unsigned char*)d_ws;
#if !MK_MULTI && !MK_CGSYNC
    (void)hipMemsetAsync((char*)d_ws + WS_BAR, 0, XCD_BAR_WORDS * 4, stream);
#endif
#if MK_MULTI
    for (int p = 0; p < NPHASE; ++p) {
        if (p == 5 || p == 6 || p == 13 || p == 25) continue;
        a.ph_lo = p; a.ph_hi = p + 1; void* kargs[] = {&a};
        hipError_t e = hipLaunchCooperativeKernel((const void*)trunk_fwd, dim3(grid), dim3(512), kargs, LDS_BYTES, stream);
        if (e != hipSuccess) { fprintf(stderr, "kernel_launch: launch of phase %d failed: %s\n", p, hipGetErrorString(e)); break; }
    }
#else
    a.ph_lo = 0; a.ph_hi = NPHASE; void* kargs[] = {&a};
    hipError_t e = hipLaunchCooperativeKernel((const void*)trunk_fwd, dim3(grid), dim3(512), kargs, LDS_BYTES, stream);
    if (e != hipSuccess) fprintf(stderr, "kernel_launch: cooperative launch failed: %s (grid %d)\n", hipGetErrorString(e), grid);
#endif
}
```

```cpp
#include <hip/hip_runtime.h>
#include <hip/hip_cooperative_groups.h>
#include <cstdio>
#include <cstdint>
namespace cg = cooperative_groups;

#ifndef MK_MULTI
#define MK_MULTI 0
#endif
#ifndef MK_ALIGN
#define MK_ALIGN true
#endif
#ifndef MK_CGSYNC
#define MK_CGSYNC 0
#endif

#define LAS __attribute__((address_space(3)))
typedef unsigned short bf16_t;
typedef short bf16x8 __attribute__((ext_vector_type(8)));
typedef float f32x4 __attribute__((ext_vector_type(4)));
typedef float f32x2 __attribute__((ext_vector_type(2)));
typedef unsigned u32x4 __attribute__((ext_vector_type(4)));
typedef unsigned u32x2 __attribute__((ext_vector_type(2)));

constexpr int T = 32768, D = 1024, SEQ = 4096, NB = 8, MT = 2048, FH = 2816;
constexpr float EPS = 1e-6f;
constexpr int SL = 32;
constexpr int NCH = T / SL;
constexpr int AK = SL * 16 + 128;

constexpr size_t MiB = 1u << 20;
constexpr size_t WS_WIN0 = 0, WS_WOUT0 = 4 * MiB, WS_WOIN = 6 * MiB, WS_WOOUT = 7 * MiB, WS_WQ = 9 * MiB, WS_WK = 13 * MiB, WS_WV = 17 * MiB, WS_WO = 21 * MiB;
constexpr size_t WS_WGU = 25 * MiB, WS_WD = 47 * MiB, WS_GW = 58 * MiB, WS_AL = 59 * MiB, WS_BT3 = 60 * MiB, WS_GM = 80 * MiB, WS_MEMN = 88 * MiB, WS_KL = 92 * MiB, WS_VL = 100 * MiB;
constexpr size_t WS_XB = 110 * MiB, WS_QO = 174 * MiB, WS_P = 238 * MiB, WS_R0 = 302 * MiB;
constexpr size_t WS_WQK = WS_P, WS_WVO = WS_P + 32 * MiB;
constexpr size_t WS_HM = WS_R0, WS_U = WS_R0, WS_V = WS_R0 + 32 * MiB, WS_H = WS_R0 + 64 * MiB, WS_MIX = WS_R0 + 96 * MiB;
constexpr size_t WS_ACOMB = WS_R0, WS_XLOC = WS_R0 + 40 * MiB, WS_Y = WS_R0 + 56 * MiB;
constexpr size_t WS_SS = WS_R0 + 176 * MiB, WS_VST = WS_SS + 2 * MiB, WS_BAR = WS_VST + 1 * MiB, WS_END = WS_BAR + 1 * MiB;
constexpr size_t WGU_L = (size_t)2 * FH * D * 2, WD_L = (size_t)D * FH * 2, WSQ_L = (size_t)D * D * 2;

constexpr int RING_BYTES = 131072, XCH_OFF = RING_BYTES, MISC_OFF = RING_BYTES + 8192, LDS_BYTES = 147456;

__device__ __forceinline__ unsigned cvt_pk_bf16(float lo, float hi) { unsigned r; asm volatile("v_cvt_pk_bf16_f32 %0, %1, %2" : "=v"(r) : "v"(lo), "v"(hi)); return r; }
__device__ __forceinline__ float bf2f(unsigned short b) { return __builtin_bit_cast(float, (unsigned)b << 16); }
__device__ __forceinline__ float bflo(unsigned w) { return __builtin_bit_cast(float, w << 16); }
__device__ __forceinline__ float bfhi(unsigned w) { return __builtin_bit_cast(float, w & 0xffff0000u); }
__device__ __forceinline__ float sigmoid_f(float x) { return __builtin_amdgcn_rcpf(1.0f + __expf(-x)); }
__device__ __forceinline__ float silu_f(float x) { return x * sigmoid_f(x); }
__device__ __forceinline__ float gelu_f(float x) { return x * sigmoid_f(1.5957691216f * (x + 0.044715f * x * x * x)); }
typedef unsigned long long u64;
__device__ __forceinline__ void fx_add(u64* p, float q) { atomicAdd(p, (u64)(long long)(q * 16777216.0f)); }
__device__ __forceinline__ float fx_get(const u64* p) { return (float)(long long)(*p) * (1.0f / 16777216.0f); }
__device__ __forceinline__ float wave_sum(float v) {
#pragma unroll
    for (int o = 1; o < 64; o <<= 1) v += __shfl_xor(v, o);
    return v;
}
__device__ __forceinline__ u32x4 pack8(f32x4 a, f32x4 b) { u32x4 w; w.x = cvt_pk_bf16(a[0], a[1]); w.y = cvt_pk_bf16(a[2], a[3]); w.z = cvt_pk_bf16(b[0], b[1]); w.w = cvt_pk_bf16(b[2], b[3]); return w; }

namespace pg8 {
constexpr int BM = 256, BK = 64, HALF = 128, HTB = HALF * BK * 2, NXCD = 8, WGM = 8;
__device__ __forceinline__ int lds_byte(int r, int c) { const int st = (r >> 4) * 2 + (c >> 5), rr = r & 15, cc = c & 31, ob = rr * 64 + cc * 2; return st * 1024 + (ob ^ (((ob >> 9) & 1) << 5)); }
__device__ __forceinline__ void stage_rc(int b, int& R, int& C) { const int st = b / 1024, sb = b % 1024, swz = sb ^ (((sb >> 9) & 1) << 5); R = (st >> 1) * 16 + swz / 64; C = (st & 1) * 32 + (swz % 64) / 2; }
__device__ __forceinline__ int perm32(int rho) { const int n = rho >> 4, i = rho & 15; return 8 * (i >> 2) + 4 * n + (i & 3); }

struct Unit { int pm, pn, z; };
struct Gemm { const bf16_t* A; const bf16_t* Bt; int lda, ldb, K, nz0; long sAz0, sAz1, sBz0, sBz1; };
struct Sched {
    int nM, nN, per, total, G, c;
    __device__ __forceinline__ void init(int nM_, int nN_, int nz, int G_, int c_) { nM = nM_; nN = nN_; per = nM_ * nN_; total = per * nz; G = G_; c = c_; }
    __device__ __forceinline__ bool next(int i, Unit& u) const {
        const long L = (long)i * G + c; if (L >= total) return false;
        const int z = (int)(L / per); int wgid = (int)(L % per);
        { const int q = per / NXCD, r = per % NXCD, xcd = wgid % NXCD, off = wgid / NXCD; wgid = (xcd < r ? xcd * (q + 1) : r * (q + 1) + (xcd - r) * q) + off; }
        const int nig = WGM * nN, gid = wgid / nig, fm = gid * WGM, gsz = (nM - fm) < WGM ? (nM - fm) : WGM;
        u.pm = fm + ((wgid % nig) % gsz); u.pn = (wgid % nig) / gsz; u.z = z; return true;
    }
};

template <bool ALIGN, class Epi>
__device__ __forceinline__ void gemm_phase(LAS unsigned char* lds, const Gemm g, const Sched& S, const Epi& E, const int tid) {
    const int wid = __builtin_amdgcn_readfirstlane(tid >> 6), lane = tid & 63, wr = wid >> 2, wc = wid & 3, fr = lane & 15, fq = lane >> 4;
    const int nt = g.K / BK;
    unsigned voffA[2], voffB[2];
#pragma unroll
    for (int i = 0; i < 2; ++i) { int R, C; stage_rc(tid * 16 + i * 8192, R, C); const int Rb = (R & ~31) + perm32(R & 31);
        voffA[i] = (unsigned)(R * g.lda + C) * 2u; voffB[i] = (unsigned)(Rb * g.ldb + C) * 2u; }
    const size_t kstep = (size_t)(BK * 2);
    const size_t hsA = (size_t)HALF * g.lda * 2, hsB = (size_t)HALF * g.ldb * 2;
    const unsigned ldsw = (unsigned)wid * 1024u;
    const int aoff = lds_byte(wr * 64 + fr, fq * 8), boff = lds_byte(wc * 32 + fr, fq * 8);
#define PG8_SA(b, h) (((b) * 2 + (h)) * HTB)
#define PG8_SB(b, h) ((4 + (b) * 2 + (h)) * HTB)
#define PG8_STAGE(bufoff, gbase, voff) do { _Pragma("unroll") for (int _i = 0; _i < 2; ++_i) \
        __builtin_amdgcn_global_load_lds((const unsigned*)((const char*)(gbase) + (voff)[_i]), (LAS unsigned*)(lds + (bufoff) + ldsw + _i * 8192), 16, 0, 0); } while (0)
#define PG8_LDA(dst, b, h) do { _Pragma("unroll") for (int m = 0; m < 4; ++m) _Pragma("unroll") for (int k = 0; k < 2; ++k) dst[m][k] = *(const LAS bf16x8*)(lds + PG8_SA(b, h) + aoff + m * 2048 + k * 1024); } while (0)
#define PG8_LDB(dst, b, h) do { _Pragma("unroll") for (int n = 0; n < 2; ++n) _Pragma("unroll") for (int k = 0; k < 2; ++k) dst[n][k] = *(const LAS bf16x8*)(lds + PG8_SB(b, h) + boff + n * 2048 + k * 1024); } while (0)
#define PG8_MMA(ai, bj, At, Bt) do { __builtin_amdgcn_s_setprio(1); _Pragma("unroll") for (int m = 0; m < 4; ++m) _Pragma("unroll") for (int n = 0; n < 2; ++n) _Pragma("unroll") for (int k = 0; k < 2; ++k) \
        acc[ai][bj][m][n] = __builtin_amdgcn_mfma_f32_16x16x32_bf16(Bt[n][k], At[m][k], acc[ai][bj][m][n], 0, 0, 0); __builtin_amdgcn_s_setprio(0); } while (0)
#define PG8_WAIT_V(n) asm volatile("s_waitcnt vmcnt(" #n ")" ::: "memory")
#define PG8_WAIT_L(n) asm volatile("s_waitcnt lgkmcnt(" #n ")" ::: "memory")
#define PG8_BAR __builtin_amdgcn_s_barrier()
#define PG8_SCHED __builtin_amdgcn_sched_barrier(0)
#define PG8_UA(u) ((const char*)g.A + 2 * ((size_t)((u).z % g.nz0) * g.sAz0 + (size_t)((u).z / g.nz0) * g.sAz1 + (size_t)(u).pm * BM * g.lda))
#define PG8_UB(u) ((const char*)g.Bt + 2 * ((size_t)((u).z % g.nz0) * g.sBz0 + (size_t)((u).z / g.nz0) * g.sBz1 + (size_t)(u).pn * BM * g.ldb))
    Unit cur, nxt; int ui = 0;
    if (!S.next(0, cur)) return;
    f32x4 acc[2][2][4][2];
#pragma unroll
    for (int a = 0; a < 2; ++a)
#pragma unroll
        for (int b = 0; b < 2; ++b)
#pragma unroll
            for (int m = 0; m < 4; ++m)
#pragma unroll
                for (int n = 0; n < 2; ++n) acc[a][b][m][n] = (f32x4){0.f, 0.f, 0.f, 0.f};
    bf16x8 At[4][2], B0[2][2], B1[2][2];
    const char* cA = PG8_UA(cur); const char* cB = PG8_UB(cur);
    PG8_STAGE(PG8_SB(0, 0), cB, voffB); PG8_STAGE(PG8_SB(0, 1), cB + hsB, voffB); PG8_STAGE(PG8_SA(0, 0), cA, voffA); PG8_STAGE(PG8_SA(0, 1), cA + hsA, voffA);
    if (wr == 1) PG8_BAR;
    PG8_WAIT_V(2); PG8_BAR;
    PG8_STAGE(PG8_SB(1, 0), cB + kstep, voffB); PG8_STAGE(PG8_SA(1, 0), cA + kstep, voffA); PG8_STAGE(PG8_SB(1, 1), cB + hsB + kstep, voffB);
    PG8_WAIT_V(6); PG8_BAR;
    for (;;) {
        const bool has_next = S.next(ui + 1, nxt);
        const char* nA = has_next ? PG8_UA(nxt) : cA; const char* nB = has_next ? PG8_UB(nxt) : cB;
        for (int t = 0; t < nt; t += 2) {
            const bool last = (t == nt - 2);
            const char* a1 = cA + (size_t)(t + 1) * kstep;
            const char* a2 = last ? nA : cA + (size_t)(t + 2) * kstep; const char* b2 = last ? nB : cB + (size_t)(t + 2) * kstep;
            const char* a3 = a2 + kstep; const char* b3 = b2 + kstep;
            PG8_LDB(B0, 0, 0); PG8_LDB(B1, 0, 1); PG8_SCHED; PG8_LDA(At, 0, 0); PG8_STAGE(PG8_SA(1, 1), a1 + hsA, voffA);
            PG8_WAIT_V(8); PG8_WAIT_L(0); PG8_BAR; PG8_MMA(0, 0, At, B0); PG8_MMA(0, 1, At, B1); PG8_BAR; PG8_SCHED;
            PG8_LDA(At, 0, 1); PG8_STAGE(PG8_SB(0, 0), b2, voffB); PG8_STAGE(PG8_SB(0, 1), b2 + hsB, voffB); PG8_STAGE(PG8_SA(0, 0), a2, voffA);
            PG8_WAIT_V(8); PG8_WAIT_L(0); PG8_BAR; PG8_MMA(1, 0, At, B0); PG8_MMA(1, 1, At, B1); PG8_BAR; PG8_SCHED;
            PG8_LDB(B0, 1, 0); PG8_LDB(B1, 1, 1); PG8_SCHED; PG8_LDA(At, 1, 0); PG8_STAGE(PG8_SA(0, 1), a2 + hsA, voffA);
            PG8_WAIT_V(8); PG8_WAIT_L(0); PG8_BAR; PG8_MMA(0, 0, At, B0); PG8_MMA(0, 1, At, B1); PG8_BAR; PG8_SCHED;
            PG8_LDA(At, 1, 1); PG8_STAGE(PG8_SB(1, 0), b3, voffB); PG8_STAGE(PG8_SB(1, 1), b3 + hsB, voffB); PG8_STAGE(PG8_SA(1, 0), a3, voffA);
            PG8_WAIT_V(8); PG8_WAIT_L(0); PG8_BAR; PG8_MMA(1, 0, At, B0); PG8_MMA(1, 1, At, B1); PG8_BAR; PG8_SCHED;
        }
        if (ALIGN) { if (wr == 0) PG8_BAR; }
        E(acc, cur, wr, wc, fr, fq, lds);
        if (!has_next) break;
#pragma unroll
        for (int a = 0; a < 2; ++a)
#pragma unroll
            for (int b = 0; b < 2; ++b)
#pragma unroll
                for (int m = 0; m < 4; ++m)
#pragma unroll
                    for (int n = 0; n < 2; ++n) acc[a][b][m][n] = (f32x4){0.f, 0.f, 0.f, 0.f};
        cur = nxt; cA = nA; cB = nB; ++ui;
        if (ALIGN) { if (wr == 1) PG8_BAR; }
    }
    PG8_WAIT_V(0);
    if (!ALIGN) { if (wr == 0) PG8_BAR; }
    PG8_BAR;
#undef PG8_SA
#undef PG8_SB
#undef PG8_STAGE
#undef PG8_LDA
#undef PG8_LDB
#undef PG8_MMA
#undef PG8_UA
#undef PG8_UB
}

typedef f32x4 Acc[2][2][4][2];
#define EPI_ARGS Acc& acc, const Unit& u, int wr, int wc, int fr, int fq, LAS unsigned char* lds
__device__ __forceinline__ int efence() { asm volatile("" ::: "memory"); return 1; }
#define ROWLOOP _Pragma("unroll") for (int ai = 0; ai < 2; ++ai) _Pragma("unroll") for (int m = 0; m < 4; ++m) for (int once_ = efence(); once_; once_ = 0)

#define LOAD_RS8(rs, ssp, row0) float rs[2][4]; { u64 raw_[2][4]; _Pragma("unroll") for (int ai = 0; ai < 2; ++ai) _Pragma("unroll") for (int m = 0; m < 4; ++m) raw_[ai][m] = (ssp)[(row0) + ai * 128 + m * 16]; \
    _Pragma("unroll") for (int ai = 0; ai < 2; ++ai) _Pragma("unroll") for (int m = 0; m < 4; ++m) rs[ai][m] = rsqrtf((float)(long long)raw_[ai][m] * (1.0f / 16777216.0f) * (1.0f / D) + EPS); }
struct EpiIn0 {
    const u64* ss; bf16_t* U; bf16_t* V; bf16_t* H; u64* vst;
    __device__ __forceinline__ void operator()(EPI_ARGS) const {
        const int row0 = u.pm * 256 + wr * 64 + fr;
        LOAD_RS8(rs8, ss, row0);
        if (u.pn < 4) {
            bf16_t* dst = (u.pn < 2) ? U : V; const int col0 = (u.pn & 1) * 256 + wc * 32 + 8 * fq; const bool st = u.pn >= 2;
            ROWLOOP { const int row = row0 + ai * 128 + m * 16; const float rs = rs8[ai][m]; float s = 0.f, q = 0.f;
#pragma unroll
                for (int bj = 0; bj < 2; ++bj) { f32x4 v0 = acc[ai][bj][m][0] * rs, v1 = acc[ai][bj][m][1] * rs;
#pragma unroll
                    for (int e = 0; e < 4; ++e) { v0[e] = gelu_f(v0[e]); v1[e] = gelu_f(v1[e]); s += v0[e] + v1[e]; q += v0[e] * v0[e] + v1[e] * v1[e]; }
                    *(u32x4*)(dst + (size_t)row * 512 + col0 + bj * 128) = pack8(v0, v1); }
                if (st) { s += __shfl_xor(s, 16); s += __shfl_xor(s, 32); q += __shfl_xor(q, 16); q += __shfl_xor(q, 32);
                    if (fq == 0) { fx_add(vst + 2 * row, s); fx_add(vst + 2 * row + 1, q); } }
            }
        } else {
            const int col0 = (u.pn - 4) * 128 + wc * 32 + 8 * fq;
            ROWLOOP { const int row = row0 + ai * 128 + m * 16; const float rs = rs8[ai][m]; f32x4 h0, h1;
#pragma unroll
                for (int e = 0; e < 4; ++e) { h0[e] = acc[ai][0][m][0][e] * rs * sigmoid_f(acc[ai][1][m][0][e] * rs); h1[e] = acc[ai][0][m][1][e] * rs * sigmoid_f(acc[ai][1][m][1][e] * rs); }
                *(u32x4*)(H + (size_t)row * 512 + col0) = pack8(h0, h1); }
        }
    }
};
__device__ __forceinline__ void unpack8(u32x4 b, f32x4& o0, f32x4& o1) { o0 = (f32x4){bflo(b.x), bfhi(b.x), bflo(b.y), bfhi(b.y)}; o1 = (f32x4){bflo(b.z), bfhi(b.z), bflo(b.w), bfhi(b.w)}; }
template <bool GLU> struct EpiRes {
    bf16_t* xb; u64* ss; int zrows;
    __device__ __forceinline__ void operator()(EPI_ARGS) const {
        const int row0 = u.z * zrows + u.pm * 256 + wr * 64 + fr;
#pragma unroll
        for (int ai = 0; ai < 2; ++ai) {
            u32x4 pre[4][2];
#pragma unroll
            for (int m = 0; m < 4; ++m) { const int row = row0 + ai * 128 + m * 16;
                if (GLU) pre[m][0] = *(const u32x4*)(xb + (size_t)row * D + u.pn * 128 + wc * 32 + 8 * fq);
                else {
#pragma unroll
                    for (int bj = 0; bj < 2; ++bj) pre[m][bj] = *(const u32x4*)(xb + (size_t)row * D + u.pn * 256 + bj * 128 + wc * 32 + 8 * fq); } }
#pragma unroll
            for (int m = 0; m < 4; ++m) for (int once_ = efence(); once_; once_ = 0) { const int row = row0 + ai * 128 + m * 16; float q = 0.f;
                if (GLU) { const size_t off = (size_t)row * D + u.pn * 128 + wc * 32 + 8 * fq;
                    f32x4 o0, o1; unpack8(pre[m][0], o0, o1);
#pragma unroll
                    for (int e = 0; e < 4; ++e) { o0[e] += acc[ai][0][m][0][e] * sigmoid_f(acc[ai][1][m][0][e]); o1[e] += acc[ai][0][m][1][e] * sigmoid_f(acc[ai][1][m][1][e]);
                        q += o0[e] * o0[e] + o1[e] * o1[e]; }
                    *(u32x4*)(xb + off) = pack8(o0, o1);
                } else {
#pragma unroll
                    for (int bj = 0; bj < 2; ++bj) { const size_t off = (size_t)row * D + u.pn * 256 + bj * 128 + wc * 32 + 8 * fq;
                        f32x4 o0, o1; unpack8(pre[m][bj], o0, o1); o0 += acc[ai][bj][m][0]; o1 += acc[ai][bj][m][1];
#pragma unroll
                        for (int e = 0; e < 4; ++e) q += o0[e] * o0[e] + o1[e] * o1[e];
                        *(u32x4*)(xb + off) = pack8(o0, o1); }
                }
                q += __shfl_xor(q, 16); q += __shfl_xor(q, 32);
                if (fq == 0) fx_add(ss + row, q);
            }
        }
    }
};
struct EpiStore {
    bf16_t* O; int ldc, nz0; long sz0, sz1; const u64* ss; float scale;
    __device__ __forceinline__ void operator()(EPI_ARGS) const {
        bf16_t* base = O + (size_t)(u.z % nz0) * sz0 + (size_t)(u.z / nz0) * sz1; const int row0 = u.pm * 256 + wr * 64 + fr, col0 = u.pn * 256 + wc * 32 + 8 * fq;
        float rs8[2][4];
        if (ss) { LOAD_RS8(t8, ss, row0);
#pragma unroll
            for (int ai = 0; ai < 2; ++ai)
#pragma unroll
                for (int m = 0; m < 4; ++m) rs8[ai][m] = t8[ai][m] * scale; }
        else {
#pragma unroll
            for (int ai = 0; ai < 2; ++ai)
#pragma unroll
                for (int m = 0; m < 4; ++m) rs8[ai][m] = scale; }
        ROWLOOP { const int row = row0 + ai * 128 + m * 16; const float rs = rs8[ai][m];
#pragma unroll
            for (int bj = 0; bj < 2; ++bj) *(u32x4*)(base + (size_t)row * ldc + col0 + bj * 128) = pack8(acc[ai][bj][m][0] * rs, acc[ai][bj][m][1] * rs); }
    }
};
struct EpiSoftmax {
    bf16_t* P; const u64* ss;
    __device__ __forceinline__ void operator()(EPI_ARGS) const {
        LAS float* X = (LAS float*)(lds + XCH_OFF); LAS float* Y = X + 1024;
        const int grow0 = u.z * SEQ + u.pm * 256 + wr * 64 + fr;
        LOAD_RS8(rs8, ss, grow0);
        ROWLOOP { const int r = ai * 128 + wr * 64 + m * 16 + fr; const float sc = rs8[ai][m] * 0.0625f; float mx = -3.0e38f;
#pragma unroll
            for (int bj = 0; bj < 2; ++bj)
#pragma unroll
                for (int n = 0; n < 2; ++n) { acc[ai][bj][m][n] = acc[ai][bj][m][n] * sc;
#pragma unroll
                    for (int e = 0; e < 4; ++e) mx = fmaxf(mx, acc[ai][bj][m][n][e]); }
            mx = fmaxf(mx, __shfl_xor(mx, 16)); mx = fmaxf(mx, __shfl_xor(mx, 32));
            if (fq == 0) X[r * 4 + wc] = mx; }
        asm volatile("s_waitcnt lgkmcnt(0)" ::: "memory"); __builtin_amdgcn_s_barrier(); asm volatile("" ::: "memory");
        ROWLOOP { const int r = ai * 128 + wr * 64 + m * 16 + fr; const f32x4 xm = *(const LAS f32x4*)(X + r * 4); const float mx = fmaxf(fmaxf(xm[0], xm[1]), fmaxf(xm[2], xm[3])); float s = 0.f;
#pragma unroll
            for (int bj = 0; bj < 2; ++bj)
#pragma unroll
                for (int n = 0; n < 2; ++n)
#pragma unroll
                    for (int e = 0; e < 4; ++e) { const float p = __expf(acc[ai][bj][m][n][e] - mx); acc[ai][bj][m][n][e] = p; s += p; }
            s += __shfl_xor(s, 16); s += __shfl_xor(s, 32);
            if (fq == 0) Y[r * 4 + wc] = s; }
        asm volatile("s_waitcnt lgkmcnt(0)" ::: "memory"); __builtin_amdgcn_s_barrier(); asm volatile("" ::: "memory");
        ROWLOOP { const int r = ai * 128 + wr * 64 + m * 16 + fr; const f32x4 ys = *(const LAS f32x4*)(Y + r * 4); const float inv = 1.0f / ((ys[0] + ys[1]) + (ys[2] + ys[3]));
#pragma unroll
            for (int bj = 0; bj < 2; ++bj) *(u32x4*)(P + (size_t)(u.z * SEQ + u.pm * 256 + r) * D + u.pn * 256 + bj * 128 + wc * 32 + 8 * fq) = pack8(acc[ai][bj][m][0] * inv, acc[ai][bj][m][1] * inv); }
    }
};
struct EpiFfn1 {
    const u64* ss; bf16_t* HM;
    __device__ __forceinline__ void operator()(EPI_ARGS) const {
        const int row0 = u.pm * 256 + wr * 64 + fr, col0 = u.pn * 128 + wc * 32 + 8 * fq;
        LOAD_RS8(rs8, ss, row0);
        ROWLOOP { const int row = row0 + ai * 128 + m * 16; const float rs = rs8[ai][m]; f32x4 h0, h1;
#pragma unroll
            for (int e = 0; e < 4; ++e) { h0[e] = silu_f(acc[ai][0][m][0][e] * rs) * (acc[ai][1][m][0][e] * rs); h1[e] = silu_f(acc[ai][0][m][1][e] * rs) * (acc[ai][1][m][1][e] * rs); }
            *(u32x4*)(HM + (size_t)row * FH + col0) = pack8(h0, h1); }
    }
};
struct EpiOin {
    const u64* ss; bf16_t* AC;
    __device__ __forceinline__ void operator()(EPI_ARGS) const {
        const int row0 = u.pm * 256 + wr * 64 + fr;
        LOAD_RS8(rs8, ss, row0);
        ROWLOOP { const int row = row0 + ai * 128 + m * 16; const float rs = rs8[ai][m];
#pragma unroll
            for (int bj = 0; bj < 2; ++bj) { const int col = u.pn * 256 + bj * 128 + wc * 32 + 8 * fq;
                *(u32x4*)(AC + (size_t)(col >> 4) * NCH * AK + (size_t)(row / SL) * AK + (row % SL) * 16 + (col & 8)) = pack8(acc[ai][bj][m][0] * rs, acc[ai][bj][m][1] * rs); } }
    }
};
struct EpiS5State {
    float* XL;
    __device__ __forceinline__ void operator()(EPI_ARGS) const {
        const int row0 = u.pm * 256 + wr * 64 + fr, col0 = wc * 32 + 8 * fq;
        ROWLOOP { const int row = row0 + ai * 128 + m * 16; float* p = XL + (size_t)u.z * NCH * 128 + (size_t)row * 128 + col0;
            *(f32x4*)p = acc[ai][0][m][0]; *(f32x4*)(p + 4) = acc[ai][0][m][1]; }
    }
};
struct EpiS5Out {
    const bf16_t* AC; const float* dsk; bf16_t* Y;
    __device__ __forceinline__ void operator()(EPI_ARGS) const {
        const int g = u.z, row0 = u.pm * 256 + wr * 64 + fr;
        f32x4 dv[2][2];
#pragma unroll
        for (int bj = 0; bj < 2; ++bj) { const int ch = g * 16 + ((u.pn * 256 + bj * 128 + wc * 32 + 8 * fq) & 8); dv[bj][0] = *(const f32x4*)(dsk + ch); dv[bj][1] = *(const f32x4*)(dsk + ch + 4); }
#pragma unroll
        for (int ai = 0; ai < 2; ++ai) {
            u32x4 pre[4][2];
#pragma unroll
            for (int m = 0; m < 4; ++m)
#pragma unroll
                for (int bj = 0; bj < 2; ++bj) pre[m][bj] = *(const u32x4*)(AC + (size_t)g * NCH * AK + (size_t)(row0 + ai * 128 + m * 16) * AK + u.pn * 256 + bj * 128 + wc * 32 + 8 * fq);
#pragma unroll
            for (int m = 0; m < 4; ++m) for (int once_ = efence(); once_; once_ = 0) { const int row = row0 + ai * 128 + m * 16;
#pragma unroll
                for (int bj = 0; bj < 2; ++bj) { const int col = u.pn * 256 + bj * 128 + wc * 32 + 8 * fq, k = col >> 4, ch = g * 16 + (col & 8);
                    f32x4 u0, u1; unpack8(pre[m][bj], u0, u1);
                    f32x4 y0 = acc[ai][bj][m][0] + dv[bj][0] * u0, y1 = acc[ai][bj][m][1] + dv[bj][1] * u1;
#pragma unroll
                    for (int e = 0; e < 4; ++e) { y0[e] = gelu_f(y0[e]); y1[e] = gelu_f(y1[e]); }
                    *(u32x4*)(Y + (size_t)(row * SL + k) * 512 + ch) = pack8(y0, y1); } }
        }
    }
};
}

#define XB_TMO      128
#define XB_XCNT(j)  (256  + 64 * (j))
#define XB_XSUB(j)  (1280 + 64 * (j))
#define XB_XGEN(j)  (2304 + 64 * (j))
#define XB_TOP      3328
#define XB_TOPGEN   3392
#define XCD_BAR_WORDS 3456
#define XB_SPIN_CAP (1u << 22)
__device__ __forceinline__ unsigned xb_ld(unsigned* p)              { return __hip_atomic_load(p, __ATOMIC_RELAXED, __HIP_MEMORY_SCOPE_AGENT); }
__device__ __forceinline__ unsigned xb_add(unsigned* p, unsigned v) { return __hip_atomic_fetch_add(p, v, __ATOMIC_RELAXED, __HIP_MEMORY_SCOPE_AGENT); }
__device__ __forceinline__ unsigned xb_xcc_id() { return (unsigned)__builtin_amdgcn_s_getreg((3 << 11) | 20) & 0xFu; }
#define XB_SPIN(cond, bar) do { unsigned _sp = 0; while (cond) { __builtin_amdgcn_s_sleep(1); \
    if ((++_sp & 255u) == 0u) { if (xb_ld(&(bar)[XB_TMO])) break; if (_sp > XB_SPIN_CAP) { atomicAdd(&(bar)[XB_TMO], 1u); break; } } } } while (0)
struct XcdBarrier { unsigned* bar; unsigned x; volatile LAS unsigned* st; };
__device__ __forceinline__ XcdBarrier xcd_barrier_post(unsigned* bar, volatile LAS unsigned* st) {
    XcdBarrier b; b.bar = bar; b.x = xb_xcc_id(); b.st = st;
    if (threadIdx.x == 0) (void)xb_add(&bar[XB_XCNT(b.x)], 1u);
    return b;
}
__device__ __forceinline__ void xcd_barrier_complete(unsigned* bar, unsigned x, unsigned& nloc, unsigned& nx) {
    const unsigned G = gridDim.x * gridDim.y * gridDim.z;
    unsigned sum, cnt, mine, sp = 0u;
    for (;;) {
        sum = 0u; cnt = 0u; mine = 0u;
#pragma unroll
        for (unsigned j = 0; j < 16; ++j) { const unsigned c = xb_ld(&bar[XB_XCNT(j)]); sum += c; cnt += (c > 0u) ? 1u : 0u; mine = (j == x) ? c : mine; }
        if (sum == G) break;
        __builtin_amdgcn_s_sleep(1);
        if ((++sp & 255u) == 0u) { if (xb_ld(&bar[XB_TMO])) break; if (sp > XB_SPIN_CAP) { atomicAdd(&bar[XB_TMO], 1u); break; } }
    }
    nloc = mine > 0u ? mine : 1u; nx = cnt > 0u ? cnt : 1u;
}
__device__ __forceinline__ void xcd_barrier(const XcdBarrier& b) {
    asm volatile("s_waitcnt vmcnt(0)" ::: "memory");
    __syncthreads();
    if (threadIdx.x == 0) {
        unsigned* bar = b.bar;
        __builtin_amdgcn_s_waitcnt(0);
        unsigned nloc = b.st[0], nx = b.st[1];
        if (nloc == 0u) { xcd_barrier_complete(bar, b.x, nloc, nx); b.st[0] = nloc; b.st[1] = nx; }
        const unsigned old = xb_add(&bar[XB_XSUB(b.x)], 1u);
        const unsigned gen = old / nloc;
        if (old + 1u == (gen + 1u) * nloc) {
            __builtin_amdgcn_fence(__ATOMIC_RELEASE, "agent");
            asm volatile("s_waitcnt vmcnt(0)" ::: "memory");
            const unsigned og = xb_add(&bar[XB_TOP], 1u);
            const unsigned tg = og / nx;
            if (og + 1u == (tg + 1u) * nx) xb_add(&bar[XB_TOPGEN], 1u);
            else XB_SPIN(xb_ld(&bar[XB_TOPGEN]) == tg, bar);
            __builtin_amdgcn_fence(__ATOMIC_ACQUIRE, "agent");
            xb_add(&bar[XB_XGEN(b.x)], 1u);
            asm volatile("s_waitcnt vmcnt(0)" ::: "memory");
        } else {
            XB_SPIN(xb_ld(&bar[XB_XGEN(b.x)]) == gen, bar);
            __builtin_amdgcn_fence(__ATOMIC_ACQUIRE, "agent");
            asm volatile("s_waitcnt vmcnt(0)" ::: "memory");
        }
    }
    __syncthreads();
}

constexpr int NBF = 1;
struct ConvP { const float* W; bf16_t* WT; const float* gain; int K, ldn, cs, nblk, mode, roff, r; };
__device__ __forceinline__ void conv_load(const ConvP& p, float (&v)[32], int lane) {
    const int nkb = p.K / 64, kb = (p.r / NBF) % nkb, nb = (p.r / (NBF * nkb)) * NBF + p.r % NBF; const float* src = p.W + (size_t)(64 * kb + (lane >> 5)) * p.ldn + p.cs + 32 * nb + (lane & 31);
#pragma unroll
    for (int i = 0; i < 32; ++i) v[i] = src[(size_t)(2 * i) * p.ldn];
}
__device__ __forceinline__ void conv_store(const ConvP& p, const float (&v)[32], LAS float* scr, int lane) {
    const int nkb = p.K / 64, kb = (p.r / NBF) % nkb, nb = (p.r / (NBF * nkb)) * NBF + p.r % NBF, k0 = 64 * kb, c0 = 32 * nb, c = lane & 7;
    f32x4 g0 = {1.f, 1.f, 1.f, 1.f}, g1 = g0;
    if (p.gain) { g0 = *(const f32x4*)(p.gain + k0 + 8 * c); g1 = *(const f32x4*)(p.gain + k0 + 8 * c + 4); }
#pragma unroll
    for (int i = 0; i < 32; ++i) scr[(2 * i + (lane >> 5)) * 33 + (lane & 31)] = v[i];
    asm volatile("s_waitcnt lgkmcnt(0)" ::: "memory");
    const int drow = p.roff + (p.mode == 0 ? c0 : ((c0 >> 7) * 256 + (p.mode - 1) * 128 + (c0 & 127)));
#pragma unroll
    for (int j = 0; j < 4; ++j) { const int n = (lane >> 3) + 8 * j; const LAS float* s = scr + (8 * c) * 33 + n;
        u32x4 o; o.x = cvt_pk_bf16(s[0 * 33] * g0[0], s[1 * 33] * g0[1]); o.y = cvt_pk_bf16(s[2 * 33] * g0[2], s[3 * 33] * g0[3]); o.z = cvt_pk_bf16(s[4 * 33] * g1[0], s[5 * 33] * g1[1]); o.w = cvt_pk_bf16(s[6 * 33] * g1[2], s[7 * 33] * g1[3]);
        *(u32x4*)(p.WT + (size_t)(drow + n) * p.K + k0 + 8 * c) = o; }
    asm volatile("s_waitcnt lgkmcnt(0)" ::: "memory");
}
template <bool NORM, int R> __device__ __forceinline__ void rows_to_bf16(const float* x0, bf16_t* o0, u64* ssq, int lane) {
    f32x4 v[R][4]; float s[R];
#pragma unroll
    for (int r = 0; r < R; ++r) { const f32x4* xr = (const f32x4*)(x0 + (size_t)r * D) + lane;
#pragma unroll
        for (int j = 0; j < 4; ++j) v[r][j] = xr[64 * j]; }
#pragma unroll
    for (int r = 0; r < R; ++r) { float a = 0.f;
#pragma unroll
        for (int j = 0; j < 4; ++j) a += (v[r][j][0] * v[r][j][0] + v[r][j][1] * v[r][j][1]) + (v[r][j][2] * v[r][j][2] + v[r][j][3] * v[r][j][3]);
        s[r] = wave_sum(a); }
#pragma unroll
    for (int r = 0; r < R; ++r) { const float rs = NORM ? rsqrtf(s[r] * (1.0f / D) + EPS) : 1.0f; u32x2* o = (u32x2*)(o0 + (size_t)r * D) + lane;
#pragma unroll
        for (int j = 0; j < 4; ++j) { u32x2 w; w.x = cvt_pk_bf16(v[r][j][0] * rs, v[r][j][1] * rs); w.y = cvt_pk_bf16(v[r][j][2] * rs, v[r][j][3] * rs); o[64 * j] = w; }
        if (ssq && lane == 0) ssq[r] = (u64)(long long)(s[r] * 16777216.0f); }
}
__device__ __forceinline__ void cis_f(float ang, float& c, float& s) {
    float rev = ang * 0.15915494309189535f; rev = rev - rintf(rev);
    const float x = rev * 6.283185307179586f;
    const float h = x * 0.25f, h2 = h * h;
    float sh = h * (1.0f + h2 * (-1.6666667e-1f + h2 * (8.3333333e-3f + h2 * (-1.9841270e-4f + h2 * 2.7557319e-6f))));
    float ch = 1.0f + h2 * (-0.5f + h2 * (4.1666667e-2f + h2 * (-1.3888889e-3f + h2 * (2.4801587e-5f + h2 * -2.7557319e-7f))));
    float s2 = 2.f * sh * ch, c2 = 1.f - 2.f * sh * sh;
    s = 2.f * s2 * c2; c = 1.f - 2.f * s2 * s2;
}
__device__ __forceinline__ void s5_setup(int g, LAS unsigned char* lds, const float* lam_re, const float* lam_im, const float* log_dt, const float* b_re, const float* b_im, const float* c_re, const float* c_im,
                                         bf16_t* BT3, bf16_t* GM, float* AL, int tid) {
    LAS float* pwr = (LAS float*)lds; LAS float* pwi = pwr + 33 * 64; LAS float* Bbr = pwi + 33 * 64; LAS float* Bbi = Bbr + 1024; LAS float* Cr = Bbi + 1024; LAS float* Ci = Cr + 1024; LAS float* Kd = Ci + 1024;
    const float dt = __expf(log_dt[g]);
    for (int idx = tid; idx < 33 * 64; idx += 512) { const int d = idx >> 6, p = idx & 63; const float lr = lam_re[g * 64 + p], li = lam_im[g * 64 + p];
        const float mag = __expf(lr * dt * (float)d); float c, s; cis_f(li * dt * (float)d, c, s); pwr[idx] = mag * c; pwi[idx] = mag * s; }
    for (int idx = tid; idx < 1024; idx += 512) { const int p = idx >> 4; const float lr = lam_re[g * 64 + p], li = lam_im[g * 64 + p];
        const float mag = __expf(lr * dt); float c, s; cis_f(li * dt, c, s); const float ar = mag * c, ai = mag * s, den = lr * lr + li * li;
        const float qr = ((ar - 1.0f) * lr + ai * li) / den, qi = (ai * lr - (ar - 1.0f) * li) / den;
        const float br = b_re[g * 1024 + idx], bi = b_im[g * 1024 + idx];
        Bbr[idx] = qr * br - qi * bi; Bbi[idx] = qr * bi + qi * br;
        Cr[idx] = c_re[g * 1024 + idx]; Ci[idx] = c_im[g * 1024 + idx]; }
    __syncthreads();
    for (int idx = tid; idx < 32 * 256; idx += 512) { const int d = idx >> 8, co = (idx >> 4) & 15, ci = idx & 15; float a = 0.f;
        for (int p = 0; p < 64; ++p) { const float cr = Cr[co * 64 + p], cim = Ci[co * 64 + p], pr = pwr[d * 64 + p], pi = pwi[d * 64 + p];
            const float tr = cr * pr - cim * pi, ti = cr * pi + cim * pr; a += tr * Bbr[p * 16 + ci] - ti * Bbi[p * 16 + ci]; }
        Kd[idx] = a; }
    __syncthreads();
    bf16_t* bt = BT3 + (size_t)g * 512 * AK;
    for (int idx = tid; idx < 512 * (AK / 8); idx += 512) { const int n = idx / (AK / 8), q = idx % (AK / 8), kk0 = q * 8, k = n >> 4, co = n & 15; float v[8];
        if (kk0 < 512) { const int j = kk0 >> 4, ci0 = kk0 & 15;
#pragma unroll
            for (int e = 0; e < 8; ++e) v[e] = (j <= k) ? Kd[(k - j) * 256 + co * 16 + ci0 + e] : 0.f;
        } else { const int p0 = kk0 - 512;
#pragma unroll
            for (int e = 0; e < 8; ++e) { const int p = (p0 & 63) + e; const float cr = Cr[co * 64 + p], cim = Ci[co * 64 + p], pr = pwr[(k + 1) * 64 + p], pi = pwi[(k + 1) * 64 + p];
                v[e] = (p0 < 64) ? (cr * pr - cim * pi) : -(cr * pi + cim * pr); } }
        u32x4 w; w.x = cvt_pk_bf16(v[0], v[1]); w.y = cvt_pk_bf16(v[2], v[3]); w.z = cvt_pk_bf16(v[4], v[5]); w.w = cvt_pk_bf16(v[6], v[7]);
        *(u32x4*)(bt + (size_t)n * AK + kk0) = w; }
    bf16_t* gm = GM + (size_t)g * 256 * 512;
    for (int idx = tid; idx < 256 * 64; idx += 512) { const int n = idx >> 6, q = idx & 63, kk0 = q * 8; float v[8];
        if (n < 128) { const int p = n & 63, j = kk0 >> 4, ci0 = kk0 & 15; const float pr = pwr[(SL - 1 - j) * 64 + p], pi = pwi[(SL - 1 - j) * 64 + p];
#pragma unroll
            for (int e = 0; e < 8; ++e) { const float br = Bbr[p * 16 + ci0 + e], bi = Bbi[p * 16 + ci0 + e]; v[e] = (n < 64) ? (pr * br - pi * bi) : (pr * bi + pi * br); }
        } else {
#pragma unroll
            for (int e = 0; e < 8; ++e) v[e] = 0.f; }
        u32x4 w; w.x = cvt_pk_bf16(v[0], v[1]); w.y = cvt_pk_bf16(v[2], v[3]); w.z = cvt_pk_bf16(v[4], v[5]); w.w = cvt_pk_bf16(v[6], v[7]);
        *(u32x4*)(gm + (size_t)n * 512 + kk0) = w; }
    if (tid < 64) { AL[(g * 64 + tid) * 2] = pwr[SL * 64 + tid]; AL[(g * 64 + tid) * 2 + 1] = pwi[SL * 64 + tid]; }
    __syncthreads();
}

__device__ __forceinline__ void gmlp_unit(int unit, LAS unsigned char* lds, const bf16_t* U, const bf16_t* V, const u64* vst, const bf16_t* GW, const float* gb, bf16_t* MIX, int tid) {
    const int g = unit & 3, t0 = (unit >> 2) * 128, lane = tid & 63, wid = tid >> 6;
    LAS bf16_t* vT = (LAS bf16_t*)lds;
    const int il = lane & 15, kq = lane >> 4, i = wid * 16 + il;
    u32x4 raw[4]; u64 st[4][2];
#pragma unroll
    for (int e = 0; e < 4; ++e) { const int q = tid + 512 * e, j = q >> 4, c8 = (q & 15) * 8;
        raw[e] = *(const u32x4*)(V + (size_t)(t0 + j) * 512 + g * 128 + c8); st[e][0] = vst[2 * (t0 + j)]; st[e][1] = vst[2 * (t0 + j) + 1]; }
    bf16x8 wf[4];
#pragma unroll
    for (int ks = 0; ks < 4; ++ks) wf[ks] = *(const bf16x8*)(GW + (size_t)g * 16384 + (size_t)i * 128 + ks * 32 + kq * 8);
    const float bias = gb[g * 128 + i];
    const size_t tok = (size_t)(t0 + i);
    u32x2 uu[8];
#pragma unroll
    for (int nt = 0; nt < 8; ++nt) uu[nt] = *(const u32x2*)(U + tok * 512 + g * 128 + nt * 16 + kq * 4);
#pragma unroll
    for (int e = 0; e < 4; ++e) { const int q = tid + 512 * e, j = q >> 4, c8 = (q & 15) * 8;
        const float s = (float)(long long)st[e][0] * (1.0f / 16777216.0f), ss = (float)(long long)st[e][1] * (1.0f / 16777216.0f), mean = s * (1.0f / 512.0f), var = ss * (1.0f / 512.0f) - mean * mean, rstd = rsqrtf(fmaxf(var, 0.f) + EPS);
        const float v[8] = {bflo(raw[e].x), bfhi(raw[e].x), bflo(raw[e].y), bfhi(raw[e].y), bflo(raw[e].z), bfhi(raw[e].z), bflo(raw[e].w), bfhi(raw[e].w)};
        const int jo = ((((j >> 3) ^ (c8 >> 3)) & 15) << 3) + (j & 7);
#pragma unroll
        for (int k = 0; k < 8; k += 2) { const unsigned pk = cvt_pk_bf16((v[k] - mean) * rstd, (v[k + 1] - mean) * rstd); vT[(c8 + k) * 136 + jo] = (bf16_t)(pk & 0xffffu); vT[(c8 + k + 1) * 136 + jo] = (bf16_t)(pk >> 16); } }
    __syncthreads();
#pragma unroll 2
    for (int nt = 0; nt < 8; ++nt) { f32x4 a = {0.f, 0.f, 0.f, 0.f}; const int c = nt * 16 + il;
#pragma unroll
        for (int ks = 0; ks < 4; ++ks) { const bf16x8 vf = *(const LAS bf16x8*)(vT + c * 136 + ((((ks * 4 + kq) ^ (c >> 3)) & 15) << 3)); a = __builtin_amdgcn_mfma_f32_16x16x32_bf16(vf, wf[ks], a, 0, 0, 0); }
        u32x2 o; o.x = cvt_pk_bf16(bflo(uu[nt].x) * (a[0] + bias), bfhi(uu[nt].x) * (a[1] + bias)); o.y = cvt_pk_bf16(bflo(uu[nt].y) * (a[2] + bias), bfhi(uu[nt].y) * (a[3] + bias));
        *(u32x2*)(MIX + tok * 1024 + g * 128 + nt * 16 + kq * 4) = o; }
    __syncthreads();
}
__device__ __forceinline__ void conv_units(int first, int stride, int nunits, LAS unsigned char* lds, const bf16_t* H, const float* cw, const float* cb, const float* lng, const float* lnb, bf16_t* MIX, int tid) {
    if (first >= nunits) return;
    const int lane = tid & 63, wid = tid >> 6;
    LAS bf16_t* hin = (LAS bf16_t*)lds;
    LAS float* cout = (LAS float*)(lds + 62 * 1024);
    float w[31];
#pragma unroll
    for (int k = 0; k < 31; ++k) w[k] = cw[k * 512 + tid];
    const float bias = cb[tid];
    const f32x4 g0 = *(const f32x4*)(lng + lane * 8), g1 = *(const f32x4*)(lng + lane * 8 + 4), b0 = *(const f32x4*)(lnb + lane * 8), b1 = *(const f32x4*)(lnb + lane * 8 + 4);
    u32x4 pre[8];
#define CONV_PREFETCH(unit_) { const int t0_ = (unit_) * 32, s0_ = t0_ % SEQ; _Pragma("unroll") for (int e = 0; e < 8; ++e) { const int q = tid + 512 * e, r = q >> 6, c8 = (q & 63) * 8; \
        u32x4 v_ = {0u, 0u, 0u, 0u}; if (q < 62 * 64 && s0_ - 30 + r >= 0) v_ = *(const u32x4*)(H + (size_t)(t0_ - 30 + r) * 512 + c8); pre[e] = v_; } }
    CONV_PREFETCH(first);
#pragma unroll 1
    for (int unit = first; unit < nunits; unit += stride) {
        const int t0 = unit * 32;
#pragma unroll
        for (int e = 0; e < 8; ++e) { const int q = tid + 512 * e; if (q < 62 * 64) *(LAS u32x4*)(hin + (q >> 6) * 512 + (q & 63) * 8) = pre[e]; }
        if (unit + stride < nunits) CONV_PREFETCH(unit + stride);
        __syncthreads();
#pragma unroll 1
        for (int tg = 0; tg < 4; ++tg) { float x[38];
#pragma unroll
            for (int r = 0; r < 38; ++r) x[r] = bf2f(hin[(tg * 8 + r) * 512 + tid]);
#pragma unroll
            for (int o = 0; o < 8; ++o) { float a = bias;
#pragma unroll
                for (int k = 0; k < 31; ++k) a += w[k] * x[o + k];
                cout[(tg * 8 + o) * 516 + tid] = a; } }
        __syncthreads();
#pragma unroll 1
        for (int tt = 0; tt < 4; ++tt) { const int row = wid * 4 + tt; const f32x4 v0 = *(const LAS f32x4*)(cout + row * 516 + lane * 8), v1 = *(const LAS f32x4*)(cout + row * 516 + lane * 8 + 4);
            const float mean = wave_sum((v0[0] + v0[1]) + (v0[2] + v0[3]) + (v1[0] + v1[1]) + (v1[2] + v1[3])) * (1.0f / 512.0f);
            const f32x4 d0 = v0 - mean, d1 = v1 - mean;
            const float var = wave_sum((d0[0] * d0[0] + d0[1] * d0[1]) + (d0[2] * d0[2] + d0[3] * d0[3]) + (d1[0] * d1[0] + d1[1] * d1[1]) + (d1[2] * d1[2] + d1[3] * d1[3])) * (1.0f / 512.0f);
            const float rstd = rsqrtf(var + EPS);
            f32x4 y0 = d0 * rstd * g0 + b0, y1 = d1 * rstd * g1 + b1;
#pragma unroll
            for (int e = 0; e < 4; ++e) { y0[e] = silu_f(y0[e]); y1[e] = silu_f(y1[e]); }
            *(u32x4*)(MIX + (size_t)(t0 + row) * 1024 + 512 + lane * 8) = pack8(y0, y1); }
    }
    __syncthreads();
#undef CONV_PREFETCH
}

struct Args { const float* in[33]; float* out; unsigned char* ws; int ph_lo, ph_hi; };
constexpr int NPHASE = 28;

typedef const __attribute__((address_space(4))) Args* KArgP;
__device__ __forceinline__ KArgP fresh_args() { KArgP p = (KArgP)__builtin_amdgcn_kernarg_segment_ptr(); asm volatile("" : "+s"(p)); return p; }

__global__ void __launch_bounds__(512, 2) trunk_fwd(Args args_unused) {
    extern __shared__ __attribute__((aligned(16))) unsigned char lds_raw[];
    LAS unsigned char* lds = (LAS unsigned char*)lds_raw;
    cg::grid_group grid = cg::this_grid();
    { volatile LAS unsigned* MISC0 = (volatile LAS unsigned*)(lds + MISC_OFF); if (threadIdx.x < 32) MISC0[threadIdx.x] = 0u; }
    __syncthreads();
    int lo, hi;
    { KArgP ap = fresh_args(); lo = ap->ph_lo; hi = ap->ph_hi; }
#if !MK_MULTI && !MK_CGSYNC
    { KArgP ap = fresh_args(); (void)xcd_barrier_post((unsigned*)(ap->ws + WS_BAR), (volatile LAS unsigned*)(lds + MISC_OFF) + 8); }
#endif
    int nsync = 0;
#if MK_MULTI
#define SEAM(k) do { } while (0)
#elif MK_CGSYNC
#define SEAM(k) do { if (rep_ + 1 == nrep_ && (k) + 1 < hi) grid.sync(); } while (0)
#else
#define SEAM(k) do { if (rep_ + 1 == nrep_ && (k) + 1 < hi) { if (hi > 1000) grid.sync(); else { KArgP ap_ = fresh_args(); XcdBarrier xb_; xb_.bar = (unsigned*)(ap_->ws + WS_BAR); xb_.x = xb_xcc_id(); xb_.st = (volatile LAS unsigned*)(lds + MISC_OFF) + 8; xcd_barrier(xb_); } ++nsync; } } while (0)
#endif
#ifndef ONLY
#define ONLY -1
#endif
#ifndef REPMASK
#define REPMASK 0
#endif
#define PHASE(id, k) if ((ONLY < 0 || ONLY == (id)) && lo <= (k) && (k) < hi) for (int rep_ = 0, nrep_ = (((REPMASK) >> (id)) & 1) ? 2 : 1; rep_ < nrep_; ++rep_)
    (void)nsync;
#define LOCALS KArgP ap = fresh_args(); unsigned char* ws = ap->ws; float* out = ap->out; const float* x_in = ap->in[0]; \
    int tid_ = threadIdx.x, G_ = gridDim.x, bx_ = blockIdx.x; asm volatile("" : "+v"(tid_), "+s"(G_), "+s"(bx_)); \
    const int tid = tid_, lane = tid & 63, wave = __builtin_amdgcn_readfirstlane(tid >> 6), G = G_, bx = bx_, gw = bx * 8 + wave, NGW = G * 8; \
    bf16_t* XB = (bf16_t*)(ws + WS_XB); u64* SS = (u64*)(ws + WS_SS); u64* VST = (u64*)(ws + WS_VST); bf16_t* QO = (bf16_t*)(ws + WS_QO); \
    bf16_t* HM = (bf16_t*)(ws + WS_HM); bf16_t* MEMN = (bf16_t*)(ws + WS_MEMN); bf16_t* KL = (bf16_t*)(ws + WS_KL); bf16_t* VL = (bf16_t*)(ws + WS_VL); \
    bf16_t* U = (bf16_t*)(ws + WS_U); bf16_t* V = (bf16_t*)(ws + WS_V); bf16_t* H = (bf16_t*)(ws + WS_H); bf16_t* MIX = (bf16_t*)(ws + WS_MIX); \
    bf16_t* AC = (bf16_t*)(ws + WS_ACOMB); float* XL = (float*)(ws + WS_XLOC); bf16_t* Y = (bf16_t*)(ws + WS_Y); u64* SSa = SS + (size_t)(3 * l) * T; \
    (void)out; (void)x_in; (void)lane; (void)gw; (void)NGW; (void)XB; (void)VST; (void)QO; (void)HM; (void)MEMN; (void)KL; (void)VL; (void)U; (void)V; (void)H; (void)MIX; (void)AC; (void)XL; (void)Y; (void)SSa; (void)wave;

    PHASE(0, 0) { const int l = 0; LOCALS
        { f32x4* z = (f32x4*)(SS + T); const int n4 = 7 * T * 2 / 4; for (int i = bx * 512 + tid; i < n4; i += G * 512) z[i] = (f32x4){0.f, 0.f, 0.f, 0.f};
          f32x4* z2 = (f32x4*)VST; const int m4 = 2 * T * 2 / 4; for (int i = bx * 512 + tid; i < m4; i += G * 512) z2[i] = (f32x4){0.f, 0.f, 0.f, 0.f}; }
        LAS float* scr = (LAS float*)(lds + wave * 16384);
#define CONVJOB(Wp, K_, ldn_, cs_, nc_, WTp, mode_, roff_, gain_) { const int nblk_ = (nc_) / 32, cnt_ = ((K_) / 64) * nblk_; \
            if (r >= 0 && r < cnt_) { cp.W = (Wp); cp.WT = (bf16_t*)(WTp); cp.gain = (gain_); cp.K = (K_); cp.ldn = (ldn_); cp.cs = (cs_); cp.nblk = nblk_; cp.mode = (mode_); cp.roff = (roff_); cp.r = r; } r -= cnt_; }
#define CONVLOOKUP(cp, it_) { int r = (it_); \
            CONVJOB(ap->in[3], 1024, 2048, 0, 1024, ws + WS_WIN0, 0, 0, ap->in[2]); \
            CONVJOB(ap->in[3], 1024, 2048, 1024, 512, ws + WS_WIN0, 1, 1024, ap->in[2]); \
            CONVJOB(ap->in[3], 1024, 2048, 1536, 512, ws + WS_WIN0, 2, 1024, ap->in[2]); \
            CONVJOB(ap->in[10], 1024, 1024, 0, 1024, ws + WS_WOUT0, 0, 0, nullptr); \
            CONVJOB(ap->in[12], 1024, 512, 0, 512, ws + WS_WOIN, 0, 0, ap->in[11]); \
            CONVJOB(ap->in[21], 512, 2048, 0, 1024, ws + WS_WOOUT, 1, 0, nullptr); \
            CONVJOB(ap->in[21], 512, 2048, 1024, 1024, ws + WS_WOOUT, 2, 0, nullptr); \
            _Pragma("unroll") for (int l2 = 0; l2 < 2; ++l2) { \
                CONVJOB(ap->in[25] + (size_t)l2 * D * D, 1024, 1024, 0, 1024, ws + WS_WK + l2 * WSQ_L, 0, 0, ap->in[23] + l2 * D); \
                CONVJOB(ap->in[26] + (size_t)l2 * D * D, 1024, 1024, 0, 1024, ws + WS_WV + l2 * WSQ_L, 0, 0, ap->in[23] + l2 * D); \
                CONVJOB(ap->in[27] + (size_t)l2 * D * D, 1024, 1024, 0, 1024, ws + WS_WO + l2 * WSQ_L, 0, 0, nullptr); \
                CONVJOB(ap->in[29] + (size_t)l2 * D * FH, 1024, FH, 0, FH, ws + WS_WGU + l2 * WGU_L, 1, 0, ap->in[28] + l2 * D); \
                CONVJOB(ap->in[30] + (size_t)l2 * D * FH, 1024, FH, 0, FH, ws + WS_WGU + l2 * WGU_L, 2, 0, ap->in[28] + l2 * D); \
                CONVJOB(ap->in[31] + (size_t)l2 * FH * D, FH, 1024, 0, 1024, ws + WS_WD + l2 * WD_L, 0, 0, nullptr); } }
        constexpr int NITEMS = 512 + 256 + 256 + 512 + 256 + 256 + 256 + 2 * (3 * 512 + 3 * 1408);
        for (int it = gw; it < NITEMS; it += 4 * NGW) {
            ConvP c0{}, c1{}, c2{}, c3{}; float v0[32], v1[32], v2[32], v3[32];
            const bool h1 = it + NGW < NITEMS, h2 = it + 2 * NGW < NITEMS, h3 = it + 3 * NGW < NITEMS;
            { ConvP cp{}; CONVLOOKUP(cp, it); c0 = cp; } conv_load(c0, v0, lane);
            if (h1) { ConvP cp{}; CONVLOOKUP(cp, it + NGW); c1 = cp; conv_load(c1, v1, lane); }
            if (h2) { ConvP cp{}; CONVLOOKUP(cp, it + 2 * NGW); c2 = cp; conv_load(c2, v2, lane); }
            if (h3) { ConvP cp{}; CONVLOOKUP(cp, it + 3 * NGW); c3 = cp; conv_load(c3, v3, lane); }
            conv_store(c0, v0, scr, lane);
            if (h1) conv_store(c1, v1, scr, lane);
            if (h2) conv_store(c2, v2, scr, lane);
            if (h3) conv_store(c3, v3, scr, lane);
        }
        { const int nb5 = (G > 64) ? G - 32 : G;
          if (bx < nb5) { const int NW5 = nb5 * 8;
              for (int m = gw * 4; m < T; m += NW5 * 4) rows_to_bf16<false, 4>(x_in + (size_t)m * D, XB + (size_t)m * D, SS + m, lane);
              for (int m = gw * 4; m < MT; m += NW5 * 4) rows_to_bf16<true, 4>(ap->in[1] + (size_t)m * D, MEMN + (size_t)m * D, nullptr, lane); } }
        for (int i = bx * 512 + tid; i < 2 * D * D / 8; i += G * 512) { const int l2 = i / (D * D / 8), e = (i % (D * D / 8)) * 8, k = e >> 10; const float gk = ap->in[22][l2 * D + k];
            const f32x4 a = *(const f32x4*)(ap->in[24] + (size_t)l2 * D * D + e), b = *(const f32x4*)(ap->in[24] + (size_t)l2 * D * D + e + 4);
            *(u32x4*)((bf16_t*)(ws + WS_WQ) + (size_t)l2 * D * D + e) = pack8(a * gk, b * gk); }
        { bf16_t* GW = (bf16_t*)(ws + WS_GW); const float* w = ap->in[4];
          for (int i = bx * 512 + tid; i < 4 * 128 * 128 / 2; i += G * 512) { const int e = 2 * i, ii = (e >> 7) & 127, jj = e & 127; const bool keep = (jj >> 6) <= (ii >> 6);
              ((unsigned*)GW)[i] = keep ? cvt_pk_bf16(w[e], w[e + 1]) : 0u; } }
        __syncthreads();
        for (int g = G - 1 - bx; g < 32; g += G)
            s5_setup(g, lds, ap->in[13], ap->in[14], ap->in[15], ap->in[16], ap->in[17], ap->in[18], ap->in[19], (bf16_t*)(ws + WS_BT3), (bf16_t*)(ws + WS_GM), (float*)(ws + WS_AL), tid);
        SEAM(0);
    }
    PHASE(1, 1) { const int l = 0; LOCALS
        { pg8::Gemm g{MEMN, (const bf16_t*)(ws + WS_WK), D, D, D, 2, 0, 0, (long)D * D, 0}; pg8::Sched S; S.init(MT / 256, D / 256, 2, G, bx);
          pg8::EpiStore E{KL, D, 2, (long)MT * D, 0, nullptr, 1.0f}; pg8::gemm_phase<MK_ALIGN>(lds, g, S, E, tid); }
        { pg8::Gemm g{MEMN, (const bf16_t*)(ws + WS_WV), D, D, D, 2, 0, 0, (long)D * D, 0}; pg8::Sched S; S.init(MT / 256, D / 256, 2, G, (bx + G / 2) % G);
          pg8::EpiStore E{VL, D, 2, (long)MT * D, 0, nullptr, 1.0f}; pg8::gemm_phase<MK_ALIGN>(lds, g, S, E, tid); }
        SEAM(1);
    }
    PHASE(17, 2) { const int l = 0; LOCALS
#pragma unroll 1
        for (int l2 = 0; l2 < 2; ++l2) {
            { pg8::Gemm g{KL + (size_t)l2 * MT * D, (const bf16_t*)(ws + WS_WQ) + (size_t)l2 * D * D, D, D, 256, 4, 256, 256L * D, 256, 0}; pg8::Sched S; S.init(1, 4, 32, G, bx);
              pg8::EpiStore E{(bf16_t*)(ws + WS_WQK) + (size_t)l2 * 8 * D * D, D, 4, 256L * D, (long)D * D, nullptr, 1.0f}; pg8::gemm_phase<MK_ALIGN>(lds, g, S, E, tid); }
            { pg8::Gemm g{(const bf16_t*)(ws + WS_WO) + (size_t)l2 * D * D, VL + (size_t)l2 * MT * D, D, D, 256, 4, 256, 0, 256, 256L * D}; pg8::Sched S; S.init(4, 1, 32, G, (bx + G / 2) % G);
              pg8::EpiStore E{(bf16_t*)(ws + WS_WVO) + (size_t)l2 * 8 * D * D, D, 4, 256, (long)D * D, nullptr, 1.0f}; pg8::gemm_phase<MK_ALIGN>(lds, g, S, E, tid); }
        }
        SEAM(2);
    }
#pragma unroll 1
    for (int l = 0; l < 2; ++l) {
        const int pb = 3 + 12 * l;
        if (l == 0) {
            PHASE(2, pb + 0) { LOCALS
                pg8::Gemm g{XB, (const bf16_t*)(ws + WS_WIN0), D, D, D, 1, 0, 0, 0, 0}; pg8::Sched S; S.init(T / 256, 2048 / 256, 1, G, bx);
                pg8::EpiIn0 E{SSa, U, V, H, VST}; pg8::gemm_phase<MK_ALIGN>(lds, g, S, E, tid);
                SEAM(pb + 0);
            }
            PHASE(3, pb + 1) { LOCALS
                for (int i = bx; i < 1024; i += G) gmlp_unit(i, lds, U, V, VST, (const bf16_t*)(ws + WS_GW), ap->in[5], MIX, tid);
                conv_units(bx, G, 1024, lds, H, ap->in[6], ap->in[7], ap->in[8], ap->in[9], MIX, tid);
                SEAM(pb + 1);
            }
            PHASE(4, pb + 2) { LOCALS
                pg8::Gemm g{MIX, (const bf16_t*)(ws + WS_WOUT0), D, D, D, 1, 0, 0, 0, 0}; pg8::Sched S; S.init(T / 256, D / 256, 1, G, bx);
                pg8::EpiRes<false> E{XB, SSa + T, 0}; pg8::gemm_phase<MK_ALIGN>(lds, g, S, E, tid);
                SEAM(pb + 2);
            }
        } else {
            PHASE(5, pb + 0) { LOCALS
                pg8::Gemm g{XB, (const bf16_t*)(ws + WS_WOIN), D, D, D, 1, 0, 0, 0, 0}; pg8::Sched S; S.init(T / 256, 512 / 256, 1, G, bx);
                pg8::EpiOin E{SSa, AC}; pg8::gemm_phase<MK_ALIGN>(lds, g, S, E, tid);
                SEAM(pb + 0);
            }
            PHASE(6, pb + 1) { LOCALS
                pg8::Gemm g{AC, (const bf16_t*)(ws + WS_GM), AK, 512, 512, 32, (long)NCH * AK, 0, 256L * 512, 0}; pg8::Sched S; S.init(NCH / 256, 1, 32, G, bx);
                pg8::EpiS5State E{XL}; pg8::gemm_phase<MK_ALIGN>(lds, g, S, E, tid);
                SEAM(pb + 1);
            }
            PHASE(7, pb + 2) { LOCALS
                if (wave == 0) {
                    const int idx = bx * 64 + lane;
                    if (idx < NB * 32 * 64) { const int p = idx & 63, g = (idx >> 6) & 31, b = idx >> 11;
                        const float* AL = (const float*)(ws + WS_AL); const float ar = AL[(g * 64 + p) * 2], ai = AL[(g * 64 + p) * 2 + 1];
                        const float* xl = XL + (size_t)g * NCH * 128 + (size_t)(b * (SEQ / SL)) * 128; bf16_t* ac = AC + (size_t)g * NCH * AK + (size_t)(b * (SEQ / SL)) * AK + 512;
                        float xr = 0.f, xi = 0.f;
#pragma unroll 1
                        for (int c0 = 0; c0 < SEQ / SL; c0 += 32) { float lr[32], li[32];
#pragma unroll
                            for (int i = 0; i < 32; ++i) { lr[i] = xl[(size_t)(c0 + i) * 128 + p]; li[i] = xl[(size_t)(c0 + i) * 128 + 64 + p]; }
#pragma unroll
                            for (int i = 0; i < 32; ++i) { const unsigned pk = cvt_pk_bf16(xr, xi); ac[(size_t)(c0 + i) * AK + p] = (bf16_t)(pk & 0xffffu); ac[(size_t)(c0 + i) * AK + 64 + p] = (bf16_t)(pk >> 16);
                                const float nr = ar * xr - ai * xi + lr[i], ni = ar * xi + ai * xr + li[i]; xr = nr; xi = ni; } }
                    }
                }
                SEAM(pb + 2);
            }
            PHASE(8, pb + 3) { LOCALS
                pg8::Gemm g{AC, (const bf16_t*)(ws + WS_BT3), AK, AK, AK, 32, (long)NCH * AK, 0, 512L * AK, 0}; pg8::Sched S; S.init(NCH / 256, 2, 32, G, bx);
                pg8::EpiS5Out E{AC, ap->in[20], Y}; pg8::gemm_phase<MK_ALIGN>(lds, g, S, E, tid);
                SEAM(pb + 3);
            }
            PHASE(9, pb + 4) { LOCALS
                pg8::Gemm g{Y, (const bf16_t*)(ws + WS_WOOUT), 512, 512, 512, 1, 0, 0, 0, 0}; pg8::Sched S; S.init(T / 256, 2048 / 256, 1, G, bx);
                pg8::EpiRes<true> E{XB, SSa + T, 0}; pg8::gemm_phase<MK_ALIGN>(lds, g, S, E, tid);
                SEAM(pb + 4);
            }
        }
        PHASE(10, pb + 5) { LOCALS
            pg8::Gemm g{XB, (const bf16_t*)(ws + WS_WQK) + (size_t)l * 8 * D * D, D, D, D, 8, (long)SEQ * D, 0, (long)D * D, 0}; pg8::Sched S; S.init(SEQ / 256, D / 256, 8, G, bx);
            pg8::EpiSoftmax E{QO, SSa + T}; pg8::gemm_phase<true>(lds, g, S, E, tid);
            SEAM(pb + 5);
        }
        PHASE(13, pb + 6) { LOCALS
            pg8::Gemm g{QO, (const bf16_t*)(ws + WS_WVO) + (size_t)l * 8 * D * D, D, D, D, 8, (long)SEQ * D, 0, (long)D * D, 0}; pg8::Sched S; S.init(SEQ / 256, D / 256, 8, G, bx);
            pg8::EpiRes<false> E{XB, SSa + 2 * T, SEQ}; pg8::gemm_phase<MK_ALIGN>(lds, g, S, E, tid);
            SEAM(pb + 6);
        }
        PHASE(14, pb + 9) { LOCALS
            pg8::Gemm g{XB, (const bf16_t*)(ws + WS_WGU + l * WGU_L), D, D, D, 1, 0, 0, 0, 0}; pg8::Sched S; S.init(T / 256, 2 * FH / 256, 1, G, bx);
            pg8::EpiFfn1 E{SSa + 2 * T, HM}; pg8::gemm_phase<MK_ALIGN>(lds, g, S, E, tid);
            SEAM(pb + 9);
        }
        PHASE(15, pb + 10) { LOCALS
            pg8::Gemm g{HM, (const bf16_t*)(ws + WS_WD + l * WD_L), FH, FH, FH, 1, 0, 0, 0, 0}; pg8::Sched S; S.init(T / 256, D / 256, 1, G, bx);
            pg8::EpiRes<false> E{XB, SSa + 3 * T, 0}; pg8::gemm_phase<MK_ALIGN>(lds, g, S, E, tid);
            SEAM(pb + 10);
        }
    }
    PHASE(16, 27) { const int l = 0; LOCALS
        const u64* ssf = SS + (size_t)6 * T; const float* gf = ap->in[32];
        const f32x4 ga = *(const f32x4*)(gf + 8 * lane), gb = *(const f32x4*)(gf + 8 * lane + 4), gc = *(const f32x4*)(gf + 512 + 8 * lane), gd = *(const f32x4*)(gf + 512 + 8 * lane + 4);
        for (int m = gw * 4; m < T; m += NGW * 4) { u32x4 v[4][2]; float rs[4];
#pragma unroll
            for (int r = 0; r < 4; ++r) { rs[r] = rsqrtf(fx_get(ssf + m + r) * (1.0f / D) + EPS); const bf16_t* xr = XB + (size_t)(m + r) * D + 8 * lane; v[r][0] = *(const u32x4*)xr; v[r][1] = *(const u32x4*)(xr + 512); }
#pragma unroll
            for (int r = 0; r < 4; ++r) { float* orow = out + (size_t)(m + r) * D + 8 * lane; f32x4 a0, a1, b0, b1; pg8::unpack8(v[r][0], a0, a1); pg8::unpack8(v[r][1], b0, b1);
                *(f32x4*)orow = a0 * rs[r] * ga; *(f32x4*)(orow + 4) = a1 * rs[r] * gb; *(f32x4*)(orow + 512) = b0 * rs[r] * gc; *(f32x4*)(orow + 516) = b1 * rs[r] * gd; } }
    }
}

extern "C" void kernel_launch(void* const* d_in, const int* in_sizes, int n_in, void* d_out, int out_size, void* d_ws, size_t ws_size, hipStream_t stream) {
    static int grid = 0;
    if (grid == 0) {
        if (n_in != 33 || in_sizes[0] != T * D || out_size != T * D || ws_size < WS_END) { fprintf(stderr, "kernel_launch: unexpected shapes (n_in %d, in0 %d, out %d, ws %zu < %zu)\n", n_in, n_in > 0 ? in_sizes[0] : -1, out_size, ws_size, (size_t)WS_END); grid = -1; return; }
        int dev = 0, cus = 0, per_cu = 0;
        hipGetDevice(&dev); hipDeviceGetAttribute(&cus, hipDeviceAttributeMultiprocessorCount, dev);
        if (hipFuncSetAttribute((const void*)trunk_fwd, hipFuncAttributeMaxDynamicSharedMemorySize, LDS_BYTES) != hipSuccess) { fprintf(stderr, "kernel_launch: hipFuncSetAttribute failed\n"); grid = -1; return; }
        if (hipOccupancyMaxActiveBlocksPerMultiprocessor(&per_cu, (const void*)trunk_fwd, 512, LDS_BYTES) != hipSuccess || per_cu < 1) { fprintf(stderr, "kernel_launch: occupancy query says %d\n", per_cu); per_cu = 1; }
        (void)hipGetLastError();
        grid = cus * 1;
        if (grid <= 0) grid = 256;
    }
    if (grid < 0) return;
    Args a{};
    for (int i = 0; i < 33; ++i) a.in[i] = (const float*)d_in[i];
    a.out = (float*)d_out; a.ws = (unsigned char*)d_ws;
#if !MK_MULTI && !MK_CGSYNC
    (void)hipMemsetAsync((char*)d_ws + WS_BAR, 0, XCD_BAR_WORDS * 4, stream);
#endif
#if MK_MULTI
    for (int p = 0; p < NPHASE; ++p) {
        if (p == 6 || p == 7 || p == 10 || p == 11 || p == 14 || p == 22 || p == 23 || p == 26) continue;
        a.ph_lo = p; a.ph_hi = p + 1; void* kargs[] = {&a};
        hipError_t e = hipLaunchCooperativeKernel((const void*)trunk_fwd, dim3(grid), dim3(512), kargs, LDS_BYTES, stream);
        if (e != hipSuccess) { fprintf(stderr, "kernel_launch: launch of phase %d failed: %s\n", p, hipGetErrorString(e)); break; }
    }
#else
    a.ph_lo = 0; a.ph_hi = NPHASE; void* kargs[] = {&a};
    hipError_t e = hipLaunchCooperativeKernel((const void*)trunk_fwd, dim3(grid), dim3(512), kargs, LDS_BYTES, stream);
    if (e != hipSuccess) fprintf(stderr, "kernel_launch: cooperative launch failed: %s (grid %d)\n", hipGetErrorString(e), grid);
#endif
}
```

```cpp
#include <hip/hip_runtime.h>
#include <hip/hip_cooperative_groups.h>
#include <cstdio>
#include <cstdint>
namespace cg = cooperative_groups;

#ifndef MK_MULTI
#define MK_MULTI 0
#endif
#ifndef MK_ALIGN
#define MK_ALIGN true
#endif
#ifndef BARPROBE
#define BARPROBE 0
#endif
#ifndef MK_CGSYNC
#define MK_CGSYNC 0
#endif

#define LAS __attribute__((address_space(3)))
typedef unsigned short bf16_t;
typedef short bf16x8 __attribute__((ext_vector_type(8)));
typedef float f32x4 __attribute__((ext_vector_type(4)));
typedef float f32x2 __attribute__((ext_vector_type(2)));
typedef unsigned u32x4 __attribute__((ext_vector_type(4)));
typedef unsigned u32x2 __attribute__((ext_vector_type(2)));

constexpr int T = 32768, D = 1024, SEQ = 4096, NB = 8, MT = 2048, FH = 2816;
constexpr float EPS = 1e-6f;
constexpr int SL = 32;
constexpr int NCH = T / SL;
constexpr int AK = SL * 16 + 128;

constexpr size_t MiB = 1u << 20;
constexpr size_t WS_WIN0 = 0, WS_WOUT0 = 4 * MiB, WS_WOIN = 6 * MiB, WS_WOOUT = 7 * MiB, WS_WQ = 9 * MiB, WS_WK = 13 * MiB, WS_WV = 17 * MiB, WS_WO = 21 * MiB;
constexpr size_t WS_WGU = 25 * MiB, WS_WD = 47 * MiB, WS_GW = 58 * MiB, WS_AL = 59 * MiB, WS_BT3 = 60 * MiB, WS_GM = 80 * MiB, WS_MEMN = 88 * MiB, WS_KL = 92 * MiB, WS_VL = 100 * MiB;
constexpr size_t WS_XB = 110 * MiB, WS_QO = 174 * MiB, WS_P = 238 * MiB, WS_R0 = 302 * MiB;
constexpr size_t WS_WQK = WS_P, WS_WVO = WS_P + 32 * MiB;
constexpr size_t WS_HM = WS_R0, WS_U = WS_R0, WS_V = WS_R0 + 32 * MiB, WS_H = WS_R0 + 64 * MiB, WS_MIX = WS_R0 + 96 * MiB;
constexpr size_t WS_ACOMB = WS_R0, WS_XLOC = WS_R0 + 40 * MiB, WS_Y = WS_R0 + 56 * MiB;
constexpr size_t WS_SS = WS_R0 + 176 * MiB, WS_VST = WS_SS + 2 * MiB, WS_BAR = WS_VST + 1 * MiB, WS_END = WS_BAR + 1 * MiB;
constexpr size_t WGU_L = (size_t)2 * FH * D * 2, WD_L = (size_t)D * FH * 2, WSQ_L = (size_t)D * D * 2;

constexpr int RING_BYTES = 131072, XCH_OFF = RING_BYTES, MISC_OFF = RING_BYTES + 8192, LDS_BYTES = 147456;

__device__ __forceinline__ unsigned cvt_pk_bf16(float lo, float hi) { unsigned r; asm volatile("v_cvt_pk_bf16_f32 %0, %1, %2" : "=v"(r) : "v"(lo), "v"(hi)); return r; }
__device__ __forceinline__ float bf2f(unsigned short b) { return __builtin_bit_cast(float, (unsigned)b << 16); }
__device__ __forceinline__ float bflo(unsigned w) { return __builtin_bit_cast(float, w << 16); }
__device__ __forceinline__ float bfhi(unsigned w) { return __builtin_bit_cast(float, w & 0xffff0000u); }
__device__ __forceinline__ float sigmoid_f(float x) { return __builtin_amdgcn_rcpf(1.0f + __expf(-x)); }
__device__ __forceinline__ float silu_f(float x) { return x * sigmoid_f(x); }
__device__ __forceinline__ float gelu_f(float x) { return x * sigmoid_f(1.5957691216f * (x + 0.044715f * x * x * x)); }
typedef unsigned long long u64;
__device__ __forceinline__ void fx_add(u64* p, float q) { atomicAdd(p, (u64)(long long)(q * 16777216.0f)); }
__device__ __forceinline__ float fx_get(const u64* p) { return (float)(long long)(*p) * (1.0f / 16777216.0f); }
__device__ __forceinline__ float wave_sum(float v) {
#pragma unroll
    for (int o = 1; o < 64; o <<= 1) v += __shfl_xor(v, o);
    return v;
}
__device__ __forceinline__ u32x4 pack8(f32x4 a, f32x4 b) { u32x4 w; w.x = cvt_pk_bf16(a[0], a[1]); w.y = cvt_pk_bf16(a[2], a[3]); w.z = cvt_pk_bf16(b[0], b[1]); w.w = cvt_pk_bf16(b[2], b[3]); return w; }

namespace pg8 {
constexpr int BM = 256, BK = 64, HALF = 128, HTB = HALF * BK * 2, NXCD = 8, WGM = 8;
__device__ __forceinline__ int lds_byte(int r, int c) { const int st = (r >> 4) * 2 + (c >> 5), rr = r & 15, cc = c & 31, ob = rr * 64 + cc * 2; return st * 1024 + (ob ^ (((ob >> 9) & 1) << 5)); }
__device__ __forceinline__ void stage_rc(int b, int& R, int& C) { const int st = b / 1024, sb = b % 1024, swz = sb ^ (((sb >> 9) & 1) << 5); R = (st >> 1) * 16 + swz / 64; C = (st & 1) * 32 + (swz % 64) / 2; }
__device__ __forceinline__ int perm32(int rho) { const int n = rho >> 4, i = rho & 15; return 8 * (i >> 2) + 4 * n + (i & 3); }

struct Unit { int pm, pn, z; };
struct Gemm { const bf16_t* A; const bf16_t* Bt; int lda, ldb, K, nz0; long sAz0, sAz1, sBz0, sBz1; };
struct Sched {
    int nM, nN, per, total, G, c;
    __device__ __forceinline__ void init(int nM_, int nN_, int nz, int G_, int c_) { nM = nM_; nN = nN_; per = nM_ * nN_; total = per * nz; G = G_; c = c_; }
    __device__ __forceinline__ bool next(int i, Unit& u) const {
        const long L = (long)i * G + c; if (L >= total) return false;
        const int z = (int)(L / per); int wgid = (int)(L % per);
        { const int q = per / NXCD, r = per % NXCD, xcd = wgid % NXCD, off = wgid / NXCD; wgid = (xcd < r ? xcd * (q + 1) : r * (q + 1) + (xcd - r) * q) + off; }
        const int nig = WGM * nN, gid = wgid / nig, fm = gid * WGM, gsz = (nM - fm) < WGM ? (nM - fm) : WGM;
        u.pm = fm + ((wgid % nig) % gsz); u.pn = (wgid % nig) / gsz; u.z = z; return true;
    }
};

template <bool ALIGN, class Epi>
__device__ __forceinline__ void gemm_phase(LAS unsigned char* lds, const Gemm g, const Sched& S, const Epi& E, const int tid) {
    const int wid = __builtin_amdgcn_readfirstlane(tid >> 6), lane = tid & 63, wr = wid >> 2, wc = wid & 3, fr = lane & 15, fq = lane >> 4;
    const int nt = g.K / BK;
    unsigned voffA[2], voffB[2];
#pragma unroll
    for (int i = 0; i < 2; ++i) { int R, C; stage_rc(tid * 16 + i * 8192, R, C); const int Rb = (R & ~31) + perm32(R & 31);
        voffA[i] = (unsigned)(R * g.lda + C) * 2u; voffB[i] = (unsigned)(Rb * g.ldb + C) * 2u; }
    const size_t kstep = (size_t)(BK * 2);
    const size_t hsA = (size_t)HALF * g.lda * 2, hsB = (size_t)HALF * g.ldb * 2;
    const unsigned ldsw = (unsigned)wid * 1024u;
    const int aoff = lds_byte(wr * 64 + fr, fq * 8), boff = lds_byte(wc * 32 + fr, fq * 8);
#define PG8_SA(b, h) (((b) * 2 + (h)) * HTB)
#define PG8_SB(b, h) ((4 + (b) * 2 + (h)) * HTB)
#define PG8_STAGE(bufoff, gbase, voff) do { _Pragma("unroll") for (int _i = 0; _i < 2; ++_i) \
        __builtin_amdgcn_global_load_lds((const unsigned*)((const char*)(gbase) + (voff)[_i]), (LAS unsigned*)(lds + (bufoff) + ldsw + _i * 8192), 16, 0, 0); } while (0)
#define PG8_LDA(dst, b, h) do { _Pragma("unroll") for (int m = 0; m < 4; ++m) _Pragma("unroll") for (int k = 0; k < 2; ++k) dst[m][k] = *(const LAS bf16x8*)(lds + PG8_SA(b, h) + aoff + m * 2048 + k * 1024); } while (0)
#define PG8_LDB(dst, b, h) do { _Pragma("unroll") for (int n = 0; n < 2; ++n) _Pragma("unroll") for (int k = 0; k < 2; ++k) dst[n][k] = *(const LAS bf16x8*)(lds + PG8_SB(b, h) + boff + n * 2048 + k * 1024); } while (0)
#define PG8_MMA(ai, bj, At, Bt) do { __builtin_amdgcn_s_setprio(1); _Pragma("unroll") for (int m = 0; m < 4; ++m) _Pragma("unroll") for (int n = 0; n < 2; ++n) _Pragma("unroll") for (int k = 0; k < 2; ++k) \
        acc[ai][bj][m][n] = __builtin_amdgcn_mfma_f32_16x16x32_bf16(Bt[n][k], At[m][k], acc[ai][bj][m][n], 0, 0, 0); __builtin_amdgcn_s_setprio(0); } while (0)
#define PG8_WAIT_V(n) asm volatile("s_waitcnt vmcnt(" #n ")" ::: "memory")
#define PG8_WAIT_L(n) asm volatile("s_waitcnt lgkmcnt(" #n ")" ::: "memory")
#define PG8_BAR __builtin_amdgcn_s_barrier()
#define PG8_SCHED __builtin_amdgcn_sched_barrier(0)
#define PG8_UA(u) ((const char*)g.A + 2 * ((size_t)((u).z % g.nz0) * g.sAz0 + (size_t)((u).z / g.nz0) * g.sAz1 + (size_t)(u).pm * BM * g.lda))
#define PG8_UB(u) ((const char*)g.Bt + 2 * ((size_t)((u).z % g.nz0) * g.sBz0 + (size_t)((u).z / g.nz0) * g.sBz1 + (size_t)(u).pn * BM * g.ldb))
    Unit cur, nxt; int ui = 0;
    if (!S.next(0, cur)) return;
    f32x4 acc[2][2][4][2];
#pragma unroll
    for (int a = 0; a < 2; ++a)
#pragma unroll
        for (int b = 0; b < 2; ++b)
#pragma unroll
            for (int m = 0; m < 4; ++m)
#pragma unroll
                for (int n = 0; n < 2; ++n) acc[a][b][m][n] = (f32x4){0.f, 0.f, 0.f, 0.f};
    bf16x8 At[4][2], B0[2][2], B1[2][2];
    const char* cA = PG8_UA(cur); const char* cB = PG8_UB(cur);
    PG8_STAGE(PG8_SB(0, 0), cB, voffB); PG8_STAGE(PG8_SB(0, 1), cB + hsB, voffB); PG8_STAGE(PG8_SA(0, 0), cA, voffA); PG8_STAGE(PG8_SA(0, 1), cA + hsA, voffA);
    if (wr == 1) PG8_BAR;
    PG8_WAIT_V(2); PG8_BAR;
    PG8_STAGE(PG8_SB(1, 0), cB + kstep, voffB); PG8_STAGE(PG8_SA(1, 0), cA + kstep, voffA); PG8_STAGE(PG8_SB(1, 1), cB + hsB + kstep, voffB);
    PG8_WAIT_V(6); PG8_BAR;
    for (;;) {
        const bool has_next = S.next(ui + 1, nxt);
        const char* nA = has_next ? PG8_UA(nxt) : cA; const char* nB = has_next ? PG8_UB(nxt) : cB;
        for (int t = 0; t < nt; t += 2) {
            const bool last = (t == nt - 2);
            const char* a1 = cA + (size_t)(t + 1) * kstep;
            const char* a2 = last ? nA : cA + (size_t)(t + 2) * kstep; const char* b2 = last ? nB : cB + (size_t)(t + 2) * kstep;
            const char* a3 = a2 + kstep; const char* b3 = b2 + kstep;
            PG8_LDB(B0, 0, 0); PG8_LDB(B1, 0, 1); PG8_SCHED; PG8_LDA(At, 0, 0); PG8_STAGE(PG8_SA(1, 1), a1 + hsA, voffA);
            PG8_WAIT_V(8); PG8_WAIT_L(0); PG8_BAR; PG8_MMA(0, 0, At, B0); PG8_MMA(0, 1, At, B1); PG8_BAR; PG8_SCHED;
            PG8_LDA(At, 0, 1); PG8_STAGE(PG8_SB(0, 0), b2, voffB); PG8_STAGE(PG8_SB(0, 1), b2 + hsB, voffB); PG8_STAGE(PG8_SA(0, 0), a2, voffA);
            PG8_WAIT_V(8); PG8_WAIT_L(0); PG8_BAR; PG8_MMA(1, 0, At, B0); PG8_MMA(1, 1, At, B1); PG8_BAR; PG8_SCHED;
            PG8_LDB(B0, 1, 0); PG8_LDB(B1, 1, 1); PG8_SCHED; PG8_LDA(At, 1, 0); PG8_STAGE(PG8_SA(0, 1), a2 + hsA, voffA);
            PG8_WAIT_V(8); PG8_WAIT_L(0); PG8_BAR; PG8_MMA(0, 0, At, B0); PG8_MMA(0, 1, At, B1); PG8_BAR; PG8_SCHED;
            PG8_LDA(At, 1, 1); PG8_STAGE(PG8_SB(1, 0), b3, voffB); PG8_STAGE(PG8_SB(1, 1), b3 + hsB, voffB); PG8_STAGE(PG8_SA(1, 0), a3, voffA);
            PG8_WAIT_V(8); PG8_WAIT_L(0); PG8_BAR; PG8_MMA(1, 0, At, B0); PG8_MMA(1, 1, At, B1); PG8_BAR; PG8_SCHED;
        }
        if (ALIGN) { if (wr == 0) PG8_BAR; }
        E(acc, cur, wr, wc, fr, fq, lds);
        if (!has_next) break;
#pragma unroll
        for (int a = 0; a < 2; ++a)
#pragma unroll
            for (int b = 0; b < 2; ++b)
#pragma unroll
                for (int m = 0; m < 4; ++m)
#pragma unroll
                    for (int n = 0; n < 2; ++n) acc[a][b][m][n] = (f32x4){0.f, 0.f, 0.f, 0.f};
        cur = nxt; cA = nA; cB = nB; ++ui;
        if (ALIGN) { if (wr == 1) PG8_BAR; }
    }
    PG8_WAIT_V(0);
    if (!ALIGN) { if (wr == 0) PG8_BAR; }
    PG8_BAR;
#undef PG8_SA
#undef PG8_SB
#undef PG8_STAGE
#undef PG8_LDA
#undef PG8_LDB
#undef PG8_MMA
#undef PG8_UA
#undef PG8_UB
}

typedef f32x4 Acc[2][2][4][2];
#define EPI_ARGS Acc& acc, const Unit& u, int wr, int wc, int fr, int fq, LAS unsigned char* lds
__device__ __forceinline__ int efence() { asm volatile("" ::: "memory"); return 1; }
#define ROWLOOP _Pragma("unroll") for (int ai = 0; ai < 2; ++ai) _Pragma("unroll") for (int m = 0; m < 4; ++m) for (int once_ = efence(); once_; once_ = 0)

#define LOAD_RS8(rs, ssp, row0) float rs[2][4]; { u64 raw_[2][4]; _Pragma("unroll") for (int ai = 0; ai < 2; ++ai) _Pragma("unroll") for (int m = 0; m < 4; ++m) raw_[ai][m] = (ssp)[(row0) + ai * 128 + m * 16]; \
    _Pragma("unroll") for (int ai = 0; ai < 2; ++ai) _Pragma("unroll") for (int m = 0; m < 4; ++m) rs[ai][m] = rsqrtf((float)(long long)raw_[ai][m] * (1.0f / 16777216.0f) * (1.0f / D) + EPS); }
struct EpiIn0 {
    const u64* ss; bf16_t* U; bf16_t* V; bf16_t* H; u64* vst;
    __device__ __forceinline__ void operator()(EPI_ARGS) const {
        const int row0 = u.pm * 256 + wr * 64 + fr;
        LOAD_RS8(rs8, ss, row0);
        if (u.pn < 4) {
            bf16_t* dst = (u.pn < 2) ? U : V; const int col0 = (u.pn & 1) * 256 + wc * 32 + 8 * fq; const bool st = u.pn >= 2;
            ROWLOOP { const int row = row0 + ai * 128 + m * 16; const float rs = rs8[ai][m]; float s = 0.f, q = 0.f;
#pragma unroll
                for (int bj = 0; bj < 2; ++bj) { f32x4 v0 = acc[ai][bj][m][0] * rs, v1 = acc[ai][bj][m][1] * rs;
#pragma unroll
                    for (int e = 0; e < 4; ++e) { v0[e] = gelu_f(v0[e]); v1[e] = gelu_f(v1[e]); s += v0[e] + v1[e]; q += v0[e] * v0[e] + v1[e] * v1[e]; }
                    *(u32x4*)(dst + (size_t)row * 512 + col0 + bj * 128) = pack8(v0, v1); }
                if (st) { s += __shfl_xor(s, 16); s += __shfl_xor(s, 32); q += __shfl_xor(q, 16); q += __shfl_xor(q, 32);
                    if (fq == 0) { fx_add(vst + 2 * row, s); fx_add(vst + 2 * row + 1, q); } }
            }
        } else {
            const int col0 = (u.pn - 4) * 128 + wc * 32 + 8 * fq;
            ROWLOOP { const int row = row0 + ai * 128 + m * 16; const float rs = rs8[ai][m]; f32x4 h0, h1;
#pragma unroll
                for (int e = 0; e < 4; ++e) { h0[e] = acc[ai][0][m][0][e] * rs * sigmoid_f(acc[ai][1][m][0][e] * rs); h1[e] = acc[ai][0][m][1][e] * rs * sigmoid_f(acc[ai][1][m][1][e] * rs); }
                *(u32x4*)(H + (size_t)row * 512 + col0) = pack8(h0, h1); }
        }
    }
};
__device__ __forceinline__ void unpack8(u32x4 b, f32x4& o0, f32x4& o1) { o0 = (f32x4){bflo(b.x), bfhi(b.x), bflo(b.y), bfhi(b.y)}; o1 = (f32x4){bflo(b.z), bfhi(b.z), bflo(b.w), bfhi(b.w)}; }
template <bool GLU> struct EpiRes {
    bf16_t* xb; u64* ss; int zrows;
    __device__ __forceinline__ void operator()(EPI_ARGS) const {
        const int row0 = u.z * zrows + u.pm * 256 + wr * 64 + fr;
#pragma unroll
        for (int ai = 0; ai < 2; ++ai) {
            u32x4 pre[4][2];
#pragma unroll
            for (int m = 0; m < 4; ++m) { const int row = row0 + ai * 128 + m * 16;
                if (GLU) pre[m][0] = *(const u32x4*)(xb + (size_t)row * D + u.pn * 128 + wc * 32 + 8 * fq);
                else {
#pragma unroll
                    for (int bj = 0; bj < 2; ++bj) pre[m][bj] = *(const u32x4*)(xb + (size_t)row * D + u.pn * 256 + bj * 128 + wc * 32 + 8 * fq); } }
#pragma unroll
            for (int m = 0; m < 4; ++m) for (int once_ = efence(); once_; once_ = 0) { const int row = row0 + ai * 128 + m * 16; float q = 0.f;
                if (GLU) { const size_t off = (size_t)row * D + u.pn * 128 + wc * 32 + 8 * fq;
                    f32x4 o0, o1; unpack8(pre[m][0], o0, o1);
#pragma unroll
                    for (int e = 0; e < 4; ++e) { o0[e] += acc[ai][0][m][0][e] * sigmoid_f(acc[ai][1][m][0][e]); o1[e] += acc[ai][0][m][1][e] * sigmoid_f(acc[ai][1][m][1][e]);
                        q += o0[e] * o0[e] + o1[e] * o1[e]; }
                    *(u32x4*)(xb + off) = pack8(o0, o1);
                } else {
#pragma unroll
                    for (int bj = 0; bj < 2; ++bj) { const size_t off = (size_t)row * D + u.pn * 256 + bj * 128 + wc * 32 + 8 * fq;
                        f32x4 o0, o1; unpack8(pre[m][bj], o0, o1); o0 += acc[ai][bj][m][0]; o1 += acc[ai][bj][m][1];
#pragma unroll
                        for (int e = 0; e < 4; ++e) q += o0[e] * o0[e] + o1[e] * o1[e];
                        *(u32x4*)(xb + off) = pack8(o0, o1); }
                }
                q += __shfl_xor(q, 16); q += __shfl_xor(q, 32);
                if (fq == 0) fx_add(ss + row, q);
            }
        }
    }
};
struct EpiStore {
    bf16_t* O; int ldc, nz0; long sz0, sz1; const u64* ss; float scale;
    __device__ __forceinline__ void operator()(EPI_ARGS) const {
        bf16_t* base = O + (size_t)(u.z % nz0) * sz0 + (size_t)(u.z / nz0) * sz1; const int row0 = u.pm * 256 + wr * 64 + fr, col0 = u.pn * 256 + wc * 32 + 8 * fq;
        float rs8[2][4];
        if (ss) { LOAD_RS8(t8, ss, row0);
#pragma unroll
            for (int ai = 0; ai < 2; ++ai)
#pragma unroll
                for (int m = 0; m < 4; ++m) rs8[ai][m] = t8[ai][m] * scale; }
        else {
#pragma unroll
            for (int ai = 0; ai < 2; ++ai)
#pragma unroll
                for (int m = 0; m < 4; ++m) rs8[ai][m] = scale; }
        ROWLOOP { const int row = row0 + ai * 128 + m * 16; const float rs = rs8[ai][m];
#pragma unroll
            for (int bj = 0; bj < 2; ++bj) *(u32x4*)(base + (size_t)row * ldc + col0 + bj * 128) = pack8(acc[ai][bj][m][0] * rs, acc[ai][bj][m][1] * rs); }
    }
};
struct EpiSoftmax {
    bf16_t* P; const u64* ss;
    __device__ __forceinline__ void operator()(EPI_ARGS) const {
        LAS float* X = (LAS float*)(lds + XCH_OFF); LAS float* Y = X + 1024;
        const int grow0 = u.z * SEQ + u.pm * 256 + wr * 64 + fr;
        LOAD_RS8(rs8, ss, grow0);
        ROWLOOP { const int r = ai * 128 + wr * 64 + m * 16 + fr; const float sc = rs8[ai][m] * 0.0625f; float mx = -3.0e38f;
#pragma unroll
            for (int bj = 0; bj < 2; ++bj)
#pragma unroll
                for (int n = 0; n < 2; ++n) { acc[ai][bj][m][n] = acc[ai][bj][m][n] * sc;
#pragma unroll
                    for (int e = 0; e < 4; ++e) mx = fmaxf(mx, acc[ai][bj][m][n][e]); }
            mx = fmaxf(mx, __shfl_xor(mx, 16)); mx = fmaxf(mx, __shfl_xor(mx, 32));
            if (fq == 0) X[r * 4 + wc] = mx; }
        asm volatile("s_waitcnt lgkmcnt(0)" ::: "memory"); __builtin_amdgcn_s_barrier(); asm volatile("" ::: "memory");
        ROWLOOP { const int r = ai * 128 + wr * 64 + m * 16 + fr; const f32x4 xm = *(const LAS f32x4*)(X + r * 4); const float mx = fmaxf(fmaxf(xm[0], xm[1]), fmaxf(xm[2], xm[3])); float s = 0.f;
#pragma unroll
            for (int bj = 0; bj < 2; ++bj)
#pragma unroll
                for (int n = 0; n < 2; ++n)
#pragma unroll
                    for (int e = 0; e < 4; ++e) { const float p = __expf(acc[ai][bj][m][n][e] - mx); acc[ai][bj][m][n][e] = p; s += p; }
            s += __shfl_xor(s, 16); s += __shfl_xor(s, 32);
            if (fq == 0) Y[r * 4 + wc] = s; }
        asm volatile("s_waitcnt lgkmcnt(0)" ::: "memory"); __builtin_amdgcn_s_barrier(); asm volatile("" ::: "memory");
        ROWLOOP { const int r = ai * 128 + wr * 64 + m * 16 + fr; const f32x4 ys = *(const LAS f32x4*)(Y + r * 4); const float inv = 1.0f / ((ys[0] + ys[1]) + (ys[2] + ys[3]));
#pragma unroll
            for (int bj = 0; bj < 2; ++bj) *(u32x4*)(P + (size_t)(u.z * SEQ + u.pm * 256 + r) * D + u.pn * 256 + bj * 128 + wc * 32 + 8 * fq) = pack8(acc[ai][bj][m][0] * inv, acc[ai][bj][m][1] * inv); }
    }
};
struct EpiFfn1 {
    const u64* ss; bf16_t* HM;
    __device__ __forceinline__ void operator()(EPI_ARGS) const {
        const int row0 = u.pm * 256 + wr * 64 + fr, col0 = u.pn * 128 + wc * 32 + 8 * fq;
        LOAD_RS8(rs8, ss, row0);
        ROWLOOP { const int row = row0 + ai * 128 + m * 16; const float rs = rs8[ai][m]; f32x4 h0, h1;
#pragma unroll
            for (int e = 0; e < 4; ++e) { h0[e] = silu_f(acc[ai][0][m][0][e] * rs) * (acc[ai][1][m][0][e] * rs); h1[e] = silu_f(acc[ai][0][m][1][e] * rs) * (acc[ai][1][m][1][e] * rs); }
            *(u32x4*)(HM + (size_t)row * FH + col0) = pack8(h0, h1); }
    }
};
struct EpiOin {
    const u64* ss; bf16_t* AC;
    __device__ __forceinline__ void operator()(EPI_ARGS) const {
        const int row0 = u.pm * 256 + wr * 64 + fr;
        LOAD_RS8(rs8, ss, row0);
        ROWLOOP { const int row = row0 + ai * 128 + m * 16; const float rs = rs8[ai][m];
#pragma unroll
            for (int bj = 0; bj < 2; ++bj) { const int col = u.pn * 256 + bj * 128 + wc * 32 + 8 * fq;
                *(u32x4*)(AC + (size_t)(col >> 4) * NCH * AK + (size_t)(row / SL) * AK + (row % SL) * 16 + (col & 8)) = pack8(acc[ai][bj][m][0] * rs, acc[ai][bj][m][1] * rs); } }
    }
};
struct EpiS5State {
    float* XL;
    __device__ __forceinline__ void operator()(EPI_ARGS) const {
        const int row0 = u.pm * 256 + wr * 64 + fr, col0 = wc * 32 + 8 * fq;
        ROWLOOP { const int row = row0 + ai * 128 + m * 16; float* p = XL + (size_t)u.z * NCH * 128 + (size_t)row * 128 + col0;
            *(f32x4*)p = acc[ai][0][m][0]; *(f32x4*)(p + 4) = acc[ai][0][m][1]; }
    }
};
struct EpiS5Out {
    const bf16_t* AC; const float* dsk; bf16_t* Y;
    __device__ __forceinline__ void operator()(EPI_ARGS) const {
        const int g = u.z, row0 = u.pm * 256 + wr * 64 + fr;
        f32x4 dv[2][2];
#pragma unroll
        for (int bj = 0; bj < 2; ++bj) { const int ch = g * 16 + ((u.pn * 256 + bj * 128 + wc * 32 + 8 * fq) & 8); dv[bj][0] = *(const f32x4*)(dsk + ch); dv[bj][1] = *(const f32x4*)(dsk + ch + 4); }
#pragma unroll
        for (int ai = 0; ai < 2; ++ai) {
            u32x4 pre[4][2];
#pragma unroll
            for (int m = 0; m < 4; ++m)
#pragma unroll
                for (int bj = 0; bj < 2; ++bj) pre[m][bj] = *(const u32x4*)(AC + (size_t)g * NCH * AK + (size_t)(row0 + ai * 128 + m * 16) * AK + u.pn * 256 + bj * 128 + wc * 32 + 8 * fq);
#pragma unroll
            for (int m = 0; m < 4; ++m) for (int once_ = efence(); once_; once_ = 0) { const int row = row0 + ai * 128 + m * 16;
#pragma unroll
                for (int bj = 0; bj < 2; ++bj) { const int col = u.pn * 256 + bj * 128 + wc * 32 + 8 * fq, k = col >> 4, ch = g * 16 + (col & 8);
                    f32x4 u0, u1; unpack8(pre[m][bj], u0, u1);
                    f32x4 y0 = acc[ai][bj][m][0] + dv[bj][0] * u0, y1 = acc[ai][bj][m][1] + dv[bj][1] * u1;
#pragma unroll
                    for (int e = 0; e < 4; ++e) { y0[e] = gelu_f(y0[e]); y1[e] = gelu_f(y1[e]); }
                    *(u32x4*)(Y + (size_t)(row * SL + k) * 512 + ch) = pack8(y0, y1); } }
        }
    }
};
}

#define XB_TMO      128
#define XB_XCNT(j)  (256  + 64 * (j))
#define XB_XSUB(j)  (1280 + 64 * (j))
#define XB_XGEN(j)  (2304 + 64 * (j))
#define XB_TOP      3328
#define XB_TOPGEN   3392
#define XCD_BAR_WORDS 3456
#define XB_SPIN_CAP (1u << 22)
__device__ __forceinline__ unsigned xb_ld(unsigned* p)              { return __hip_atomic_load(p, __ATOMIC_RELAXED, __HIP_MEMORY_SCOPE_AGENT); }
__device__ __forceinline__ unsigned xb_add(unsigned* p, unsigned v) { return __hip_atomic_fetch_add(p, v, __ATOMIC_RELAXED, __HIP_MEMORY_SCOPE_AGENT); }
__device__ __forceinline__ unsigned xb_xcc_id() { return (unsigned)__builtin_amdgcn_s_getreg((3 << 11) | 20) & 0xFu; }
#define XB_SPIN(cond, bar) do { unsigned _sp = 0; while (cond) { __builtin_amdgcn_s_sleep(1); \
    if ((++_sp & 255u) == 0u) { if (xb_ld(&(bar)[XB_TMO])) break; if (_sp > XB_SPIN_CAP) { atomicAdd(&(bar)[XB_TMO], 1u); break; } } } } while (0)
struct XcdBarrier { unsigned* bar; unsigned x; volatile LAS unsigned* st; };
__device__ __forceinline__ XcdBarrier xcd_barrier_post(unsigned* bar, volatile LAS unsigned* st) {
    XcdBarrier b; b.bar = bar; b.x = xb_xcc_id(); b.st = st;
    if (threadIdx.x == 0) (void)xb_add(&bar[XB_XCNT(b.x)], 1u);
    return b;
}
__device__ __forceinline__ void xcd_barrier_complete(unsigned* bar, unsigned x, unsigned& nloc, unsigned& nx) {
    const unsigned G = gridDim.x * gridDim.y * gridDim.z;
    unsigned sum, cnt, mine, sp = 0u;
    for (;;) {
        sum = 0u; cnt = 0u; mine = 0u;
#pragma unroll
        for (unsigned j = 0; j < 16; ++j) { const unsigned c = xb_ld(&bar[XB_XCNT(j)]); sum += c; cnt += (c > 0u) ? 1u : 0u; mine = (j == x) ? c : mine; }
        if (sum == G) break;
        __builtin_amdgcn_s_sleep(1);
        if ((++sp & 255u) == 0u) { if (xb_ld(&bar[XB_TMO])) break; if (sp > XB_SPIN_CAP) { atomicAdd(&bar[XB_TMO], 1u); break; } }
    }
    nloc = mine > 0u ? mine : 1u; nx = cnt > 0u ? cnt : 1u;
}
__device__ __forceinline__ void xcd_barrier(const XcdBarrier& b) {
    asm volatile("s_waitcnt vmcnt(0)" ::: "memory");
    __syncthreads();
    if (threadIdx.x == 0) {
        unsigned* bar = b.bar;
        __builtin_amdgcn_s_waitcnt(0);
        unsigned nloc = b.st[0], nx = b.st[1];
        if (nloc == 0u) { xcd_barrier_complete(bar, b.x, nloc, nx); b.st[0] = nloc; b.st[1] = nx; }
        const unsigned old = xb_add(&bar[XB_XSUB(b.x)], 1u);
        const unsigned gen = old / nloc;
        if (old + 1u == (gen + 1u) * nloc) {
            __builtin_amdgcn_fence(__ATOMIC_RELEASE, "agent");
            asm volatile("s_waitcnt vmcnt(0)" ::: "memory");
            const unsigned og = xb_add(&bar[XB_TOP], 1u);
            const unsigned tg = og / nx;
            if (og + 1u == (tg + 1u) * nx) xb_add(&bar[XB_TOPGEN], 1u);
            else XB_SPIN(xb_ld(&bar[XB_TOPGEN]) == tg, bar);
            __builtin_amdgcn_fence(__ATOMIC_ACQUIRE, "agent");
            xb_add(&bar[XB_XGEN(b.x)], 1u);
            asm volatile("s_waitcnt vmcnt(0)" ::: "memory");
        } else {
            XB_SPIN(xb_ld(&bar[XB_XGEN(b.x)]) == gen, bar);
            __builtin_amdgcn_fence(__ATOMIC_ACQUIRE, "agent");
            asm volatile("s_waitcnt vmcnt(0)" ::: "memory");
        }
    }
    __syncthreads();
}

struct ConvP { const float* W; bf16_t* WT; const float* gain; int K, ldn, cs, nblk, mode, roff, r; };
__device__ __forceinline__ void conv_load(const ConvP& p, f32x4 (&v)[32], int lane) {
    const int nkb = p.K / 64, kb = p.r % nkb, nb = p.r / nkb; const float* src = p.W + (size_t)(64 * kb + (lane >> 5)) * p.ldn + p.cs + 128 * nb + 4 * (lane & 31);
#pragma unroll
    for (int i = 0; i < 32; ++i) v[i] = *(const f32x4*)(src + (size_t)(2 * i) * p.ldn);
}
__device__ __forceinline__ void conv_store(const ConvP& p, const f32x4 (&v)[32], LAS float* scr, int lane) {
    const int nkb = p.K / 64, kb = p.r % nkb, nb = p.r / nkb, k0 = 64 * kb, c = lane & 7;
    f32x4 g0 = {1.f, 1.f, 1.f, 1.f}, g1 = g0;
    if (p.gain) { g0 = *(const f32x4*)(p.gain + k0 + 8 * c); g1 = *(const f32x4*)(p.gain + k0 + 8 * c + 4); }
#pragma unroll 1
    for (int sb = 0; sb < 4; ++sb) {
        if (((lane & 31) >> 3) == sb) {
#pragma unroll
            for (int i = 0; i < 32; ++i)
#pragma unroll
                for (int e = 0; e < 4; ++e) scr[(2 * i + (lane >> 5)) * 33 + 4 * (lane & 7) + e] = v[i][e]; }
        asm volatile("s_waitcnt lgkmcnt(0)" ::: "memory");
        const int c0 = 128 * nb + 32 * sb, drow = p.roff + (p.mode == 0 ? c0 : ((c0 >> 7) * 256 + (p.mode - 1) * 128 + (c0 & 127)));
#pragma unroll
        for (int j = 0; j < 4; ++j) { const int n = (lane >> 3) + 8 * j; const LAS float* s = scr + (8 * c) * 33 + n;
            u32x4 o; o.x = cvt_pk_bf16(s[0 * 33] * g0[0], s[1 * 33] * g0[1]); o.y = cvt_pk_bf16(s[2 * 33] * g0[2], s[3 * 33] * g0[3]); o.z = cvt_pk_bf16(s[4 * 33] * g1[0], s[5 * 33] * g1[1]); o.w = cvt_pk_bf16(s[6 * 33] * g1[2], s[7 * 33] * g1[3]);
            *(u32x4*)(p.WT + (size_t)(drow + n) * p.K + k0 + 8 * c) = o; }
        asm volatile("s_waitcnt lgkmcnt(0)" ::: "memory");
    }
}
template <bool NORM, int R> __device__ __forceinline__ void rows_to_bf16(const float* x0, bf16_t* o0, u64* ssq, int lane) {
    f32x4 v[R][4]; float s[R];
#pragma unroll
    for (int r = 0; r < R; ++r) { const f32x4* xr = (const f32x4*)(x0 + (size_t)r * D) + lane;
#pragma unroll
        for (int j = 0; j < 4; ++j) v[r][j] = xr[64 * j]; }
#pragma unroll
    for (int r = 0; r < R; ++r) { float a = 0.f;
#pragma unroll
        for (int j = 0; j < 4; ++j) a += (v[r][j][0] * v[r][j][0] + v[r][j][1] * v[r][j][1]) + (v[r][j][2] * v[r][j][2] + v[r][j][3] * v[r][j][3]);
        s[r] = wave_sum(a); }
#pragma unroll
    for (int r = 0; r < R; ++r) { const float rs = NORM ? rsqrtf(s[r] * (1.0f / D) + EPS) : 1.0f; u32x2* o = (u32x2*)(o0 + (size_t)r * D) + lane;
#pragma unroll
        for (int j = 0; j < 4; ++j) { u32x2 w; w.x = cvt_pk_bf16(v[r][j][0] * rs, v[r][j][1] * rs); w.y = cvt_pk_bf16(v[r][j][2] * rs, v[r][j][3] * rs); o[64 * j] = w; }
        if (ssq && lane == 0) ssq[r] = (u64)(long long)(s[r] * 16777216.0f); }
}
__device__ __forceinline__ void cis_f(float ang, float& c, float& s) {
    float rev = ang * 0.15915494309189535f; rev = rev - rintf(rev);
    const float x = rev * 6.283185307179586f;
    const float h = x * 0.25f, h2 = h * h;
    float sh = h * (1.0f + h2 * (-1.6666667e-1f + h2 * (8.3333333e-3f + h2 * (-1.9841270e-4f + h2 * 2.7557319e-6f))));
    float ch = 1.0f + h2 * (-0.5f + h2 * (4.1666667e-2f + h2 * (-1.3888889e-3f + h2 * (2.4801587e-5f + h2 * -2.7557319e-7f))));
    float s2 = 2.f * sh * ch, c2 = 1.f - 2.f * sh * sh;
    s = 2.f * s2 * c2; c = 1.f - 2.f * s2 * s2;
}
__device__ __forceinline__ void s5_setup(int g, LAS unsigned char* lds, const float* lam_re, const float* lam_im, const float* log_dt, const float* b_re, const float* b_im, const float* c_re, const float* c_im,
                                         bf16_t* BT3, bf16_t* GM, float* AL, int tid) {
    LAS float* pwr = (LAS float*)lds; LAS float* pwi = pwr + 33 * 64; LAS float* Bbr = pwi + 33 * 64; LAS float* Bbi = Bbr + 1024; LAS float* Cr = Bbi + 1024; LAS float* Ci = Cr + 1024; LAS float* Kd = Ci + 1024;
    const float dt = __expf(log_dt[g]);
    for (int idx = tid; idx < 33 * 64; idx += 512) { const int d = idx >> 6, p = idx & 63; const float lr = lam_re[g * 64 + p], li = lam_im[g * 64 + p];
        const float mag = __expf(lr * dt * (float)d); float c, s; cis_f(li * dt * (float)d, c, s); pwr[idx] = mag * c; pwi[idx] = mag * s; }
    for (int idx = tid; idx < 1024; idx += 512) { const int p = idx >> 4; const float lr = lam_re[g * 64 + p], li = lam_im[g * 64 + p];
        const float mag = __expf(lr * dt); float c, s; cis_f(li * dt, c, s); const float ar = mag * c, ai = mag * s, den = lr * lr + li * li;
        const float qr = ((ar - 1.0f) * lr + ai * li) / den, qi = (ai * lr - (ar - 1.0f) * li) / den;
        const float br = b_re[g * 1024 + idx], bi = b_im[g * 1024 + idx];
        Bbr[idx] = qr * br - qi * bi; Bbi[idx] = qr * bi + qi * br;
        Cr[idx] = c_re[g * 1024 + idx]; Ci[idx] = c_im[g * 1024 + idx]; }
    __syncthreads();
    for (int idx = tid; idx < 32 * 256; idx += 512) { const int d = idx >> 8, co = (idx >> 4) & 15, ci = idx & 15; float a = 0.f;
        for (int p = 0; p < 64; ++p) { const float cr = Cr[co * 64 + p], cim = Ci[co * 64 + p], pr = pwr[d * 64 + p], pi = pwi[d * 64 + p];
            const float tr = cr * pr - cim * pi, ti = cr * pi + cim * pr; a += tr * Bbr[p * 16 + ci] - ti * Bbi[p * 16 + ci]; }
        Kd[idx] = a; }
    __syncthreads();
    bf16_t* bt = BT3 + (size_t)g * 512 * AK;
    for (int idx = tid; idx < 512 * (AK / 8); idx += 512) { const int n = idx / (AK / 8), q = idx % (AK / 8), kk0 = q * 8, k = n >> 4, co = n & 15; float v[8];
        if (kk0 < 512) { const int j = kk0 >> 4, ci0 = kk0 & 15;
#pragma unroll
            for (int e = 0; e < 8; ++e) v[e] = (j <= k) ? Kd[(k - j) * 256 + co * 16 + ci0 + e] : 0.f;
        } else { const int p0 = kk0 - 512;
#pragma unroll
            for (int e = 0; e < 8; ++e) { const int p = (p0 & 63) + e; const float cr = Cr[co * 64 + p], cim = Ci[co * 64 + p], pr = pwr[(k + 1) * 64 + p], pi = pwi[(k + 1) * 64 + p];
                v[e] = (p0 < 64) ? (cr * pr - cim * pi) : -(cr * pi + cim * pr); } }
        u32x4 w; w.x = cvt_pk_bf16(v[0], v[1]); w.y = cvt_pk_bf16(v[2], v[3]); w.z = cvt_pk_bf16(v[4], v[5]); w.w = cvt_pk_bf16(v[6], v[7]);
        *(u32x4*)(bt + (size_t)n * AK + kk0) = w; }
    bf16_t* gm = GM + (size_t)g * 256 * 512;
    for (int idx = tid; idx < 256 * 64; idx += 512) { const int n = idx >> 6, q = idx & 63, kk0 = q * 8; float v[8];
        if (n < 128) { const int p = n & 63, j = kk0 >> 4, ci0 = kk0 & 15; const float pr = pwr[(SL - 1 - j) * 64 + p], pi = pwi[(SL - 1 - j) * 64 + p];
#pragma unroll
            for (int e = 0; e < 8; ++e) { const float br = Bbr[p * 16 + ci0 + e], bi = Bbi[p * 16 + ci0 + e]; v[e] = (n < 64) ? (pr * br - pi * bi) : (pr * bi + pi * br); }
        } else {
#pragma unroll
            for (int e = 0; e < 8; ++e) v[e] = 0.f; }
        u32x4 w; w.x = cvt_pk_bf16(v[0], v[1]); w.y = cvt_pk_bf16(v[2], v[3]); w.z = cvt_pk_bf16(v[4], v[5]); w.w = cvt_pk_bf16(v[6], v[7]);
        *(u32x4*)(gm + (size_t)n * 512 + kk0) = w; }
    if (tid < 64) { AL[(g * 64 + tid) * 2] = pwr[SL * 64 + tid]; AL[(g * 64 + tid) * 2 + 1] = pwi[SL * 64 + tid]; }
    __syncthreads();
}

__device__ __forceinline__ void gmlp_unit(int unit, LAS unsigned char* lds, const bf16_t* U, const bf16_t* V, const u64* vst, const bf16_t* GW, const float* gb, bf16_t* MIX, int tid) {
    const int g = unit & 3, t0 = (unit >> 2) * 128, lane = tid & 63, wid = tid >> 6;
    LAS bf16_t* vT = (LAS bf16_t*)lds;
    const int il = lane & 15, kq = lane >> 4, i = wid * 16 + il;
    u32x4 raw[4]; u64 st[4][2];
#pragma unroll
    for (int e = 0; e < 4; ++e) { const int q = tid + 512 * e, j = q >> 4, c8 = (q & 15) * 8;
        raw[e] = *(const u32x4*)(V + (size_t)(t0 + j) * 512 + g * 128 + c8); st[e][0] = vst[2 * (t0 + j)]; st[e][1] = vst[2 * (t0 + j) + 1]; }
    bf16x8 wf[4];
#pragma unroll
    for (int ks = 0; ks < 4; ++ks) wf[ks] = *(const bf16x8*)(GW + (size_t)g * 16384 + (size_t)i * 128 + ks * 32 + kq * 8);
    const float bias = gb[g * 128 + i];
    const size_t tok = (size_t)(t0 + i);
    u32x2 uu[8];
#pragma unroll
    for (int nt = 0; nt < 8; ++nt) uu[nt] = *(const u32x2*)(U + tok * 512 + g * 128 + nt * 16 + kq * 4);
#pragma unroll
    for (int e = 0; e < 4; ++e) { const int q = tid + 512 * e, j = q >> 4, c8 = (q & 15) * 8;
        const float s = (float)(long long)st[e][0] * (1.0f / 16777216.0f), ss = (float)(long long)st[e][1] * (1.0f / 16777216.0f), mean = s * (1.0f / 512.0f), var = ss * (1.0f / 512.0f) - mean * mean, rstd = rsqrtf(fmaxf(var, 0.f) + EPS);
        const float v[8] = {bflo(raw[e].x), bfhi(raw[e].x), bflo(raw[e].y), bfhi(raw[e].y), bflo(raw[e].z), bfhi(raw[e].z), bflo(raw[e].w), bfhi(raw[e].w)};
        const int jo = ((((j >> 3) ^ (c8 >> 3)) & 15) << 3) + (j & 7);
#pragma unroll
        for (int k = 0; k < 8; k += 2) { const unsigned pk = cvt_pk_bf16((v[k] - mean) * rstd, (v[k + 1] - mean) * rstd); vT[(c8 + k) * 136 + jo] = (bf16_t)(pk & 0xffffu); vT[(c8 + k + 1) * 136 + jo] = (bf16_t)(pk >> 16); } }
    __syncthreads();
#pragma unroll 2
    for (int nt = 0; nt < 8; ++nt) { f32x4 a = {0.f, 0.f, 0.f, 0.f}; const int c = nt * 16 + il;
#pragma unroll
        for (int ks = 0; ks < 4; ++ks) { const bf16x8 vf = *(const LAS bf16x8*)(vT + c * 136 + ((((ks * 4 + kq) ^ (c >> 3)) & 15) << 3)); a = __builtin_amdgcn_mfma_f32_16x16x32_bf16(vf, wf[ks], a, 0, 0, 0); }
        u32x2 o; o.x = cvt_pk_bf16(bflo(uu[nt].x) * (a[0] + bias), bfhi(uu[nt].x) * (a[1] + bias)); o.y = cvt_pk_bf16(bflo(uu[nt].y) * (a[2] + bias), bfhi(uu[nt].y) * (a[3] + bias));
        *(u32x2*)(MIX + tok * 1024 + g * 128 + nt * 16 + kq * 4) = o; }
    __syncthreads();
}
__device__ __forceinline__ void conv_units(int first, int stride, int nunits, LAS unsigned char* lds, const bf16_t* H, const float* cw, const float* cb, const float* lng, const float* lnb, bf16_t* MIX, int tid) {
    if (first >= nunits) return;
    const int lane = tid & 63, wid = tid >> 6;
    LAS bf16_t* hin = (LAS bf16_t*)lds;
    LAS float* cout = (LAS float*)(lds + 62 * 1024);
    float w[31];
#pragma unroll
    for (int k = 0; k < 31; ++k) w[k] = cw[k * 512 + tid];
    const float bias = cb[tid];
    const f32x4 g0 = *(const f32x4*)(lng + lane * 8), g1 = *(const f32x4*)(lng + lane * 8 + 4), b0 = *(const f32x4*)(lnb + lane * 8), b1 = *(const f32x4*)(lnb + lane * 8 + 4);
    u32x4 pre[8];
#define CONV_PREFETCH(unit_) { const int t0_ = (unit_) * 32, s0_ = t0_ % SEQ; _Pragma("unroll") for (int e = 0; e < 8; ++e) { const int q = tid + 512 * e, r = q >> 6, c8 = (q & 63) * 8; \
        u32x4 v_ = {0u, 0u, 0u, 0u}; if (q < 62 * 64 && s0_ - 30 + r >= 0) v_ = *(const u32x4*)(H + (size_t)(t0_ - 30 + r) * 512 + c8); pre[e] = v_; } }
    CONV_PREFETCH(first);
#pragma unroll 1
    for (int unit = first; unit < nunits; unit += stride) {
        const int t0 = unit * 32;
#pragma unroll
        for (int e = 0; e < 8; ++e) { const int q = tid + 512 * e; if (q < 62 * 64) *(LAS u32x4*)(hin + (q >> 6) * 512 + (q & 63) * 8) = pre[e]; }
        if (unit + stride < nunits) CONV_PREFETCH(unit + stride);
        __syncthreads();
#pragma unroll 1
        for (int tg = 0; tg < 4; ++tg) { float x[38];
#pragma unroll
            for (int r = 0; r < 38; ++r) x[r] = bf2f(hin[(tg * 8 + r) * 512 + tid]);
#pragma unroll
            for (int o = 0; o < 8; ++o) { float a = bias;
#pragma unroll
                for (int k = 0; k < 31; ++k) a += w[k] * x[o + k];
                cout[(tg * 8 + o) * 516 + tid] = a; } }
        __syncthreads();
#pragma unroll 1
        for (int tt = 0; tt < 4; ++tt) { const int row = wid * 4 + tt; const f32x4 v0 = *(const LAS f32x4*)(cout + row * 516 + lane * 8), v1 = *(const LAS f32x4*)(cout + row * 516 + lane * 8 + 4);
            const float mean = wave_sum((v0[0] + v0[1]) + (v0[2] + v0[3]) + (v1[0] + v1[1]) + (v1[2] + v1[3])) * (1.0f / 512.0f);
            const f32x4 d0 = v0 - mean, d1 = v1 - mean;
            const float var = wave_sum((d0[0] * d0[0] + d0[1] * d0[1]) + (d0[2] * d0[2] + d0[3] * d0[3]) + (d1[0] * d1[0] + d1[1] * d1[1]) + (d1[2] * d1[2] + d1[3] * d1[3])) * (1.0f / 512.0f);
            const float rstd = rsqrtf(var + EPS);
            f32x4 y0 = d0 * rstd * g0 + b0, y1 = d1 * rstd * g1 + b1;
#pragma unroll
            for (int e = 0; e < 4; ++e) { y0[e] = silu_f(y0[e]); y1[e] = silu_f(y1[e]); }
            *(u32x4*)(MIX + (size_t)(t0 + row) * 1024 + 512 + lane * 8) = pack8(y0, y1); }
    }
    __syncthreads();
#undef CONV_PREFETCH
}

struct Args { const float* in[33]; float* out; unsigned char* ws; int ph_lo, ph_hi; };
constexpr int NPHASE = 28;

typedef const __attribute__((address_space(4))) Args* KArgP;
__device__ __forceinline__ KArgP fresh_args() { KArgP p = (KArgP)__builtin_amdgcn_kernarg_segment_ptr(); asm volatile("" : "+s"(p)); return p; }

__global__ void __launch_bounds__(512, 2) trunk_fwd(Args args_unused) {
    extern __shared__ __attribute__((aligned(16))) unsigned char lds_raw[];
    LAS unsigned char* lds = (LAS unsigned char*)lds_raw;
    cg::grid_group grid = cg::this_grid();
    { volatile LAS unsigned* MISC0 = (volatile LAS unsigned*)(lds + MISC_OFF); if (threadIdx.x < 32) MISC0[threadIdx.x] = 0u; }
    __syncthreads();
    int lo, hi;
    { KArgP ap = fresh_args(); lo = ap->ph_lo; hi = ap->ph_hi; }
#if !MK_MULTI && !MK_CGSYNC
    { KArgP ap = fresh_args(); (void)xcd_barrier_post((unsigned*)(ap->ws + WS_BAR), (volatile LAS unsigned*)(lds + MISC_OFF) + 8); }
#endif
    int nsync = 0;
#if MK_MULTI
#define SEAM(k) do { } while (0)
#elif MK_CGSYNC
#define SEAM(k) do { if (rep_ + 1 == nrep_ && (k) + 1 < hi) grid.sync(); } while (0)
#else
#define SEAM(k) do { if (rep_ + 1 == nrep_ && (k) + 1 < hi) { if (hi > 1000) grid.sync(); else { KArgP ap_ = fresh_args(); XcdBarrier xb_; xb_.bar = (unsigned*)(ap_->ws + WS_BAR); xb_.x = xb_xcc_id(); xb_.st = (volatile LAS unsigned*)(lds + MISC_OFF) + 8; xcd_barrier(xb_); if (BARPROBE) xcd_barrier(xb_); } ++nsync; } } while (0)
#endif
#ifndef ONLY
#define ONLY -1
#endif
#ifndef REPMASK
#define REPMASK 0
#endif
#define PHASE(id, k) if ((ONLY < 0 || ONLY == (id)) && lo <= (k) && (k) < hi) for (int rep_ = 0, nrep_ = (((REPMASK) >> (id)) & 1) ? 2 : 1; rep_ < nrep_; ++rep_)
    (void)nsync;
#define LOCALS KArgP ap = fresh_args(); unsigned char* ws = ap->ws; float* out = ap->out; const float* x_in = ap->in[0]; \
    int tid_ = threadIdx.x, G_ = gridDim.x, bx_ = blockIdx.x; asm volatile("" : "+v"(tid_), "+s"(G_), "+s"(bx_)); \
    const int tid = tid_, lane = tid & 63, wave = __builtin_amdgcn_readfirstlane(tid >> 6), G = G_, bx = bx_, gw = bx * 8 + wave, NGW = G * 8; \
    bf16_t* XB = (bf16_t*)(ws + WS_XB); u64* SS = (u64*)(ws + WS_SS); u64* VST = (u64*)(ws + WS_VST); bf16_t* QO = (bf16_t*)(ws + WS_QO); \
    bf16_t* HM = (bf16_t*)(ws + WS_HM); bf16_t* MEMN = (bf16_t*)(ws + WS_MEMN); bf16_t* KL = (bf16_t*)(ws + WS_KL); bf16_t* VL = (bf16_t*)(ws + WS_VL); \
    bf16_t* U = (bf16_t*)(ws + WS_U); bf16_t* V = (bf16_t*)(ws + WS_V); bf16_t* H = (bf16_t*)(ws + WS_H); bf16_t* MIX = (bf16_t*)(ws + WS_MIX); \
    bf16_t* AC = (bf16_t*)(ws + WS_ACOMB); float* XL = (float*)(ws + WS_XLOC); bf16_t* Y = (bf16_t*)(ws + WS_Y); u64* SSa = SS + (size_t)(3 * l) * T; \
    (void)out; (void)x_in; (void)lane; (void)gw; (void)NGW; (void)XB; (void)VST; (void)QO; (void)HM; (void)MEMN; (void)KL; (void)VL; (void)U; (void)V; (void)H; (void)MIX; (void)AC; (void)XL; (void)Y; (void)SSa; (void)wave;

    PHASE(0, 0) { const int l = 0; LOCALS
        { f32x4* z = (f32x4*)(SS + T); const int n4 = 7 * T * 2 / 4; for (int i = bx * 512 + tid; i < n4; i += G * 512) z[i] = (f32x4){0.f, 0.f, 0.f, 0.f};
          f32x4* z2 = (f32x4*)VST; const int m4 = 2 * T * 2 / 4; for (int i = bx * 512 + tid; i < m4; i += G * 512) z2[i] = (f32x4){0.f, 0.f, 0.f, 0.f}; }
        LAS float* scr = (LAS float*)(lds + wave * 16384);
#define CONVJOB(Wp, K_, ldn_, cs_, nc_, WTp, mode_, roff_, gain_) { const int nblk_ = (nc_) / 128, cnt_ = ((K_) / 64) * nblk_; \
            if (r >= 0 && r < cnt_) { cp.W = (Wp); cp.WT = (bf16_t*)(WTp); cp.gain = (gain_); cp.K = (K_); cp.ldn = (ldn_); cp.cs = (cs_); cp.nblk = nblk_; cp.mode = (mode_); cp.roff = (roff_); cp.r = r; } r -= cnt_; }
#define CONVLOOKUP(cp, it_) { int r = (it_); \
            CONVJOB(ap->in[3], 1024, 2048, 0, 1024, ws + WS_WIN0, 0, 0, ap->in[2]); \
            CONVJOB(ap->in[3], 1024, 2048, 1024, 512, ws + WS_WIN0, 1, 1024, ap->in[2]); \
            CONVJOB(ap->in[3], 1024, 2048, 1536, 512, ws + WS_WIN0, 2, 1024, ap->in[2]); \
            CONVJOB(ap->in[10], 1024, 1024, 0, 1024, ws + WS_WOUT0, 0, 0, nullptr); \
            CONVJOB(ap->in[12], 1024, 512, 0, 512, ws + WS_WOIN, 0, 0, ap->in[11]); \
            CONVJOB(ap->in[21], 512, 2048, 0, 1024, ws + WS_WOOUT, 1, 0, nullptr); \
            CONVJOB(ap->in[21], 512, 2048, 1024, 1024, ws + WS_WOOUT, 2, 0, nullptr); \
            _Pragma("unroll") for (int l2 = 0; l2 < 2; ++l2) { \
                CONVJOB(ap->in[25] + (size_t)l2 * D * D, 1024, 1024, 0, 1024, ws + WS_WK + l2 * WSQ_L, 0, 0, ap->in[23] + l2 * D); \
                CONVJOB(ap->in[26] + (size_t)l2 * D * D, 1024, 1024, 0, 1024, ws + WS_WV + l2 * WSQ_L, 0, 0, ap->in[23] + l2 * D); \
                CONVJOB(ap->in[27] + (size_t)l2 * D * D, 1024, 1024, 0, 1024, ws + WS_WO + l2 * WSQ_L, 0, 0, nullptr); \
                CONVJOB(ap->in[29] + (size_t)l2 * D * FH, 1024, FH, 0, FH, ws + WS_WGU + l2 * WGU_L, 1, 0, ap->in[28] + l2 * D); \
                CONVJOB(ap->in[30] + (size_t)l2 * D * FH, 1024, FH, 0, FH, ws + WS_WGU + l2 * WGU_L, 2, 0, ap->in[28] + l2 * D); \
                CONVJOB(ap->in[31] + (size_t)l2 * FH * D, FH, 1024, 0, 1024, ws + WS_WD + l2 * WD_L, 0, 0, nullptr); } }
        constexpr int NITEMS = (512 + 256 + 256 + 512 + 256 + 256 + 256 + 2 * (3 * 512 + 3 * 1408)) / 4;
        for (int it = gw; it < NITEMS; it += NGW) { ConvP c0{}; f32x4 v0[32]; { ConvP cp{}; CONVLOOKUP(cp, it); c0 = cp; } conv_load(c0, v0, lane); conv_store(c0, v0, scr, lane); }
        { const int nb5 = (G > 64) ? G - 32 : G;
          if (bx < nb5) { const int NW5 = nb5 * 8;
              for (int m = gw * 4; m < T; m += NW5 * 4) rows_to_bf16<false, 4>(x_in + (size_t)m * D, XB + (size_t)m * D, SS + m, lane);
              for (int m = gw * 4; m < MT; m += NW5 * 4) rows_to_bf16<true, 4>(ap->in[1] + (size_t)m * D, MEMN + (size_t)m * D, nullptr, lane); } }
        for (int i = bx * 512 + tid; i < 2 * D * D / 8; i += G * 512) { const int l2 = i / (D * D / 8), e = (i % (D * D / 8)) * 8, k = e >> 10; const float gk = ap->in[22][l2 * D + k];
            const f32x4 a = *(const f32x4*)(ap->in[24] + (size_t)l2 * D * D + e), b = *(const f32x4*)(ap->in[24] + (size_t)l2 * D * D + e + 4);
            *(u32x4*)((bf16_t*)(ws + WS_WQ) + (size_t)l2 * D * D + e) = pack8(a * gk, b * gk); }
        { bf16_t* GW = (bf16_t*)(ws + WS_GW); const float* w = ap->in[4];
          for (int i = bx * 512 + tid; i < 4 * 128 * 128 / 2; i += G * 512) { const int e = 2 * i, ii = (e >> 7) & 127, jj = e & 127; const bool keep = (jj >> 6) <= (ii >> 6);
              ((unsigned*)GW)[i] = keep ? cvt_pk_bf16(w[e], w[e + 1]) : 0u; } }
        __syncthreads();
        for (int g = G - 1 - bx; g < 32; g += G)
            s5_setup(g, lds, ap->in[13], ap->in[14], ap->in[15], ap->in[16], ap->in[17], ap->in[18], ap->in[19], (bf16_t*)(ws + WS_BT3), (bf16_t*)(ws + WS_GM), (float*)(ws + WS_AL), tid);
        SEAM(0);
    }
#pragma unroll 1
    for (int l = 0; l < 2; ++l) {
        const int pb = 3 + 12 * l;
        if (l == 0) {
            PHASE(2, pb + 0) { LOCALS
                pg8::Gemm g{XB, (const bf16_t*)(ws + WS_WIN0), D, D, D, 1, 0, 0, 0, 0}; pg8::Sched S; S.init(T / 256, 2048 / 256, 1, G, bx);
                { pg8::EpiIn0 E{SSa, U, V, H, VST}; pg8::gemm_phase<MK_ALIGN>(lds, g, S, E, tid); }
                { pg8::Gemm g{MEMN, (const bf16_t*)(ws + WS_WK), D, D, D, 2, 0, 0, (long)D * D, 0}; pg8::Sched S; S.init(MT / 256, D / 256, 2, G, bx);
                  pg8::EpiStore E{KL, D, 2, (long)MT * D, 0, nullptr, 1.0f}; pg8::gemm_phase<MK_ALIGN>(lds, g, S, E, tid); }
                { pg8::Gemm g{MEMN, (const bf16_t*)(ws + WS_WV), D, D, D, 2, 0, 0, (long)D * D, 0}; pg8::Sched S; S.init(MT / 256, D / 256, 2, G, (bx + G / 2) % G);
                  pg8::EpiStore E{VL, D, 2, (long)MT * D, 0, nullptr, 1.0f}; pg8::gemm_phase<MK_ALIGN>(lds, g, S, E, tid); }
                SEAM(pb + 0);
            }
            PHASE(3, pb + 1) { LOCALS
                for (int i = bx; i < 1024; i += G) gmlp_unit(i, lds, U, V, VST, (const bf16_t*)(ws + WS_GW), ap->in[5], MIX, tid);
                conv_units(bx, G, 1024, lds, H, ap->in[6], ap->in[7], ap->in[8], ap->in[9], MIX, tid);
#pragma unroll 1
                for (int l2 = 0; l2 < 2; ++l2) {
                    { pg8::Gemm g{KL + (size_t)l2 * MT * D, (const bf16_t*)(ws + WS_WQ) + (size_t)l2 * D * D, D, D, 256, 4, 256, 256L * D, 256, 0}; pg8::Sched S; S.init(1, 4, 32, G, bx);
                      pg8::EpiStore E{(bf16_t*)(ws + WS_WQK) + (size_t)l2 * 8 * D * D, D, 4, 256L * D, (long)D * D, nullptr, 1.0f}; pg8::gemm_phase<MK_ALIGN>(lds, g, S, E, tid); }
                    { pg8::Gemm g{(const bf16_t*)(ws + WS_WO) + (size_t)l2 * D * D, VL + (size_t)l2 * MT * D, D, D, 256, 4, 256, 0, 256, 256L * D}; pg8::Sched S; S.init(4, 1, 32, G, (bx + G / 2) % G);
                      pg8::EpiStore E{(bf16_t*)(ws + WS_WVO) + (size_t)l2 * 8 * D * D, D, 4, 256, (long)D * D, nullptr, 1.0f}; pg8::gemm_phase<MK_ALIGN>(lds, g, S, E, tid); }
                }
                SEAM(pb + 1);
            }
            PHASE(4, pb + 2) { LOCALS
                pg8::Gemm g{MIX, (const bf16_t*)(ws + WS_WOUT0), D, D, D, 1, 0, 0, 0, 0}; pg8::Sched S; S.init(T / 256, D / 256, 1, G, bx);
                pg8::EpiRes<false> E{XB, SSa + T, 0}; pg8::gemm_phase<MK_ALIGN>(lds, g, S, E, tid);
                SEAM(pb + 2);
            }
        } else {
            PHASE(5, pb + 0) { LOCALS
                pg8::Gemm g{XB, (const bf16_t*)(ws + WS_WOIN), D, D, D, 1, 0, 0, 0, 0}; pg8::Sched S; S.init(T / 256, 512 / 256, 1, G, bx);
                pg8::EpiOin E{SSa, AC}; pg8::gemm_phase<MK_ALIGN>(lds, g, S, E, tid);
                SEAM(pb + 0);
            }
            PHASE(6, pb + 1) { LOCALS
                pg8::Gemm g{AC, (const bf16_t*)(ws + WS_GM), AK, 512, 512, 32, (long)NCH * AK, 0, 256L * 512, 0}; pg8::Sched S; S.init(NCH / 256, 1, 32, G, bx);
                pg8::EpiS5State E{XL}; pg8::gemm_phase<MK_ALIGN>(lds, g, S, E, tid);
                SEAM(pb + 1);
            }
            PHASE(7, pb + 2) { LOCALS
                if (wave == 0) {
                    const int idx = bx * 64 + lane;
                    if (idx < NB * 32 * 64) { const int p = idx & 63, g = (idx >> 6) & 31, b = idx >> 11;
                        const float* AL = (const float*)(ws + WS_AL); const float ar = AL[(g * 64 + p) * 2], ai = AL[(g * 64 + p) * 2 + 1];
                        const float* xl = XL + (size_t)g * NCH * 128 + (size_t)(b * (SEQ / SL)) * 128; bf16_t* ac = AC + (size_t)g * NCH * AK + (size_t)(b * (SEQ / SL)) * AK + 512;
                        float xr = 0.f, xi = 0.f;
#pragma unroll 1
                        for (int c0 = 0; c0 < SEQ / SL; c0 += 32) { float lr[32], li[32];
#pragma unroll
                            for (int i = 0; i < 32; ++i) { lr[i] = xl[(size_t)(c0 + i) * 128 + p]; li[i] = xl[(size_t)(c0 + i) * 128 + 64 + p]; }
#pragma unroll
                            for (int i = 0; i < 32; ++i) { const unsigned pk = cvt_pk_bf16(xr, xi); ac[(size_t)(c0 + i) * AK + p] = (bf16_t)(pk & 0xffffu); ac[(size_t)(c0 + i) * AK + 64 + p] = (bf16_t)(pk >> 16);
                                const float nr = ar * xr - ai * xi + lr[i], ni = ar * xi + ai * xr + li[i]; xr = nr; xi = ni; } }
                    }
                }
                SEAM(pb + 2);
            }
            PHASE(8, pb + 3) { LOCALS
                pg8::Gemm g{AC, (const bf16_t*)(ws + WS_BT3), AK, AK, AK, 32, (long)NCH * AK, 0, 512L * AK, 0}; pg8::Sched S; S.init(NCH / 256, 2, 32, G, bx);
                pg8::EpiS5Out E{AC, ap->in[20], Y}; pg8::gemm_phase<MK_ALIGN>(lds, g, S, E, tid);
                SEAM(pb + 3);
            }
            PHASE(9, pb + 4) { LOCALS
                pg8::Gemm g{Y, (const bf16_t*)(ws + WS_WOOUT), 512, 512, 512, 1, 0, 0, 0, 0}; pg8::Sched S; S.init(T / 256, 2048 / 256, 1, G, bx);
                pg8::EpiRes<true> E{XB, SSa + T, 0}; pg8::gemm_phase<MK_ALIGN>(lds, g, S, E, tid);
                SEAM(pb + 4);
            }
        }
        PHASE(10, pb + 5) { LOCALS
            pg8::Gemm g{XB, (const bf16_t*)(ws + WS_WQK) + (size_t)l * 8 * D * D, D, D, D, 8, (long)SEQ * D, 0, (long)D * D, 0}; pg8::Sched S; S.init(SEQ / 256, D / 256, 8, G, bx);
            pg8::EpiSoftmax E{QO, SSa + T}; pg8::gemm_phase<true>(lds, g, S, E, tid);
            SEAM(pb + 5);
        }
        PHASE(13, pb + 6) { LOCALS
            pg8::Gemm g{QO, (const bf16_t*)(ws + WS_WVO) + (size_t)l * 8 * D * D, D, D, D, 8, (long)SEQ * D, 0, (long)D * D, 0}; pg8::Sched S; S.init(SEQ / 256, D / 256, 8, G, bx);
            pg8::EpiRes<false> E{XB, SSa + 2 * T, SEQ}; pg8::gemm_phase<MK_ALIGN>(lds, g, S, E, tid);
            SEAM(pb + 6);
        }
        PHASE(14, pb + 9) { LOCALS
            pg8::Gemm g{XB, (const bf16_t*)(ws + WS_WGU + l * WGU_L), D, D, D, 1, 0, 0, 0, 0}; pg8::Sched S; S.init(T / 256, 2 * FH / 256, 1, G, bx);
            pg8::EpiFfn1 E{SSa + 2 * T, HM}; pg8::gemm_phase<MK_ALIGN>(lds, g, S, E, tid);
            SEAM(pb + 9);
        }
        PHASE(15, pb + 10) { LOCALS
            pg8::Gemm g{HM, (const bf16_t*)(ws + WS_WD + l * WD_L), FH, FH, FH, 1, 0, 0, 0, 0}; pg8::Sched S; S.init(T / 256, D / 256, 1, G, bx);
            pg8::EpiRes<false> E{XB, SSa + 3 * T, 0}; pg8::gemm_phase<MK_ALIGN>(lds, g, S, E, tid);
            SEAM(pb + 10);
        }
    }
    PHASE(16, 27) { const int l = 0; LOCALS
        const u64* ssf = SS + (size_t)6 * T; const float* gf = ap->in[32];
        const f32x4 ga = *(const f32x4*)(gf + 8 * lane), gb = *(const f32x4*)(gf + 8 * lane + 4), gc = *(const f32x4*)(gf + 512 + 8 * lane), gd = *(const f32x4*)(gf + 512 + 8 * lane + 4);
        for (int m = gw * 4; m < T; m += NGW * 4) { u32x4 v[4][2]; float rs[4];
#pragma unroll
            for (int r = 0; r < 4; ++r) { rs[r] = rsqrtf(fx_get(ssf + m + r) * (1.0f / D) + EPS); const bf16_t* xr = XB + (size_t)(m + r) * D + 8 * lane; v[r][0] = *(const u32x4*)xr; v[r][1] = *(const u32x4*)(xr + 512); }
#pragma unroll
            for (int r = 0; r < 4; ++r) { float* orow = out + (size_t)(m + r) * D + 8 * lane; f32x4 a0, a1, b0, b1; pg8::unpack8(v[r][0], a0, a1); pg8::unpack8(v[r][1], b0, b1);
                *(f32x4*)orow = a0 * rs[r] * ga; *(f32x4*)(orow + 4) = a1 * rs[r] * gb; *(f32x4*)(orow + 512) = b0 * rs[r] * gc; *(f32x4*)(orow + 516) = b1 * rs[r] * gd; } }
    }
}

extern "C" void kernel_launch(void* const* d_in, const int* in_sizes, int n_in, void* d_out, int out_size, void* d_ws, size_t ws_size, hipStream_t stream) {
    static int grid = 0;
    if (grid == 0) {
        if (n_in != 33 || in_sizes[0] != T * D || out_size != T * D || ws_size < WS_END) { fprintf(stderr, "kernel_launch: unexpected shapes (n_in %d, in0 %d, out %d, ws %zu < %zu)\n", n_in, n_in > 0 ? in_sizes[0] : -1, out_size, ws_size, (size_t)WS_END); grid = -1; return; }
        int dev = 0, cus = 0, per_cu = 0;
        hipGetDevice(&dev); hipDeviceGetAttribute(&cus, hipDeviceAttributeMultiprocessorCount, dev);
        if (hipFuncSetAttribute((const void*)trunk_fwd, hipFuncAttributeMaxDynamicSharedMemorySize, LDS_BYTES) != hipSuccess) { fprintf(stderr, "kernel_launch: hipFuncSetAttribute failed\n"); grid = -1; return; }
        if (hipOccupancyMaxActiveBlocksPerMultiprocessor(&per_cu, (const void*)trunk_fwd, 512, LDS_BYTES) != hipSuccess || per_cu < 1) { fprintf(stderr, "kernel_launch: occupancy query says %d\n", per_cu); per_cu = 1; }
        (void)hipGetLastError();
        grid = cus * 1;
        if (grid <= 0) grid = 256;
    }
    if (grid < 0) return;
    Args a{};
    for (int i = 0; i < 33; ++i) a.in[i] = (const float*)d_in[i];
    a.out = (float*)d_out; a.ws = (unsigned char*)d_ws;
#if !MK_MULTI && !MK_CGSYNC
    (void)hipMemsetAsync((char*)d_ws + WS_BAR, 0, XCD_BAR_WORDS * 4, stream);
#endif
#if MK_MULTI
    for (int p = 0; p < NPHASE; ++p) {
        if (p == 1 || p == 2 || p == 6 || p == 7 || p == 10 || p == 11 || p == 14 || p == 22 || p == 23 || p == 26) continue;
        a.ph_lo = p; a.ph_hi = p + 1; void* kargs[] = {&a};
        hipError_t e = hipLaunchCooperativeKernel((const void*)trunk_fwd, dim3(grid), dim3(512), kargs, LDS_BYTES, stream);
        if (e != hipSuccess) { fprintf(stderr, "kernel_launch: launch of phase %d failed: %s\n", p, hipGetErrorString(e)); break; }
    }
#else
    a.ph_lo = 0; a.ph_hi = NPHASE; void* kargs[] = {&a};
    hipError_t e = hipLaunchCooperativeKernel((const void*)trunk_fwd, dim3(grid), dim3(512), kargs, LDS_BYTES, stream);
    if (e != hipSuccess) fprintf(stderr, "kernel_launch: cooperative launch failed: %s (grid %d)\n", hipGetErrorString(e), grid);
#endif
}
```

```cpp
#include <hip/hip_runtime.h>
#include <hip/hip_cooperative_groups.h>
#include <cstdio>
#include <cstdint>
namespace cg = cooperative_groups;

#ifndef MK_MULTI
#define MK_MULTI 0
#endif
#ifndef MK_ALIGN
#define MK_ALIGN true
#endif
#ifndef BARPROBE
#define BARPROBE 0
#endif
#ifndef MK_CGSYNC
#define MK_CGSYNC 0
#endif

#define LAS __attribute__((address_space(3)))
typedef unsigned short bf16_t;
typedef short bf16x8 __attribute__((ext_vector_type(8)));
typedef float f32x4 __attribute__((ext_vector_type(4)));
typedef float f32x2 __attribute__((ext_vector_type(2)));
typedef unsigned u32x4 __attribute__((ext_vector_type(4)));
typedef unsigned u32x2 __attribute__((ext_vector_type(2)));

constexpr int T = 32768, D = 1024, SEQ = 4096, NB = 8, MT = 2048, FH = 2816;
constexpr float EPS = 1e-6f;
constexpr int SL = 32;
constexpr int NCH = T / SL;
constexpr int AK = SL * 16 + 128;

constexpr size_t MiB = 1u << 20;
constexpr size_t WS_WIN0 = 0, WS_WOUT0 = 4 * MiB, WS_WOIN = 6 * MiB, WS_WOOUT = 7 * MiB, WS_WQ = 9 * MiB, WS_WK = 13 * MiB, WS_WV = 17 * MiB, WS_WO = 21 * MiB;
constexpr size_t WS_WGU = 25 * MiB, WS_WD = 47 * MiB, WS_GW = 58 * MiB, WS_AL = 59 * MiB, WS_BT3 = 60 * MiB, WS_GM = 80 * MiB, WS_MEMN = 88 * MiB, WS_KL = 92 * MiB, WS_VL = 100 * MiB;
constexpr size_t WS_XB = 110 * MiB, WS_QO = 174 * MiB, WS_P = 238 * MiB, WS_R0 = 302 * MiB;
constexpr size_t WS_WQK = WS_P, WS_WVO = WS_P + 32 * MiB;
constexpr size_t WS_HM = WS_R0, WS_U = WS_R0, WS_V = WS_R0 + 32 * MiB, WS_H = WS_R0 + 64 * MiB, WS_MIX = WS_R0 + 96 * MiB;
constexpr size_t WS_ACOMB = WS_R0, WS_XLOC = WS_R0 + 40 * MiB, WS_Y = WS_R0 + 56 * MiB;
constexpr size_t WS_SS = WS_R0 + 176 * MiB, WS_VST = WS_SS + 2 * MiB, WS_BAR = WS_VST + 1 * MiB, WS_END = WS_BAR + 1 * MiB;
constexpr size_t WGU_L = (size_t)2 * FH * D * 2, WD_L = (size_t)D * FH * 2, WSQ_L = (size_t)D * D * 2;

constexpr int RING_BYTES = 131072, XCH_OFF = RING_BYTES, MISC_OFF = RING_BYTES + 8192, LDS_BYTES = 147456;

__device__ __forceinline__ unsigned cvt_pk_bf16(float lo, float hi) { unsigned r; asm volatile("v_cvt_pk_bf16_f32 %0, %1, %2" : "=v"(r) : "v"(lo), "v"(hi)); return r; }
__device__ __forceinline__ float bf2f(unsigned short b) { return __builtin_bit_cast(float, (unsigned)b << 16); }
__device__ __forceinline__ float bflo(unsigned w) { return __builtin_bit_cast(float, w << 16); }
__device__ __forceinline__ float bfhi(unsigned w) { return __builtin_bit_cast(float, w & 0xffff0000u); }
__device__ __forceinline__ float sigmoid_f(float x) { return __builtin_amdgcn_rcpf(1.0f + __expf(-x)); }
__device__ __forceinline__ float silu_f(float x) { return x * sigmoid_f(x); }
__device__ __forceinline__ float gelu_f(float x) { return x * sigmoid_f(1.5957691216f * (x + 0.044715f * x * x * x)); }
typedef unsigned long long u64;
__device__ __forceinline__ void fx_add(u64* p, float q) { atomicAdd(p, (u64)(long long)(q * 16777216.0f)); }
__device__ __forceinline__ float fx_get(const u64* p) { return (float)(long long)(*p) * (1.0f / 16777216.0f); }
__device__ __forceinline__ float wave_sum(float v) {
#pragma unroll
    for (int o = 1; o < 64; o <<= 1) v += __shfl_xor(v, o);
    return v;
}
__device__ __forceinline__ u32x4 pack8(f32x4 a, f32x4 b) { u32x4 w; w.x = cvt_pk_bf16(a[0], a[1]); w.y = cvt_pk_bf16(a[2], a[3]); w.z = cvt_pk_bf16(b[0], b[1]); w.w = cvt_pk_bf16(b[2], b[3]); return w; }

namespace pg8 {
constexpr int BM = 256, BK = 64, HALF = 128, HTB = HALF * BK * 2, NXCD = 8, WGM = 8;
__device__ __forceinline__ int lds_byte(int r, int c) { const int st = (r >> 4) * 2 + (c >> 5), rr = r & 15, cc = c & 31, ob = rr * 64 + cc * 2; return st * 1024 + (ob ^ (((ob >> 9) & 1) << 5)); }
__device__ __forceinline__ void stage_rc(int b, int& R, int& C) { const int st = b / 1024, sb = b % 1024, swz = sb ^ (((sb >> 9) & 1) << 5); R = (st >> 1) * 16 + swz / 64; C = (st & 1) * 32 + (swz % 64) / 2; }
__device__ __forceinline__ int perm32(int rho) { const int n = rho >> 4, i = rho & 15; return 8 * (i >> 2) + 4 * n + (i & 3); }

struct Unit { int pm, pn, z; };
struct Gemm { const bf16_t* A; const bf16_t* Bt; int lda, ldb, K, nz0; long sAz0, sAz1, sBz0, sBz1; };
struct Sched {
    int nM, nN, per, total, G, c;
    __device__ __forceinline__ void init(int nM_, int nN_, int nz, int G_, int c_) { nM = nM_; nN = nN_; per = nM_ * nN_; total = per * nz; G = G_; c = c_; }
    __device__ __forceinline__ bool next(int i, Unit& u) const {
        const long L = (long)i * G + c; if (L >= total) return false;
        const int z = (int)(L / per); int wgid = (int)(L % per);
        { const int q = per / NXCD, r = per % NXCD, xcd = wgid % NXCD, off = wgid / NXCD; wgid = (xcd < r ? xcd * (q + 1) : r * (q + 1) + (xcd - r) * q) + off; }
        const int nig = WGM * nN, gid = wgid / nig, fm = gid * WGM, gsz = (nM - fm) < WGM ? (nM - fm) : WGM;
        u.pm = fm + ((wgid % nig) % gsz); u.pn = (wgid % nig) / gsz; u.z = z; return true;
    }
};

template <bool ALIGN, class Epi>
__device__ __forceinline__ void gemm_phase(LAS unsigned char* lds, const Gemm g, const Sched& S, const Epi& E, const int tid) {
    const int wid = __builtin_amdgcn_readfirstlane(tid >> 6), lane = tid & 63, wr = wid >> 2, wc = wid & 3, fr = lane & 15, fq = lane >> 4;
    const int nt = g.K / BK;
    unsigned voffA[2], voffB[2];
#pragma unroll
    for (int i = 0; i < 2; ++i) { int R, C; stage_rc(tid * 16 + i * 8192, R, C); const int Rb = (R & ~31) + perm32(R & 31);
        voffA[i] = (unsigned)(R * g.lda + C) * 2u; voffB[i] = (unsigned)(Rb * g.ldb + C) * 2u; }
    const size_t kstep = (size_t)(BK * 2);
    const size_t hsA = (size_t)HALF * g.lda * 2, hsB = (size_t)HALF * g.ldb * 2;
    const unsigned ldsw = (unsigned)wid * 1024u;
    const int aoff = lds_byte(wr * 64 + fr, fq * 8), boff = lds_byte(wc * 32 + fr, fq * 8);
#define PG8_SA(b, h) (((b) * 2 + (h)) * HTB)
#define PG8_SB(b, h) ((4 + (b) * 2 + (h)) * HTB)
#define PG8_STAGE(bufoff, gbase, voff) do { _Pragma("unroll") for (int _i = 0; _i < 2; ++_i) \
        __builtin_amdgcn_global_load_lds((const unsigned*)((const char*)(gbase) + (voff)[_i]), (LAS unsigned*)(lds + (bufoff) + ldsw + _i * 8192), 16, 0, 0); } while (0)
#define PG8_LDA(dst, b, h) do { _Pragma("unroll") for (int m = 0; m < 4; ++m) _Pragma("unroll") for (int k = 0; k < 2; ++k) dst[m][k] = *(const LAS bf16x8*)(lds + PG8_SA(b, h) + aoff + m * 2048 + k * 1024); } while (0)
#define PG8_LDB(dst, b, h) do { _Pragma("unroll") for (int n = 0; n < 2; ++n) _Pragma("unroll") for (int k = 0; k < 2; ++k) dst[n][k] = *(const LAS bf16x8*)(lds + PG8_SB(b, h) + boff + n * 2048 + k * 1024); } while (0)
#define PG8_MMA(ai, bj, At, Bt) do { __builtin_amdgcn_s_setprio(1); _Pragma("unroll") for (int m = 0; m < 4; ++m) _Pragma("unroll") for (int n = 0; n < 2; ++n) _Pragma("unroll") for (int k = 0; k < 2; ++k) \
        acc[ai][bj][m][n] = __builtin_amdgcn_mfma_f32_16x16x32_bf16(Bt[n][k], At[m][k], acc[ai][bj][m][n], 0, 0, 0); __builtin_amdgcn_s_setprio(0); } while (0)
#define PG8_WAIT_V(n) asm volatile("s_waitcnt vmcnt(" #n ")" ::: "memory")
#define PG8_WAIT_L(n) asm volatile("s_waitcnt lgkmcnt(" #n ")" ::: "memory")
#define PG8_BAR __builtin_amdgcn_s_barrier()
#define PG8_SCHED __builtin_amdgcn_sched_barrier(0)
#define PG8_UA(u) ((const char*)g.A + 2 * ((size_t)((u).z % g.nz0) * g.sAz0 + (size_t)((u).z / g.nz0) * g.sAz1 + (size_t)(u).pm * BM * g.lda))
#define PG8_UB(u) ((const char*)g.Bt + 2 * ((size_t)((u).z % g.nz0) * g.sBz0 + (size_t)((u).z / g.nz0) * g.sBz1 + (size_t)(u).pn * BM * g.ldb))
    Unit cur, nxt; int ui = 0;
    if (!S.next(0, cur)) return;
    f32x4 acc[2][2][4][2];
#pragma unroll
    for (int a = 0; a < 2; ++a)
#pragma unroll
        for (int b = 0; b < 2; ++b)
#pragma unroll
            for (int m = 0; m < 4; ++m)
#pragma unroll
                for (int n = 0; n < 2; ++n) acc[a][b][m][n] = (f32x4){0.f, 0.f, 0.f, 0.f};
    bf16x8 At[4][2], B0[2][2], B1[2][2];
    const char* cA = PG8_UA(cur); const char* cB = PG8_UB(cur);
    PG8_STAGE(PG8_SB(0, 0), cB, voffB); PG8_STAGE(PG8_SB(0, 1), cB + hsB, voffB); PG8_STAGE(PG8_SA(0, 0), cA, voffA); PG8_STAGE(PG8_SA(0, 1), cA + hsA, voffA);
    if (wr == 1) PG8_BAR;
    PG8_WAIT_V(2); PG8_BAR;
    PG8_STAGE(PG8_SB(1, 0), cB + kstep, voffB); PG8_STAGE(PG8_SA(1, 0), cA + kstep, voffA); PG8_STAGE(PG8_SB(1, 1), cB + hsB + kstep, voffB);
    PG8_WAIT_V(6); PG8_BAR;
    for (;;) {
        const bool has_next = S.next(ui + 1, nxt);
        const char* nA = has_next ? PG8_UA(nxt) : cA; const char* nB = has_next ? PG8_UB(nxt) : cB;
        for (int t = 0; t < nt; t += 2) {
            const bool last = (t == nt - 2);
            const char* a1 = cA + (size_t)(t + 1) * kstep;
            const char* a2 = last ? nA : cA + (size_t)(t + 2) * kstep; const char* b2 = last ? nB : cB + (size_t)(t + 2) * kstep;
            const char* a3 = a2 + kstep; const char* b3 = b2 + kstep;
            PG8_LDB(B0, 0, 0); PG8_LDB(B1, 0, 1); PG8_SCHED; PG8_LDA(At, 0, 0); PG8_STAGE(PG8_SA(1, 1), a1 + hsA, voffA);
            PG8_WAIT_V(8); PG8_WAIT_L(0); PG8_BAR; PG8_MMA(0, 0, At, B0); PG8_MMA(0, 1, At, B1); PG8_BAR; PG8_SCHED;
            PG8_LDA(At, 0, 1); PG8_STAGE(PG8_SB(0, 0), b2, voffB); PG8_STAGE(PG8_SB(0, 1), b2 + hsB, voffB); PG8_STAGE(PG8_SA(0, 0), a2, voffA);
            PG8_WAIT_V(8); PG8_WAIT_L(0); PG8_BAR; PG8_MMA(1, 0, At, B0); PG8_MMA(1, 1, At, B1); PG8_BAR; PG8_SCHED;
            PG8_LDB(B0, 1, 0); PG8_LDB(B1, 1, 1); PG8_SCHED; PG8_LDA(At, 1, 0); PG8_STAGE(PG8_SA(0, 1), a2 + hsA, voffA);
            PG8_WAIT_V(8); PG8_WAIT_L(0); PG8_BAR; PG8_MMA(0, 0, At, B0); PG8_MMA(0, 1, At, B1); PG8_BAR; PG8_SCHED;
            PG8_LDA(At, 1, 1); PG8_STAGE(PG8_SB(1, 0), b3, voffB); PG8_STAGE(PG8_SB(1, 1), b3 + hsB, voffB); PG8_STAGE(PG8_SA(1, 0), a3, voffA);
            PG8_WAIT_V(8); PG8_WAIT_L(0); PG8_BAR; PG8_MMA(1, 0, At, B0); PG8_MMA(1, 1, At, B1); PG8_BAR; PG8_SCHED;
        }
        if (ALIGN) { if (wr == 0) PG8_BAR; }
        E(acc, cur, wr, wc, fr, fq, lds);
        if (!has_next) break;
#pragma unroll
        for (int a = 0; a < 2; ++a)
#pragma unroll
            for (int b = 0; b < 2; ++b)
#pragma unroll
                for (int m = 0; m < 4; ++m)
#pragma unroll
                    for (int n = 0; n < 2; ++n) acc[a][b][m][n] = (f32x4){0.f, 0.f, 0.f, 0.f};
        cur = nxt; cA = nA; cB = nB; ++ui;
        if (ALIGN) { if (wr == 1) PG8_BAR; }
    }
    PG8_WAIT_V(0);
    if (!ALIGN) { if (wr == 0) PG8_BAR; }
    PG8_BAR;
#undef PG8_SA
#undef PG8_SB
#undef PG8_STAGE
#undef PG8_LDA
#undef PG8_LDB
#undef PG8_MMA
#undef PG8_UA
#undef PG8_UB
}

typedef f32x4 Acc[2][2][4][2];
#define EPI_ARGS Acc& acc, const Unit& u, int wr, int wc, int fr, int fq, LAS unsigned char* lds
__device__ __forceinline__ int efence() { asm volatile("" ::: "memory"); return 1; }
#define ROWLOOP _Pragma("unroll") for (int ai = 0; ai < 2; ++ai) _Pragma("unroll") for (int m = 0; m < 4; ++m) for (int once_ = efence(); once_; once_ = 0)

#define LOAD_RS8(rs, ssp, row0) float rs[2][4]; { u64 raw_[2][4]; _Pragma("unroll") for (int ai = 0; ai < 2; ++ai) _Pragma("unroll") for (int m = 0; m < 4; ++m) raw_[ai][m] = (ssp)[(row0) + ai * 128 + m * 16]; \
    _Pragma("unroll") for (int ai = 0; ai < 2; ++ai) _Pragma("unroll") for (int m = 0; m < 4; ++m) rs[ai][m] = rsqrtf((float)(long long)raw_[ai][m] * (1.0f / 16777216.0f) * (1.0f / D) + EPS); }
struct EpiIn0 {
    const u64* ss; bf16_t* U; bf16_t* V; bf16_t* H; u64* vst;
    __device__ __forceinline__ void operator()(EPI_ARGS) const {
        const int row0 = u.pm * 256 + wr * 64 + fr;
        LOAD_RS8(rs8, ss, row0);
        if (u.pn < 4) {
            bf16_t* dst = (u.pn < 2) ? U : V; const int col0 = (u.pn & 1) * 256 + wc * 32 + 8 * fq; const bool st = u.pn >= 2;
            ROWLOOP { const int row = row0 + ai * 128 + m * 16; const float rs = rs8[ai][m]; float s = 0.f, q = 0.f;
#pragma unroll
                for (int bj = 0; bj < 2; ++bj) { f32x4 v0 = acc[ai][bj][m][0] * rs, v1 = acc[ai][bj][m][1] * rs;
#pragma unroll
                    for (int e = 0; e < 4; ++e) { v0[e] = gelu_f(v0[e]); v1[e] = gelu_f(v1[e]); s += v0[e] + v1[e]; q += v0[e] * v0[e] + v1[e] * v1[e]; }
                    *(u32x4*)(dst + (size_t)row * 512 + col0 + bj * 128) = pack8(v0, v1); }
                if (st) { s += __shfl_xor(s, 16); s += __shfl_xor(s, 32); q += __shfl_xor(q, 16); q += __shfl_xor(q, 32);
                    if (fq == 0) { fx_add(vst + 2 * row, s); fx_add(vst + 2 * row + 1, q); } }
            }
        } else {
            const int col0 = (u.pn - 4) * 128 + wc * 32 + 8 * fq;
            ROWLOOP { const int row = row0 + ai * 128 + m * 16; const float rs = rs8[ai][m]; f32x4 h0, h1;
#pragma unroll
                for (int e = 0; e < 4; ++e) { h0[e] = acc[ai][0][m][0][e] * rs * sigmoid_f(acc[ai][1][m][0][e] * rs); h1[e] = acc[ai][0][m][1][e] * rs * sigmoid_f(acc[ai][1][m][1][e] * rs); }
                *(u32x4*)(H + (size_t)row * 512 + col0) = pack8(h0, h1); }
        }
    }
};
__device__ __forceinline__ void unpack8(u32x4 b, f32x4& o0, f32x4& o1) { o0 = (f32x4){bflo(b.x), bfhi(b.x), bflo(b.y), bfhi(b.y)}; o1 = (f32x4){bflo(b.z), bfhi(b.z), bflo(b.w), bfhi(b.w)}; }
template <bool GLU> struct EpiRes {
    bf16_t* xb; u64* ss; int zrows;
    __device__ __forceinline__ void operator()(EPI_ARGS) const {
        const int row0 = u.z * zrows + u.pm * 256 + wr * 64 + fr;
#pragma unroll
        for (int ai = 0; ai < 2; ++ai) {
            u32x4 pre[4][2];
#pragma unroll
            for (int m = 0; m < 4; ++m) { const int row = row0 + ai * 128 + m * 16;
                if (GLU) pre[m][0] = *(const u32x4*)(xb + (size_t)row * D + u.pn * 128 + wc * 32 + 8 * fq);
                else {
#pragma unroll
                    for (int bj = 0; bj < 2; ++bj) pre[m][bj] = *(const u32x4*)(xb + (size_t)row * D + u.pn * 256 + bj * 128 + wc * 32 + 8 * fq); } }
#pragma unroll
            for (int m = 0; m < 4; ++m) for (int once_ = efence(); once_; once_ = 0) { const int row = row0 + ai * 128 + m * 16; float q = 0.f;
                if (GLU) { const size_t off = (size_t)row * D + u.pn * 128 + wc * 32 + 8 * fq;
                    f32x4 o0, o1; unpack8(pre[m][0], o0, o1);
#pragma unroll
                    for (int e = 0; e < 4; ++e) { o0[e] += acc[ai][0][m][0][e] * sigmoid_f(acc[ai][1][m][0][e]); o1[e] += acc[ai][0][m][1][e] * sigmoid_f(acc[ai][1][m][1][e]);
                        q += o0[e] * o0[e] + o1[e] * o1[e]; }
                    *(u32x4*)(xb + off) = pack8(o0, o1);
                } else {
#pragma unroll
                    for (int bj = 0; bj < 2; ++bj) { const size_t off = (size_t)row * D + u.pn * 256 + bj * 128 + wc * 32 + 8 * fq;
                        f32x4 o0, o1; unpack8(pre[m][bj], o0, o1); o0 += acc[ai][bj][m][0]; o1 += acc[ai][bj][m][1];
#pragma unroll
                        for (int e = 0; e < 4; ++e) q += o0[e] * o0[e] + o1[e] * o1[e];
                        *(u32x4*)(xb + off) = pack8(o0, o1); }
                }
                q += __shfl_xor(q, 16); q += __shfl_xor(q, 32);
                if (fq == 0) fx_add(ss + row, q);
            }
        }
    }
};
struct EpiStore {
    bf16_t* O; int ldc, nz0; long sz0, sz1; const u64* ss; float scale;
    __device__ __forceinline__ void operator()(EPI_ARGS) const {
        bf16_t* base = O + (size_t)(u.z % nz0) * sz0 + (size_t)(u.z / nz0) * sz1; const int row0 = u.pm * 256 + wr * 64 + fr, col0 = u.pn * 256 + wc * 32 + 8 * fq;
        float rs8[2][4];
        if (ss) { LOAD_RS8(t8, ss, row0);
#pragma unroll
            for (int ai = 0; ai < 2; ++ai)
#pragma unroll
                for (int m = 0; m < 4; ++m) rs8[ai][m] = t8[ai][m] * scale; }
        else {
#pragma unroll
            for (int ai = 0; ai < 2; ++ai)
#pragma unroll
                for (int m = 0; m < 4; ++m) rs8[ai][m] = scale; }
        ROWLOOP { const int row = row0 + ai * 128 + m * 16; const float rs = rs8[ai][m];
#pragma unroll
            for (int bj = 0; bj < 2; ++bj) *(u32x4*)(base + (size_t)row * ldc + col0 + bj * 128) = pack8(acc[ai][bj][m][0] * rs, acc[ai][bj][m][1] * rs); }
    }
};
struct EpiSoftmax {
    bf16_t* P; const u64* ss;
    __device__ __forceinline__ void operator()(EPI_ARGS) const {
        LAS float* X = (LAS float*)(lds + XCH_OFF); LAS float* Y = X + 1024;
        const int grow0 = u.z * SEQ + u.pm * 256 + wr * 64 + fr;
        LOAD_RS8(rs8, ss, grow0);
        ROWLOOP { const int r = ai * 128 + wr * 64 + m * 16 + fr; const float sc = rs8[ai][m] * 0.0625f; float mx = -3.0e38f;
#pragma unroll
            for (int bj = 0; bj < 2; ++bj)
#pragma unroll
                for (int n = 0; n < 2; ++n) { acc[ai][bj][m][n] = acc[ai][bj][m][n] * sc;
#pragma unroll
                    for (int e = 0; e < 4; ++e) mx = fmaxf(mx, acc[ai][bj][m][n][e]); }
            mx = fmaxf(mx, __shfl_xor(mx, 16)); mx = fmaxf(mx, __shfl_xor(mx, 32));
            if (fq == 0) X[r * 4 + wc] = mx; }
        asm volatile("s_waitcnt lgkmcnt(0)" ::: "memory"); __builtin_amdgcn_s_barrier(); asm volatile("" ::: "memory");
        ROWLOOP { const int r = ai * 128 + wr * 64 + m * 16 + fr; const f32x4 xm = *(const LAS f32x4*)(X + r * 4); const float mx = fmaxf(fmaxf(xm[0], xm[1]), fmaxf(xm[2], xm[3])); float s = 0.f;
#pragma unroll
            for (int bj = 0; bj < 2; ++bj)
#pragma unroll
                for (int n = 0; n < 2; ++n)
#pragma unroll
                    for (int e = 0; e < 4; ++e) { const float p = __expf(acc[ai][bj][m][n][e] - mx); acc[ai][bj][m][n][e] = p; s += p; }
            s += __shfl_xor(s, 16); s += __shfl_xor(s, 32);
            if (fq == 0) Y[r * 4 + wc] = s; }
        asm volatile("s_waitcnt lgkmcnt(0)" ::: "memory"); __builtin_amdgcn_s_barrier(); asm volatile("" ::: "memory");
        ROWLOOP { const int r = ai * 128 + wr * 64 + m * 16 + fr; const f32x4 ys = *(const LAS f32x4*)(Y + r * 4); const float inv = 1.0f / ((ys[0] + ys[1]) + (ys[2] + ys[3]));
#pragma unroll
            for (int bj = 0; bj < 2; ++bj) *(u32x4*)(P + (size_t)(u.z * SEQ + u.pm * 256 + r) * D + u.pn * 256 + bj * 128 + wc * 32 + 8 * fq) = pack8(acc[ai][bj][m][0] * inv, acc[ai][bj][m][1] * inv); }
    }
};
struct EpiFfn1 {
    const u64* ss; bf16_t* HM;
    __device__ __forceinline__ void operator()(EPI_ARGS) const {
        const int row0 = u.pm * 256 + wr * 64 + fr, col0 = u.pn * 128 + wc * 32 + 8 * fq;
        LOAD_RS8(rs8, ss, row0);
        ROWLOOP { const int row = row0 + ai * 128 + m * 16; const float rs = rs8[ai][m]; f32x4 h0, h1;
#pragma unroll
            for (int e = 0; e < 4; ++e) { h0[e] = silu_f(acc[ai][0][m][0][e] * rs) * (acc[ai][1][m][0][e] * rs); h1[e] = silu_f(acc[ai][0][m][1][e] * rs) * (acc[ai][1][m][1][e] * rs); }
            *(u32x4*)(HM + (size_t)row * FH + col0) = pack8(h0, h1); }
    }
};
struct EpiOin {
    const u64* ss; bf16_t* AC;
    __device__ __forceinline__ void operator()(EPI_ARGS) const {
        const int row0 = u.pm * 256 + wr * 64 + fr;
        LOAD_RS8(rs8, ss, row0);
        ROWLOOP { const int row = row0 + ai * 128 + m * 16; const float rs = rs8[ai][m];
#pragma unroll
            for (int bj = 0; bj < 2; ++bj) { const int col = u.pn * 256 + bj * 128 + wc * 32 + 8 * fq;
                *(u32x4*)(AC + (size_t)(col >> 4) * NCH * AK + (size_t)(row / SL) * AK + (row % SL) * 16 + (col & 8)) = pack8(acc[ai][bj][m][0] * rs, acc[ai][bj][m][1] * rs); } }
    }
};
struct EpiS5State {
    float* XL;
    __device__ __forceinline__ void operator()(EPI_ARGS) const {
        const int row0 = u.pm * 256 + wr * 64 + fr, col0 = wc * 32 + 8 * fq;
        ROWLOOP { const int row = row0 + ai * 128 + m * 16; float* p = XL + (size_t)u.z * NCH * 128 + (size_t)row * 128 + col0;
            *(f32x4*)p = acc[ai][0][m][0]; *(f32x4*)(p + 4) = acc[ai][0][m][1]; }
    }
};
struct EpiS5Out {
    const bf16_t* AC; const float* dsk; bf16_t* Y;
    __device__ __forceinline__ void operator()(EPI_ARGS) const {
        const int g = u.z, row0 = u.pm * 256 + wr * 64 + fr;
        f32x4 dv[2][2];
#pragma unroll
        for (int bj = 0; bj < 2; ++bj) { const int ch = g * 16 + ((u.pn * 256 + bj * 128 + wc * 32 + 8 * fq) & 8); dv[bj][0] = *(const f32x4*)(dsk + ch); dv[bj][1] = *(const f32x4*)(dsk + ch + 4); }
#pragma unroll
        for (int ai = 0; ai < 2; ++ai) {
            u32x4 pre[4][2];
#pragma unroll
            for (int m = 0; m < 4; ++m)
#pragma unroll
                for (int bj = 0; bj < 2; ++bj) pre[m][bj] = *(const u32x4*)(AC + (size_t)g * NCH * AK + (size_t)(row0 + ai * 128 + m * 16) * AK + u.pn * 256 + bj * 128 + wc * 32 + 8 * fq);
#pragma unroll
            for (int m = 0; m < 4; ++m) for (int once_ = efence(); once_; once_ = 0) { const int row = row0 + ai * 128 + m * 16;
#pragma unroll
                for (int bj = 0; bj < 2; ++bj) { const int col = u.pn * 256 + bj * 128 + wc * 32 + 8 * fq, k = col >> 4, ch = g * 16 + (col & 8);
                    f32x4 u0, u1; unpack8(pre[m][bj], u0, u1);
                    f32x4 y0 = acc[ai][bj][m][0] + dv[bj][0] * u0, y1 = acc[ai][bj][m][1] + dv[bj][1] * u1;
#pragma unroll
                    for (int e = 0; e < 4; ++e) { y0[e] = gelu_f(y0[e]); y1[e] = gelu_f(y1[e]); }
                    *(u32x4*)(Y + (size_t)(row * SL + k) * 512 + ch) = pack8(y0, y1); } }
        }
    }
};
}

#define XB_TMO      128
#define XB_XCNT(j)  (256  + 64 * (j))
#define XB_XSUB(j)  (1280 + 64 * (j))
#define XB_XGEN(j)  (2304 + 64 * (j))
#define XB_TOP      3328
#define XB_TOPGEN   3392
#define XCD_BAR_WORDS 3456
#define XB_SPIN_CAP (1u << 22)
__device__ __forceinline__ unsigned xb_ld(unsigned* p)              { return __hip_atomic_load(p, __ATOMIC_RELAXED, __HIP_MEMORY_SCOPE_AGENT); }
__device__ __forceinline__ unsigned xb_add(unsigned* p, unsigned v) { return __hip_atomic_fetch_add(p, v, __ATOMIC_RELAXED, __HIP_MEMORY_SCOPE_AGENT); }
__device__ __forceinline__ unsigned xb_xcc_id() { return (unsigned)__builtin_amdgcn_s_getreg((3 << 11) | 20) & 0xFu; }
#define XB_SPIN(cond, bar) do { unsigned _sp = 0; while (cond) { __builtin_amdgcn_s_sleep(1); \
    if ((++_sp & 255u) == 0u) { if (xb_ld(&(bar)[XB_TMO])) break; if (_sp > XB_SPIN_CAP) { atomicAdd(&(bar)[XB_TMO], 1u); break; } } } } while (0)
struct XcdBarrier { unsigned* bar; unsigned x; volatile LAS unsigned* st; };
__device__ __forceinline__ XcdBarrier xcd_barrier_post(unsigned* bar, volatile LAS unsigned* st) {
    XcdBarrier b; b.bar = bar; b.x = xb_xcc_id(); b.st = st;
    if (threadIdx.x == 0) (void)xb_add(&bar[XB_XCNT(b.x)], 1u);
    return b;
}
__device__ __forceinline__ void xcd_barrier_complete(unsigned* bar, unsigned x, unsigned& nloc, unsigned& nx) {
    const unsigned G = gridDim.x * gridDim.y * gridDim.z;
    unsigned sum, cnt, mine, sp = 0u;
    for (;;) {
        sum = 0u; cnt = 0u; mine = 0u;
#pragma unroll
        for (unsigned j = 0; j < 16; ++j) { const unsigned c = xb_ld(&bar[XB_XCNT(j)]); sum += c; cnt += (c > 0u) ? 1u : 0u; mine = (j == x) ? c : mine; }
        if (sum == G) break;
        __builtin_amdgcn_s_sleep(1);
        if ((++sp & 255u) == 0u) { if (xb_ld(&bar[XB_TMO])) break; if (sp > XB_SPIN_CAP) { atomicAdd(&bar[XB_TMO], 1u); break; } }
    }
    nloc = mine > 0u ? mine : 1u; nx = cnt > 0u ? cnt : 1u;
}
__device__ __forceinline__ void xcd_barrier(const XcdBarrier& b) {
    asm volatile("s_waitcnt vmcnt(0)" ::: "memory");
    __syncthreads();
    if (threadIdx.x == 0) {
        unsigned* bar = b.bar;
        __builtin_amdgcn_s_waitcnt(0);
        unsigned nloc = b.st[0], nx = b.st[1];
        if (nloc == 0u) { xcd_barrier_complete(bar, b.x, nloc, nx); b.st[0] = nloc; b.st[1] = nx; }
        const unsigned old = xb_add(&bar[XB_XSUB(b.x)], 1u);
        const unsigned gen = old / nloc;
        if (old + 1u == (gen + 1u) * nloc) {
            __builtin_amdgcn_fence(__ATOMIC_RELEASE, "agent");
            asm volatile("s_waitcnt vmcnt(0)" ::: "memory");
            const unsigned og = xb_add(&bar[XB_TOP], 1u);
            const unsigned tg = og / nx;
            if (og + 1u == (tg + 1u) * nx) xb_add(&bar[XB_TOPGEN], 1u);
            else XB_SPIN(xb_ld(&bar[XB_TOPGEN]) == tg, bar);
            __builtin_amdgcn_fence(__ATOMIC_ACQUIRE, "agent");
            xb_add(&bar[XB_XGEN(b.x)], 1u);
            asm volatile("s_waitcnt vmcnt(0)" ::: "memory");
        } else {
            XB_SPIN(xb_ld(&bar[XB_XGEN(b.x)]) == gen, bar);
            __builtin_amdgcn_fence(__ATOMIC_ACQUIRE, "agent");
            asm volatile("s_waitcnt vmcnt(0)" ::: "memory");
        }
    }
    __syncthreads();
}

struct ConvP { const float* W; bf16_t* WT; const float* gain; int K, ldn, cs, nblk, mode, roff, r; };
__device__ __forceinline__ void conv_load(const ConvP& p, f32x4 (&v)[32], int lane) {
    const int nkb = p.K / 64, kb = p.r % nkb, nb = p.r / nkb; const float* src = p.W + (size_t)(64 * kb + (lane >> 5)) * p.ldn + p.cs + 128 * nb + 4 * (lane & 31);
#pragma unroll
    for (int i = 0; i < 32; ++i) v[i] = *(const f32x4*)(src + (size_t)(2 * i) * p.ldn);
}
__device__ __forceinline__ void conv_store(const ConvP& p, const f32x4 (&v)[32], LAS float* scr, int lane) {
    const int nkb = p.K / 64, kb = p.r % nkb, nb = p.r / nkb, k0 = 64 * kb, c = lane & 7;
    f32x4 g0 = {1.f, 1.f, 1.f, 1.f}, g1 = g0;
    if (p.gain) { g0 = *(const f32x4*)(p.gain + k0 + 8 * c); g1 = *(const f32x4*)(p.gain + k0 + 8 * c + 4); }
#pragma unroll 1
    for (int sb = 0; sb < 4; ++sb) {
        if (((lane & 31) >> 3) == sb) {
#pragma unroll
            for (int i = 0; i < 32; ++i)
#pragma unroll
                for (int e = 0; e < 4; ++e) scr[(2 * i + (lane >> 5)) * 33 + 4 * (lane & 7) + e] = v[i][e]; }
        asm volatile("s_waitcnt lgkmcnt(0)" ::: "memory");
        const int c0 = 128 * nb + 32 * sb, drow = p.roff + (p.mode == 0 ? c0 : ((c0 >> 7) * 256 + (p.mode - 1) * 128 + (c0 & 127)));
#pragma unroll
        for (int j = 0; j < 4; ++j) { const int n = (lane >> 3) + 8 * j; const LAS float* s = scr + (8 * c) * 33 + n;
            u32x4 o; o.x = cvt_pk_bf16(s[0 * 33] * g0[0], s[1 * 33] * g0[1]); o.y = cvt_pk_bf16(s[2 * 33] * g0[2], s[3 * 33] * g0[3]); o.z = cvt_pk_bf16(s[4 * 33] * g1[0], s[5 * 33] * g1[1]); o.w = cvt_pk_bf16(s[6 * 33] * g1[2], s[7 * 33] * g1[3]);
            *(u32x4*)(p.WT + (size_t)(drow + n) * p.K + k0 + 8 * c) = o; }
        asm volatile("s_waitcnt lgkmcnt(0)" ::: "memory");
    }
}
template <bool NORM, int R> __device__ __forceinline__ void rows_to_bf16(const float* x0, bf16_t* o0, u64* ssq, int lane) {
    f32x4 v[R][4]; float s[R];
#pragma unroll
    for (int r = 0; r < R; ++r) { const f32x4* xr = (const f32x4*)(x0 + (size_t)r * D) + lane;
#pragma unroll
        for (int j = 0; j < 4; ++j) v[r][j] = xr[64 * j]; }
#pragma unroll
    for (int r = 0; r < R; ++r) { float a = 0.f;
#pragma unroll
        for (int j = 0; j < 4; ++j) a += (v[r][j][0] * v[r][j][0] + v[r][j][1] * v[r][j][1]) + (v[r][j][2] * v[r][j][2] + v[r][j][3] * v[r][j][3]);
        s[r] = wave_sum(a); }
#pragma unroll
    for (int r = 0; r < R; ++r) { const float rs = NORM ? rsqrtf(s[r] * (1.0f / D) + EPS) : 1.0f; u32x2* o = (u32x2*)(o0 + (size_t)r * D) + lane;
#pragma unroll
        for (int j = 0; j < 4; ++j) { u32x2 w; w.x = cvt_pk_bf16(v[r][j][0] * rs, v[r][j][1] * rs); w.y = cvt_pk_bf16(v[r][j][2] * rs, v[r][j][3] * rs); o[64 * j] = w; }
        if (ssq && lane == 0) ssq[r] = (u64)(long long)(s[r] * 16777216.0f); }
}
__device__ __forceinline__ void cis_f(float ang, float& c, float& s) {
    float rev = ang * 0.15915494309189535f; rev = rev - rintf(rev);
    const float x = rev * 6.283185307179586f;
    const float h = x * 0.25f, h2 = h * h;
    float sh = h * (1.0f + h2 * (-1.6666667e-1f + h2 * (8.3333333e-3f + h2 * (-1.9841270e-4f + h2 * 2.7557319e-6f))));
    float ch = 1.0f + h2 * (-0.5f + h2 * (4.1666667e-2f + h2 * (-1.3888889e-3f + h2 * (2.4801587e-5f + h2 * -2.7557319e-7f))));
    float s2 = 2.f * sh * ch, c2 = 1.f - 2.f * sh * sh;
    s = 2.f * s2 * c2; c = 1.f - 2.f * s2 * s2;
}
__device__ __forceinline__ void s5_setup(int g, LAS unsigned char* lds, const float* lam_re, const float* lam_im, const float* log_dt, const float* b_re, const float* b_im, const float* c_re, const float* c_im,
                                         bf16_t* BT3, bf16_t* GM, float* AL, int tid) {
    LAS float* pwr = (LAS float*)lds; LAS float* pwi = pwr + 33 * 64; LAS float* Bbr = pwi + 33 * 64; LAS float* Bbi = Bbr + 1024; LAS float* Cr = Bbi + 1024; LAS float* Ci = Cr + 1024; LAS float* Kd = Ci + 1024;
    const float dt = __expf(log_dt[g]);
    for (int idx = tid; idx < 33 * 64; idx += 512) { const int d = idx >> 6, p = idx & 63; const float lr = lam_re[g * 64 + p], li = lam_im[g * 64 + p];
        const float mag = __expf(lr * dt * (float)d); float c, s; cis_f(li * dt * (float)d, c, s); pwr[idx] = mag * c; pwi[idx] = mag * s; }
    for (int idx = tid; idx < 1024; idx += 512) { const int p = idx >> 4; const float lr = lam_re[g * 64 + p], li = lam_im[g * 64 + p];
        const float mag = __expf(lr * dt); float c, s; cis_f(li * dt, c, s); const float ar = mag * c, ai = mag * s, den = lr * lr + li * li;
        const float qr = ((ar - 1.0f) * lr + ai * li) / den, qi = (ai * lr - (ar - 1.0f) * li) / den;
        const float br = b_re[g * 1024 + idx], bi = b_im[g * 1024 + idx];
        Bbr[idx] = qr * br - qi * bi; Bbi[idx] = qr * bi + qi * br;
        Cr[idx] = c_re[g * 1024 + idx]; Ci[idx] = c_im[g * 1024 + idx]; }
    __syncthreads();
    for (int idx = tid; idx < 32 * 256; idx += 512) { const int d = idx >> 8, co = (idx >> 4) & 15, ci = idx & 15; float a = 0.f;
        for (int p = 0; p < 64; ++p) { const float cr = Cr[co * 64 + p], cim = Ci[co * 64 + p], pr = pwr[d * 64 + p], pi = pwi[d * 64 + p];
            const float tr = cr * pr - cim * pi, ti = cr * pi + cim * pr; a += tr * Bbr[p * 16 + ci] - ti * Bbi[p * 16 + ci]; }
        Kd[idx] = a; }
    __syncthreads();
    bf16_t* bt = BT3 + (size_t)g * 512 * AK;
    for (int idx = tid; idx < 512 * (AK / 8); idx += 512) { const int n = idx / (AK / 8), q = idx % (AK / 8), kk0 = q * 8, k = n >> 4, co = n & 15; float v[8];
        if (kk0 < 512) { const int j = kk0 >> 4, ci0 = kk0 & 15;
#pragma unroll
            for (int e = 0; e < 8; ++e) v[e] = (j <= k) ? Kd[(k - j) * 256 + co * 16 + ci0 + e] : 0.f;
        } else { const int p0 = kk0 - 512;
#pragma unroll
            for (int e = 0; e < 8; ++e) { const int p = (p0 & 63) + e; const float cr = Cr[co * 64 + p], cim = Ci[co * 64 + p], pr = pwr[(k + 1) * 64 + p], pi = pwi[(k + 1) * 64 + p];
                v[e] = (p0 < 64) ? (cr * pr - cim * pi) : -(cr * pi + cim * pr); } }
        u32x4 w; w.x = cvt_pk_bf16(v[0], v[1]); w.y = cvt_pk_bf16(v[2], v[3]); w.z = cvt_pk_bf16(v[4], v[5]); w.w = cvt_pk_bf16(v[6], v[7]);
        *(u32x4*)(bt + (size_t)n * AK + kk0) = w; }
    bf16_t* gm = GM + (size_t)g * 256 * 512;
    for (int idx = tid; idx < 256 * 64; idx += 512) { const int n = idx >> 6, q = idx & 63, kk0 = q * 8; float v[8];
        if (n < 128) { const int p = n & 63, j = kk0 >> 4, ci0 = kk0 & 15; const float pr = pwr[(SL - 1 - j) * 64 + p], pi = pwi[(SL - 1 - j) * 64 + p];
#pragma unroll
            for (int e = 0; e < 8; ++e) { const float br = Bbr[p * 16 + ci0 + e], bi = Bbi[p * 16 + ci0 + e]; v[e] = (n < 64) ? (pr * br - pi * bi) : (pr * bi + pi * br); }
        } else {
#pragma unroll
            for (int e = 0; e < 8; ++e) v[e] = 0.f; }
        u32x4 w; w.x = cvt_pk_bf16(v[0], v[1]); w.y = cvt_pk_bf16(v[2], v[3]); w.z = cvt_pk_bf16(v[4], v[5]); w.w = cvt_pk_bf16(v[6], v[7]);
        *(u32x4*)(gm + (size_t)n * 512 + kk0) = w; }
    if (tid < 64) { AL[(g * 64 + tid) * 2] = pwr[SL * 64 + tid]; AL[(g * 64 + tid) * 2 + 1] = pwi[SL * 64 + tid]; }
    __syncthreads();
}

__device__ __forceinline__ void gmlp_unit(int unit, LAS unsigned char* lds, const bf16_t* U, const bf16_t* V, const u64* vst, const bf16_t* GW, const float* gb, bf16_t* MIX, int tid) {
    const int g = unit & 3, t0 = (unit >> 2) * 128, lane = tid & 63, wid = tid >> 6;
    LAS bf16_t* vT = (LAS bf16_t*)lds;
    const int il = lane & 15, kq = lane >> 4, i = wid * 16 + il;
    u32x4 raw[4]; u64 st[4][2];
#pragma unroll
    for (int e = 0; e < 4; ++e) { const int q = tid + 512 * e, j = q >> 4, c8 = (q & 15) * 8;
        raw[e] = *(const u32x4*)(V + (size_t)(t0 + j) * 512 + g * 128 + c8); st[e][0] = vst[2 * (t0 + j)]; st[e][1] = vst[2 * (t0 + j) + 1]; }
    bf16x8 wf[4];
#pragma unroll
    for (int ks = 0; ks < 4; ++ks) wf[ks] = *(const bf16x8*)(GW + (size_t)g * 16384 + (size_t)i * 128 + ks * 32 + kq * 8);
    const float bias = gb[g * 128 + i];
    const size_t tok = (size_t)(t0 + i);
    u32x2 uu[8];
#pragma unroll
    for (int nt = 0; nt < 8; ++nt) uu[nt] = *(const u32x2*)(U + tok * 512 + g * 128 + nt * 16 + kq * 4);
#pragma unroll
    for (int e = 0; e < 4; ++e) { const int q = tid + 512 * e, j = q >> 4, c8 = (q & 15) * 8;
        const float s = (float)(long long)st[e][0] * (1.0f / 16777216.0f), ss = (float)(long long)st[e][1] * (1.0f / 16777216.0f), mean = s * (1.0f / 512.0f), var = ss * (1.0f / 512.0f) - mean * mean, rstd = rsqrtf(fmaxf(var, 0.f) + EPS);
        const float v[8] = {bflo(raw[e].x), bfhi(raw[e].x), bflo(raw[e].y), bfhi(raw[e].y), bflo(raw[e].z), bfhi(raw[e].z), bflo(raw[e].w), bfhi(raw[e].w)};
        const int jo = ((((j >> 3) ^ (c8 >> 3)) & 15) << 3) + (j & 7);
#pragma unroll
        for (int k = 0; k < 8; k += 2) { const unsigned pk = cvt_pk_bf16((v[k] - mean) * rstd, (v[k + 1] - mean) * rstd); vT[(c8 + k) * 136 + jo] = (bf16_t)(pk & 0xffffu); vT[(c8 + k + 1) * 136 + jo] = (bf16_t)(pk >> 16); } }
    __syncthreads();
#pragma unroll 2
    for (int nt = 0; nt < 8; ++nt) { f32x4 a = {0.f, 0.f, 0.f, 0.f}; const int c = nt * 16 + il;
#pragma unroll
        for (int ks = 0; ks < 4; ++ks) { const bf16x8 vf = *(const LAS bf16x8*)(vT + c * 136 + ((((ks * 4 + kq) ^ (c >> 3)) & 15) << 3)); a = __builtin_amdgcn_mfma_f32_16x16x32_bf16(vf, wf[ks], a, 0, 0, 0); }
        u32x2 o; o.x = cvt_pk_bf16(bflo(uu[nt].x) * (a[0] + bias), bfhi(uu[nt].x) * (a[1] + bias)); o.y = cvt_pk_bf16(bflo(uu[nt].y) * (a[2] + bias), bfhi(uu[nt].y) * (a[3] + bias));
        *(u32x2*)(MIX + tok * 1024 + g * 128 + nt * 16 + kq * 4) = o; }
    __syncthreads();
}
__device__ __forceinline__ void conv_units(int first, int stride, int nunits, LAS unsigned char* lds, const bf16_t* H, const float* cw, const float* cb, const float* lng, const float* lnb, bf16_t* MIX, int tid) {
    if (first >= nunits) return;
    const int lane = tid & 63, wid = tid >> 6;
    LAS bf16_t* hin = (LAS bf16_t*)lds;
    LAS float* cout = (LAS float*)(lds + 62 * 1024);
    float w[31];
#pragma unroll
    for (int k = 0; k < 31; ++k) w[k] = cw[k * 512 + tid];
    const float bias = cb[tid];
    const f32x4 g0 = *(const f32x4*)(lng + lane * 8), g1 = *(const f32x4*)(lng + lane * 8 + 4), b0 = *(const f32x4*)(lnb + lane * 8), b1 = *(const f32x4*)(lnb + lane * 8 + 4);
    u32x4 pre[8];
#define CONV_PREFETCH(unit_) { const int t0_ = (unit_) * 32, s0_ = t0_ % SEQ; _Pragma("unroll") for (int e = 0; e < 8; ++e) { const int q = tid + 512 * e, r = q >> 6, c8 = (q & 63) * 8; \
        u32x4 v_ = {0u, 0u, 0u, 0u}; if (q < 62 * 64 && s0_ - 30 + r >= 0) v_ = *(const u32x4*)(H + (size_t)(t0_ - 30 + r) * 512 + c8); pre[e] = v_; } }
    CONV_PREFETCH(first);
#pragma unroll 1
    for (int unit = first; unit < nunits; unit += stride) {
        const int t0 = unit * 32;
#pragma unroll
        for (int e = 0; e < 8; ++e) { const int q = tid + 512 * e; if (q < 62 * 64) *(LAS u32x4*)(hin + (q >> 6) * 512 + (q & 63) * 8) = pre[e]; }
        if (unit + stride < nunits) CONV_PREFETCH(unit + stride);
        __syncthreads();
#pragma unroll 1
        for (int tg = 0; tg < 4; ++tg) { float x[38];
#pragma unroll
            for (int r = 0; r < 38; ++r) x[r] = bf2f(hin[(tg * 8 + r) * 512 + tid]);
#pragma unroll
            for (int o = 0; o < 8; ++o) { float a = bias;
#pragma unroll
                for (int k = 0; k < 31; ++k) a += w[k] * x[o + k];
                cout[(tg * 8 + o) * 516 + tid] = a; } }
        __syncthreads();
#pragma unroll 1
        for (int tt = 0; tt < 4; ++tt) { const int row = wid * 4 + tt; const f32x4 v0 = *(const LAS f32x4*)(cout + row * 516 + lane * 8), v1 = *(const LAS f32x4*)(cout + row * 516 + lane * 8 + 4);
            const float mean = wave_sum((v0[0] + v0[1]) + (v0[2] + v0[3]) + (v1[0] + v1[1]) + (v1[2] + v1[3])) * (1.0f / 512.0f);
            const f32x4 d0 = v0 - mean, d1 = v1 - mean;
            const float var = wave_sum((d0[0] * d0[0] + d0[1] * d0[1]) + (d0[2] * d0[2] + d0[3] * d0[3]) + (d1[0] * d1[0] + d1[1] * d1[1]) + (d1[2] * d1[2] + d1[3] * d1[3])) * (1.0f / 512.0f);
            const float rstd = rsqrtf(var + EPS);
            f32x4 y0 = d0 * rstd * g0 + b0, y1 = d1 * rstd * g1 + b1;
#pragma unroll
            for (int e = 0; e < 4; ++e) { y0[e] = silu_f(y0[e]); y1[e] = silu_f(y1[e]); }
            *(u32x4*)(MIX + (size_t)(t0 + row) * 1024 + 512 + lane * 8) = pack8(y0, y1); }
    }
    __syncthreads();
#undef CONV_PREFETCH
}

struct Args { const float* in[33]; float* out; unsigned char* ws; int ph_lo, ph_hi; };
constexpr int NPHASE = 28;

typedef const __attribute__((address_space(4))) Args* KArgP;
__device__ __forceinline__ KArgP fresh_args() { KArgP p = (KArgP)__builtin_amdgcn_kernarg_segment_ptr(); asm volatile("" : "+s"(p)); return p; }

__global__ void __launch_bounds__(512, 2) trunk_fwd(Args args_unused) {
    extern __shared__ __attribute__((aligned(16))) unsigned char lds_raw[];
    LAS unsigned char* lds = (LAS unsigned char*)lds_raw;
    cg::grid_group grid = cg::this_grid();
    { volatile LAS unsigned* MISC0 = (volatile LAS unsigned*)(lds + MISC_OFF); if (threadIdx.x < 32) MISC0[threadIdx.x] = 0u; }
    __syncthreads();
    int lo, hi;
    { KArgP ap = fresh_args(); lo = ap->ph_lo; hi = ap->ph_hi; }
#if !MK_MULTI && !MK_CGSYNC
    { KArgP ap = fresh_args(); (void)xcd_barrier_post((unsigned*)(ap->ws + WS_BAR), (volatile LAS unsigned*)(lds + MISC_OFF) + 8); }
#endif
    int nsync = 0;
#if MK_MULTI
#define SEAM(k) do { } while (0)
#elif MK_CGSYNC
#define SEAM(k) do { if (rep_ + 1 == nrep_ && (k) + 1 < hi) grid.sync(); } while (0)
#else
#define SEAM(k) do { if (rep_ + 1 == nrep_ && (k) + 1 < hi) { if (hi > 1000) grid.sync(); else { KArgP ap_ = fresh_args(); XcdBarrier xb_; xb_.bar = (unsigned*)(ap_->ws + WS_BAR); xb_.x = xb_xcc_id(); xb_.st = (volatile LAS unsigned*)(lds + MISC_OFF) + 8; xcd_barrier(xb_); if (BARPROBE) xcd_barrier(xb_); } ++nsync; } } while (0)
#endif
#ifndef ONLY
#define ONLY -1
#endif
#ifndef REPMASK
#define REPMASK 0
#endif
#define PHASE(id, k) if ((ONLY < 0 || ONLY == (id)) && lo <= (k) && (k) < hi) for (int rep_ = 0, nrep_ = (((REPMASK) >> (id)) & 1) ? 2 : 1; rep_ < nrep_; ++rep_)
    (void)nsync;
#define LOCALS KArgP ap = fresh_args(); unsigned char* ws = ap->ws; float* out = ap->out; const float* x_in = ap->in[0]; \
    int tid_ = threadIdx.x, G_ = gridDim.x, bx_ = blockIdx.x; asm volatile("" : "+v"(tid_), "+s"(G_), "+s"(bx_)); \
    const int tid = tid_, lane = tid & 63, wave = __builtin_amdgcn_readfirstlane(tid >> 6), G = G_, bx = bx_, gw = bx * 8 + wave, NGW = G * 8; \
    bf16_t* XB = (bf16_t*)(ws + WS_XB); u64* SS = (u64*)(ws + WS_SS); u64* VST = (u64*)(ws + WS_VST); bf16_t* QO = (bf16_t*)(ws + WS_QO); \
    bf16_t* HM = (bf16_t*)(ws + WS_HM); bf16_t* MEMN = (bf16_t*)(ws + WS_MEMN); bf16_t* KL = (bf16_t*)(ws + WS_KL); bf16_t* VL = (bf16_t*)(ws + WS_VL); \
    bf16_t* U = (bf16_t*)(ws + WS_U); bf16_t* V = (bf16_t*)(ws + WS_V); bf16_t* H = (bf16_t*)(ws + WS_H); bf16_t* MIX = (bf16_t*)(ws + WS_MIX); \
    bf16_t* AC = (bf16_t*)(ws + WS_ACOMB); float* XL = (float*)(ws + WS_XLOC); bf16_t* Y = (bf16_t*)(ws + WS_Y); u64* SSa = SS + (size_t)(3 * l) * T; \
    (void)out; (void)x_in; (void)lane; (void)gw; (void)NGW; (void)XB; (void)VST; (void)QO; (void)HM; (void)MEMN; (void)KL; (void)VL; (void)U; (void)V; (void)H; (void)MIX; (void)AC; (void)XL; (void)Y; (void)SSa; (void)wave;

    PHASE(0, 0) { const int l = 0; LOCALS
        { f32x4* z = (f32x4*)(SS + T); const int n4 = 7 * T * 2 / 4; for (int i = bx * 512 + tid; i < n4; i += G * 512) z[i] = (f32x4){0.f, 0.f, 0.f, 0.f};
          f32x4* z2 = (f32x4*)VST; const int m4 = 2 * T * 2 / 4; for (int i = bx * 512 + tid; i < m4; i += G * 512) z2[i] = (f32x4){0.f, 0.f, 0.f, 0.f}; }
        LAS float* scr = (LAS float*)(lds + wave * 16384);
#define CONVJOB(Wp, K_, ldn_, cs_, nc_, WTp, mode_, roff_, gain_) { const int nblk_ = (nc_) / 128, cnt_ = ((K_) / 64) * nblk_; \
            if (r >= 0 && r < cnt_) { cp.W = (Wp); cp.WT = (bf16_t*)(WTp); cp.gain = (gain_); cp.K = (K_); cp.ldn = (ldn_); cp.cs = (cs_); cp.nblk = nblk_; cp.mode = (mode_); cp.roff = (roff_); cp.r = r; } r -= cnt_; }
#define CONVLOOKUP(cp, it_) { int r = (it_); \
            CONVJOB(ap->in[3], 1024, 2048, 0, 1024, ws + WS_WIN0, 0, 0, ap->in[2]); \
            CONVJOB(ap->in[3], 1024, 2048, 1024, 512, ws + WS_WIN0, 1, 1024, ap->in[2]); \
            CONVJOB(ap->in[3], 1024, 2048, 1536, 512, ws + WS_WIN0, 2, 1024, ap->in[2]); \
            CONVJOB(ap->in[10], 1024, 1024, 0, 1024, ws + WS_WOUT0, 0, 0, nullptr); \
            CONVJOB(ap->in[12], 1024, 512, 0, 512, ws + WS_WOIN, 0, 0, ap->in[11]); \
            CONVJOB(ap->in[21], 512, 2048, 0, 1024, ws + WS_WOOUT, 1, 0, nullptr); \
            CONVJOB(ap->in[21], 512, 2048, 1024, 1024, ws + WS_WOOUT, 2, 0, nullptr); \
            _Pragma("unroll") for (int l2 = 0; l2 < 2; ++l2) { \
                CONVJOB(ap->in[25] + (size_t)l2 * D * D, 1024, 1024, 0, 1024, ws + WS_WK + l2 * WSQ_L, 0, 0, ap->in[23] + l2 * D); \
                CONVJOB(ap->in[26] + (size_t)l2 * D * D, 1024, 1024, 0, 1024, ws + WS_WV + l2 * WSQ_L, 0, 0, ap->in[23] + l2 * D); \
                CONVJOB(ap->in[27] + (size_t)l2 * D * D, 1024, 1024, 0, 1024, ws + WS_WO + l2 * WSQ_L, 0, 0, nullptr); \
                CONVJOB(ap->in[29] + (size_t)l2 * D * FH, 1024, FH, 0, FH, ws + WS_WGU + l2 * WGU_L, 1, 0, ap->in[28] + l2 * D); \
                CONVJOB(ap->in[30] + (size_t)l2 * D * FH, 1024, FH, 0, FH, ws + WS_WGU + l2 * WGU_L, 2, 0, ap->in[28] + l2 * D); \
                CONVJOB(ap->in[31] + (size_t)l2 * FH * D, FH, 1024, 0, 1024, ws + WS_WD + l2 * WD_L, 0, 0, nullptr); } }
        constexpr int NITEMS = (512 + 256 + 256 + 512 + 256 + 256 + 256 + 2 * (3 * 512 + 3 * 1408)) / 4;
        for (int it = gw; it < NITEMS; it += NGW) { ConvP c0{}; f32x4 v0[32]; { ConvP cp{}; CONVLOOKUP(cp, it); c0 = cp; } conv_load(c0, v0, lane); conv_store(c0, v0, scr, lane); }
        { const int nb5 = (G > 64) ? G - 32 : G;
          if (bx < nb5) { const int NW5 = nb5 * 8;
              for (int m = gw * 4; m < T; m += NW5 * 4) rows_to_bf16<false, 4>(x_in + (size_t)m * D, XB + (size_t)m * D, SS + m, lane);
              for (int m = gw * 4; m < MT; m += NW5 * 4) rows_to_bf16<true, 4>(ap->in[1] + (size_t)m * D, MEMN + (size_t)m * D, nullptr, lane); } }
        for (int i = bx * 512 + tid; i < 2 * D * D / 8; i += G * 512) { const int l2 = i / (D * D / 8), e = (i % (D * D / 8)) * 8, k = e >> 10; const float gk = ap->in[22][l2 * D + k];
            const f32x4 a = *(const f32x4*)(ap->in[24] + (size_t)l2 * D * D + e), b = *(const f32x4*)(ap->in[24] + (size_t)l2 * D * D + e + 4);
            *(u32x4*)((bf16_t*)(ws + WS_WQ) + (size_t)l2 * D * D + e) = pack8(a * gk, b * gk); }
        { bf16_t* GW = (bf16_t*)(ws + WS_GW); const float* w = ap->in[4];
          for (int i = bx * 512 + tid; i < 4 * 128 * 128 / 2; i += G * 512) { const int e = 2 * i, ii = (e >> 7) & 127, jj = e & 127; const bool keep = (jj >> 6) <= (ii >> 6);
              ((unsigned*)GW)[i] = keep ? cvt_pk_bf16(w[e], w[e + 1]) : 0u; } }
        __syncthreads();
        for (int g = G - 1 - bx; g < 32; g += G)
            s5_setup(g, lds, ap->in[13], ap->in[14], ap->in[15], ap->in[16], ap->in[17], ap->in[18], ap->in[19], (bf16_t*)(ws + WS_BT3), (bf16_t*)(ws + WS_GM), (float*)(ws + WS_AL), tid);
        SEAM(0);
    }
#pragma unroll 1
    for (int l = 0; l < 2; ++l) {
        const int pb = 3 + 12 * l;
        if (l == 0) {
            PHASE(2, pb + 0) { LOCALS
                pg8::Gemm g{XB, (const bf16_t*)(ws + WS_WIN0), D, D, D, 1, 0, 0, 0, 0}; pg8::Sched S; S.init(T / 256, 2048 / 256, 1, G, bx);
                { pg8::EpiIn0 E{SSa, U, V, H, VST}; pg8::gemm_phase<MK_ALIGN>(lds, g, S, E, tid); }
                { pg8::Gemm g{MEMN, (const bf16_t*)(ws + WS_WK), D, D, D, 2, 0, 0, (long)D * D, 0}; pg8::Sched S; S.init(MT / 256, D / 256, 2, G, bx);
                  pg8::EpiStore E{KL, D, 2, (long)MT * D, 0, nullptr, 1.0f}; pg8::gemm_phase<MK_ALIGN>(lds, g, S, E, tid); }
                { pg8::Gemm g{MEMN, (const bf16_t*)(ws + WS_WV), D, D, D, 2, 0, 0, (long)D * D, 0}; pg8::Sched S; S.init(MT / 256, D / 256, 2, G, (bx + G / 2) % G);
                  pg8::EpiStore E{VL, D, 2, (long)MT * D, 0, nullptr, 1.0f}; pg8::gemm_phase<MK_ALIGN>(lds, g, S, E, tid); }
                SEAM(pb + 0);
            }
            PHASE(3, pb + 1) { LOCALS
                for (int i = bx; i < 1024; i += G) gmlp_unit(i, lds, U, V, VST, (const bf16_t*)(ws + WS_GW), ap->in[5], MIX, tid);
                conv_units(bx, G, 1024, lds, H, ap->in[6], ap->in[7], ap->in[8], ap->in[9], MIX, tid);
#pragma unroll 1
                for (int l2 = 0; l2 < 2; ++l2) {
                    { pg8::Gemm g{KL + (size_t)l2 * MT * D, (const bf16_t*)(ws + WS_WQ) + (size_t)l2 * D * D, D, D, 256, 4, 256, 256L * D, 256, 0}; pg8::Sched S; S.init(1, 4, 32, G, bx);
                      pg8::EpiStore E{(bf16_t*)(ws + WS_WQK) + (size_t)l2 * 8 * D * D, D, 4, 256L * D, (long)D * D, nullptr, 1.0f}; pg8::gemm_phase<MK_ALIGN>(lds, g, S, E, tid); }
                    { pg8::Gemm g{(const bf16_t*)(ws + WS_WO) + (size_t)l2 * D * D, VL + (size_t)l2 * MT * D, D, D, 256, 4, 256, 0, 256, 256L * D}; pg8::Sched S; S.init(4, 1, 32, G, (bx + G / 2) % G);
                      pg8::EpiStore E{(bf16_t*)(ws + WS_WVO) + (size_t)l2 * 8 * D * D, D, 4, 256, (long)D * D, nullptr, 1.0f}; pg8::gemm_phase<MK_ALIGN>(lds, g, S, E, tid); }
                }
                SEAM(pb + 1);
            }
            PHASE(4, pb + 2) { LOCALS
                pg8::Gemm g{MIX, (const bf16_t*)(ws + WS_WOUT0), D, D, D, 1, 0, 0, 0, 0}; pg8::Sched S; S.init(T / 256, D / 256, 1, G, bx);
                pg8::EpiRes<false> E{XB, SSa + T, 0}; pg8::gemm_phase<MK_ALIGN>(lds, g, S, E, tid);
                SEAM(pb + 2);
            }
        } else {
            PHASE(5, pb + 0) { LOCALS
                pg8::Gemm g{XB, (const bf16_t*)(ws + WS_WOIN), D, D, D, 1, 0, 0, 0, 0}; pg8::Sched S; S.init(T / 256, 512 / 256, 1, G, bx);
                pg8::EpiOin E{SSa, AC}; pg8::gemm_phase<MK_ALIGN>(lds, g, S, E, tid);
                SEAM(pb + 0);
            }
            PHASE(6, pb + 1) { LOCALS
                pg8::Gemm g{AC, (const bf16_t*)(ws + WS_GM), AK, 512, 512, 32, (long)NCH * AK, 0, 256L * 512, 0}; pg8::Sched S; S.init(NCH / 256, 1, 32, G, bx);
                pg8::EpiS5State E{XL}; pg8::gemm_phase<MK_ALIGN>(lds, g, S, E, tid);
                SEAM(pb + 1);
            }
            PHASE(7, pb + 2) { LOCALS
                if (wave == 0) {
#pragma unroll 1
                    for (int idx = bx * 64 + lane; idx < NB * 32 * 64; idx += G * 64) { const int p = idx & 63, g = (idx >> 6) & 31, b = idx >> 11;
                        const float* AL = (const float*)(ws + WS_AL); const float ar = AL[(g * 64 + p) * 2], ai = AL[(g * 64 + p) * 2 + 1];
                        const float* xl = XL + (size_t)g * NCH * 128 + (size_t)(b * (SEQ / SL)) * 128; bf16_t* ac = AC + (size_t)g * NCH * AK + (size_t)(b * (SEQ / SL)) * AK + 512;
                        float xr = 0.f, xi = 0.f;
#pragma unroll 1
                        for (int c0 = 0; c0 < SEQ / SL; c0 += 32) { float lr[32], li[32];
#pragma unroll
                            for (int i = 0; i < 32; ++i) { lr[i] = xl[(size_t)(c0 + i) * 128 + p]; li[i] = xl[(size_t)(c0 + i) * 128 + 64 + p]; }
#pragma unroll
                            for (int i = 0; i < 32; ++i) { const unsigned pk = cvt_pk_bf16(xr, xi); ac[(size_t)(c0 + i) * AK + p] = (bf16_t)(pk & 0xffffu); ac[(size_t)(c0 + i) * AK + 64 + p] = (bf16_t)(pk >> 16);
                                const float nr = ar * xr - ai * xi + lr[i], ni = ar * xi + ai * xr + li[i]; xr = nr; xi = ni; } }
                    }
                }
                SEAM(pb + 2);
            }
            PHASE(8, pb + 3) { LOCALS
                pg8::Gemm g{AC, (const bf16_t*)(ws + WS_BT3), AK, AK, AK, 32, (long)NCH * AK, 0, 512L * AK, 0}; pg8::Sched S; S.init(NCH / 256, 2, 32, G, bx);
                pg8::EpiS5Out E{AC, ap->in[20], Y}; pg8::gemm_phase<MK_ALIGN>(lds, g, S, E, tid);
                SEAM(pb + 3);
            }
            PHASE(9, pb + 4) { LOCALS
                pg8::Gemm g{Y, (const bf16_t*)(ws + WS_WOOUT), 512, 512, 512, 1, 0, 0, 0, 0}; pg8::Sched S; S.init(T / 256, 2048 / 256, 1, G, bx);
                pg8::EpiRes<true> E{XB, SSa + T, 0}; pg8::gemm_phase<MK_ALIGN>(lds, g, S, E, tid);
                SEAM(pb + 4);
            }
        }
        PHASE(10, pb + 5) { LOCALS
            pg8::Gemm g{XB, (const bf16_t*)(ws + WS_WQK) + (size_t)l * 8 * D * D, D, D, D, 8, (long)SEQ * D, 0, (long)D * D, 0}; pg8::Sched S; S.init(SEQ / 256, D / 256, 8, G, bx);
            pg8::EpiSoftmax E{QO, SSa + T}; pg8::gemm_phase<true>(lds, g, S, E, tid);
            SEAM(pb + 5);
        }
        PHASE(13, pb + 6) { LOCALS
            pg8::Gemm g{QO, (const bf16_t*)(ws + WS_WVO) + (size_t)l * 8 * D * D, D, D, D, 8, (long)SEQ * D, 0, (long)D * D, 0}; pg8::Sched S; S.init(SEQ / 256, D / 256, 8, G, bx);
            pg8::EpiRes<false> E{XB, SSa + 2 * T, SEQ}; pg8::gemm_phase<MK_ALIGN>(lds, g, S, E, tid);
            SEAM(pb + 6);
        }
        PHASE(14, pb + 9) { LOCALS
            pg8::Gemm g{XB, (const bf16_t*)(ws + WS_WGU + l * WGU_L), D, D, D, 1, 0, 0, 0, 0}; pg8::Sched S; S.init(T / 256, 2 * FH / 256, 1, G, bx);
            pg8::EpiFfn1 E{SSa + 2 * T, HM}; pg8::gemm_phase<MK_ALIGN>(lds, g, S, E, tid);
            SEAM(pb + 9);
        }
        PHASE(15, pb + 10) { LOCALS
            pg8::Gemm g{HM, (const bf16_t*)(ws + WS_WD + l * WD_L), FH, FH, FH, 1, 0, 0, 0, 0}; pg8::Sched S; S.init(T / 256, D / 256, 1, G, bx);
            pg8::EpiRes<false> E{XB, SSa + 3 * T, 0}; pg8::gemm_phase<MK_ALIGN>(lds, g, S, E, tid);
            SEAM(pb + 10);
        }
    }
    PHASE(16, 27) { const int l = 0; LOCALS
        const u64* ssf = SS + (size_t)6 * T; const float* gf = ap->in[32];
        const f32x4 ga = *(const f32x4*)(gf + 8 * lane), gb = *(const f32x4*)(gf + 8 * lane + 4), gc = *(const f32x4*)(gf + 512 + 8 * lane), gd = *(const f32x4*)(gf + 512 + 8 * lane + 4);
        for (int m = gw * 4; m < T; m += NGW * 4) { u32x4 v[4][2]; float rs[4];
#pragma unroll
            for (int r = 0; r < 4; ++r) { rs[r] = rsqrtf(fx_get(ssf + m + r) * (1.0f / D) + EPS); const bf16_t* xr = XB + (size_t)(m + r) * D + 8 * lane; v[r][0] = *(const u32x4*)xr; v[r][1] = *(const u32x4*)(xr + 512); }
#pragma unroll
            for (int r = 0; r < 4; ++r) { float* orow = out + (size_t)(m + r) * D + 8 * lane; f32x4 a0, a1, b0, b1; pg8::unpack8(v[r][0], a0, a1); pg8::unpack8(v[r][1], b0, b1);
                *(f32x4*)orow = a0 * rs[r] * ga; *(f32x4*)(orow + 4) = a1 * rs[r] * gb; *(f32x4*)(orow + 512) = b0 * rs[r] * gc; *(f32x4*)(orow + 516) = b1 * rs[r] * gd; } }
    }
}

extern "C" void kernel_launch(void* const* d_in, const int* in_sizes, int n_in, void* d_out, int out_size, void* d_ws, size_t ws_size, hipStream_t stream) {
    static int grid = 0;
    if (grid == 0) {
        if (n_in != 33 || in_sizes[0] != T * D || out_size != T * D || ws_size < WS_END) { fprintf(stderr, "kernel_launch: unexpected shapes (n_in %d, in0 %d, out %d, ws %zu < %zu)\n", n_in, n_in > 0 ? in_sizes[0] : -1, out_size, ws_size, (size_t)WS_END); grid = -1; return; }
        int dev = 0, cus = 0, per_cu = 0;
        hipGetDevice(&dev); hipDeviceGetAttribute(&cus, hipDeviceAttributeMultiprocessorCount, dev);
        if (hipFuncSetAttribute((const void*)trunk_fwd, hipFuncAttributeMaxDynamicSharedMemorySize, LDS_BYTES) != hipSuccess) { fprintf(stderr, "kernel_launch: hipFuncSetAttribute failed\n"); grid = -1; return; }
        if (hipOccupancyMaxActiveBlocksPerMultiprocessor(&per_cu, (const void*)trunk_fwd, 512, LDS_BYTES) != hipSuccess || per_cu < 1) { fprintf(stderr, "kernel_launch: occupancy query says %d\n", per_cu); per_cu = 1; }
        (void)hipGetLastError();
        grid = cus * 1;
        if (grid <= 0) grid = 256;
    }
    if (grid < 0) return;
    Args a{};
    for (int i = 0; i < 33; ++i) a.in[i] = (const float*)d_in[i];
    a.out = (float*)d_out; a.ws = (unsigned char*)d_ws;
#if !MK_MULTI && !MK_CGSYNC
    (void)hipMemsetAsync((char*)d_ws + WS_BAR, 0, XCD_BAR_WORDS * 4, stream);
#endif
#if MK_MULTI
    for (int p = 0; p < NPHASE; ++p) {
        if (p == 1 || p == 2 || p == 6 || p == 7 || p == 10 || p == 11 || p == 14 || p == 22 || p == 23 || p == 26) continue;
        a.ph_lo = p; a.ph_hi = p + 1; void* kargs[] = {&a};
        hipError_t e = hipLaunchCooperativeKernel((const void*)trunk_fwd, dim3(grid), dim3(512), kargs, LDS_BYTES, stream);
        if (e != hipSuccess) { fprintf(stderr, "kernel_launch: launch of phase %d failed: %s\n", p, hipGetErrorString(e)); break; }
    }
#else
    a.ph_lo = 0; a.ph_hi = NPHASE; void* kargs[] = {&a};
    hipError_t e = hipLaunchCooperativeKernel((const void*)trunk_fwd, dim3(grid), dim3(512), kargs, LDS_BYTES, stream);
    if (e != hipSuccess) fprintf(stderr, "kernel_launch: cooperative launch failed: %s (grid %d)\n", hipGetErrorString(e), grid);
#endif
}
```

```cpp
#include <hip/hip_runtime.h>
#include <hip/hip_cooperative_groups.h>
#include <cstdio>
#include <cstdint>
namespace cg = cooperative_groups;

#ifndef MK_MULTI
#define MK_MULTI 0
#endif
#ifndef MK_ALIGN
#define MK_ALIGN true
#endif
#ifndef BARPROBE
#define BARPROBE 0
#endif
#ifndef MK_CGSYNC
#define MK_CGSYNC 0
#endif

#define LAS __attribute__((address_space(3)))
typedef unsigned short bf16_t;
typedef short bf16x8 __attribute__((ext_vector_type(8)));
typedef float f32x4 __attribute__((ext_vector_type(4)));
typedef float f32x2 __attribute__((ext_vector_type(2)));
typedef unsigned u32x4 __attribute__((ext_vector_type(4)));
typedef unsigned u32x2 __attribute__((ext_vector_type(2)));

constexpr int T = 32768, D = 1024, SEQ = 4096, NB = 8, MT = 2048, FH = 2816;
constexpr float EPS = 1e-6f;
constexpr int SL = 32;
constexpr int NCH = T / SL;
constexpr int AK = SL * 16 + 128;

constexpr size_t MiB = 1u << 20;
constexpr size_t WS_WIN0 = 0, WS_WOUT0 = 4 * MiB, WS_WOIN = 6 * MiB, WS_WOOUT = 7 * MiB, WS_WQ = 9 * MiB, WS_WK = 13 * MiB, WS_WV = 17 * MiB, WS_WO = 21 * MiB;
constexpr size_t WS_WGU = 25 * MiB, WS_WD = 47 * MiB, WS_GW = 58 * MiB, WS_AL = 59 * MiB, WS_BT3 = 60 * MiB, WS_GM = 80 * MiB, WS_MEMN = 88 * MiB, WS_KL = 92 * MiB, WS_VL = 100 * MiB;
constexpr size_t WS_XB = 110 * MiB, WS_QO = 174 * MiB, WS_P = 238 * MiB, WS_R0 = 302 * MiB;
constexpr size_t WS_WQK = WS_P, WS_WVO = WS_P + 32 * MiB;
constexpr size_t WS_HM = WS_R0, WS_U = WS_R0, WS_V = WS_R0 + 32 * MiB, WS_H = WS_R0 + 64 * MiB, WS_MIX = WS_R0 + 96 * MiB;
constexpr size_t WS_ACOMB = WS_R0, WS_XLOC = WS_R0 + 40 * MiB, WS_Y = WS_R0 + 56 * MiB;
constexpr size_t WS_SS = WS_R0 + 176 * MiB, WS_VST = WS_SS + 2 * MiB, WS_BAR = WS_VST + 1 * MiB, WS_END = WS_BAR + 1 * MiB;
constexpr size_t WGU_L = (size_t)2 * FH * D * 2, WD_L = (size_t)D * FH * 2, WSQ_L = (size_t)D * D * 2;

constexpr int RING_BYTES = 131072, XCH_OFF = RING_BYTES, MISC_OFF = RING_BYTES + 8192, LDS_BYTES = 147456;

__device__ __forceinline__ unsigned cvt_pk_bf16(float lo, float hi) { unsigned r; asm volatile("v_cvt_pk_bf16_f32 %0, %1, %2" : "=v"(r) : "v"(lo), "v"(hi)); return r; }
__device__ __forceinline__ float bf2f(unsigned short b) { return __builtin_bit_cast(float, (unsigned)b << 16); }
__device__ __forceinline__ float bflo(unsigned w) { return __builtin_bit_cast(float, w << 16); }
__device__ __forceinline__ float bfhi(unsigned w) { return __builtin_bit_cast(float, w & 0xffff0000u); }
__device__ __forceinline__ float sigmoid_f(float x) { return __builtin_amdgcn_rcpf(1.0f + __expf(-x)); }
__device__ __forceinline__ float silu_f(float x) { return x * sigmoid_f(x); }
__device__ __forceinline__ float gelu_f(float x) { return x * sigmoid_f(1.5957691216f * (x + 0.044715f * x * x * x)); }
typedef unsigned long long u64;
__device__ __forceinline__ void fx_add(u64* p, float q) { atomicAdd(p, (u64)(long long)(q * 16777216.0f)); }
__device__ __forceinline__ float fx_get(const u64* p) { return (float)(long long)(*p) * (1.0f / 16777216.0f); }
__device__ __forceinline__ float wave_sum(float v) {
#pragma unroll
    for (int o = 1; o < 64; o <<= 1) v += __shfl_xor(v, o);
    return v;
}
__device__ __forceinline__ u32x4 pack8(f32x4 a, f32x4 b) { u32x4 w; w.x = cvt_pk_bf16(a[0], a[1]); w.y = cvt_pk_bf16(a[2], a[3]); w.z = cvt_pk_bf16(b[0], b[1]); w.w = cvt_pk_bf16(b[2], b[3]); return w; }

namespace pg8 {
constexpr int BM = 256, BK = 64, HALF = 128, HTB = HALF * BK * 2, NXCD = 8, WGM = 4;
__device__ __forceinline__ int lds_byte(int r, int c) { const int st = (r >> 4) * 2 + (c >> 5), rr = r & 15, cc = c & 31, ob = rr * 64 + cc * 2; return st * 1024 + (ob ^ (((ob >> 9) & 1) << 5)); }
__device__ __forceinline__ void stage_rc(int b, int& R, int& C) { const int st = b / 1024, sb = b % 1024, swz = sb ^ (((sb >> 9) & 1) << 5); R = (st >> 1) * 16 + swz / 64; C = (st & 1) * 32 + (swz % 64) / 2; }
__device__ __forceinline__ int perm32(int rho) { const int n = rho >> 4, i = rho & 15; return 8 * (i >> 2) + 4 * n + (i & 3); }

struct Unit { int pm, pn, z; };
struct Gemm { const bf16_t* A; const bf16_t* Bt; int lda, ldb, K, nz0; long sAz0, sAz1, sBz0, sBz1; };
struct Sched {
    int nM, nN, per, total, G, c;
    __device__ __forceinline__ void init(int nM_, int nN_, int nz, int G_, int c_) { nM = nM_; nN = nN_; per = nM_ * nN_; total = per * nz; G = G_; c = c_; }
    __device__ __forceinline__ bool next(int i, Unit& u) const {
        const long L = (long)i * G + c; if (L >= total) return false;
        const int z = (int)(L / per); int wgid = (int)(L % per);
        { const int q = per / NXCD, r = per % NXCD, xcd = wgid % NXCD, off = wgid / NXCD; wgid = (xcd < r ? xcd * (q + 1) : r * (q + 1) + (xcd - r) * q) + off; }
        const int nig = WGM * nN, gid = wgid / nig, fm = gid * WGM, gsz = (nM - fm) < WGM ? (nM - fm) : WGM;
        u.pm = fm + ((wgid % nig) % gsz); u.pn = (wgid % nig) / gsz; u.z = z; return true;
    }
};

template <bool ALIGN, class Epi>
__device__ __forceinline__ void gemm_phase(LAS unsigned char* lds, const Gemm g, const Sched& S, const Epi& E, const int tid) {
    const int wid = __builtin_amdgcn_readfirstlane(tid >> 6), lane = tid & 63, wr = wid >> 2, wc = wid & 3, fr = lane & 15, fq = lane >> 4;
    const int nt = g.K / BK;
    unsigned voffA[2], voffB[2];
#pragma unroll
    for (int i = 0; i < 2; ++i) { int R, C; stage_rc(tid * 16 + i * 8192, R, C); const int Rb = (R & ~31) + perm32(R & 31);
        voffA[i] = (unsigned)(R * g.lda + C) * 2u; voffB[i] = (unsigned)(Rb * g.ldb + C) * 2u; }
    const size_t kstep = (size_t)(BK * 2);
    const size_t hsA = (size_t)HALF * g.lda * 2, hsB = (size_t)HALF * g.ldb * 2;
    const unsigned ldsw = (unsigned)wid * 1024u;
    const int aoff = lds_byte(wr * 64 + fr, fq * 8), boff = lds_byte(wc * 32 + fr, fq * 8);
#define PG8_SA(b, h) (((b) * 2 + (h)) * HTB)
#define PG8_SB(b, h) ((4 + (b) * 2 + (h)) * HTB)
#define PG8_STAGE(bufoff, gbase, voff) do { _Pragma("unroll") for (int _i = 0; _i < 2; ++_i) \
        __builtin_amdgcn_global_load_lds((const unsigned*)((const char*)(gbase) + (voff)[_i]), (LAS unsigned*)(lds + (bufoff) + ldsw + _i * 8192), 16, 0, 0); } while (0)
#define PG8_LDA(dst, b, h) do { _Pragma("unroll") for (int m = 0; m < 4; ++m) _Pragma("unroll") for (int k = 0; k < 2; ++k) dst[m][k] = *(const LAS bf16x8*)(lds + PG8_SA(b, h) + aoff + m * 2048 + k * 1024); } while (0)
#define PG8_LDB(dst, b, h) do { _Pragma("unroll") for (int n = 0; n < 2; ++n) _Pragma("unroll") for (int k = 0; k < 2; ++k) dst[n][k] = *(const LAS bf16x8*)(lds + PG8_SB(b, h) + boff + n * 2048 + k * 1024); } while (0)
#define PG8_MMA(ai, bj, At, Bt) do { __builtin_amdgcn_s_setprio(1); _Pragma("unroll") for (int m = 0; m < 4; ++m) _Pragma("unroll") for (int n = 0; n < 2; ++n) _Pragma("unroll") for (int k = 0; k < 2; ++k) \
        acc[ai][bj][m][n] = __builtin_amdgcn_mfma_f32_16x16x32_bf16(Bt[n][k], At[m][k], acc[ai][bj][m][n], 0, 0, 0); __builtin_amdgcn_s_setprio(0); } while (0)
#define PG8_WAIT_V(n) asm volatile("s_waitcnt vmcnt(" #n ")" ::: "memory")
#define PG8_WAIT_L(n) asm volatile("s_waitcnt lgkmcnt(" #n ")" ::: "memory")
#define PG8_BAR __builtin_amdgcn_s_barrier()
#define PG8_SCHED __builtin_amdgcn_sched_barrier(0)
#define PG8_UA(u) ((const char*)g.A + 2 * ((size_t)((u).z % g.nz0) * g.sAz0 + (size_t)((u).z / g.nz0) * g.sAz1 + (size_t)(u).pm * BM * g.lda))
#define PG8_UB(u) ((const char*)g.Bt + 2 * ((size_t)((u).z % g.nz0) * g.sBz0 + (size_t)((u).z / g.nz0) * g.sBz1 + (size_t)(u).pn * BM * g.ldb))
    Unit cur, nxt; int ui = 0;
    if (!S.next(0, cur)) return;
    f32x4 acc[2][2][4][2];
#pragma unroll
    for (int a = 0; a < 2; ++a)
#pragma unroll
        for (int b = 0; b < 2; ++b)
#pragma unroll
            for (int m = 0; m < 4; ++m)
#pragma unroll
                for (int n = 0; n < 2; ++n) acc[a][b][m][n] = (f32x4){0.f, 0.f, 0.f, 0.f};
    bf16x8 At[4][2], B0[2][2], B1[2][2];
    const char* cA = PG8_UA(cur); const char* cB = PG8_UB(cur);
    PG8_STAGE(PG8_SB(0, 0), cB, voffB); PG8_STAGE(PG8_SB(0, 1), cB + hsB, voffB); PG8_STAGE(PG8_SA(0, 0), cA, voffA); PG8_STAGE(PG8_SA(0, 1), cA + hsA, voffA);
    if (wr == 1) PG8_BAR;
    PG8_WAIT_V(2); PG8_BAR;
    PG8_STAGE(PG8_SB(1, 0), cB + kstep, voffB); PG8_STAGE(PG8_SA(1, 0), cA + kstep, voffA); PG8_STAGE(PG8_SB(1, 1), cB + hsB + kstep, voffB);
    PG8_WAIT_V(6); PG8_BAR;
    for (;;) {
        const bool has_next = S.next(ui + 1, nxt);
        const char* nA = has_next ? PG8_UA(nxt) : cA; const char* nB = has_next ? PG8_UB(nxt) : cB;
        for (int t = 0; t < nt; t += 2) {
            const bool last = (t == nt - 2);
            const char* a1 = cA + (size_t)(t + 1) * kstep;
            const char* a2 = last ? nA : cA + (size_t)(t + 2) * kstep; const char* b2 = last ? nB : cB + (size_t)(t + 2) * kstep;
            const char* a3 = a2 + kstep; const char* b3 = b2 + kstep;
            PG8_LDB(B0, 0, 0); PG8_LDB(B1, 0, 1); PG8_SCHED; PG8_LDA(At, 0, 0); PG8_STAGE(PG8_SA(1, 1), a1 + hsA, voffA);
            PG8_WAIT_V(8); PG8_WAIT_L(0); PG8_BAR; PG8_MMA(0, 0, At, B0); PG8_MMA(0, 1, At, B1); PG8_BAR; PG8_SCHED;
            PG8_LDA(At, 0, 1); PG8_STAGE(PG8_SB(0, 0), b2, voffB); PG8_STAGE(PG8_SB(0, 1), b2 + hsB, voffB); PG8_STAGE(PG8_SA(0, 0), a2, voffA);
            PG8_WAIT_V(8); PG8_WAIT_L(0); PG8_BAR; PG8_MMA(1, 0, At, B0); PG8_MMA(1, 1, At, B1); PG8_BAR; PG8_SCHED;
            PG8_LDB(B0, 1, 0); PG8_LDB(B1, 1, 1); PG8_SCHED; PG8_LDA(At, 1, 0); PG8_STAGE(PG8_SA(0, 1), a2 + hsA, voffA);
            PG8_WAIT_V(8); PG8_WAIT_L(0); PG8_BAR; PG8_MMA(0, 0, At, B0); PG8_MMA(0, 1, At, B1); PG8_BAR; PG8_SCHED;
            PG8_LDA(At, 1, 1); PG8_STAGE(PG8_SB(1, 0), b3, voffB); PG8_STAGE(PG8_SB(1, 1), b3 + hsB, voffB); PG8_STAGE(PG8_SA(1, 0), a3, voffA);
            PG8_WAIT_V(8); PG8_WAIT_L(0); PG8_BAR; PG8_MMA(1, 0, At, B0); PG8_MMA(1, 1, At, B1); PG8_BAR; PG8_SCHED;
        }
        if (ALIGN) { if (wr == 0) PG8_BAR; }
        E(acc, cur, wr, wc, fr, fq, lds);
        if (!has_next) break;
#pragma unroll
        for (int a = 0; a < 2; ++a)
#pragma unroll
            for (int b = 0; b < 2; ++b)
#pragma unroll
                for (int m = 0; m < 4; ++m)
#pragma unroll
                    for (int n = 0; n < 2; ++n) acc[a][b][m][n] = (f32x4){0.f, 0.f, 0.f, 0.f};
        cur = nxt; cA = nA; cB = nB; ++ui;
        if (ALIGN) { if (wr == 1) PG8_BAR; }
    }
    PG8_WAIT_V(0);
    if (!ALIGN) { if (wr == 0) PG8_BAR; }
    PG8_BAR;
#undef PG8_SA
#undef PG8_SB
#undef PG8_STAGE
#undef PG8_LDA
#undef PG8_LDB
#undef PG8_MMA
#undef PG8_UA
#undef PG8_UB
}

typedef f32x4 Acc[2][2][4][2];
#define EPI_ARGS Acc& acc, const Unit& u, int wr, int wc, int fr, int fq, LAS unsigned char* lds
__device__ __forceinline__ int efence() { asm volatile("" ::: "memory"); return 1; }
#define ROWLOOP _Pragma("unroll") for (int ai = 0; ai < 2; ++ai) _Pragma("unroll") for (int m = 0; m < 4; ++m) for (int once_ = efence(); once_; once_ = 0)

#define LOAD_RS8(rs, ssp, row0) float rs[2][4]; { u64 raw_[2][4]; _Pragma("unroll") for (int ai = 0; ai < 2; ++ai) _Pragma("unroll") for (int m = 0; m < 4; ++m) raw_[ai][m] = (ssp)[(row0) + ai * 128 + m * 16]; \
    _Pragma("unroll") for (int ai = 0; ai < 2; ++ai) _Pragma("unroll") for (int m = 0; m < 4; ++m) rs[ai][m] = rsqrtf((float)(long long)raw_[ai][m] * (1.0f / 16777216.0f) * (1.0f / D) + EPS); }
struct EpiIn0 {
    const u64* ss; bf16_t* U; bf16_t* V; bf16_t* H; u64* vst;
    __device__ __forceinline__ void operator()(EPI_ARGS) const {
        const int row0 = u.pm * 256 + wr * 64 + fr;
        LOAD_RS8(rs8, ss, row0);
        if (u.pn < 4) {
            bf16_t* dst = (u.pn < 2) ? U : V; const int col0 = (u.pn & 1) * 256 + wc * 32 + 8 * fq; const bool st = u.pn >= 2;
            ROWLOOP { const int row = row0 + ai * 128 + m * 16; const float rs = rs8[ai][m]; float s = 0.f, q = 0.f;
#pragma unroll
                for (int bj = 0; bj < 2; ++bj) { f32x4 v0 = acc[ai][bj][m][0] * rs, v1 = acc[ai][bj][m][1] * rs;
#pragma unroll
                    for (int e = 0; e < 4; ++e) { v0[e] = gelu_f(v0[e]); v1[e] = gelu_f(v1[e]); s += v0[e] + v1[e]; q += v0[e] * v0[e] + v1[e] * v1[e]; }
                    *(u32x4*)(dst + (size_t)row * 512 + col0 + bj * 128) = pack8(v0, v1); }
                if (st) { s += __shfl_xor(s, 16); s += __shfl_xor(s, 32); q += __shfl_xor(q, 16); q += __shfl_xor(q, 32);
                    if (fq == 0) { fx_add(vst + 2 * row, s); fx_add(vst + 2 * row + 1, q); } }
            }
        } else {
            const int col0 = (u.pn - 4) * 128 + wc * 32 + 8 * fq;
            ROWLOOP { const int row = row0 + ai * 128 + m * 16; const float rs = rs8[ai][m]; f32x4 h0, h1;
#pragma unroll
                for (int e = 0; e < 4; ++e) { h0[e] = acc[ai][0][m][0][e] * rs * sigmoid_f(acc[ai][1][m][0][e] * rs); h1[e] = acc[ai][0][m][1][e] * rs * sigmoid_f(acc[ai][1][m][1][e] * rs); }
                *(u32x4*)(H + (size_t)row * 512 + col0) = pack8(h0, h1); }
        }
    }
};
__device__ __forceinline__ void unpack8(u32x4 b, f32x4& o0, f32x4& o1) { o0 = (f32x4){bflo(b.x), bfhi(b.x), bflo(b.y), bfhi(b.y)}; o1 = (f32x4){bflo(b.z), bfhi(b.z), bflo(b.w), bfhi(b.w)}; }
template <bool GLU> struct EpiRes {
    bf16_t* xb; u64* ss; int zrows;
    __device__ __forceinline__ void operator()(EPI_ARGS) const {
        const int row0 = u.z * zrows + u.pm * 256 + wr * 64 + fr;
#pragma unroll
        for (int ai = 0; ai < 2; ++ai) {
            u32x4 pre[4][2];
#pragma unroll
            for (int m = 0; m < 4; ++m) { const int row = row0 + ai * 128 + m * 16;
                if (GLU) pre[m][0] = *(const u32x4*)(xb + (size_t)row * D + u.pn * 128 + wc * 32 + 8 * fq);
                else {
#pragma unroll
                    for (int bj = 0; bj < 2; ++bj) pre[m][bj] = *(const u32x4*)(xb + (size_t)row * D + u.pn * 256 + bj * 128 + wc * 32 + 8 * fq); } }
#pragma unroll
            for (int m = 0; m < 4; ++m) for (int once_ = efence(); once_; once_ = 0) { const int row = row0 + ai * 128 + m * 16; float q = 0.f;
                if (GLU) { const size_t off = (size_t)row * D + u.pn * 128 + wc * 32 + 8 * fq;
                    f32x4 o0, o1; unpack8(pre[m][0], o0, o1);
#pragma unroll
                    for (int e = 0; e < 4; ++e) { o0[e] += acc[ai][0][m][0][e] * sigmoid_f(acc[ai][1][m][0][e]); o1[e] += acc[ai][0][m][1][e] * sigmoid_f(acc[ai][1][m][1][e]);
                        q += o0[e] * o0[e] + o1[e] * o1[e]; }
                    *(u32x4*)(xb + off) = pack8(o0, o1);
                } else {
#pragma unroll
                    for (int bj = 0; bj < 2; ++bj) { const size_t off = (size_t)row * D + u.pn * 256 + bj * 128 + wc * 32 + 8 * fq;
                        f32x4 o0, o1; unpack8(pre[m][bj], o0, o1); o0 += acc[ai][bj][m][0]; o1 += acc[ai][bj][m][1];
#pragma unroll
                        for (int e = 0; e < 4; ++e) q += o0[e] * o0[e] + o1[e] * o1[e];
                        *(u32x4*)(xb + off) = pack8(o0, o1); }
                }
                q += __shfl_xor(q, 16); q += __shfl_xor(q, 32);
                if (fq == 0) fx_add(ss + row, q);
            }
        }
    }
};
struct EpiStore {
    bf16_t* O; int ldc, nz0; long sz0, sz1; const u64* ss; float scale;
    __device__ __forceinline__ void operator()(EPI_ARGS) const {
        bf16_t* base = O + (size_t)(u.z % nz0) * sz0 + (size_t)(u.z / nz0) * sz1; const int row0 = u.pm * 256 + wr * 64 + fr, col0 = u.pn * 256 + wc * 32 + 8 * fq;
        float rs8[2][4];
        if (ss) { LOAD_RS8(t8, ss, row0);
#pragma unroll
            for (int ai = 0; ai < 2; ++ai)
#pragma unroll
                for (int m = 0; m < 4; ++m) rs8[ai][m] = t8[ai][m] * scale; }
        else {
#pragma unroll
            for (int ai = 0; ai < 2; ++ai)
#pragma unroll
                for (int m = 0; m < 4; ++m) rs8[ai][m] = scale; }
        ROWLOOP { const int row = row0 + ai * 128 + m * 16; const float rs = rs8[ai][m];
#pragma unroll
            for (int bj = 0; bj < 2; ++bj) *(u32x4*)(base + (size_t)row * ldc + col0 + bj * 128) = pack8(acc[ai][bj][m][0] * rs, acc[ai][bj][m][1] * rs); }
    }
};
struct EpiSoftmax {
    bf16_t* P; const u64* ss;
    __device__ __forceinline__ void operator()(EPI_ARGS) const {
        LAS float* X = (LAS float*)(lds + XCH_OFF); LAS float* Y = X + 1024;
        const int grow0 = u.z * SEQ + u.pm * 256 + wr * 64 + fr;
        LOAD_RS8(rs8, ss, grow0);
        ROWLOOP { const int r = ai * 128 + wr * 64 + m * 16 + fr; const float sc = rs8[ai][m] * 0.0625f; float mx = -3.0e38f;
#pragma unroll
            for (int bj = 0; bj < 2; ++bj)
#pragma unroll
                for (int n = 0; n < 2; ++n) { acc[ai][bj][m][n] = acc[ai][bj][m][n] * sc;
#pragma unroll
                    for (int e = 0; e < 4; ++e) mx = fmaxf(mx, acc[ai][bj][m][n][e]); }
            mx = fmaxf(mx, __shfl_xor(mx, 16)); mx = fmaxf(mx, __shfl_xor(mx, 32));
            if (fq == 0) X[r * 4 + wc] = mx; }
        asm volatile("s_waitcnt lgkmcnt(0)" ::: "memory"); __builtin_amdgcn_s_barrier(); asm volatile("" ::: "memory");
        ROWLOOP { const int r = ai * 128 + wr * 64 + m * 16 + fr; const f32x4 xm = *(const LAS f32x4*)(X + r * 4); const float mx = fmaxf(fmaxf(xm[0], xm[1]), fmaxf(xm[2], xm[3])); float s = 0.f;
#pragma unroll
            for (int bj = 0; bj < 2; ++bj)
#pragma unroll
                for (int n = 0; n < 2; ++n)
#pragma unroll
                    for (int e = 0; e < 4; ++e) { const float p = __expf(acc[ai][bj][m][n][e] - mx); acc[ai][bj][m][n][e] = p; s += p; }
            s += __shfl_xor(s, 16); s += __shfl_xor(s, 32);
            if (fq == 0) Y[r * 4 + wc] = s; }
        asm volatile("s_waitcnt lgkmcnt(0)" ::: "memory"); __builtin_amdgcn_s_barrier(); asm volatile("" ::: "memory");
        ROWLOOP { const int r = ai * 128 + wr * 64 + m * 16 + fr; const f32x4 ys = *(const LAS f32x4*)(Y + r * 4); const float inv = 1.0f / ((ys[0] + ys[1]) + (ys[2] + ys[3]));
#pragma unroll
            for (int bj = 0; bj < 2; ++bj) *(u32x4*)(P + (size_t)(u.z * SEQ + u.pm * 256 + r) * D + u.pn * 256 + bj * 128 + wc * 32 + 8 * fq) = pack8(acc[ai][bj][m][0] * inv, acc[ai][bj][m][1] * inv); }
    }
};
struct EpiFfn1 {
    const u64* ss; bf16_t* HM;
    __device__ __forceinline__ void operator()(EPI_ARGS) const {
        const int row0 = u.pm * 256 + wr * 64 + fr, col0 = u.pn * 128 + wc * 32 + 8 * fq;
        LOAD_RS8(rs8, ss, row0);
        ROWLOOP { const int row = row0 + ai * 128 + m * 16; const float rs = rs8[ai][m]; f32x4 h0, h1;
#pragma unroll
            for (int e = 0; e < 4; ++e) { h0[e] = silu_f(acc[ai][0][m][0][e] * rs) * (acc[ai][1][m][0][e] * rs); h1[e] = silu_f(acc[ai][0][m][1][e] * rs) * (acc[ai][1][m][1][e] * rs); }
            *(u32x4*)(HM + (size_t)row * FH + col0) = pack8(h0, h1); }
    }
};
struct EpiOin {
    const u64* ss; bf16_t* AC;
    __device__ __forceinline__ void operator()(EPI_ARGS) const {
        const int row0 = u.pm * 256 + wr * 64 + fr;
        LOAD_RS8(rs8, ss, row0);
        ROWLOOP { const int row = row0 + ai * 128 + m * 16; const float rs = rs8[ai][m];
#pragma unroll
            for (int bj = 0; bj < 2; ++bj) { const int col = u.pn * 256 + bj * 128 + wc * 32 + 8 * fq;
                *(u32x4*)(AC + (size_t)(col >> 4) * NCH * AK + (size_t)(row / SL) * AK + (row % SL) * 16 + (col & 8)) = pack8(acc[ai][bj][m][0] * rs, acc[ai][bj][m][1] * rs); } }
    }
};
struct EpiS5State {
    float* XL;
    __device__ __forceinline__ void operator()(EPI_ARGS) const {
        const int row0 = u.pm * 256 + wr * 64 + fr, col0 = wc * 32 + 8 * fq;
        ROWLOOP { const int row = row0 + ai * 128 + m * 16; float* p = XL + (size_t)u.z * NCH * 128 + (size_t)row * 128 + col0;
            *(f32x4*)p = acc[ai][0][m][0]; *(f32x4*)(p + 4) = acc[ai][0][m][1]; }
    }
};
struct EpiS5Out {
    const bf16_t* AC; const float* dsk; bf16_t* Y;
    __device__ __forceinline__ void operator()(EPI_ARGS) const {
        const int g = u.z, row0 = u.pm * 256 + wr * 64 + fr;
        f32x4 dv[2][2];
#pragma unroll
        for (int bj = 0; bj < 2; ++bj) { const int ch = g * 16 + ((u.pn * 256 + bj * 128 + wc * 32 + 8 * fq) & 8); dv[bj][0] = *(const f32x4*)(dsk + ch); dv[bj][1] = *(const f32x4*)(dsk + ch + 4); }
#pragma unroll
        for (int ai = 0; ai < 2; ++ai) {
            u32x4 pre[4][2];
#pragma unroll
            for (int m = 0; m < 4; ++m)
#pragma unroll
                for (int bj = 0; bj < 2; ++bj) pre[m][bj] = *(const u32x4*)(AC + (size_t)g * NCH * AK + (size_t)(row0 + ai * 128 + m * 16) * AK + u.pn * 256 + bj * 128 + wc * 32 + 8 * fq);
#pragma unroll
            for (int m = 0; m < 4; ++m) for (int once_ = efence(); once_; once_ = 0) { const int row = row0 + ai * 128 + m * 16;
#pragma unroll
                for (int bj = 0; bj < 2; ++bj) { const int col = u.pn * 256 + bj * 128 + wc * 32 + 8 * fq, k = col >> 4, ch = g * 16 + (col & 8);
                    f32x4 u0, u1; unpack8(pre[m][bj], u0, u1);
                    f32x4 y0 = acc[ai][bj][m][0] + dv[bj][0] * u0, y1 = acc[ai][bj][m][1] + dv[bj][1] * u1;
#pragma unroll
                    for (int e = 0; e < 4; ++e) { y0[e] = gelu_f(y0[e]); y1[e] = gelu_f(y1[e]); }
                    *(u32x4*)(Y + (size_t)(row * SL + k) * 512 + ch) = pack8(y0, y1); } }
        }
    }
};
}

#define XB_TMO      128
#define XB_XCNT(j)  (256  + 64 * (j))
#define XB_XSUB(j)  (1280 + 64 * (j))
#define XB_XGEN(j)  (2304 + 64 * (j))
#define XB_TOP      3328
#define XB_TOPGEN   3392
#define XCD_BAR_WORDS 3456
#define XB_SPIN_CAP (1u << 22)
__device__ __forceinline__ unsigned xb_ld(unsigned* p)              { return __hip_atomic_load(p, __ATOMIC_RELAXED, __HIP_MEMORY_SCOPE_AGENT); }
__device__ __forceinline__ unsigned xb_add(unsigned* p, unsigned v) { return __hip_atomic_fetch_add(p, v, __ATOMIC_RELAXED, __HIP_MEMORY_SCOPE_AGENT); }
__device__ __forceinline__ unsigned xb_xcc_id() { return (unsigned)__builtin_amdgcn_s_getreg((3 << 11) | 20) & 0xFu; }
#define XB_SPIN(cond, bar) do { unsigned _sp = 0; while (cond) { __builtin_amdgcn_s_sleep(1); \
    if ((++_sp & 255u) == 0u) { if (xb_ld(&(bar)[XB_TMO])) break; if (_sp > XB_SPIN_CAP) { atomicAdd(&(bar)[XB_TMO], 1u); break; } } } } while (0)
struct XcdBarrier { unsigned* bar; unsigned x; volatile LAS unsigned* st; };
__device__ __forceinline__ XcdBarrier xcd_barrier_post(unsigned* bar, volatile LAS unsigned* st) {
    XcdBarrier b; b.bar = bar; b.x = xb_xcc_id(); b.st = st;
    if (threadIdx.x == 0) (void)xb_add(&bar[XB_XCNT(b.x)], 1u);
    return b;
}
__device__ __forceinline__ void xcd_barrier_complete(unsigned* bar, unsigned x, unsigned& nloc, unsigned& nx) {
    const unsigned G = gridDim.x * gridDim.y * gridDim.z;
    unsigned sum, cnt, mine, sp = 0u;
    for (;;) {
        sum = 0u; cnt = 0u; mine = 0u;
#pragma unroll
        for (unsigned j = 0; j < 16; ++j) { const unsigned c = xb_ld(&bar[XB_XCNT(j)]); sum += c; cnt += (c > 0u) ? 1u : 0u; mine = (j == x) ? c : mine; }
        if (sum == G) break;
        __builtin_amdgcn_s_sleep(1);
        if ((++sp & 255u) == 0u) { if (xb_ld(&bar[XB_TMO])) break; if (sp > XB_SPIN_CAP) { atomicAdd(&bar[XB_TMO], 1u); break; } }
    }
    nloc = mine > 0u ? mine : 1u; nx = cnt > 0u ? cnt : 1u;
}
__device__ __forceinline__ void xcd_barrier(const XcdBarrier& b) {
    asm volatile("s_waitcnt vmcnt(0)" ::: "memory");
    __syncthreads();
    if (threadIdx.x == 0) {
        unsigned* bar = b.bar;
        __builtin_amdgcn_s_waitcnt(0);
        unsigned nloc = b.st[0], nx = b.st[1];
        if (nloc == 0u) { xcd_barrier_complete(bar, b.x, nloc, nx); b.st[0] = nloc; b.st[1] = nx; }
        const unsigned old = xb_add(&bar[XB_XSUB(b.x)], 1u);
        const unsigned gen = old / nloc;
        if (old + 1u == (gen + 1u) * nloc) {
            __builtin_amdgcn_fence(__ATOMIC_RELEASE, "agent");
            asm volatile("s_waitcnt vmcnt(0)" ::: "memory");
            const unsigned og = xb_add(&bar[XB_TOP], 1u);
            const unsigned tg = og / nx;
            if (og + 1u == (tg + 1u) * nx) xb_add(&bar[XB_TOPGEN], 1u);
            else XB_SPIN(xb_ld(&bar[XB_TOPGEN]) == tg, bar);
            __builtin_amdgcn_fence(__ATOMIC_ACQUIRE, "agent");
            xb_add(&bar[XB_XGEN(b.x)], 1u);
            asm volatile("s_waitcnt vmcnt(0)" ::: "memory");
        } else {
            XB_SPIN(xb_ld(&bar[XB_XGEN(b.x)]) == gen, bar);
            __builtin_amdgcn_fence(__ATOMIC_ACQUIRE, "agent");
            asm volatile("s_waitcnt vmcnt(0)" ::: "memory");
        }
    }
    __syncthreads();
}

struct ConvP { const float* W; bf16_t* WT; const float* gain; int K, ldn, cs, nblk, mode, roff, r; };
__device__ __forceinline__ void conv_load(const ConvP& p, f32x4 (&v)[32], int lane) {
    const int nkb = p.K / 64, kb = p.r % nkb, nb = p.r / nkb; const float* src = p.W + (size_t)(64 * kb + (lane >> 5)) * p.ldn + p.cs + 128 * nb + 4 * (lane & 31);
#pragma unroll
    for (int i = 0; i < 32; ++i) v[i] = *(const f32x4*)(src + (size_t)(2 * i) * p.ldn);
}
__device__ __forceinline__ void conv_store(const ConvP& p, const f32x4 (&v)[32], LAS float* scr, int lane) {
    const int nkb = p.K / 64, kb = p.r % nkb, nb = p.r / nkb, k0 = 64 * kb, c = lane & 7;
    f32x4 g0 = {1.f, 1.f, 1.f, 1.f}, g1 = g0;
    if (p.gain) { g0 = *(const f32x4*)(p.gain + k0 + 8 * c); g1 = *(const f32x4*)(p.gain + k0 + 8 * c + 4); }
#pragma unroll 1
    for (int sb = 0; sb < 4; ++sb) {
        if (((lane & 31) >> 3) == sb) {
#pragma unroll
            for (int i = 0; i < 32; ++i)
#pragma unroll
                for (int e = 0; e < 4; ++e) scr[(2 * i + (lane >> 5)) * 33 + 4 * (lane & 7) + e] = v[i][e]; }
        asm volatile("s_waitcnt lgkmcnt(0)" ::: "memory");
        const int c0 = 128 * nb + 32 * sb, drow = p.roff + (p.mode == 0 ? c0 : ((c0 >> 7) * 256 + (p.mode - 1) * 128 + (c0 & 127)));
#pragma unroll
        for (int j = 0; j < 4; ++j) { const int n = (lane >> 3) + 8 * j; const LAS float* s = scr + (8 * c) * 33 + n;
            u32x4 o; o.x = cvt_pk_bf16(s[0 * 33] * g0[0], s[1 * 33] * g0[1]); o.y = cvt_pk_bf16(s[2 * 33] * g0[2], s[3 * 33] * g0[3]); o.z = cvt_pk_bf16(s[4 * 33] * g1[0], s[5 * 33] * g1[1]); o.w = cvt_pk_bf16(s[6 * 33] * g1[2], s[7 * 33] * g1[3]);
            *(u32x4*)(p.WT + (size_t)(drow + n) * p.K + k0 + 8 * c) = o; }
        asm volatile("s_waitcnt lgkmcnt(0)" ::: "memory");
    }
}
template <bool NORM, int R> __device__ __forceinline__ void rows_to_bf16(const float* x0, bf16_t* o0, u64* ssq, int lane) {
    f32x4 v[R][4]; float s[R];
#pragma unroll
    for (int r = 0; r < R; ++r) { const f32x4* xr = (const f32x4*)(x0 + (size_t)r * D) + lane;
#pragma unroll
        for (int j = 0; j < 4; ++j) v[r][j] = xr[64 * j]; }
#pragma unroll
    for (int r = 0; r < R; ++r) { float a = 0.f;
#pragma unroll
        for (int j = 0; j < 4; ++j) a += (v[r][j][0] * v[r][j][0] + v[r][j][1] * v[r][j][1]) + (v[r][j][2] * v[r][j][2] + v[r][j][3] * v[r][j][3]);
        s[r] = wave_sum(a); }
#pragma unroll
    for (int r = 0; r < R; ++r) { const float rs = NORM ? rsqrtf(s[r] * (1.0f / D) + EPS) : 1.0f; u32x2* o = (u32x2*)(o0 + (size_t)r * D) + lane;
#pragma unroll
        for (int j = 0; j < 4; ++j) { u32x2 w; w.x = cvt_pk_bf16(v[r][j][0] * rs, v[r][j][1] * rs); w.y = cvt_pk_bf16(v[r][j][2] * rs, v[r][j][3] * rs); o[64 * j] = w; }
        if (ssq && lane == 0) ssq[r] = (u64)(long long)(s[r] * 16777216.0f); }
}
__device__ __forceinline__ void cis_f(float ang, float& c, float& s) {
    float rev = ang * 0.15915494309189535f; rev = rev - rintf(rev);
    const float x = rev * 6.283185307179586f;
    const float h = x * 0.25f, h2 = h * h;
    float sh = h * (1.0f + h2 * (-1.6666667e-1f + h2 * (8.3333333e-3f + h2 * (-1.9841270e-4f + h2 * 2.7557319e-6f))));
    float ch = 1.0f + h2 * (-0.5f + h2 * (4.1666667e-2f + h2 * (-1.3888889e-3f + h2 * (2.4801587e-5f + h2 * -2.7557319e-7f))));
    float s2 = 2.f * sh * ch, c2 = 1.f - 2.f * sh * sh;
    s = 2.f * s2 * c2; c = 1.f - 2.f * s2 * s2;
}
__device__ __forceinline__ void s5_setup(int g, LAS unsigned char* lds, const float* lam_re, const float* lam_im, const float* log_dt, const float* b_re, const float* b_im, const float* c_re, const float* c_im,
                                         bf16_t* BT3, bf16_t* GM, float* AL, int tid) {
    LAS float* pwr = (LAS float*)lds; LAS float* pwi = pwr + 33 * 64; LAS float* Bbr = pwi + 33 * 64; LAS float* Bbi = Bbr + 1024; LAS float* Cr = Bbi + 1024; LAS float* Ci = Cr + 1024; LAS float* Kd = Ci + 1024;
    const float dt = __expf(log_dt[g]);
    for (int idx = tid; idx < 33 * 64; idx += 512) { const int d = idx >> 6, p = idx & 63; const float lr = lam_re[g * 64 + p], li = lam_im[g * 64 + p];
        const float mag = __expf(lr * dt * (float)d); float c, s; cis_f(li * dt * (float)d, c, s); pwr[idx] = mag * c; pwi[idx] = mag * s; }
    for (int idx = tid; idx < 1024; idx += 512) { const int p = idx >> 4; const float lr = lam_re[g * 64 + p], li = lam_im[g * 64 + p];
        const float mag = __expf(lr * dt); float c, s; cis_f(li * dt, c, s); const float ar = mag * c, ai = mag * s, den = lr * lr + li * li;
        const float qr = ((ar - 1.0f) * lr + ai * li) / den, qi = (ai * lr - (ar - 1.0f) * li) / den;
        const float br = b_re[g * 1024 + idx], bi = b_im[g * 1024 + idx];
        Bbr[idx] = qr * br - qi * bi; Bbi[idx] = qr * bi + qi * br;
        Cr[idx] = c_re[g * 1024 + idx]; Ci[idx] = c_im[g * 1024 + idx]; }
    __syncthreads();
    for (int idx = tid; idx < 32 * 256; idx += 512) { const int d = idx >> 8, co = (idx >> 4) & 15, ci = idx & 15; float a = 0.f;
        for (int p = 0; p < 64; ++p) { const float cr = Cr[co * 64 + p], cim = Ci[co * 64 + p], pr = pwr[d * 64 + p], pi = pwi[d * 64 + p];
            const float tr = cr * pr - cim * pi, ti = cr * pi + cim * pr; a += tr * Bbr[p * 16 + ci] - ti * Bbi[p * 16 + ci]; }
        Kd[idx] = a; }
    __syncthreads();
    bf16_t* bt = BT3 + (size_t)g * 512 * AK;
    for (int idx = tid; idx < 512 * (AK / 8); idx += 512) { const int n = idx / (AK / 8), q = idx % (AK / 8), kk0 = q * 8, k = n >> 4, co = n & 15; float v[8];
        if (kk0 < 512) { const int j = kk0 >> 4, ci0 = kk0 & 15;
#pragma unroll
            for (int e = 0; e < 8; ++e) v[e] = (j <= k) ? Kd[(k - j) * 256 + co * 16 + ci0 + e] : 0.f;
        } else { const int p0 = kk0 - 512;
#pragma unroll
            for (int e = 0; e < 8; ++e) { const int p = (p0 & 63) + e; const float cr = Cr[co * 64 + p], cim = Ci[co * 64 + p], pr = pwr[(k + 1) * 64 + p], pi = pwi[(k + 1) * 64 + p];
                v[e] = (p0 < 64) ? (cr * pr - cim * pi) : -(cr * pi + cim * pr); } }
        u32x4 w; w.x = cvt_pk_bf16(v[0], v[1]); w.y = cvt_pk_bf16(v[2], v[3]); w.z = cvt_pk_bf16(v[4], v[5]); w.w = cvt_pk_bf16(v[6], v[7]);
        *(u32x4*)(bt + (size_t)n * AK + kk0) = w; }
    bf16_t* gm = GM + (size_t)g * 256 * 512;
    for (int idx = tid; idx < 256 * 64; idx += 512) { const int n = idx >> 6, q = idx & 63, kk0 = q * 8; float v[8];
        if (n < 128) { const int p = n & 63, j = kk0 >> 4, ci0 = kk0 & 15; const float pr = pwr[(SL - 1 - j) * 64 + p], pi = pwi[(SL - 1 - j) * 64 + p];
#pragma unroll
            for (int e = 0; e < 8; ++e) { const float br = Bbr[p * 16 + ci0 + e], bi = Bbi[p * 16 + ci0 + e]; v[e] = (n < 64) ? (pr * br - pi * bi) : (pr * bi + pi * br); }
        } else {
#pragma unroll
            for (int e = 0; e < 8; ++e) v[e] = 0.f; }
        u32x4 w; w.x = cvt_pk_bf16(v[0], v[1]); w.y = cvt_pk_bf16(v[2], v[3]); w.z = cvt_pk_bf16(v[4], v[5]); w.w = cvt_pk_bf16(v[6], v[7]);
        *(u32x4*)(gm + (size_t)n * 512 + kk0) = w; }
    if (tid < 64) { AL[(g * 64 + tid) * 2] = pwr[SL * 64 + tid]; AL[(g * 64 + tid) * 2 + 1] = pwi[SL * 64 + tid]; }
    __syncthreads();
}

__device__ __forceinline__ void gmlp_unit(int unit, LAS unsigned char* lds, const bf16_t* U, const bf16_t* V, const u64* vst, const bf16_t* GW, const float* gb, bf16_t* MIX, int tid) {
    const int g = unit & 3, t0 = (unit >> 2) * 128, lane = tid & 63, wid = tid >> 6;
    LAS bf16_t* vT = (LAS bf16_t*)lds;
    const int il = lane & 15, kq = lane >> 4, i = wid * 16 + il;
    u32x4 raw[4]; u64 st[4][2];
#pragma unroll
    for (int e = 0; e < 4; ++e) { const int q = tid + 512 * e, j = q >> 4, c8 = (q & 15) * 8;
        raw[e] = *(const u32x4*)(V + (size_t)(t0 + j) * 512 + g * 128 + c8); st[e][0] = vst[2 * (t0 + j)]; st[e][1] = vst[2 * (t0 + j) + 1]; }
    bf16x8 wf[4];
#pragma unroll
    for (int ks = 0; ks < 4; ++ks) wf[ks] = *(const bf16x8*)(GW + (size_t)g * 16384 + (size_t)i * 128 + ks * 32 + kq * 8);
    const float bias = gb[g * 128 + i];
    const size_t tok = (size_t)(t0 + i);
    u32x2 uu[8];
#pragma unroll
    for (int nt = 0; nt < 8; ++nt) uu[nt] = *(const u32x2*)(U + tok * 512 + g * 128 + nt * 16 + kq * 4);
#pragma unroll
    for (int e = 0; e < 4; ++e) { const int q = tid + 512 * e, j = q >> 4, c8 = (q & 15) * 8;
        const float s = (float)(long long)st[e][0] * (1.0f / 16777216.0f), ss = (float)(long long)st[e][1] * (1.0f / 16777216.0f), mean = s * (1.0f / 512.0f), var = ss * (1.0f / 512.0f) - mean * mean, rstd = rsqrtf(fmaxf(var, 0.f) + EPS);
        const float v[8] = {bflo(raw[e].x), bfhi(raw[e].x), bflo(raw[e].y), bfhi(raw[e].y), bflo(raw[e].z), bfhi(raw[e].z), bflo(raw[e].w), bfhi(raw[e].w)};
        const int jo = ((((j >> 3) ^ (c8 >> 3)) & 15) << 3) + (j & 7);
#pragma unroll
        for (int k = 0; k < 8; k += 2) { const unsigned pk = cvt_pk_bf16((v[k] - mean) * rstd, (v[k + 1] - mean) * rstd); vT[(c8 + k) * 136 + jo] = (bf16_t)(pk & 0xffffu); vT[(c8 + k + 1) * 136 + jo] = (bf16_t)(pk >> 16); } }
    __syncthreads();
#pragma unroll 2
    for (int nt = 0; nt < 8; ++nt) { f32x4 a = {0.f, 0.f, 0.f, 0.f}; const int c = nt * 16 + il;
#pragma unroll
        for (int ks = 0; ks < 4; ++ks) { const bf16x8 vf = *(const LAS bf16x8*)(vT + c * 136 + ((((ks * 4 + kq) ^ (c >> 3)) & 15) << 3)); a = __builtin_amdgcn_mfma_f32_16x16x32_bf16(vf, wf[ks], a, 0, 0, 0); }
        u32x2 o; o.x = cvt_pk_bf16(bflo(uu[nt].x) * (a[0] + bias), bfhi(uu[nt].x) * (a[1] + bias)); o.y = cvt_pk_bf16(bflo(uu[nt].y) * (a[2] + bias), bfhi(uu[nt].y) * (a[3] + bias));
        *(u32x2*)(MIX + tok * 1024 + g * 128 + nt * 16 + kq * 4) = o; }
    __syncthreads();
}
__device__ __forceinline__ void conv_units(int first, int stride, int nunits, LAS unsigned char* lds, const bf16_t* H, const float* cw, const float* cb, const float* lng, const float* lnb, bf16_t* MIX, int tid) {
    if (first >= nunits) return;
    const int lane = tid & 63, wid = tid >> 6;
    LAS bf16_t* hin = (LAS bf16_t*)lds;
    LAS float* cout = (LAS float*)(lds + 62 * 1024);
    float w[31];
#pragma unroll
    for (int k = 0; k < 31; ++k) w[k] = cw[k * 512 + tid];
    const float bias = cb[tid];
    const f32x4 g0 = *(const f32x4*)(lng + lane * 8), g1 = *(const f32x4*)(lng + lane * 8 + 4), b0 = *(const f32x4*)(lnb + lane * 8), b1 = *(const f32x4*)(lnb + lane * 8 + 4);
    u32x4 pre[8];
#define CONV_PREFETCH(unit_) { const int t0_ = (unit_) * 32, s0_ = t0_ % SEQ; _Pragma("unroll") for (int e = 0; e < 8; ++e) { const int q = tid + 512 * e, r = q >> 6, c8 = (q & 63) * 8; \
        u32x4 v_ = {0u, 0u, 0u, 0u}; if (q < 62 * 64 && s0_ - 30 + r >= 0) v_ = *(const u32x4*)(H + (size_t)(t0_ - 30 + r) * 512 + c8); pre[e] = v_; } }
    CONV_PREFETCH(first);
#pragma unroll 1
    for (int unit = first; unit < nunits; unit += stride) {
        const int t0 = unit * 32;
#pragma unroll
        for (int e = 0; e < 8; ++e) { const int q = tid + 512 * e; if (q < 62 * 64) *(LAS u32x4*)(hin + (q >> 6) * 512 + (q & 63) * 8) = pre[e]; }
        if (unit + stride < nunits) CONV_PREFETCH(unit + stride);
        __syncthreads();
#pragma unroll 1
        for (int tg = 0; tg < 4; ++tg) { float x[38];
#pragma unroll
            for (int r = 0; r < 38; ++r) x[r] = bf2f(hin[(tg * 8 + r) * 512 + tid]);
#pragma unroll
            for (int o = 0; o < 8; ++o) { float a = bias;
#pragma unroll
                for (int k = 0; k < 31; ++k) a += w[k] * x[o + k];
                cout[(tg * 8 + o) * 516 + tid] = a; } }
        __syncthreads();
#pragma unroll 1
        for (int tt = 0; tt < 4; ++tt) { const int row = wid * 4 + tt; const f32x4 v0 = *(const LAS f32x4*)(cout + row * 516 + lane * 8), v1 = *(const LAS f32x4*)(cout + row * 516 + lane * 8 + 4);
            const float mean = wave_sum((v0[0] + v0[1]) + (v0[2] + v0[3]) + (v1[0] + v1[1]) + (v1[2] + v1[3])) * (1.0f / 512.0f);
            const f32x4 d0 = v0 - mean, d1 = v1 - mean;
            const float var = wave_sum((d0[0] * d0[0] + d0[1] * d0[1]) + (d0[2] * d0[2] + d0[3] * d0[3]) + (d1[0] * d1[0] + d1[1] * d1[1]) + (d1[2] * d1[2] + d1[3] * d1[3])) * (1.0f / 512.0f);
            const float rstd = rsqrtf(var + EPS);
            f32x4 y0 = d0 * rstd * g0 + b0, y1 = d1 * rstd * g1 + b1;
#pragma unroll
            for (int e = 0; e < 4; ++e) { y0[e] = silu_f(y0[e]); y1[e] = silu_f(y1[e]); }
            *(u32x4*)(MIX + (size_t)(t0 + row) * 1024 + 512 + lane * 8) = pack8(y0, y1); }
    }
    __syncthreads();
#undef CONV_PREFETCH
}

struct Args { const float* in[33]; float* out; unsigned char* ws; int ph_lo, ph_hi; };
constexpr int NPHASE = 28;

typedef const __attribute__((address_space(4))) Args* KArgP;
__device__ __forceinline__ KArgP fresh_args() { KArgP p = (KArgP)__builtin_amdgcn_kernarg_segment_ptr(); asm volatile("" : "+s"(p)); return p; }

__global__ void __launch_bounds__(512, 2) trunk_fwd(Args args_unused) {
    extern __shared__ __attribute__((aligned(16))) unsigned char lds_raw[];
    LAS unsigned char* lds = (LAS unsigned char*)lds_raw;
    cg::grid_group grid = cg::this_grid();
    { volatile LAS unsigned* MISC0 = (volatile LAS unsigned*)(lds + MISC_OFF); if (threadIdx.x < 32) MISC0[threadIdx.x] = 0u; }
    __syncthreads();
    int lo, hi;
    { KArgP ap = fresh_args(); lo = ap->ph_lo; hi = ap->ph_hi; }
#if !MK_MULTI && !MK_CGSYNC
    { KArgP ap = fresh_args(); (void)xcd_barrier_post((unsigned*)(ap->ws + WS_BAR), (volatile LAS unsigned*)(lds + MISC_OFF) + 8); }
#endif
    int nsync = 0;
#if MK_MULTI
#define SEAM(k) do { } while (0)
#elif MK_CGSYNC
#define SEAM(k) do { if (rep_ + 1 == nrep_ && (k) + 1 < hi) grid.sync(); } while (0)
#else
#define SEAM(k) do { if (rep_ + 1 == nrep_ && (k) + 1 < hi) { if (hi > 1000) grid.sync(); else { KArgP ap_ = fresh_args(); XcdBarrier xb_; xb_.bar = (unsigned*)(ap_->ws + WS_BAR); xb_.x = xb_xcc_id(); xb_.st = (volatile LAS unsigned*)(lds + MISC_OFF) + 8; xcd_barrier(xb_); if (BARPROBE) xcd_barrier(xb_); } ++nsync; } } while (0)
#endif
#ifndef ONLY
#define ONLY -1
#endif
#ifndef REPMASK
#define REPMASK 0
#endif
#define PHASE(id, k) if ((ONLY < 0 || ONLY == (id)) && lo <= (k) && (k) < hi) for (int rep_ = 0, nrep_ = (((REPMASK) >> (id)) & 1) ? 2 : 1; rep_ < nrep_; ++rep_)
    (void)nsync;
#define LOCALS KArgP ap = fresh_args(); unsigned char* ws = ap->ws; float* out = ap->out; const float* x_in = ap->in[0]; \
    int tid_ = threadIdx.x, G_ = gridDim.x, bx_ = blockIdx.x; asm volatile("" : "+v"(tid_), "+s"(G_), "+s"(bx_)); \
    const int tid = tid_, lane = tid & 63, wave = __builtin_amdgcn_readfirstlane(tid >> 6), G = G_, bx = bx_, gw = bx * 8 + wave, NGW = G * 8; \
    bf16_t* XB = (bf16_t*)(ws + WS_XB); u64* SS = (u64*)(ws + WS_SS); u64* VST = (u64*)(ws + WS_VST); bf16_t* QO = (bf16_t*)(ws + WS_QO); \
    bf16_t* HM = (bf16_t*)(ws + WS_HM); bf16_t* MEMN = (bf16_t*)(ws + WS_MEMN); bf16_t* KL = (bf16_t*)(ws + WS_KL); bf16_t* VL = (bf16_t*)(ws + WS_VL); \
    bf16_t* U = (bf16_t*)(ws + WS_U); bf16_t* V = (bf16_t*)(ws + WS_V); bf16_t* H = (bf16_t*)(ws + WS_H); bf16_t* MIX = (bf16_t*)(ws + WS_MIX); \
    bf16_t* AC = (bf16_t*)(ws + WS_ACOMB); float* XL = (float*)(ws + WS_XLOC); bf16_t* Y = (bf16_t*)(ws + WS_Y); u64* SSa = SS + (size_t)(3 * l) * T; \
    (void)out; (void)x_in; (void)lane; (void)gw; (void)NGW; (void)XB; (void)VST; (void)QO; (void)HM; (void)MEMN; (void)KL; (void)VL; (void)U; (void)V; (void)H; (void)MIX; (void)AC; (void)XL; (void)Y; (void)SSa; (void)wave;

    PHASE(0, 0) { const int l = 0; LOCALS
        { f32x4* z = (f32x4*)(SS + T); const int n4 = 7 * T * 2 / 4; for (int i = bx * 512 + tid; i < n4; i += G * 512) z[i] = (f32x4){0.f, 0.f, 0.f, 0.f};
          f32x4* z2 = (f32x4*)VST; const int m4 = 2 * T * 2 / 4; for (int i = bx * 512 + tid; i < m4; i += G * 512) z2[i] = (f32x4){0.f, 0.f, 0.f, 0.f}; }
        LAS float* scr = (LAS float*)(lds + wave * 16384);
#define CONVJOB(Wp, K_, ldn_, cs_, nc_, WTp, mode_, roff_, gain_) { const int nblk_ = (nc_) / 128, cnt_ = ((K_) / 64) * nblk_; \
            if (r >= 0 && r < cnt_) { cp.W = (Wp); cp.WT = (bf16_t*)(WTp); cp.gain = (gain_); cp.K = (K_); cp.ldn = (ldn_); cp.cs = (cs_); cp.nblk = nblk_; cp.mode = (mode_); cp.roff = (roff_); cp.r = r; } r -= cnt_; }
#define CONVLOOKUP(cp, it_) { int r = (it_); \
            CONVJOB(ap->in[3], 1024, 2048, 0, 1024, ws + WS_WIN0, 0, 0, ap->in[2]); \
            CONVJOB(ap->in[3], 1024, 2048, 1024, 512, ws + WS_WIN0, 1, 1024, ap->in[2]); \
            CONVJOB(ap->in[3], 1024, 2048, 1536, 512, ws + WS_WIN0, 2, 1024, ap->in[2]); \
            CONVJOB(ap->in[10], 1024, 1024, 0, 1024, ws + WS_WOUT0, 0, 0, nullptr); \
            CONVJOB(ap->in[12], 1024, 512, 0, 512, ws + WS_WOIN, 0, 0, ap->in[11]); \
            CONVJOB(ap->in[21], 512, 2048, 0, 1024, ws + WS_WOOUT, 1, 0, nullptr); \
            CONVJOB(ap->in[21], 512, 2048, 1024, 1024, ws + WS_WOOUT, 2, 0, nullptr); \
            _Pragma("unroll") for (int l2 = 0; l2 < 2; ++l2) { \
                CONVJOB(ap->in[25] + (size_t)l2 * D * D, 1024, 1024, 0, 1024, ws + WS_WK + l2 * WSQ_L, 0, 0, ap->in[23] + l2 * D); \
                CONVJOB(ap->in[26] + (size_t)l2 * D * D, 1024, 1024, 0, 1024, ws + WS_WV + l2 * WSQ_L, 0, 0, ap->in[23] + l2 * D); \
                CONVJOB(ap->in[27] + (size_t)l2 * D * D, 1024, 1024, 0, 1024, ws + WS_WO + l2 * WSQ_L, 0, 0, nullptr); \
                CONVJOB(ap->in[29] + (size_t)l2 * D * FH, 1024, FH, 0, FH, ws + WS_WGU + l2 * WGU_L, 1, 0, ap->in[28] + l2 * D); \
                CONVJOB(ap->in[30] + (size_t)l2 * D * FH, 1024, FH, 0, FH, ws + WS_WGU + l2 * WGU_L, 2, 0, ap->in[28] + l2 * D); \
                CONVJOB(ap->in[31] + (size_t)l2 * FH * D, FH, 1024, 0, 1024, ws + WS_WD + l2 * WD_L, 0, 0, nullptr); } }
        constexpr int NITEMS = (512 + 256 + 256 + 512 + 256 + 256 + 256 + 2 * (3 * 512 + 3 * 1408)) / 4;
        for (int it = gw; it < NITEMS; it += NGW) { ConvP c0{}; f32x4 v0[32]; { ConvP cp{}; CONVLOOKUP(cp, it); c0 = cp; } conv_load(c0, v0, lane); conv_store(c0, v0, scr, lane); }
        { const int nb5 = (G > 64) ? G - 32 : G;
          if (bx < nb5) { const int NW5 = nb5 * 8;
              for (int m = gw * 4; m < T; m += NW5 * 4) rows_to_bf16<false, 4>(x_in + (size_t)m * D, XB + (size_t)m * D, SS + m, lane);
              for (int m = gw * 4; m < MT; m += NW5 * 4) rows_to_bf16<true, 4>(ap->in[1] + (size_t)m * D, MEMN + (size_t)m * D, nullptr, lane); } }
        for (int i = bx * 512 + tid; i < 2 * D * D / 8; i += G * 512) { const int l2 = i / (D * D / 8), e = (i % (D * D / 8)) * 8, k = e >> 10; const float gk = ap->in[22][l2 * D + k];
            const f32x4 a = *(const f32x4*)(ap->in[24] + (size_t)l2 * D * D + e), b = *(const f32x4*)(ap->in[24] + (size_t)l2 * D * D + e + 4);
            *(u32x4*)((bf16_t*)(ws + WS_WQ) + (size_t)l2 * D * D + e) = pack8(a * gk, b * gk); }
        { bf16_t* GW = (bf16_t*)(ws + WS_GW); const float* w = ap->in[4];
          for (int i = bx * 512 + tid; i < 4 * 128 * 128 / 2; i += G * 512) { const int e = 2 * i, ii = (e >> 7) & 127, jj = e & 127; const bool keep = (jj >> 6) <= (ii >> 6);
              ((unsigned*)GW)[i] = keep ? cvt_pk_bf16(w[e], w[e + 1]) : 0u; } }
        __syncthreads();
        for (int g = G - 1 - bx; g < 32; g += G)
            s5_setup(g, lds, ap->in[13], ap->in[14], ap->in[15], ap->in[16], ap->in[17], ap->in[18], ap->in[19], (bf16_t*)(ws + WS_BT3), (bf16_t*)(ws + WS_GM), (float*)(ws + WS_AL), tid);
        SEAM(0);
    }
#pragma unroll 1
    for (int l = 0; l < 2; ++l) {
        const int pb = 3 + 12 * l;
        if (l == 0) {
            PHASE(2, pb + 0) { LOCALS
                pg8::Gemm g{XB, (const bf16_t*)(ws + WS_WIN0), D, D, D, 1, 0, 0, 0, 0}; pg8::Sched S; S.init(T / 256, 2048 / 256, 1, G, bx);
                { pg8::EpiIn0 E{SSa, U, V, H, VST}; pg8::gemm_phase<MK_ALIGN>(lds, g, S, E, tid); }
                { pg8::Gemm g{MEMN, (const bf16_t*)(ws + WS_WK), D, D, D, 2, 0, 0, (long)D * D, 0}; pg8::Sched S; S.init(MT / 256, D / 256, 2, G, bx);
                  pg8::EpiStore E{KL, D, 2, (long)MT * D, 0, nullptr, 1.0f}; pg8::gemm_phase<MK_ALIGN>(lds, g, S, E, tid); }
                { pg8::Gemm g{MEMN, (const bf16_t*)(ws + WS_WV), D, D, D, 2, 0, 0, (long)D * D, 0}; pg8::Sched S; S.init(MT / 256, D / 256, 2, G, (bx + G / 2) % G);
                  pg8::EpiStore E{VL, D, 2, (long)MT * D, 0, nullptr, 1.0f}; pg8::gemm_phase<MK_ALIGN>(lds, g, S, E, tid); }
                SEAM(pb + 0);
            }
            PHASE(3, pb + 1) { LOCALS
                for (int i = bx; i < 1024; i += G) gmlp_unit(i, lds, U, V, VST, (const bf16_t*)(ws + WS_GW), ap->in[5], MIX, tid);
                conv_units(bx, G, 1024, lds, H, ap->in[6], ap->in[7], ap->in[8], ap->in[9], MIX, tid);
#pragma unroll 1
                for (int l2 = 0; l2 < 2; ++l2) {
                    { pg8::Gemm g{KL + (size_t)l2 * MT * D, (const bf16_t*)(ws + WS_WQ) + (size_t)l2 * D * D, D, D, 256, 4, 256, 256L * D, 256, 0}; pg8::Sched S; S.init(1, 4, 32, G, bx);
                      pg8::EpiStore E{(bf16_t*)(ws + WS_WQK) + (size_t)l2 * 8 * D * D, D, 4, 256L * D, (long)D * D, nullptr, 1.0f}; pg8::gemm_phase<MK_ALIGN>(lds, g, S, E, tid); }
                    { pg8::Gemm g{(const bf16_t*)(ws + WS_WO) + (size_t)l2 * D * D, VL + (size_t)l2 * MT * D, D, D, 256, 4, 256, 0, 256, 256L * D}; pg8::Sched S; S.init(4, 1, 32, G, (bx + G / 2) % G);
                      pg8::EpiStore E{(bf16_t*)(ws + WS_WVO) + (size_t)l2 * 8 * D * D, D, 4, 256, (long)D * D, nullptr, 1.0f}; pg8::gemm_phase<MK_ALIGN>(lds, g, S, E, tid); }
                }
                SEAM(pb + 1);
            }
            PHASE(4, pb + 2) { LOCALS
                pg8::Gemm g{MIX, (const bf16_t*)(ws + WS_WOUT0), D, D, D, 1, 0, 0, 0, 0}; pg8::Sched S; S.init(T / 256, D / 256, 1, G, bx);
                pg8::EpiRes<false> E{XB, SSa + T, 0}; pg8::gemm_phase<MK_ALIGN>(lds, g, S, E, tid);
                SEAM(pb + 2);
            }
        } else {
            PHASE(5, pb + 0) { LOCALS
                pg8::Gemm g{XB, (const bf16_t*)(ws + WS_WOIN), D, D, D, 1, 0, 0, 0, 0}; pg8::Sched S; S.init(T / 256, 512 / 256, 1, G, bx);
                pg8::EpiOin E{SSa, AC}; pg8::gemm_phase<MK_ALIGN>(lds, g, S, E, tid);
                SEAM(pb + 0);
            }
            PHASE(6, pb + 1) { LOCALS
                pg8::Gemm g{AC, (const bf16_t*)(ws + WS_GM), AK, 512, 512, 32, (long)NCH * AK, 0, 256L * 512, 0}; pg8::Sched S; S.init(NCH / 256, 1, 32, G, bx);
                pg8::EpiS5State E{XL}; pg8::gemm_phase<MK_ALIGN>(lds, g, S, E, tid);
                SEAM(pb + 1);
            }
            PHASE(7, pb + 2) { LOCALS
                if (wave == 0) {
#pragma unroll 1
                    for (int idx = bx * 64 + lane; idx < NB * 32 * 64; idx += G * 64) { const int p = idx & 63, g = (idx >> 6) & 31, b = idx >> 11;
                        const float* AL = (const float*)(ws + WS_AL); const float ar = AL[(g * 64 + p) * 2], ai = AL[(g * 64 + p) * 2 + 1];
                        const float* xl = XL + (size_t)g * NCH * 128 + (size_t)(b * (SEQ / SL)) * 128; bf16_t* ac = AC + (size_t)g * NCH * AK + (size_t)(b * (SEQ / SL)) * AK + 512;
                        float xr = 0.f, xi = 0.f;
#pragma unroll 1
                        for (int c0 = 0; c0 < SEQ / SL; c0 += 32) { float lr[32], li[32];
#pragma unroll
                            for (int i = 0; i < 32; ++i) { lr[i] = xl[(size_t)(c0 + i) * 128 + p]; li[i] = xl[(size_t)(c0 + i) * 128 + 64 + p]; }
#pragma unroll
                            for (int i = 0; i < 32; ++i) { const unsigned pk = cvt_pk_bf16(xr, xi); ac[(size_t)(c0 + i) * AK + p] = (bf16_t)(pk & 0xffffu); ac[(size_t)(c0 + i) * AK + 64 + p] = (bf16_t)(pk >> 16);
                                const float nr = ar * xr - ai * xi + lr[i], ni = ar * xi + ai * xr + li[i]; xr = nr; xi = ni; } }
                    }
                }
                SEAM(pb + 2);
            }
            PHASE(8, pb + 3) { LOCALS
                pg8::Gemm g{AC, (const bf16_t*)(ws + WS_BT3), AK, AK, AK, 32, (long)NCH * AK, 0, 512L * AK, 0}; pg8::Sched S; S.init(NCH / 256, 2, 32, G, bx);
                pg8::EpiS5Out E{AC, ap->in[20], Y}; pg8::gemm_phase<MK_ALIGN>(lds, g, S, E, tid);
                SEAM(pb + 3);
            }
            PHASE(9, pb + 4) { LOCALS
                pg8::Gemm g{Y, (const bf16_t*)(ws + WS_WOOUT), 512, 512, 512, 1, 0, 0, 0, 0}; pg8::Sched S; S.init(T / 256, 2048 / 256, 1, G, bx);
                pg8::EpiRes<true> E{XB, SSa + T, 0}; pg8::gemm_phase<MK_ALIGN>(lds, g, S, E, tid);
                SEAM(pb + 4);
            }
        }
        PHASE(10, pb + 5) { LOCALS
            pg8::Gemm g{XB, (const bf16_t*)(ws + WS_WQK) + (size_t)l * 8 * D * D, D, D, D, 8, (long)SEQ * D, 0, (long)D * D, 0}; pg8::Sched S; S.init(SEQ / 256, D / 256, 8, G, bx);
            pg8::EpiSoftmax E{QO, SSa + T}; pg8::gemm_phase<true>(lds, g, S, E, tid);
            SEAM(pb + 5);
        }
        PHASE(13, pb + 6) { LOCALS
            pg8::Gemm g{QO, (const bf16_t*)(ws + WS_WVO) + (size_t)l * 8 * D * D, D, D, D, 8, (long)SEQ * D, 0, (long)D * D, 0}; pg8::Sched S; S.init(SEQ / 256, D / 256, 8, G, bx);
            pg8::EpiRes<false> E{XB, SSa + 2 * T, SEQ}; pg8::gemm_phase<MK_ALIGN>(lds, g, S, E, tid);
            SEAM(pb + 6);
        }
        PHASE(14, pb + 9) { LOCALS
            pg8::Gemm g{XB, (const bf16_t*)(ws + WS_WGU + l * WGU_L), D, D, D, 1, 0, 0, 0, 0}; pg8::Sched S; S.init(T / 256, 2 * FH / 256, 1, G, bx);
            pg8::EpiFfn1 E{SSa + 2 * T, HM}; pg8::gemm_phase<MK_ALIGN>(lds, g, S, E, tid);
            SEAM(pb + 9);
        }
        PHASE(15, pb + 10) { LOCALS
            pg8::Gemm g{HM, (const bf16_t*)(ws + WS_WD + l * WD_L), FH, FH, FH, 1, 0, 0, 0, 0}; pg8::Sched S; S.init(T / 256, D / 256, 1, G, bx);
            pg8::EpiRes<false> E{XB, SSa + 3 * T, 0}; pg8::gemm_phase<MK_ALIGN>(lds, g, S, E, tid);
            SEAM(pb + 10);
        }
    }
    PHASE(16, 27) { const int l = 0; LOCALS
        const u64* ssf = SS + (size_t)6 * T; const float* gf = ap->in[32];
        const f32x4 ga = *(const f32x4*)(gf + 8 * lane), gb = *(const f32x4*)(gf + 8 * lane + 4), gc = *(const f32x4*)(gf + 512 + 8 * lane), gd = *(const f32x4*)(gf + 512 + 8 * lane + 4);
        for (int m = gw * 4; m < T; m += NGW * 4) { u32x4 v[4][2]; float rs[4];
#pragma unroll
            for (int r = 0; r < 4; ++r) { rs[r] = rsqrtf(fx_get(ssf + m + r) * (1.0f / D) + EPS); const bf16_t* xr = XB + (size_t)(m + r) * D + 8 * lane; v[r][0] = *(const u32x4*)xr; v[r][1] = *(const u32x4*)(xr + 512); }
#pragma unroll
            for (int r = 0; r < 4; ++r) { float* orow = out + (size_t)(m + r) * D + 8 * lane; f32x4 a0, a1, b0, b1; pg8::unpack8(v[r][0], a0, a1); pg8::unpack8(v[r][1], b0, b1);
                *(f32x4*)orow = a0 * rs[r] * ga; *(f32x4*)(orow + 4) = a1 * rs[r] * gb; *(f32x4*)(orow + 512) = b0 * rs[r] * gc; *(f32x4*)(orow + 516) = b1 * rs[r] * gd; } }
    }
}

extern "C" void kernel_launch(void* const* d_in, const int* in_sizes, int n_in, void* d_out, int out_size, void* d_ws, size_t ws_size, hipStream_t stream) {
    static int grid = 0;
    if (grid == 0) {
        if (n_in != 33 || in_sizes[0] != T * D || out_size != T * D || ws_size < WS_END) { fprintf(stderr, "kernel_launch: unexpected shapes (n_in %d, in0 %d, out %d, ws %zu < %zu)\n", n_in, n_in > 0 ? in_sizes[0] : -1, out_size, ws_size, (size_t)WS_END); grid = -1; return; }
        int dev = 0, cus = 0, per_cu = 0;
        hipGetDevice(&dev); hipDeviceGetAttribute(&cus, hipDeviceAttributeMultiprocessorCount, dev);
        if (hipFuncSetAttribute((const void*)trunk_fwd, hipFuncAttributeMaxDynamicSharedMemorySize, LDS_BYTES) != hipSuccess) { fprintf(stderr, "kernel_launch: hipFuncSetAttribute failed\n"); grid = -1; return; }
        if (hipOccupancyMaxActiveBlocksPerMultiprocessor(&per_cu, (const void*)trunk_fwd, 512, LDS_BYTES) != hipSuccess || per_cu < 1) { fprintf(stderr, "kernel_launch: occupancy query says %d\n", per_cu); per_cu = 1; }
        (void)hipGetLastError();
        grid = cus * 1;
        if (grid <= 0) grid = 256;
    }
    if (grid < 0) return;
    Args a{};
    for (int i = 0; i < 33; ++i) a.in[i] = (const float*)d_in[i];
    a.out = (float*)d_out; a.ws = (unsigned char*)d_ws;
#if !MK_MULTI && !MK_CGSYNC
    (void)hipMemsetAsync((char*)d_ws + WS_BAR, 0, XCD_BAR_WORDS * 4, stream);
#endif
#if MK_MULTI
    for (int p = 0; p < NPHASE; ++p) {
        if (p == 1 || p == 2 || p == 6 || p == 7 || p == 10 || p == 11 || p == 14 || p == 22 || p == 23 || p == 26) continue;
        a.ph_lo = p; a.ph_hi = p + 1; void* kargs[] = {&a};
        hipError_t e = hipLaunchCooperativeKernel((const void*)trunk_fwd, dim3(grid), dim3(512), kargs, LDS_BYTES, stream);
        if (e != hipSuccess) { fprintf(stderr, "kernel_launch: launch of phase %d failed: %s\n", p, hipGetErrorString(e)); break; }
    }
#else
    a.ph_lo = 0; a.ph_hi = NPHASE; void* kargs[] = {&a};
    hipError_t e = hipLaunchCooperativeKernel((const void*)trunk_fwd, dim3(grid), dim3(512), kargs, LDS_BYTES, stream);
    if (e != hipSuccess) fprintf(stderr, "kernel_launch: cooperative launch failed: %s (grid %d)\n", hipGetErrorString(e), grid);
#endif
}
```

```cpp
#include <hip/hip_runtime.h>
#include <hip/hip_cooperative_groups.h>
#include <cstdio>
#include <cstdint>
namespace cg = cooperative_groups;

#ifndef MK_MULTI
#define MK_MULTI 0
#endif
#ifndef MK_ALIGN
#define MK_ALIGN true
#endif
#ifndef BARPROBE
#define BARPROBE 0
#endif
#ifndef MK_CGSYNC
#define MK_CGSYNC 0
#endif

#define LAS __attribute__((address_space(3)))
typedef unsigned short bf16_t;
typedef short bf16x8 __attribute__((ext_vector_type(8)));
typedef float f32x4 __attribute__((ext_vector_type(4)));
typedef float f32x2 __attribute__((ext_vector_type(2)));
typedef unsigned u32x4 __attribute__((ext_vector_type(4)));
typedef unsigned u32x2 __attribute__((ext_vector_type(2)));

constexpr int T = 32768, D = 1024, SEQ = 4096, NB = 8, MT = 2048, FH = 2816;
constexpr float EPS = 1e-6f;
constexpr int SL = 32;
constexpr int NCH = T / SL;
constexpr int AK = SL * 16 + 128;

constexpr size_t MiB = 1u << 20;
constexpr size_t WS_WIN0 = 0, WS_WOUT0 = 4 * MiB, WS_WOIN = 6 * MiB, WS_WOOUT = 7 * MiB, WS_WQ = 9 * MiB, WS_WK = 13 * MiB, WS_WV = 17 * MiB, WS_WO = 21 * MiB;
constexpr size_t WS_WGU = 25 * MiB, WS_WD = 47 * MiB, WS_GW = 58 * MiB, WS_AL = 59 * MiB, WS_BT3 = 60 * MiB, WS_GM = 80 * MiB, WS_MEMN = 88 * MiB, WS_KL = 92 * MiB, WS_VL = 100 * MiB;
constexpr size_t WS_XB = 110 * MiB, WS_QO = 174 * MiB, WS_P = 238 * MiB, WS_R0 = 302 * MiB;
constexpr size_t WS_WQK = WS_P, WS_WVO = WS_P + 32 * MiB;
constexpr size_t WS_HM = WS_R0, WS_U = WS_R0, WS_V = WS_R0 + 32 * MiB, WS_H = WS_R0 + 64 * MiB, WS_MIX = WS_R0 + 96 * MiB;
constexpr size_t WS_ACOMB = WS_R0, WS_XLOC = WS_R0 + 40 * MiB, WS_Y = WS_R0 + 56 * MiB;
constexpr size_t WS_SS = WS_R0 + 176 * MiB, WS_VST = WS_SS + 2 * MiB, WS_BAR = WS_VST + 1 * MiB, WS_END = WS_BAR + 1 * MiB;
constexpr size_t WGU_L = (size_t)2 * FH * D * 2, WD_L = (size_t)D * FH * 2, WSQ_L = (size_t)D * D * 2;

constexpr int RING_BYTES = 131072, XCH_OFF = RING_BYTES, MISC_OFF = RING_BYTES + 8192, LDS_BYTES = 147456;

__device__ __forceinline__ unsigned cvt_pk_bf16(float lo, float hi) { unsigned r; asm volatile("v_cvt_pk_bf16_f32 %0, %1, %2" : "=v"(r) : "v"(lo), "v"(hi)); return r; }
__device__ __forceinline__ float bf2f(unsigned short b) { return __builtin_bit_cast(float, (unsigned)b << 16); }
__device__ __forceinline__ float bflo(unsigned w) { return __builtin_bit_cast(float, w << 16); }
__device__ __forceinline__ float bfhi(unsigned w) { return __builtin_bit_cast(float, w & 0xffff0000u); }
__device__ __forceinline__ float sigmoid_f(float x) { return __builtin_amdgcn_rcpf(1.0f + __expf(-x)); }
__device__ __forceinline__ float silu_f(float x) { return x * sigmoid_f(x); }
__device__ __forceinline__ float gelu_f(float x) { return x * sigmoid_f(1.5957691216f * (x + 0.044715f * x * x * x)); }
typedef unsigned long long u64;
__device__ __forceinline__ void fx_add(u64* p, float q) { atomicAdd(p, (u64)(long long)(q * 16777216.0f)); }
__device__ __forceinline__ float fx_get(const u64* p) { return (float)(long long)(*p) * (1.0f / 16777216.0f); }
__device__ __forceinline__ float wave_sum(float v) {
#pragma unroll
    for (int o = 1; o < 64; o <<= 1) v += __shfl_xor(v, o);
    return v;
}
__device__ __forceinline__ u32x4 pack8(f32x4 a, f32x4 b) { u32x4 w; w.x = cvt_pk_bf16(a[0], a[1]); w.y = cvt_pk_bf16(a[2], a[3]); w.z = cvt_pk_bf16(b[0], b[1]); w.w = cvt_pk_bf16(b[2], b[3]); return w; }

namespace pg8 {
constexpr int BM = 256, BK = 64, HALF = 128, HTB = HALF * BK * 2, NXCD = 8, WGM = 4;
__device__ __forceinline__ int lds_byte(int r, int c) { const int st = (r >> 4) * 2 + (c >> 5), rr = r & 15, cc = c & 31, ob = rr * 64 + cc * 2; return st * 1024 + (ob ^ (((ob >> 9) & 1) << 5)); }
__device__ __forceinline__ void stage_rc(int b, int& R, int& C) { const int st = b / 1024, sb = b % 1024, swz = sb ^ (((sb >> 9) & 1) << 5); R = (st >> 1) * 16 + swz / 64; C = (st & 1) * 32 + (swz % 64) / 2; }
__device__ __forceinline__ int perm32(int rho) { const int n = rho >> 4, i = rho & 15; return 8 * (i >> 2) + 4 * n + (i & 3); }

struct Unit { int pm, pn, z; };
struct Gemm { const bf16_t* A; const bf16_t* Bt; int lda, ldb, K, nz0; long sAz0, sAz1, sBz0, sBz1; };
struct Sched {
    int nM, nN, per, total, G, c;
    __device__ __forceinline__ void init(int nM_, int nN_, int nz, int G_, int c_) { nM = nM_; nN = nN_; per = nM_ * nN_; total = per * nz; G = G_; c = c_; }
    __device__ __forceinline__ bool next(int i, Unit& u) const {
        const long L = (long)i * G + c; if (L >= total) return false;
        const int z = (int)(L / per); int wgid = (int)(L % per);
        { const int q = per / NXCD, r = per % NXCD, xcd = wgid % NXCD, off = wgid / NXCD; wgid = (xcd < r ? xcd * (q + 1) : r * (q + 1) + (xcd - r) * q) + off; }
        const int nig = WGM * nN, gid = wgid / nig, fm = gid * WGM, gsz = (nM - fm) < WGM ? (nM - fm) : WGM;
        u.pm = fm + ((wgid % nig) % gsz); u.pn = (wgid % nig) / gsz; u.z = z; return true;
    }
};

template <bool ALIGN, class Epi>
__device__ __forceinline__ void gemm_phase(LAS unsigned char* lds, const Gemm g, const Sched& S, const Epi& E, const int tid) {
    const int wid = __builtin_amdgcn_readfirstlane(tid >> 6), lane = tid & 63, wr = wid >> 2, wc = wid & 3, fr = lane & 15, fq = lane >> 4;
    const int nt = g.K / BK;
    unsigned voffA[2], voffB[2];
#pragma unroll
    for (int i = 0; i < 2; ++i) { int R, C; stage_rc(tid * 16 + i * 8192, R, C); const int Rb = (R & ~31) + perm32(R & 31);
        voffA[i] = (unsigned)(R * g.lda + C) * 2u; voffB[i] = (unsigned)(Rb * g.ldb + C) * 2u; }
    const size_t kstep = (size_t)(BK * 2);
    const size_t hsA = (size_t)HALF * g.lda * 2, hsB = (size_t)HALF * g.ldb * 2;
    const unsigned ldsw = (unsigned)wid * 1024u;
    const int aoff = lds_byte(wr * 64 + fr, fq * 8), boff = lds_byte(wc * 32 + fr, fq * 8);
#define PG8_SA(b, h) (((b) * 2 + (h)) * HTB)
#define PG8_SB(b, h) ((4 + (b) * 2 + (h)) * HTB)
#define PG8_STAGE(bufoff, gbase, voff) do { _Pragma("unroll") for (int _i = 0; _i < 2; ++_i) \
        __builtin_amdgcn_global_load_lds((const unsigned*)((const char*)(gbase) + (voff)[_i]), (LAS unsigned*)(lds + (bufoff) + ldsw + _i * 8192), 16, 0, 0); } while (0)
#define PG8_LDA(dst, b, h) do { _Pragma("unroll") for (int m = 0; m < 4; ++m) _Pragma("unroll") for (int k = 0; k < 2; ++k) dst[m][k] = *(const LAS bf16x8*)(lds + PG8_SA(b, h) + aoff + m * 2048 + k * 1024); } while (0)
#define PG8_LDB(dst, b, h) do { _Pragma("unroll") for (int n = 0; n < 2; ++n) _Pragma("unroll") for (int k = 0; k < 2; ++k) dst[n][k] = *(const LAS bf16x8*)(lds + PG8_SB(b, h) + boff + n * 2048 + k * 1024); } while (0)
#define PG8_MMA(ai, bj, At, Bt) do { __builtin_amdgcn_s_setprio(1); _Pragma("unroll") for (int m = 0; m < 4; ++m) _Pragma("unroll") for (int n = 0; n < 2; ++n) _Pragma("unroll") for (int k = 0; k < 2; ++k) \
        acc[ai][bj][m][n] = __builtin_amdgcn_mfma_f32_16x16x32_bf16(Bt[n][k], At[m][k], acc[ai][bj][m][n], 0, 0, 0); __builtin_amdgcn_s_setprio(0); } while (0)
#define PG8_WAIT_V(n) asm volatile("s_waitcnt vmcnt(" #n ")" ::: "memory")
#define PG8_WAIT_L(n) asm volatile("s_waitcnt lgkmcnt(" #n ")" ::: "memory")
#define PG8_BAR __builtin_amdgcn_s_barrier()
#define PG8_SCHED __builtin_amdgcn_sched_barrier(0)
#define PG8_UA(u) ((const char*)g.A + 2 * ((size_t)((u).z % g.nz0) * g.sAz0 + (size_t)((u).z / g.nz0) * g.sAz1 + (size_t)(u).pm * BM * g.lda))
#define PG8_UB(u) ((const char*)g.Bt + 2 * ((size_t)((u).z % g.nz0) * g.sBz0 + (size_t)((u).z / g.nz0) * g.sBz1 + (size_t)(u).pn * BM * g.ldb))
    Unit cur, nxt; int ui = 0;
    if (!S.next(0, cur)) return;
    f32x4 acc[2][2][4][2];
#pragma unroll
    for (int a = 0; a < 2; ++a)
#pragma unroll
        for (int b = 0; b < 2; ++b)
#pragma unroll
            for (int m = 0; m < 4; ++m)
#pragma unroll
                for (int n = 0; n < 2; ++n) acc[a][b][m][n] = (f32x4){0.f, 0.f, 0.f, 0.f};
    bf16x8 At[4][2], B0[2][2], B1[2][2];
    const char* cA = PG8_UA(cur); const char* cB = PG8_UB(cur);
    PG8_STAGE(PG8_SB(0, 0), cB, voffB); PG8_STAGE(PG8_SB(0, 1), cB + hsB, voffB); PG8_STAGE(PG8_SA(0, 0), cA, voffA); PG8_STAGE(PG8_SA(0, 1), cA + hsA, voffA);
    if (wr == 1) PG8_BAR;
    PG8_WAIT_V(2); PG8_BAR;
    PG8_STAGE(PG8_SB(1, 0), cB + kstep, voffB); PG8_STAGE(PG8_SA(1, 0), cA + kstep, voffA); PG8_STAGE(PG8_SB(1, 1), cB + hsB + kstep, voffB);
    PG8_WAIT_V(6); PG8_BAR;
    for (;;) {
        const bool has_next = S.next(ui + 1, nxt);
        const char* nA = has_next ? PG8_UA(nxt) : cA; const char* nB = has_next ? PG8_UB(nxt) : cB;
        for (int t = 0; t < nt; t += 2) {
            const bool last = (t == nt - 2);
            const char* a1 = cA + (size_t)(t + 1) * kstep;
            const char* a2 = last ? nA : cA + (size_t)(t + 2) * kstep; const char* b2 = last ? nB : cB + (size_t)(t + 2) * kstep;
            const char* a3 = a2 + kstep; const char* b3 = b2 + kstep;
            PG8_LDB(B0, 0, 0); PG8_LDB(B1, 0, 1); PG8_SCHED; PG8_LDA(At, 0, 0); PG8_STAGE(PG8_SA(1, 1), a1 + hsA, voffA);
            PG8_WAIT_V(8); PG8_WAIT_L(0); PG8_BAR; PG8_MMA(0, 0, At, B0); PG8_MMA(0, 1, At, B1); PG8_BAR; PG8_SCHED;
            PG8_LDA(At, 0, 1); PG8_STAGE(PG8_SB(0, 0), b2, voffB); PG8_STAGE(PG8_SB(0, 1), b2 + hsB, voffB); PG8_STAGE(PG8_SA(0, 0), a2, voffA);
            PG8_WAIT_V(8); PG8_WAIT_L(0); PG8_BAR; PG8_MMA(1, 0, At, B0); PG8_MMA(1, 1, At, B1); PG8_BAR; PG8_SCHED;
            PG8_LDB(B0, 1, 0); PG8_LDB(B1, 1, 1); PG8_SCHED; PG8_LDA(At, 1, 0); PG8_STAGE(PG8_SA(0, 1), a2 + hsA, voffA);
            PG8_WAIT_V(8); PG8_WAIT_L(0); PG8_BAR; PG8_MMA(0, 0, At, B0); PG8_MMA(0, 1, At, B1); PG8_BAR; PG8_SCHED;
            PG8_LDA(At, 1, 1); PG8_STAGE(PG8_SB(1, 0), b3, voffB); PG8_STAGE(PG8_SB(1, 1), b3 + hsB, voffB); PG8_STAGE(PG8_SA(1, 0), a3, voffA);
            PG8_WAIT_V(8); PG8_WAIT_L(0); PG8_BAR; PG8_MMA(1, 0, At, B0); PG8_MMA(1, 1, At, B1); PG8_BAR; PG8_SCHED;
        }
        if (ALIGN) { if (wr == 0) PG8_BAR; }
        E(acc, cur, wr, wc, fr, fq, lds);
        if (!has_next) break;
#pragma unroll
        for (int a = 0; a < 2; ++a)
#pragma unroll
            for (int b = 0; b < 2; ++b)
#pragma unroll
                for (int m = 0; m < 4; ++m)
#pragma unroll
                    for (int n = 0; n < 2; ++n) acc[a][b][m][n] = (f32x4){0.f, 0.f, 0.f, 0.f};
        cur = nxt; cA = nA; cB = nB; ++ui;
        if (ALIGN) { if (wr == 1) PG8_BAR; }
    }
    PG8_WAIT_V(0);
    if (!ALIGN) { if (wr == 0) PG8_BAR; }
    PG8_BAR;
#undef PG8_SA
#undef PG8_SB
#undef PG8_STAGE
#undef PG8_LDA
#undef PG8_LDB
#undef PG8_MMA
#undef PG8_UA
#undef PG8_UB
}

typedef f32x4 Acc[2][2][4][2];
#define EPI_ARGS Acc& acc, const Unit& u, int wr, int wc, int fr, int fq, LAS unsigned char* lds
__device__ __forceinline__ int efence() { asm volatile("" ::: "memory"); return 1; }
#define ROWLOOP _Pragma("unroll") for (int ai = 0; ai < 2; ++ai) _Pragma("unroll") for (int m = 0; m < 4; ++m) for (int once_ = efence(); once_; once_ = 0)

#define LOAD_RS8(rs, ssp, row0) float rs[2][4]; { u64 raw_[2][4]; _Pragma("unroll") for (int ai = 0; ai < 2; ++ai) _Pragma("unroll") for (int m = 0; m < 4; ++m) raw_[ai][m] = (ssp)[(row0) + ai * 128 + m * 16]; \
    _Pragma("unroll") for (int ai = 0; ai < 2; ++ai) _Pragma("unroll") for (int m = 0; m < 4; ++m) rs[ai][m] = rsqrtf((float)(long long)raw_[ai][m] * (1.0f / 16777216.0f) * (1.0f / D) + EPS); }
struct EpiIn0 {
    const u64* ss; bf16_t* U; bf16_t* V; bf16_t* H; u64* vst;
    __device__ __forceinline__ void operator()(EPI_ARGS) const {
        const int row0 = u.pm * 256 + wr * 64 + fr;
        LOAD_RS8(rs8, ss, row0);
        if (u.pn < 4) {
            bf16_t* dst = (u.pn < 2) ? U : V; const int col0 = (u.pn & 1) * 256 + wc * 32 + 8 * fq; const bool st = u.pn >= 2;
            ROWLOOP { const int row = row0 + ai * 128 + m * 16; const float rs = rs8[ai][m]; float s = 0.f, q = 0.f;
#pragma unroll
                for (int bj = 0; bj < 2; ++bj) { f32x4 v0 = acc[ai][bj][m][0] * rs, v1 = acc[ai][bj][m][1] * rs;
#pragma unroll
                    for (int e = 0; e < 4; ++e) { v0[e] = gelu_f(v0[e]); v1[e] = gelu_f(v1[e]); s += v0[e] + v1[e]; q += v0[e] * v0[e] + v1[e] * v1[e]; }
                    *(u32x4*)(dst + (size_t)row * 512 + col0 + bj * 128) = pack8(v0, v1); }
                if (st) { s += __shfl_xor(s, 16); s += __shfl_xor(s, 32); q += __shfl_xor(q, 16); q += __shfl_xor(q, 32);
                    if (fq == 0) { fx_add(vst + 2 * row, s); fx_add(vst + 2 * row + 1, q); } }
            }
        } else {
            const int col0 = (u.pn - 4) * 128 + wc * 32 + 8 * fq;
            ROWLOOP { const int row = row0 + ai * 128 + m * 16; const float rs = rs8[ai][m]; f32x4 h0, h1;
#pragma unroll
                for (int e = 0; e < 4; ++e) { h0[e] = acc[ai][0][m][0][e] * rs * sigmoid_f(acc[ai][1][m][0][e] * rs); h1[e] = acc[ai][0][m][1][e] * rs * sigmoid_f(acc[ai][1][m][1][e] * rs); }
                *(u32x4*)(H + (size_t)row * 512 + col0) = pack8(h0, h1); }
        }
    }
};
__device__ __forceinline__ void unpack8(u32x4 b, f32x4& o0, f32x4& o1) { o0 = (f32x4){bflo(b.x), bfhi(b.x), bflo(b.y), bfhi(b.y)}; o1 = (f32x4){bflo(b.z), bfhi(b.z), bflo(b.w), bfhi(b.w)}; }
template <bool GLU> struct EpiRes {
    bf16_t* xb; u64* ss; int zrows;
    __device__ __forceinline__ void operator()(EPI_ARGS) const {
        const int row0 = u.z * zrows + u.pm * 256 + wr * 64 + fr;
#pragma unroll
        for (int ai = 0; ai < 2; ++ai) {
            u32x4 pre[4][2];
#pragma unroll
            for (int m = 0; m < 4; ++m) { const int row = row0 + ai * 128 + m * 16;
                if (GLU) pre[m][0] = *(const u32x4*)(xb + (size_t)row * D + u.pn * 128 + wc * 32 + 8 * fq);
                else {
#pragma unroll
                    for (int bj = 0; bj < 2; ++bj) pre[m][bj] = *(const u32x4*)(xb + (size_t)row * D + u.pn * 256 + bj * 128 + wc * 32 + 8 * fq); } }
#pragma unroll
            for (int m = 0; m < 4; ++m) for (int once_ = efence(); once_; once_ = 0) { const int row = row0 + ai * 128 + m * 16; float q = 0.f;
                if (GLU) { const size_t off = (size_t)row * D + u.pn * 128 + wc * 32 + 8 * fq;
                    f32x4 o0, o1; unpack8(pre[m][0], o0, o1);
#pragma unroll
                    for (int e = 0; e < 4; ++e) { o0[e] += acc[ai][0][m][0][e] * sigmoid_f(acc[ai][1][m][0][e]); o1[e] += acc[ai][0][m][1][e] * sigmoid_f(acc[ai][1][m][1][e]);
                        q += o0[e] * o0[e] + o1[e] * o1[e]; }
                    *(u32x4*)(xb + off) = pack8(o0, o1);
                } else {
#pragma unroll
                    for (int bj = 0; bj < 2; ++bj) { const size_t off = (size_t)row * D + u.pn * 256 + bj * 128 + wc * 32 + 8 * fq;
                        f32x4 o0, o1; unpack8(pre[m][bj], o0, o1); o0 += acc[ai][bj][m][0]; o1 += acc[ai][bj][m][1];
#pragma unroll
                        for (int e = 0; e < 4; ++e) q += o0[e] * o0[e] + o1[e] * o1[e];
                        *(u32x4*)(xb + off) = pack8(o0, o1); }
                }
                q += __shfl_xor(q, 16); q += __shfl_xor(q, 32);
                if (fq == 0) fx_add(ss + row, q);
            }
        }
    }
};
struct EpiStore {
    bf16_t* O; int ldc, nz0; long sz0, sz1; const u64* ss; float scale;
    __device__ __forceinline__ void operator()(EPI_ARGS) const {
        bf16_t* base = O + (size_t)(u.z % nz0) * sz0 + (size_t)(u.z / nz0) * sz1; const int row0 = u.pm * 256 + wr * 64 + fr, col0 = u.pn * 256 + wc * 32 + 8 * fq;
        float rs8[2][4];
        if (ss) { LOAD_RS8(t8, ss, row0);
#pragma unroll
            for (int ai = 0; ai < 2; ++ai)
#pragma unroll
                for (int m = 0; m < 4; ++m) rs8[ai][m] = t8[ai][m] * scale; }
        else {
#pragma unroll
            for (int ai = 0; ai < 2; ++ai)
#pragma unroll
                for (int m = 0; m < 4; ++m) rs8[ai][m] = scale; }
        ROWLOOP { const int row = row0 + ai * 128 + m * 16; const float rs = rs8[ai][m];
#pragma unroll
            for (int bj = 0; bj < 2; ++bj) *(u32x4*)(base + (size_t)row * ldc + col0 + bj * 128) = pack8(acc[ai][bj][m][0] * rs, acc[ai][bj][m][1] * rs); }
    }
};
struct EpiSoftmax {
    bf16_t* P; const u64* ss;
    __device__ __forceinline__ void operator()(EPI_ARGS) const {
        LAS float* X = (LAS float*)(lds + XCH_OFF); LAS float* Y = X + 1024;
        const int grow0 = u.z * SEQ + u.pm * 256 + wr * 64 + fr;
        LOAD_RS8(rs8, ss, grow0);
        ROWLOOP { const int r = ai * 128 + wr * 64 + m * 16 + fr; const float sc = rs8[ai][m] * 0.0625f; float mx = -3.0e38f;
#pragma unroll
            for (int bj = 0; bj < 2; ++bj)
#pragma unroll
                for (int n = 0; n < 2; ++n) { acc[ai][bj][m][n] = acc[ai][bj][m][n] * sc;
#pragma unroll
                    for (int e = 0; e < 4; ++e) mx = fmaxf(mx, acc[ai][bj][m][n][e]); }
            mx = fmaxf(mx, __shfl_xor(mx, 16)); mx = fmaxf(mx, __shfl_xor(mx, 32));
            if (fq == 0) X[r * 4 + wc] = mx; }
        asm volatile("s_waitcnt lgkmcnt(0)" ::: "memory"); __builtin_amdgcn_s_barrier(); asm volatile("" ::: "memory");
        ROWLOOP { const int r = ai * 128 + wr * 64 + m * 16 + fr; const f32x4 xm = *(const LAS f32x4*)(X + r * 4); const float mx = fmaxf(fmaxf(xm[0], xm[1]), fmaxf(xm[2], xm[3])); float s = 0.f;
#pragma unroll
            for (int bj = 0; bj < 2; ++bj)
#pragma unroll
                for (int n = 0; n < 2; ++n)
#pragma unroll
                    for (int e = 0; e < 4; ++e) { const float p = __expf(acc[ai][bj][m][n][e] - mx); acc[ai][bj][m][n][e] = p; s += p; }
            s += __shfl_xor(s, 16); s += __shfl_xor(s, 32);
            if (fq == 0) Y[r * 4 + wc] = s; }
        asm volatile("s_waitcnt lgkmcnt(0)" ::: "memory"); __builtin_amdgcn_s_barrier(); asm volatile("" ::: "memory");
        ROWLOOP { const int r = ai * 128 + wr * 64 + m * 16 + fr; const f32x4 ys = *(const LAS f32x4*)(Y + r * 4); const float inv = 1.0f / ((ys[0] + ys[1]) + (ys[2] + ys[3]));
#pragma unroll
            for (int bj = 0; bj < 2; ++bj) *(u32x4*)(P + (size_t)(u.z * SEQ + u.pm * 256 + r) * D + u.pn * 256 + bj * 128 + wc * 32 + 8 * fq) = pack8(acc[ai][bj][m][0] * inv, acc[ai][bj][m][1] * inv); }
    }
};
struct EpiFfn1 {
    const u64* ss; bf16_t* HM;
    __device__ __forceinline__ void operator()(EPI_ARGS) const {
        const int row0 = u.pm * 256 + wr * 64 + fr, col0 = u.pn * 128 + wc * 32 + 8 * fq;
        LOAD_RS8(rs8, ss, row0);
        ROWLOOP { const int row = row0 + ai * 128 + m * 16; const float rs = rs8[ai][m]; f32x4 h0, h1;
#pragma unroll
            for (int e = 0; e < 4; ++e) { h0[e] = silu_f(acc[ai][0][m][0][e] * rs) * (acc[ai][1][m][0][e] * rs); h1[e] = silu_f(acc[ai][0][m][1][e] * rs) * (acc[ai][1][m][1][e] * rs); }
            *(u32x4*)(HM + (size_t)row * FH + col0) = pack8(h0, h1); }
    }
};
struct EpiOin {
    const u64* ss; bf16_t* AC;
    __device__ __forceinline__ void operator()(EPI_ARGS) const {
        const int row0 = u.pm * 256 + wr * 64 + fr;
        LOAD_RS8(rs8, ss, row0);
        ROWLOOP { const int row = row0 + ai * 128 + m * 16; const float rs = rs8[ai][m];
#pragma unroll
            for (int bj = 0; bj < 2; ++bj) { const int col = u.pn * 256 + bj * 128 + wc * 32 + 8 * fq;
                *(u32x4*)(AC + (size_t)(col >> 4) * NCH * AK + (size_t)(row / SL) * AK + (row % SL) * 16 + (col & 8)) = pack8(acc[ai][bj][m][0] * rs, acc[ai][bj][m][1] * rs); } }
    }
};
struct EpiS5State {
    float* XL;
    __device__ __forceinline__ void operator()(EPI_ARGS) const {
        const int row0 = u.pm * 256 + wr * 64 + fr, col0 = wc * 32 + 8 * fq;
        ROWLOOP { const int row = row0 + ai * 128 + m * 16; float* p = XL + (size_t)u.z * NCH * 128 + (size_t)row * 128 + col0;
            *(f32x4*)p = acc[ai][0][m][0]; *(f32x4*)(p + 4) = acc[ai][0][m][1]; }
    }
};
struct EpiS5Out {
    const bf16_t* AC; const float* dsk; bf16_t* Y;
    __device__ __forceinline__ void operator()(EPI_ARGS) const {
        const int g = u.z, row0 = u.pm * 256 + wr * 64 + fr;
        f32x4 dv[2][2];
#pragma unroll
        for (int bj = 0; bj < 2; ++bj) { const int ch = g * 16 + ((u.pn * 256 + bj * 128 + wc * 32 + 8 * fq) & 8); dv[bj][0] = *(const f32x4*)(dsk + ch); dv[bj][1] = *(const f32x4*)(dsk + ch + 4); }
#pragma unroll
        for (int ai = 0; ai < 2; ++ai) {
            u32x4 pre[4][2];
#pragma unroll
            for (int m = 0; m < 4; ++m)
#pragma unroll
                for (int bj = 0; bj < 2; ++bj) pre[m][bj] = *(const u32x4*)(AC + (size_t)g * NCH * AK + (size_t)(row0 + ai * 128 + m * 16) * AK + u.pn * 256 + bj * 128 + wc * 32 + 8 * fq);
#pragma unroll
            for (int m = 0; m < 4; ++m) for (int once_ = efence(); once_; once_ = 0) { const int row = row0 + ai * 128 + m * 16;
#pragma unroll
                for (int bj = 0; bj < 2; ++bj) { const int col = u.pn * 256 + bj * 128 + wc * 32 + 8 * fq, k = col >> 4, ch = g * 16 + (col & 8);
                    f32x4 u0, u1; unpack8(pre[m][bj], u0, u1);
                    f32x4 y0 = acc[ai][bj][m][0] + dv[bj][0] * u0, y1 = acc[ai][bj][m][1] + dv[bj][1] * u1;
#pragma unroll
                    for (int e = 0; e < 4; ++e) { y0[e] = gelu_f(y0[e]); y1[e] = gelu_f(y1[e]); }
                    *(u32x4*)(Y + (size_t)(row * SL + k) * 512 + ch) = pack8(y0, y1); } }
        }
    }
};
}

#define XB_TMO      128
#define XB_XCNT(j)  (256  + 64 * (j))
#define XB_XSUB(j)  (1280 + 64 * (j))
#define XB_XGEN(j)  (2304 + 64 * (j))
#define XB_TOP      3328
#define XB_TOPGEN   3392
#define XCD_BAR_WORDS 3456
#define XB_SPIN_CAP (1u << 22)
__device__ __forceinline__ unsigned xb_ld(unsigned* p)              { return __hip_atomic_load(p, __ATOMIC_RELAXED, __HIP_MEMORY_SCOPE_AGENT); }
__device__ __forceinline__ unsigned xb_add(unsigned* p, unsigned v) { return __hip_atomic_fetch_add(p, v, __ATOMIC_RELAXED, __HIP_MEMORY_SCOPE_AGENT); }
__device__ __forceinline__ unsigned xb_xcc_id() { return (unsigned)__builtin_amdgcn_s_getreg((3 << 11) | 20) & 0xFu; }
#define XB_SPIN(cond, bar) do { unsigned _sp = 0; while (cond) { __builtin_amdgcn_s_sleep(1); \
    if ((++_sp & 255u) == 0u) { if (xb_ld(&(bar)[XB_TMO])) break; if (_sp > XB_SPIN_CAP) { atomicAdd(&(bar)[XB_TMO], 1u); break; } } } } while (0)
struct XcdBarrier { unsigned* bar; unsigned x; volatile LAS unsigned* st; };
__device__ __forceinline__ XcdBarrier xcd_barrier_post(unsigned* bar, volatile LAS unsigned* st) {
    XcdBarrier b; b.bar = bar; b.x = xb_xcc_id(); b.st = st;
    if (threadIdx.x == 0) (void)xb_add(&bar[XB_XCNT(b.x)], 1u);
    return b;
}
__device__ __forceinline__ void xcd_barrier_complete(unsigned* bar, unsigned x, unsigned& nloc, unsigned& nx) {
    const unsigned G = gridDim.x * gridDim.y * gridDim.z;
    unsigned sum, cnt, mine, sp = 0u;
    for (;;) {
        sum = 0u; cnt = 0u; mine = 0u;
#pragma unroll
        for (unsigned j = 0; j < 16; ++j) { const unsigned c = xb_ld(&bar[XB_XCNT(j)]); sum += c; cnt += (c > 0u) ? 1u : 0u; mine = (j == x) ? c : mine; }
        if (sum == G) break;
        __builtin_amdgcn_s_sleep(1);
        if ((++sp & 255u) == 0u) { if (xb_ld(&bar[XB_TMO])) break; if (sp > XB_SPIN_CAP) { atomicAdd(&bar[XB_TMO], 1u); break; } }
    }
    nloc = mine > 0u ? mine : 1u; nx = cnt > 0u ? cnt : 1u;
}
__device__ __forceinline__ void xcd_barrier(const XcdBarrier& b) {
    asm volatile("s_waitcnt vmcnt(0)" ::: "memory");
    __syncthreads();
    if (threadIdx.x == 0) {
        unsigned* bar = b.bar;
        __builtin_amdgcn_s_waitcnt(0);
        unsigned nloc = b.st[0], nx = b.st[1];
        if (nloc == 0u) { xcd_barrier_complete(bar, b.x, nloc, nx); b.st[0] = nloc; b.st[1] = nx; }
        const unsigned old = xb_add(&bar[XB_XSUB(b.x)], 1u);
        const unsigned gen = old / nloc;
        if (old + 1u == (gen + 1u) * nloc) {
            __builtin_amdgcn_fence(__ATOMIC_RELEASE, "agent");
            asm volatile("s_waitcnt vmcnt(0)" ::: "memory");
            const unsigned og = xb_add(&bar[XB_TOP], 1u);
            const unsigned tg = og / nx;
            if (og + 1u == (tg + 1u) * nx) xb_add(&bar[XB_TOPGEN], 1u);
            else XB_SPIN(xb_ld(&bar[XB_TOPGEN]) == tg, bar);
            __builtin_amdgcn_fence(__ATOMIC_ACQUIRE, "agent");
            xb_add(&bar[XB_XGEN(b.x)], 1u);
            asm volatile("s_waitcnt vmcnt(0)" ::: "memory");
        } else {
            XB_SPIN(xb_ld(&bar[XB_XGEN(b.x)]) == gen, bar);
            __builtin_amdgcn_fence(__ATOMIC_ACQUIRE, "agent");
            asm volatile("s_waitcnt vmcnt(0)" ::: "memory");
        }
    }
    __syncthreads();
}

struct ConvP { const float* W; bf16_t* WT; const float* gain; int K, ldn, cs, nblk, mode, roff, r; };
__device__ __forceinline__ void conv_load(const ConvP& p, f32x4 (&v)[32], int lane) {
    const int nkb = p.K / 64, kb = p.r % nkb, nb = p.r / nkb; const float* src = p.W + (size_t)(64 * kb + (lane >> 5)) * p.ldn + p.cs + 128 * nb + 4 * (lane & 31);
#pragma unroll
    for (int i = 0; i < 32; ++i) v[i] = *(const f32x4*)(src + (size_t)(2 * i) * p.ldn);
}
__device__ __forceinline__ void conv_store(const ConvP& p, const f32x4 (&v)[32], LAS float* scr, int lane) {
    const int nkb = p.K / 64, kb = p.r % nkb, nb = p.r / nkb, k0 = 64 * kb, c = lane & 7;
    f32x4 g0 = {1.f, 1.f, 1.f, 1.f}, g1 = g0;
    if (p.gain) { g0 = *(const f32x4*)(p.gain + k0 + 8 * c); g1 = *(const f32x4*)(p.gain + k0 + 8 * c + 4); }
#pragma unroll 1
    for (int sb = 0; sb < 4; ++sb) {
        if (((lane & 31) >> 3) == sb) {
#pragma unroll
            for (int i = 0; i < 32; ++i)
#pragma unroll
                for (int e = 0; e < 4; ++e) scr[(2 * i + (lane >> 5)) * 33 + 4 * (lane & 7) + e] = v[i][e]; }
        asm volatile("s_waitcnt lgkmcnt(0)" ::: "memory");
        const int c0 = 128 * nb + 32 * sb, drow = p.roff + (p.mode == 0 ? c0 : ((c0 >> 7) * 256 + (p.mode - 1) * 128 + (c0 & 127)));
#pragma unroll
        for (int j = 0; j < 4; ++j) { const int n = (lane >> 3) + 8 * j; const LAS float* s = scr + (8 * c) * 33 + n;
            u32x4 o; o.x = cvt_pk_bf16(s[0 * 33] * g0[0], s[1 * 33] * g0[1]); o.y = cvt_pk_bf16(s[2 * 33] * g0[2], s[3 * 33] * g0[3]); o.z = cvt_pk_bf16(s[4 * 33] * g1[0], s[5 * 33] * g1[1]); o.w = cvt_pk_bf16(s[6 * 33] * g1[2], s[7 * 33] * g1[3]);
            *(u32x4*)(p.WT + (size_t)(drow + n) * p.K + k0 + 8 * c) = o; }
        asm volatile("s_waitcnt lgkmcnt(0)" ::: "memory");
    }
}
template <bool NORM, int R> __device__ __forceinline__ void rows_to_bf16(const float* x0, bf16_t* o0, u64* ssq, int lane) {
    f32x4 v[R][4]; float s[R];
#pragma unroll
    for (int r = 0; r < R; ++r) { const f32x4* xr = (const f32x4*)(x0 + (size_t)r * D) + lane;
#pragma unroll
        for (int j = 0; j < 4; ++j) v[r][j] = xr[64 * j]; }
#pragma unroll
    for (int r = 0; r < R; ++r) { float a = 0.f;
#pragma unroll
        for (int j = 0; j < 4; ++j) a += (v[r][j][0] * v[r][j][0] + v[r][j][1] * v[r][j][1]) + (v[r][j][2] * v[r][j][2] + v[r][j][3] * v[r][j][3]);
        s[r] = wave_sum(a); }
#pragma unroll
    for (int r = 0; r < R; ++r) { const float rs = NORM ? rsqrtf(s[r] * (1.0f / D) + EPS) : 1.0f; u32x2* o = (u32x2*)(o0 + (size_t)r * D) + lane;
#pragma unroll
        for (int j = 0; j < 4; ++j) { u32x2 w; w.x = cvt_pk_bf16(v[r][j][0] * rs, v[r][j][1] * rs); w.y = cvt_pk_bf16(v[r][j][2] * rs, v[r][j][3] * rs); o[64 * j] = w; }
        if (ssq && lane == 0) ssq[r] = (u64)(long long)(s[r] * 16777216.0f); }
}
__device__ __forceinline__ void cis_f(float ang, float& c, float& s) {
    float rev = ang * 0.15915494309189535f; rev = rev - rintf(rev);
    const float x = rev * 6.283185307179586f;
    const float h = x * 0.25f, h2 = h * h;
    float sh = h * (1.0f + h2 * (-1.6666667e-1f + h2 * (8.3333333e-3f + h2 * (-1.9841270e-4f + h2 * 2.7557319e-6f))));
    float ch = 1.0f + h2 * (-0.5f + h2 * (4.1666667e-2f + h2 * (-1.3888889e-3f + h2 * (2.4801587e-5f + h2 * -2.7557319e-7f))));
    float s2 = 2.f * sh * ch, c2 = 1.f - 2.f * sh * sh;
    s = 2.f * s2 * c2; c = 1.f - 2.f * s2 * s2;
}
__device__ __forceinline__ void s5_setup(int g, LAS unsigned char* lds, const float* lam_re, const float* lam_im, const float* log_dt, const float* b_re, const float* b_im, const float* c_re, const float* c_im,
                                         bf16_t* BT3, bf16_t* GM, float* AL, int tid) {
    LAS float* pwr = (LAS float*)lds; LAS float* pwi = pwr + 33 * 64; LAS float* Bbr = pwi + 33 * 64; LAS float* Bbi = Bbr + 1024; LAS float* Cr = Bbi + 1024; LAS float* Ci = Cr + 1024; LAS float* Kd = Ci + 1024;
    const float dt = __expf(log_dt[g]);
    for (int idx = tid; idx < 33 * 64; idx += 512) { const int d = idx >> 6, p = idx & 63; const float lr = lam_re[g * 64 + p], li = lam_im[g * 64 + p];
        const float mag = __expf(lr * dt * (float)d); float c, s; cis_f(li * dt * (float)d, c, s); pwr[idx] = mag * c; pwi[idx] = mag * s; }
    for (int idx = tid; idx < 1024; idx += 512) { const int p = idx >> 4; const float lr = lam_re[g * 64 + p], li = lam_im[g * 64 + p];
        const float mag = __expf(lr * dt); float c, s; cis_f(li * dt, c, s); const float ar = mag * c, ai = mag * s, den = lr * lr + li * li;
        const float qr = ((ar - 1.0f) * lr + ai * li) / den, qi = (ai * lr - (ar - 1.0f) * li) / den;
        const float br = b_re[g * 1024 + idx], bi = b_im[g * 1024 + idx];
        Bbr[idx] = qr * br - qi * bi; Bbi[idx] = qr * bi + qi * br;
        Cr[idx] = c_re[g * 1024 + idx]; Ci[idx] = c_im[g * 1024 + idx]; }
    __syncthreads();
    for (int idx = tid; idx < 32 * 256; idx += 512) { const int d = idx >> 8, co = (idx >> 4) & 15, ci = idx & 15; float a = 0.f;
        for (int p = 0; p < 64; ++p) { const float cr = Cr[co * 64 + p], cim = Ci[co * 64 + p], pr = pwr[d * 64 + p], pi = pwi[d * 64 + p];
            const float tr = cr * pr - cim * pi, ti = cr * pi + cim * pr; a += tr * Bbr[p * 16 + ci] - ti * Bbi[p * 16 + ci]; }
        Kd[idx] = a; }
    __syncthreads();
    bf16_t* bt = BT3 + (size_t)g * 512 * AK;
    for (int idx = tid; idx < 512 * (AK / 8); idx += 512) { const int n = idx / (AK / 8), q = idx % (AK / 8), kk0 = q * 8, k = n >> 4, co = n & 15; float v[8];
        if (kk0 < 512) { const int j = kk0 >> 4, ci0 = kk0 & 15;
#pragma unroll
            for (int e = 0; e < 8; ++e) v[e] = (j <= k) ? Kd[(k - j) * 256 + co * 16 + ci0 + e] : 0.f;
        } else { const int p0 = kk0 - 512;
#pragma unroll
            for (int e = 0; e < 8; ++e) { const int p = (p0 & 63) + e; const float cr = Cr[co * 64 + p], cim = Ci[co * 64 + p], pr = pwr[(k + 1) * 64 + p], pi = pwi[(k + 1) * 64 + p];
                v[e] = (p0 < 64) ? (cr * pr - cim * pi) : -(cr * pi + cim * pr); } }
        u32x4 w; w.x = cvt_pk_bf16(v[0], v[1]); w.y = cvt_pk_bf16(v[2], v[3]); w.z = cvt_pk_bf16(v[4], v[5]); w.w = cvt_pk_bf16(v[6], v[7]);
        *(u32x4*)(bt + (size_t)n * AK + kk0) = w; }
    bf16_t* gm = GM + (size_t)g * 256 * 512;
    for (int idx = tid; idx < 256 * 64; idx += 512) { const int n = idx >> 6, q = idx & 63, kk0 = q * 8; float v[8];
        if (n < 128) { const int p = n & 63, j = kk0 >> 4, ci0 = kk0 & 15; const float pr = pwr[(SL - 1 - j) * 64 + p], pi = pwi[(SL - 1 - j) * 64 + p];
#pragma unroll
            for (int e = 0; e < 8; ++e) { const float br = Bbr[p * 16 + ci0 + e], bi = Bbi[p * 16 + ci0 + e]; v[e] = (n < 64) ? (pr * br - pi * bi) : (pr * bi + pi * br); }
        } else {
#pragma unroll
            for (int e = 0; e < 8; ++e) v[e] = 0.f; }
        u32x4 w; w.x = cvt_pk_bf16(v[0], v[1]); w.y = cvt_pk_bf16(v[2], v[3]); w.z = cvt_pk_bf16(v[4], v[5]); w.w = cvt_pk_bf16(v[6], v[7]);
        *(u32x4*)(gm + (size_t)n * 512 + kk0) = w; }
    if (tid < 64) { AL[(g * 64 + tid) * 2] = pwr[SL * 64 + tid]; AL[(g * 64 + tid) * 2 + 1] = pwi[SL * 64 + tid]; }
    __syncthreads();
}

__device__ __forceinline__ void gmlp_unit(int unit, LAS unsigned char* lds, const bf16_t* U, const bf16_t* V, const u64* vst, const bf16_t* GW, const float* gb, bf16_t* MIX, int tid) {
    const int g = unit & 3, t0 = (unit >> 2) * 128, lane = tid & 63, wid = tid >> 6;
    LAS bf16_t* vT = (LAS bf16_t*)lds;
    const int il = lane & 15, kq = lane >> 4, i = wid * 16 + il;
    u32x4 raw[4]; u64 st[4][2];
#pragma unroll
    for (int e = 0; e < 4; ++e) { const int q = tid + 512 * e, j = q >> 4, c8 = (q & 15) * 8;
        raw[e] = *(const u32x4*)(V + (size_t)(t0 + j) * 512 + g * 128 + c8); st[e][0] = vst[2 * (t0 + j)]; st[e][1] = vst[2 * (t0 + j) + 1]; }
    bf16x8 wf[4];
#pragma unroll
    for (int ks = 0; ks < 4; ++ks) wf[ks] = *(const bf16x8*)(GW + (size_t)g * 16384 + (size_t)i * 128 + ks * 32 + kq * 8);
    const float bias = gb[g * 128 + i];
    const size_t tok = (size_t)(t0 + i);
    u32x2 uu[8];
#pragma unroll
    for (int nt = 0; nt < 8; ++nt) uu[nt] = *(const u32x2*)(U + tok * 512 + g * 128 + nt * 16 + kq * 4);
#pragma unroll
    for (int e = 0; e < 4; ++e) { const int q = tid + 512 * e, j = q >> 4, c8 = (q & 15) * 8;
        const float s = (float)(long long)st[e][0] * (1.0f / 16777216.0f), ss = (float)(long long)st[e][1] * (1.0f / 16777216.0f), mean = s * (1.0f / 512.0f), var = ss * (1.0f / 512.0f) - mean * mean, rstd = rsqrtf(fmaxf(var, 0.f) + EPS);
        const float v[8] = {bflo(raw[e].x), bfhi(raw[e].x), bflo(raw[e].y), bfhi(raw[e].y), bflo(raw[e].z), bfhi(raw[e].z), bflo(raw[e].w), bfhi(raw[e].w)};
        const int jo = ((((j >> 3) ^ (c8 >> 3)) & 15) << 3) + (j & 7);
#pragma unroll
        for (int k = 0; k < 8; k += 2) { const unsigned pk = cvt_pk_bf16((v[k] - mean) * rstd, (v[k + 1] - mean) * rstd); vT[(c8 + k) * 136 + jo] = (bf16_t)(pk & 0xffffu); vT[(c8 + k + 1) * 136 + jo] = (bf16_t)(pk >> 16); } }
    __syncthreads();
#pragma unroll 2
    for (int nt = 0; nt < 8; ++nt) { f32x4 a = {0.f, 0.f, 0.f, 0.f}; const int c = nt * 16 + il;
#pragma unroll
        for (int ks = 0; ks < 4; ++ks) { const bf16x8 vf = *(const LAS bf16x8*)(vT + c * 136 + ((((ks * 4 + kq) ^ (c >> 3)) & 15) << 3)); a = __builtin_amdgcn_mfma_f32_16x16x32_bf16(vf, wf[ks], a, 0, 0, 0); }
        u32x2 o; o.x = cvt_pk_bf16(bflo(uu[nt].x) * (a[0] + bias), bfhi(uu[nt].x) * (a[1] + bias)); o.y = cvt_pk_bf16(bflo(uu[nt].y) * (a[2] + bias), bfhi(uu[nt].y) * (a[3] + bias));
        *(u32x2*)(MIX + tok * 1024 + g * 128 + nt * 16 + kq * 4) = o; }
    __syncthreads();
}
__device__ __forceinline__ void conv_units(int first, int stride, int nunits, LAS unsigned char* lds, const bf16_t* H, const float* cw, const float* cb, const float* lng, const float* lnb, bf16_t* MIX, int tid) {
    if (first >= nunits) return;
    const int lane = tid & 63, wid = tid >> 6;
    LAS bf16_t* hin = (LAS bf16_t*)lds;
    LAS float* cout = (LAS float*)(lds + 62 * 1024);
    float w[31];
#pragma unroll
    for (int k = 0; k < 31; ++k) w[k] = cw[k * 512 + tid];
    const float bias = cb[tid];
    const f32x4 g0 = *(const f32x4*)(lng + lane * 8), g1 = *(const f32x4*)(lng + lane * 8 + 4), b0 = *(const f32x4*)(lnb + lane * 8), b1 = *(const f32x4*)(lnb + lane * 8 + 4);
    u32x4 pre[8];
#define CONV_PREFETCH(unit_) { const int t0_ = (unit_) * 32, s0_ = t0_ % SEQ; _Pragma("unroll") for (int e = 0; e < 8; ++e) { const int q = tid + 512 * e, r = q >> 6, c8 = (q & 63) * 8; \
        u32x4 v_ = {0u, 0u, 0u, 0u}; if (q < 62 * 64 && s0_ - 30 + r >= 0) v_ = *(const u32x4*)(H + (size_t)(t0_ - 30 + r) * 512 + c8); pre[e] = v_; } }
    CONV_PREFETCH(first);
#pragma unroll 1
    for (int unit = first; unit < nunits; unit += stride) {
        const int t0 = unit * 32;
#pragma unroll
        for (int e = 0; e < 8; ++e) { const int q = tid + 512 * e; if (q < 62 * 64) *(LAS u32x4*)(hin + (q >> 6) * 512 + (q & 63) * 8) = pre[e]; }
        if (unit + stride < nunits) CONV_PREFETCH(unit + stride);
        __syncthreads();
#pragma unroll 1
        for (int tg = 0; tg < 4; ++tg) { float x[38];
#pragma unroll
            for (int r = 0; r < 38; ++r) x[r] = bf2f(hin[(tg * 8 + r) * 512 + tid]);
#pragma unroll
            for (int o = 0; o < 8; ++o) { float a = bias;
#pragma unroll
                for (int k = 0; k < 31; ++k) a += w[k] * x[o + k];
                cout[(tg * 8 + o) * 516 + tid] = a; } }
        __syncthreads();
#pragma unroll 1
        for (int tt = 0; tt < 4; ++tt) { const int row = wid * 4 + tt; const f32x4 v0 = *(const LAS f32x4*)(cout + row * 516 + lane * 8), v1 = *(const LAS f32x4*)(cout + row * 516 + lane * 8 + 4);
            const float mean = wave_sum((v0[0] + v0[1]) + (v0[2] + v0[3]) + (v1[0] + v1[1]) + (v1[2] + v1[3])) * (1.0f / 512.0f);
            const f32x4 d0 = v0 - mean, d1 = v1 - mean;
            const float var = wave_sum((d0[0] * d0[0] + d0[1] * d0[1]) + (d0[2] * d0[2] + d0[3] * d0[3]) + (d1[0] * d1[0] + d1[1] * d1[1]) + (d1[2] * d1[2] + d1[3] * d1[3])) * (1.0f / 512.0f);
            const float rstd = rsqrtf(var + EPS);
            f32x4 y0 = d0 * rstd * g0 + b0, y1 = d1 * rstd * g1 + b1;
#pragma unroll
            for (int e = 0; e < 4; ++e) { y0[e] = silu_f(y0[e]); y1[e] = silu_f(y1[e]); }
            *(u32x4*)(MIX + (size_t)(t0 + row) * 1024 + 512 + lane * 8) = pack8(y0, y1); }
    }
    __syncthreads();
#undef CONV_PREFETCH
}

struct Args { const float* in[33]; float* out; unsigned char* ws; int ph_lo, ph_hi; };
constexpr int NPHASE = 28;

#define CONVJOB(Wp, K_, ldn_, cs_, nc_, WTp, mode_, roff_, gain_) { const int nblk_ = (nc_) / 128, cnt_ = ((K_) / 64) * nblk_; \
            if (r >= 0 && r < cnt_) { cp.W = (Wp); cp.WT = (bf16_t*)(WTp); cp.gain = (gain_); cp.K = (K_); cp.ldn = (ldn_); cp.cs = (cs_); cp.nblk = nblk_; cp.mode = (mode_); cp.roff = (roff_); cp.r = r; } r -= cnt_; }
#define CONVLOOKUP(cp, it_) { int r = (it_); \
            CONVJOB(ap->in[3], 1024, 2048, 0, 1024, ws + WS_WIN0, 0, 0, ap->in[2]); \
            CONVJOB(ap->in[3], 1024, 2048, 1024, 512, ws + WS_WIN0, 1, 1024, ap->in[2]); \
            CONVJOB(ap->in[3], 1024, 2048, 1536, 512, ws + WS_WIN0, 2, 1024, ap->in[2]); \
            CONVJOB(ap->in[10], 1024, 1024, 0, 1024, ws + WS_WOUT0, 0, 0, nullptr); \
            CONVJOB(ap->in[12], 1024, 512, 0, 512, ws + WS_WOIN, 0, 0, ap->in[11]); \
            CONVJOB(ap->in[21], 512, 2048, 0, 1024, ws + WS_WOOUT, 1, 0, nullptr); \
            CONVJOB(ap->in[21], 512, 2048, 1024, 1024, ws + WS_WOOUT, 2, 0, nullptr); \
            _Pragma("unroll") for (int l2 = 0; l2 < 2; ++l2) { \
                CONVJOB(ap->in[25] + (size_t)l2 * D * D, 1024, 1024, 0, 1024, ws + WS_WK + l2 * WSQ_L, 0, 0, ap->in[23] + l2 * D); \
                CONVJOB(ap->in[26] + (size_t)l2 * D * D, 1024, 1024, 0, 1024, ws + WS_WV + l2 * WSQ_L, 0, 0, ap->in[23] + l2 * D); \
                CONVJOB(ap->in[27] + (size_t)l2 * D * D, 1024, 1024, 0, 1024, ws + WS_WO + l2 * WSQ_L, 0, 0, nullptr); } \
            _Pragma("unroll") for (int l2 = 0; l2 < 2; ++l2) { \
                CONVJOB(ap->in[29] + (size_t)l2 * D * FH, 1024, FH, 0, FH, ws + WS_WGU + l2 * WGU_L, 1, 0, ap->in[28] + l2 * D); \
                CONVJOB(ap->in[30] + (size_t)l2 * D * FH, 1024, FH, 0, FH, ws + WS_WGU + l2 * WGU_L, 2, 0, ap->in[28] + l2 * D); \
                CONVJOB(ap->in[31] + (size_t)l2 * FH * D, FH, 1024, 0, 1024, ws + WS_WD + l2 * WD_L, 0, 0, nullptr); } }
constexpr int CONV_N_A = (512 + 256 + 256 + 512 + 256 + 256 + 256 + 2 * 3 * 512) / 4, CONV_N_B = CONV_N_A + 3 * 1408 / 4, CONV_N_C = CONV_N_B + 3 * 1408 / 4;
#define CONV_RANGE(lo_, hi_, wv_, nwv_) { LAS float* scr_ = (LAS float*)(lds + wave * 16384); \
        for (int it = (lo_) + (wv_); it < (hi_); it += (nwv_)) { ConvP c0{}; f32x4 v0[32]; { ConvP cp{}; CONVLOOKUP(cp, it); c0 = cp; } conv_load(c0, v0, lane); conv_store(c0, v0, scr_, lane); } }

typedef const __attribute__((address_space(4))) Args* KArgP;
__device__ __forceinline__ KArgP fresh_args() { KArgP p = (KArgP)__builtin_amdgcn_kernarg_segment_ptr(); asm volatile("" : "+s"(p)); return p; }

__global__ void __launch_bounds__(512, 2) trunk_fwd(Args args_unused) {
    extern __shared__ __attribute__((aligned(16))) unsigned char lds_raw[];
    LAS unsigned char* lds = (LAS unsigned char*)lds_raw;
    cg::grid_group grid = cg::this_grid();
    { volatile LAS unsigned* MISC0 = (volatile LAS unsigned*)(lds + MISC_OFF); if (threadIdx.x < 32) MISC0[threadIdx.x] = 0u; }
    __syncthreads();
    int lo, hi;
    { KArgP ap = fresh_args(); lo = ap->ph_lo; hi = ap->ph_hi; }
#if !MK_MULTI && !MK_CGSYNC
    { KArgP ap = fresh_args(); (void)xcd_barrier_post((unsigned*)(ap->ws + WS_BAR), (volatile LAS unsigned*)(lds + MISC_OFF) + 8); }
#endif
    int nsync = 0;
#if MK_MULTI
#define SEAM(k) do { } while (0)
#elif MK_CGSYNC
#define SEAM(k) do { if (rep_ + 1 == nrep_ && (k) + 1 < hi) grid.sync(); } while (0)
#else
#define SEAM(k) do { if (rep_ + 1 == nrep_ && (k) + 1 < hi) { if (hi > 1000) grid.sync(); else { KArgP ap_ = fresh_args(); XcdBarrier xb_; xb_.bar = (unsigned*)(ap_->ws + WS_BAR); xb_.x = xb_xcc_id(); xb_.st = (volatile LAS unsigned*)(lds + MISC_OFF) + 8; xcd_barrier(xb_); if (BARPROBE) xcd_barrier(xb_); } ++nsync; } } while (0)
#endif
#ifndef ONLY
#define ONLY -1
#endif
#ifndef REPMASK
#define REPMASK 0
#endif
#define PHASE(id, k) if ((ONLY < 0 || ONLY == (id)) && lo <= (k) && (k) < hi) for (int rep_ = 0, nrep_ = (((REPMASK) >> (id)) & 1) ? 2 : 1; rep_ < nrep_; ++rep_)
    (void)nsync;
#define LOCALS KArgP ap = fresh_args(); unsigned char* ws = ap->ws; float* out = ap->out; const float* x_in = ap->in[0]; \
    int tid_ = threadIdx.x, G_ = gridDim.x, bx_ = blockIdx.x; asm volatile("" : "+v"(tid_), "+s"(G_), "+s"(bx_)); \
    const int tid = tid_, lane = tid & 63, wave = __builtin_amdgcn_readfirstlane(tid >> 6), G = G_, bx = bx_, gw = bx * 8 + wave, NGW = G * 8; \
    bf16_t* XB = (bf16_t*)(ws + WS_XB); u64* SS = (u64*)(ws + WS_SS); u64* VST = (u64*)(ws + WS_VST); bf16_t* QO = (bf16_t*)(ws + WS_QO); \
    bf16_t* HM = (bf16_t*)(ws + WS_HM); bf16_t* MEMN = (bf16_t*)(ws + WS_MEMN); bf16_t* KL = (bf16_t*)(ws + WS_KL); bf16_t* VL = (bf16_t*)(ws + WS_VL); \
    bf16_t* U = (bf16_t*)(ws + WS_U); bf16_t* V = (bf16_t*)(ws + WS_V); bf16_t* H = (bf16_t*)(ws + WS_H); bf16_t* MIX = (bf16_t*)(ws + WS_MIX); \
    bf16_t* AC = (bf16_t*)(ws + WS_ACOMB); float* XL = (float*)(ws + WS_XLOC); bf16_t* Y = (bf16_t*)(ws + WS_Y); u64* SSa = SS + (size_t)(3 * l) * T; \
    (void)out; (void)x_in; (void)lane; (void)gw; (void)NGW; (void)XB; (void)VST; (void)QO; (void)HM; (void)MEMN; (void)KL; (void)VL; (void)U; (void)V; (void)H; (void)MIX; (void)AC; (void)XL; (void)Y; (void)SSa; (void)wave;

    PHASE(0, 0) { const int l = 0; LOCALS
        { f32x4* z = (f32x4*)(SS + T); const int n4 = 7 * T * 2 / 4; for (int i = bx * 512 + tid; i < n4; i += G * 512) z[i] = (f32x4){0.f, 0.f, 0.f, 0.f};
          f32x4* z2 = (f32x4*)VST; const int m4 = 2 * T * 2 / 4; for (int i = bx * 512 + tid; i < m4; i += G * 512) z2[i] = (f32x4){0.f, 0.f, 0.f, 0.f}; }
        CONV_RANGE(0, CONV_N_A, gw, NGW);
        { const int nb5 = (G > 64) ? G - 32 : G;
          if (bx < nb5) { const int NW5 = nb5 * 8;
              for (int m = gw * 4; m < T; m += NW5 * 4) rows_to_bf16<false, 4>(x_in + (size_t)m * D, XB + (size_t)m * D, SS + m, lane);
              for (int m = gw * 4; m < MT; m += NW5 * 4) rows_to_bf16<true, 4>(ap->in[1] + (size_t)m * D, MEMN + (size_t)m * D, nullptr, lane); } }
        for (int i = bx * 512 + tid; i < 2 * D * D / 8; i += G * 512) { const int l2 = i / (D * D / 8), e = (i % (D * D / 8)) * 8, k = e >> 10; const float gk = ap->in[22][l2 * D + k];
            const f32x4 a = *(const f32x4*)(ap->in[24] + (size_t)l2 * D * D + e), b = *(const f32x4*)(ap->in[24] + (size_t)l2 * D * D + e + 4);
            *(u32x4*)((bf16_t*)(ws + WS_WQ) + (size_t)l2 * D * D + e) = pack8(a * gk, b * gk); }
        { bf16_t* GW = (bf16_t*)(ws + WS_GW); const float* w = ap->in[4];
          for (int i = bx * 512 + tid; i < 4 * 128 * 128 / 2; i += G * 512) { const int e = 2 * i, ii = (e >> 7) & 127, jj = e & 127; const bool keep = (jj >> 6) <= (ii >> 6);
              ((unsigned*)GW)[i] = keep ? cvt_pk_bf16(w[e], w[e + 1]) : 0u; } }
        __syncthreads();
        for (int g = G - 1 - bx; g < 32; g += G)
            s5_setup(g, lds, ap->in[13], ap->in[14], ap->in[15], ap->in[16], ap->in[17], ap->in[18], ap->in[19], (bf16_t*)(ws + WS_BT3), (bf16_t*)(ws + WS_GM), (float*)(ws + WS_AL), tid);
        SEAM(0);
    }
#pragma unroll 1
    for (int l = 0; l < 2; ++l) {
        const int pb = 3 + 12 * l;
        if (l == 0) {
            PHASE(2, pb + 0) { LOCALS
                pg8::Gemm g{XB, (const bf16_t*)(ws + WS_WIN0), D, D, D, 1, 0, 0, 0, 0}; pg8::Sched S; S.init(T / 256, 2048 / 256, 1, G, bx);
                { pg8::EpiIn0 E{SSa, U, V, H, VST}; pg8::gemm_phase<MK_ALIGN>(lds, g, S, E, tid); }
                { pg8::Gemm g{MEMN, (const bf16_t*)(ws + WS_WK), D, D, D, 2, 0, 0, (long)D * D, 0}; pg8::Sched S; S.init(MT / 256, D / 256, 2, G, bx);
                  pg8::EpiStore E{KL, D, 2, (long)MT * D, 0, nullptr, 1.0f}; pg8::gemm_phase<MK_ALIGN>(lds, g, S, E, tid); }
                { pg8::Gemm g{MEMN, (const bf16_t*)(ws + WS_WV), D, D, D, 2, 0, 0, (long)D * D, 0}; pg8::Sched S; S.init(MT / 256, D / 256, 2, G, (bx + G / 2) % G);
                  pg8::EpiStore E{VL, D, 2, (long)MT * D, 0, nullptr, 1.0f}; pg8::gemm_phase<MK_ALIGN>(lds, g, S, E, tid); }
                if ((G & 3) == 0) { const int hG = G / 2, qG = G / 4; if ((bx % hG) >= qG) { const int ii = (bx / hG) * qG + (bx % hG) - qG; CONV_RANGE(CONV_N_A, CONV_N_B, ii * 8 + wave, hG * 8); } }
                else CONV_RANGE(CONV_N_A, CONV_N_B, gw, NGW);
                SEAM(pb + 0);
            }
            PHASE(3, pb + 1) { LOCALS
                for (int i = bx; i < 1024; i += G) gmlp_unit(i, lds, U, V, VST, (const bf16_t*)(ws + WS_GW), ap->in[5], MIX, tid);
                conv_units(bx, G, 1024, lds, H, ap->in[6], ap->in[7], ap->in[8], ap->in[9], MIX, tid);
#pragma unroll 1
                for (int l2 = 0; l2 < 2; ++l2) {
                    { pg8::Gemm g{KL + (size_t)l2 * MT * D, (const bf16_t*)(ws + WS_WQ) + (size_t)l2 * D * D, D, D, 256, 4, 256, 256L * D, 256, 0}; pg8::Sched S; S.init(1, 4, 32, G, bx);
                      pg8::EpiStore E{(bf16_t*)(ws + WS_WQK) + (size_t)l2 * 8 * D * D, D, 4, 256L * D, (long)D * D, nullptr, 1.0f}; pg8::gemm_phase<MK_ALIGN>(lds, g, S, E, tid); }
                    { pg8::Gemm g{(const bf16_t*)(ws + WS_WO) + (size_t)l2 * D * D, VL + (size_t)l2 * MT * D, D, D, 256, 4, 256, 0, 256, 256L * D}; pg8::Sched S; S.init(4, 1, 32, G, (bx + G / 2) % G);
                      pg8::EpiStore E{(bf16_t*)(ws + WS_WVO) + (size_t)l2 * 8 * D * D, D, 4, 256, (long)D * D, nullptr, 1.0f}; pg8::gemm_phase<MK_ALIGN>(lds, g, S, E, tid); }
                }
                SEAM(pb + 1);
            }
            PHASE(4, pb + 2) { LOCALS
                pg8::Gemm g{MIX, (const bf16_t*)(ws + WS_WOUT0), D, D, D, 1, 0, 0, 0, 0}; pg8::Sched S; S.init(T / 256, D / 256, 1, G, bx);
                pg8::EpiRes<false> E{XB, SSa + T, 0}; pg8::gemm_phase<MK_ALIGN>(lds, g, S, E, tid);
                SEAM(pb + 2);
            }
        } else {
            PHASE(5, pb + 0) { LOCALS
                pg8::Gemm g{XB, (const bf16_t*)(ws + WS_WOIN), D, D, D, 1, 0, 0, 0, 0}; pg8::Sched S; S.init(T / 256, 512 / 256, 1, G, bx);
                pg8::EpiOin E{SSa, AC}; pg8::gemm_phase<MK_ALIGN>(lds, g, S, E, tid);
                SEAM(pb + 0);
            }
            PHASE(6, pb + 1) { LOCALS
                pg8::Gemm g{AC, (const bf16_t*)(ws + WS_GM), AK, 512, 512, 32, (long)NCH * AK, 0, 256L * 512, 0}; pg8::Sched S; S.init(NCH / 256, 1, 32, G, bx);
                pg8::EpiS5State E{XL}; pg8::gemm_phase<MK_ALIGN>(lds, g, S, E, tid);
                if (G > 128) { if (bx >= 128) CONV_RANGE(CONV_N_B, CONV_N_C, (bx - 128) * 8 + wave, (G - 128) * 8); }
                else CONV_RANGE(CONV_N_B, CONV_N_C, gw, NGW);
                SEAM(pb + 1);
            }
            PHASE(7, pb + 2) { LOCALS
                if (wave == 0) {
#pragma unroll 1
                    for (int idx = bx * 64 + lane; idx < NB * 32 * 64; idx += G * 64) { const int p = idx & 63, g = (idx >> 6) & 31, b = idx >> 11;
                        const float* AL = (const float*)(ws + WS_AL); const float ar = AL[(g * 64 + p) * 2], ai = AL[(g * 64 + p) * 2 + 1];
                        const float* xl = XL + (size_t)g * NCH * 128 + (size_t)(b * (SEQ / SL)) * 128; bf16_t* ac = AC + (size_t)g * NCH * AK + (size_t)(b * (SEQ / SL)) * AK + 512;
                        float xr = 0.f, xi = 0.f;
#pragma unroll 1
                        for (int c0 = 0; c0 < SEQ / SL; c0 += 32) { float lr[32], li[32];
#pragma unroll
                            for (int i = 0; i < 32; ++i) { lr[i] = xl[(size_t)(c0 + i) * 128 + p]; li[i] = xl[(size_t)(c0 + i) * 128 + 64 + p]; }
#pragma unroll
                            for (int i = 0; i < 32; ++i) { const unsigned pk = cvt_pk_bf16(xr, xi); ac[(size_t)(c0 + i) * AK + p] = (bf16_t)(pk & 0xffffu); ac[(size_t)(c0 + i) * AK + 64 + p] = (bf16_t)(pk >> 16);
                                const float nr = ar * xr - ai * xi + lr[i], ni = ar * xi + ai * xr + li[i]; xr = nr; xi = ni; } }
                    }
                }
                SEAM(pb + 2);
            }
            PHASE(8, pb + 3) { LOCALS
                pg8::Gemm g{AC, (const bf16_t*)(ws + WS_BT3), AK, AK, AK, 32, (long)NCH * AK, 0, 512L * AK, 0}; pg8::Sched S; S.init(NCH / 256, 2, 32, G, bx);
                pg8::EpiS5Out E{AC, ap->in[20], Y}; pg8::gemm_phase<MK_ALIGN>(lds, g, S, E, tid);
                SEAM(pb + 3);
            }
            PHASE(9, pb + 4) { LOCALS
                pg8::Gemm g{Y, (const bf16_t*)(ws + WS_WOOUT), 512, 512, 512, 1, 0, 0, 0, 0}; pg8::Sched S; S.init(T / 256, 2048 / 256, 1, G, bx);
                pg8::EpiRes<true> E{XB, SSa + T, 0}; pg8::gemm_phase<MK_ALIGN>(lds, g, S, E, tid);
                SEAM(pb + 4);
            }
        }
        PHASE(10, pb + 5) { LOCALS
            pg8::Gemm g{XB, (const bf16_t*)(ws + WS_WQK) + (size_t)l * 8 * D * D, D, D, D, 8, (long)SEQ * D, 0, (long)D * D, 0}; pg8::Sched S; S.init(SEQ / 256, D / 256, 8, G, bx);
            pg8::EpiSoftmax E{QO, SSa + T}; pg8::gemm_phase<true>(lds, g, S, E, tid);
            SEAM(pb + 5);
        }
        PHASE(13, pb + 6) { LOCALS
            pg8::Gemm g{QO, (const bf16_t*)(ws + WS_WVO) + (size_t)l * 8 * D * D, D, D, D, 8, (long)SEQ * D, 0, (long)D * D, 0}; pg8::Sched S; S.init(SEQ / 256, D / 256, 8, G, bx);
            pg8::EpiRes<false> E{XB, SSa + 2 * T, SEQ}; pg8::gemm_phase<MK_ALIGN>(lds, g, S, E, tid);
            SEAM(pb + 6);
        }
        PHASE(14, pb + 9) { LOCALS
            pg8::Gemm g{XB, (const bf16_t*)(ws + WS_WGU + l * WGU_L), D, D, D, 1, 0, 0, 0, 0}; pg8::Sched S; S.init(T / 256, 2 * FH / 256, 1, G, bx);
            pg8::EpiFfn1 E{SSa + 2 * T, HM}; pg8::gemm_phase<MK_ALIGN>(lds, g, S, E, tid);
            SEAM(pb + 9);
        }
        PHASE(15, pb + 10) { LOCALS
            pg8::Gemm g{HM, (const bf16_t*)(ws + WS_WD + l * WD_L), FH, FH, FH, 1, 0, 0, 0, 0}; pg8::Sched S; S.init(T / 256, D / 256, 1, G, bx);
            pg8::EpiRes<false> E{XB, SSa + 3 * T, 0}; pg8::gemm_phase<MK_ALIGN>(lds, g, S, E, tid);
            SEAM(pb + 10);
        }
    }
    PHASE(16, 27) { const int l = 0; LOCALS
        const u64* ssf = SS + (size_t)6 * T; const float* gf = ap->in[32];
        const f32x4 ga = *(const f32x4*)(gf + 8 * lane), gb = *(const f32x4*)(gf + 8 * lane + 4), gc = *(const f32x4*)(gf + 512 + 8 * lane), gd = *(const f32x4*)(gf + 512 + 8 * lane + 4);
        for (int m = gw * 4; m < T; m += NGW * 4) { u32x4 v[4][2]; float rs[4];
#pragma unroll
            for (int r = 0; r < 4; ++r) { rs[r] = rsqrtf(fx_get(ssf + m + r) * (1.0f / D) + EPS); const bf16_t* xr = XB + (size_t)(m + r) * D + 8 * lane; v[r][0] = *(const u32x4*)xr; v[r][1] = *(const u32x4*)(xr + 512); }
#pragma unroll
            for (int r = 0; r < 4; ++r) { float* orow = out + (size_t)(m + r) * D + 8 * lane; f32x4 a0, a1, b0, b1; pg8::unpack8(v[r][0], a0, a1); pg8::unpack8(v[r][1], b0, b1);
                *(f32x4*)orow = a0 * rs[r] * ga; *(f32x4*)(orow + 4) = a1 * rs[r] * gb; *(f32x4*)(orow + 512) = b0 * rs[r] * gc; *(f32x4*)(orow + 516) = b1 * rs[r] * gd; } }
    }
}

extern "C" void kernel_launch(void* const* d_in, const int* in_sizes, int n_in, void* d_out, int out_size, void* d_ws, size_t ws_size, hipStream_t stream) {
    static int grid = 0;
    if (grid == 0) {
        if (n_in != 33 || in_sizes[0] != T * D || out_size != T * D || ws_size < WS_END) { fprintf(stderr, "kernel_launch: unexpected shapes (n_in %d, in0 %d, out %d, ws %zu < %zu)\n", n_in, n_in > 0 ? in_sizes[0] : -1, out_size, ws_size, (size_t)WS_END); grid = -1; return; }
        int dev = 0, cus = 0, per_cu = 0;
        hipGetDevice(&dev); hipDeviceGetAttribute(&cus, hipDeviceAttributeMultiprocessorCount, dev);
        if (hipFuncSetAttribute((const void*)trunk_fwd, hipFuncAttributeMaxDynamicSharedMemorySize, LDS_BYTES) != hipSuccess) { fprintf(stderr, "kernel_launch: hipFuncSetAttribute failed\n"); grid = -1; return; }
        if (hipOccupancyMaxActiveBlocksPerMultiprocessor(&per_cu, (const void*)trunk_fwd, 512, LDS_BYTES) != hipSuccess || per_cu < 1) { fprintf(stderr, "kernel_launch: occupancy query says %d\n", per_cu); per_cu = 1; }
        (void)hipGetLastError();
        grid = cus * 1;
        if (grid <= 0) grid = 256;
    }
    if (grid < 0) return;
    Args a{};
    for (int i = 0; i < 33; ++i) a.in[i] = (const float*)d_in[i];
    a.out = (float*)d_out; a.ws = (unsigned char*)d_ws;
#if !MK_MULTI && !MK_CGSYNC
    (void)hipMemsetAsync((char*)d_ws + WS_BAR, 0, XCD_BAR_WORDS * 4, stream);
#endif
#if MK_MULTI
    for (int p = 0; p < NPHASE; ++p) {
        if (p == 1 || p == 2 || p == 6 || p == 7 || p == 10 || p == 11 || p == 14 || p == 22 || p == 23 || p == 26) continue;
        a.ph_lo = p; a.ph_hi = p + 1; void* kargs[] = {&a};
        hipError_t e = hipLaunchCooperativeKernel((const void*)trunk_fwd, dim3(grid), dim3(512), kargs, LDS_BYTES, stream);
        if (e != hipSuccess) { fprintf(stderr, "kernel_launch: launch of phase %d failed: %s\n", p, hipGetErrorString(e)); break; }
    }
#else
    a.ph_lo = 0; a.ph_hi = NPHASE; void* kargs[] = {&a};
    hipError_t e = hipLaunchCooperativeKernel((const void*)trunk_fwd, dim3(grid), dim3(512), kargs, LDS_BYTES, stream);
    if (e != hipSuccess) fprintf(stderr, "kernel_launch: cooperative launch failed: %s (grid %d)\n", hipGetErrorString(e), grid);
#endif
}
```

```cpp
#include <hip/hip_runtime.h>
#include <hip/hip_cooperative_groups.h>
#include <cstdio>
#include <cstdint>
namespace cg = cooperative_groups;

#ifndef MK_MULTI
#define MK_MULTI 0
#endif
#ifndef MK_ALIGN
#define MK_ALIGN true
#endif
#ifndef BARPROBE
#define BARPROBE 0
#endif
#ifndef MK_CGSYNC
#define MK_CGSYNC 0
#endif

#define LAS __attribute__((address_space(3)))
typedef unsigned short bf16_t;
typedef short bf16x8 __attribute__((ext_vector_type(8)));
typedef float f32x4 __attribute__((ext_vector_type(4)));
typedef float f32x2 __attribute__((ext_vector_type(2)));
typedef unsigned u32x4 __attribute__((ext_vector_type(4)));
typedef unsigned u32x2 __attribute__((ext_vector_type(2)));

constexpr int T = 32768, D = 1024, SEQ = 4096, NB = 8, MT = 2048, FH = 2816;
constexpr float EPS = 1e-6f;
constexpr int SL = 32;
constexpr int NCH = T / SL;
constexpr int AK = SL * 16 + 128;

constexpr size_t MiB = 1u << 20;
constexpr size_t WS_WIN0 = 0, WS_WOUT0 = 4 * MiB, WS_WOIN = 6 * MiB, WS_WOOUT = 7 * MiB, WS_WQ = 9 * MiB, WS_WK = 13 * MiB, WS_WV = 17 * MiB, WS_WO = 21 * MiB;
constexpr size_t WS_WGU = 25 * MiB, WS_WD = 47 * MiB, WS_GW = 58 * MiB, WS_AL = 59 * MiB, WS_BT3 = 60 * MiB, WS_GM = 80 * MiB, WS_MEMN = 88 * MiB, WS_KL = 92 * MiB, WS_VL = 100 * MiB;
constexpr size_t WS_XB = 110 * MiB, WS_QO = 174 * MiB, WS_P = 238 * MiB, WS_R0 = 302 * MiB;
constexpr size_t WS_WQK = WS_P, WS_WVO = WS_P + 32 * MiB;
constexpr size_t WS_HM = WS_R0, WS_U = WS_R0, WS_V = WS_R0 + 32 * MiB, WS_H = WS_R0 + 64 * MiB, WS_MIX = WS_R0 + 96 * MiB;
constexpr size_t WS_ACOMB = WS_R0, WS_XLOC = WS_R0 + 40 * MiB, WS_Y = WS_R0 + 56 * MiB;
constexpr size_t WS_SS = WS_R0 + 176 * MiB, WS_VST = WS_SS + 2 * MiB, WS_BAR = WS_VST + 1 * MiB, WS_PCNT = WS_BAR + 16384  , WS_END = WS_BAR + 1 * MiB;
constexpr size_t WGU_L = (size_t)2 * FH * D * 2, WD_L = (size_t)D * FH * 2, WSQ_L = (size_t)D * D * 2;

constexpr int RING_BYTES = 131072, XCH_OFF = RING_BYTES, MISC_OFF = RING_BYTES + 8192, LDS_BYTES = 147456;

__device__ __forceinline__ unsigned cvt_pk_bf16(float lo, float hi) { unsigned r; asm volatile("v_cvt_pk_bf16_f32 %0, %1, %2" : "=v"(r) : "v"(lo), "v"(hi)); return r; }
__device__ __forceinline__ float bf2f(unsigned short b) { return __builtin_bit_cast(float, (unsigned)b << 16); }
__device__ __forceinline__ float bflo(unsigned w) { return __builtin_bit_cast(float, w << 16); }
__device__ __forceinline__ float bfhi(unsigned w) { return __builtin_bit_cast(float, w & 0xffff0000u); }
__device__ __forceinline__ float sigmoid_f(float x) { return __builtin_amdgcn_rcpf(1.0f + __expf(-x)); }
__device__ __forceinline__ float silu_f(float x) { return x * sigmoid_f(x); }
__device__ __forceinline__ float gelu_f(float x) { return x * sigmoid_f(1.5957691216f * (x + 0.044715f * x * x * x)); }
typedef unsigned long long u64;
__device__ __forceinline__ void fx_add(u64* p, float q) { atomicAdd(p, (u64)(long long)(q * 16777216.0f)); }
__device__ __forceinline__ float fx_get(const u64* p) { return (float)(long long)(*p) * (1.0f / 16777216.0f); }
__device__ __forceinline__ float wave_sum(float v) {
#pragma unroll
    for (int o = 1; o < 64; o <<= 1) v += __shfl_xor(v, o);
    return v;
}
__device__ __forceinline__ u32x4 pack8(f32x4 a, f32x4 b) { u32x4 w; w.x = cvt_pk_bf16(a[0], a[1]); w.y = cvt_pk_bf16(a[2], a[3]); w.z = cvt_pk_bf16(b[0], b[1]); w.w = cvt_pk_bf16(b[2], b[3]); return w; }

namespace pg8 {
constexpr int BM = 256, BK = 64, HALF = 128, HTB = HALF * BK * 2, NXCD = 8, WGM = 4;
__device__ __forceinline__ int lds_byte(int r, int c) { const int st = (r >> 4) * 2 + (c >> 5), rr = r & 15, cc = c & 31, ob = rr * 64 + cc * 2; return st * 1024 + (ob ^ (((ob >> 9) & 1) << 5)); }
__device__ __forceinline__ void stage_rc(int b, int& R, int& C) { const int st = b / 1024, sb = b % 1024, swz = sb ^ (((sb >> 9) & 1) << 5); R = (st >> 1) * 16 + swz / 64; C = (st & 1) * 32 + (swz % 64) / 2; }
__device__ __forceinline__ int perm32(int rho) { const int n = rho >> 4, i = rho & 15; return 8 * (i >> 2) + 4 * n + (i & 3); }

struct Unit { int pm, pn, z; };
struct Gemm { const bf16_t* A; const bf16_t* Bt; int lda, ldb, K, nz0; long sAz0, sAz1, sBz0, sBz1; };
struct Sched {
    int nM, nN, per, total, G, c;
    __device__ __forceinline__ void init(int nM_, int nN_, int nz, int G_, int c_) { nM = nM_; nN = nN_; per = nM_ * nN_; total = per * nz; G = G_; c = c_; }
    __device__ __forceinline__ bool next(int i, Unit& u) const {
        const long L = (long)i * G + c; if (L >= total) return false;
        const int z = (int)(L / per); int wgid = (int)(L % per);
        { const int q = per / NXCD, r = per % NXCD, xcd = wgid % NXCD, off = wgid / NXCD; wgid = (xcd < r ? xcd * (q + 1) : r * (q + 1) + (xcd - r) * q) + off; }
        const int nig = WGM * nN, gid = wgid / nig, fm = gid * WGM, gsz = (nM - fm) < WGM ? (nM - fm) : WGM;
        u.pm = fm + ((wgid % nig) % gsz); u.pn = (wgid % nig) / gsz; u.z = z; return true;
    }
};

template <bool ALIGN, class Epi>
__device__ __forceinline__ void gemm_phase(LAS unsigned char* lds, const Gemm g, const Sched& S, const Epi& E, const int tid) {
    const int wid = __builtin_amdgcn_readfirstlane(tid >> 6), lane = tid & 63, wr = wid >> 2, wc = wid & 3, fr = lane & 15, fq = lane >> 4;
    const int nt = g.K / BK;
    unsigned voffA[2], voffB[2];
#pragma unroll
    for (int i = 0; i < 2; ++i) { int R, C; stage_rc(tid * 16 + i * 8192, R, C); const int Rb = (R & ~31) + perm32(R & 31);
        voffA[i] = (unsigned)(R * g.lda + C) * 2u; voffB[i] = (unsigned)(Rb * g.ldb + C) * 2u; }
    const size_t kstep = (size_t)(BK * 2);
    const size_t hsA = (size_t)HALF * g.lda * 2, hsB = (size_t)HALF * g.ldb * 2;
    const unsigned ldsw = (unsigned)wid * 1024u;
    const int aoff = lds_byte(wr * 64 + fr, fq * 8), boff = lds_byte(wc * 32 + fr, fq * 8);
#define PG8_SA(b, h) (((b) * 2 + (h)) * HTB)
#define PG8_SB(b, h) ((4 + (b) * 2 + (h)) * HTB)
#define PG8_STAGE(bufoff, gbase, voff) do { _Pragma("unroll") for (int _i = 0; _i < 2; ++_i) \
        __builtin_amdgcn_global_load_lds((const unsigned*)((const char*)(gbase) + (voff)[_i]), (LAS unsigned*)(lds + (bufoff) + ldsw + _i * 8192), 16, 0, 0); } while (0)
#define PG8_LDA(dst, b, h) do { _Pragma("unroll") for (int m = 0; m < 4; ++m) _Pragma("unroll") for (int k = 0; k < 2; ++k) dst[m][k] = *(const LAS bf16x8*)(lds + PG8_SA(b, h) + aoff + m * 2048 + k * 1024); } while (0)
#define PG8_LDB(dst, b, h) do { _Pragma("unroll") for (int n = 0; n < 2; ++n) _Pragma("unroll") for (int k = 0; k < 2; ++k) dst[n][k] = *(const LAS bf16x8*)(lds + PG8_SB(b, h) + boff + n * 2048 + k * 1024); } while (0)
#define PG8_MMA(ai, bj, At, Bt) do { __builtin_amdgcn_s_setprio(1); _Pragma("unroll") for (int m = 0; m < 4; ++m) _Pragma("unroll") for (int n = 0; n < 2; ++n) _Pragma("unroll") for (int k = 0; k < 2; ++k) \
        acc[ai][bj][m][n] = __builtin_amdgcn_mfma_f32_16x16x32_bf16(Bt[n][k], At[m][k], acc[ai][bj][m][n], 0, 0, 0); __builtin_amdgcn_s_setprio(0); } while (0)
#define PG8_WAIT_V(n) asm volatile("s_waitcnt vmcnt(" #n ")" ::: "memory")
#define PG8_WAIT_L(n) asm volatile("s_waitcnt lgkmcnt(" #n ")" ::: "memory")
#define PG8_BAR __builtin_amdgcn_s_barrier()
#define PG8_SCHED __builtin_amdgcn_sched_barrier(0)
#define PG8_UA(u) ((const char*)g.A + 2 * ((size_t)((u).z % g.nz0) * g.sAz0 + (size_t)((u).z / g.nz0) * g.sAz1 + (size_t)(u).pm * BM * g.lda))
#define PG8_UB(u) ((const char*)g.Bt + 2 * ((size_t)((u).z % g.nz0) * g.sBz0 + (size_t)((u).z / g.nz0) * g.sBz1 + (size_t)(u).pn * BM * g.ldb))
    Unit cur, nxt; int ui = 0;
    if (!S.next(0, cur)) return;
    f32x4 acc[2][2][4][2];
#pragma unroll
    for (int a = 0; a < 2; ++a)
#pragma unroll
        for (int b = 0; b < 2; ++b)
#pragma unroll
            for (int m = 0; m < 4; ++m)
#pragma unroll
                for (int n = 0; n < 2; ++n) acc[a][b][m][n] = (f32x4){0.f, 0.f, 0.f, 0.f};
    bf16x8 At[4][2], B0[2][2], B1[2][2];
    const char* cA = PG8_UA(cur); const char* cB = PG8_UB(cur);
    PG8_STAGE(PG8_SB(0, 0), cB, voffB); PG8_STAGE(PG8_SB(0, 1), cB + hsB, voffB); PG8_STAGE(PG8_SA(0, 0), cA, voffA); PG8_STAGE(PG8_SA(0, 1), cA + hsA, voffA);
    if (wr == 1) PG8_BAR;
    PG8_WAIT_V(2); PG8_BAR;
    PG8_STAGE(PG8_SB(1, 0), cB + kstep, voffB); PG8_STAGE(PG8_SA(1, 0), cA + kstep, voffA); PG8_STAGE(PG8_SB(1, 1), cB + hsB + kstep, voffB);
    PG8_WAIT_V(6); PG8_BAR;
    for (;;) {
        const bool has_next = S.next(ui + 1, nxt);
        const char* nA = has_next ? PG8_UA(nxt) : cA; const char* nB = has_next ? PG8_UB(nxt) : cB;
        for (int t = 0; t < nt; t += 2) {
            const bool last = (t == nt - 2);
            const char* a1 = cA + (size_t)(t + 1) * kstep;
            const char* a2 = last ? nA : cA + (size_t)(t + 2) * kstep; const char* b2 = last ? nB : cB + (size_t)(t + 2) * kstep;
            const char* a3 = a2 + kstep; const char* b3 = b2 + kstep;
            PG8_LDB(B0, 0, 0); PG8_LDB(B1, 0, 1); PG8_SCHED; PG8_LDA(At, 0, 0); PG8_STAGE(PG8_SA(1, 1), a1 + hsA, voffA);
            PG8_WAIT_V(8); PG8_WAIT_L(0); PG8_BAR; PG8_MMA(0, 0, At, B0); PG8_MMA(0, 1, At, B1); PG8_BAR; PG8_SCHED;
            PG8_LDA(At, 0, 1); PG8_STAGE(PG8_SB(0, 0), b2, voffB); PG8_STAGE(PG8_SB(0, 1), b2 + hsB, voffB); PG8_STAGE(PG8_SA(0, 0), a2, voffA);
            PG8_WAIT_V(8); PG8_WAIT_L(0); PG8_BAR; PG8_MMA(1, 0, At, B0); PG8_MMA(1, 1, At, B1); PG8_BAR; PG8_SCHED;
            PG8_LDB(B0, 1, 0); PG8_LDB(B1, 1, 1); PG8_SCHED; PG8_LDA(At, 1, 0); PG8_STAGE(PG8_SA(0, 1), a2 + hsA, voffA);
            PG8_WAIT_V(8); PG8_WAIT_L(0); PG8_BAR; PG8_MMA(0, 0, At, B0); PG8_MMA(0, 1, At, B1); PG8_BAR; PG8_SCHED;
            PG8_LDA(At, 1, 1); PG8_STAGE(PG8_SB(1, 0), b3, voffB); PG8_STAGE(PG8_SB(1, 1), b3 + hsB, voffB); PG8_STAGE(PG8_SA(1, 0), a3, voffA);
            PG8_WAIT_V(8); PG8_WAIT_L(0); PG8_BAR; PG8_MMA(1, 0, At, B0); PG8_MMA(1, 1, At, B1); PG8_BAR; PG8_SCHED;
        }
        if (ALIGN) { if (wr == 0) PG8_BAR; }
        E(acc, cur, wr, wc, fr, fq, lds);
        if (!has_next) break;
#pragma unroll
        for (int a = 0; a < 2; ++a)
#pragma unroll
            for (int b = 0; b < 2; ++b)
#pragma unroll
                for (int m = 0; m < 4; ++m)
#pragma unroll
                    for (int n = 0; n < 2; ++n) acc[a][b][m][n] = (f32x4){0.f, 0.f, 0.f, 0.f};
        cur = nxt; cA = nA; cB = nB; ++ui;
        if (ALIGN) { if (wr == 1) PG8_BAR; }
    }
    PG8_WAIT_V(0);
    if (!ALIGN) { if (wr == 0) PG8_BAR; }
    PG8_BAR;
#undef PG8_SA
#undef PG8_SB
#undef PG8_STAGE
#undef PG8_LDA
#undef PG8_LDB
#undef PG8_MMA
#undef PG8_UA
#undef PG8_UB
}

typedef f32x4 Acc[2][2][4][2];
#define EPI_ARGS Acc& acc, const Unit& u, int wr, int wc, int fr, int fq, LAS unsigned char* lds
__device__ __forceinline__ int efence() { asm volatile("" ::: "memory"); return 1; }
#define ROWLOOP _Pragma("unroll") for (int ai = 0; ai < 2; ++ai) _Pragma("unroll") for (int m = 0; m < 4; ++m) for (int once_ = efence(); once_; once_ = 0)

#define LOAD_RS8(rs, ssp, row0) float rs[2][4]; { u64 raw_[2][4]; _Pragma("unroll") for (int ai = 0; ai < 2; ++ai) _Pragma("unroll") for (int m = 0; m < 4; ++m) raw_[ai][m] = (ssp)[(row0) + ai * 128 + m * 16]; \
    _Pragma("unroll") for (int ai = 0; ai < 2; ++ai) _Pragma("unroll") for (int m = 0; m < 4; ++m) rs[ai][m] = rsqrtf((float)(long long)raw_[ai][m] * (1.0f / 16777216.0f) * (1.0f / D) + EPS); }
struct EpiIn0 {
    const u64* ss; bf16_t* U; bf16_t* V; bf16_t* H; u64* vst;
    __device__ __forceinline__ void operator()(EPI_ARGS) const {
        const int row0 = u.pm * 256 + wr * 64 + fr;
        LOAD_RS8(rs8, ss, row0);
        if (u.pn < 4) {
            bf16_t* dst = (u.pn < 2) ? U : V; const int col0 = (u.pn & 1) * 256 + wc * 32 + 8 * fq; const bool st = u.pn >= 2;
            ROWLOOP { const int row = row0 + ai * 128 + m * 16; const float rs = rs8[ai][m]; float s = 0.f, q = 0.f;
#pragma unroll
                for (int bj = 0; bj < 2; ++bj) { f32x4 v0 = acc[ai][bj][m][0] * rs, v1 = acc[ai][bj][m][1] * rs;
#pragma unroll
                    for (int e = 0; e < 4; ++e) { v0[e] = gelu_f(v0[e]); v1[e] = gelu_f(v1[e]); s += v0[e] + v1[e]; q += v0[e] * v0[e] + v1[e] * v1[e]; }
                    *(u32x4*)(dst + (size_t)row * 512 + col0 + bj * 128) = pack8(v0, v1); }
                if (st) { s += __shfl_xor(s, 16); s += __shfl_xor(s, 32); q += __shfl_xor(q, 16); q += __shfl_xor(q, 32);
                    if (fq == 0) { fx_add(vst + 2 * row, s); fx_add(vst + 2 * row + 1, q); } }
            }
        } else {
            const int col0 = (u.pn - 4) * 128 + wc * 32 + 8 * fq;
            ROWLOOP { const int row = row0 + ai * 128 + m * 16; const float rs = rs8[ai][m]; f32x4 h0, h1;
#pragma unroll
                for (int e = 0; e < 4; ++e) { h0[e] = acc[ai][0][m][0][e] * rs * sigmoid_f(acc[ai][1][m][0][e] * rs); h1[e] = acc[ai][0][m][1][e] * rs * sigmoid_f(acc[ai][1][m][1][e] * rs); }
                *(u32x4*)(H + (size_t)row * 512 + col0) = pack8(h0, h1); }
        }
    }
};
__device__ __forceinline__ void unpack8(u32x4 b, f32x4& o0, f32x4& o1) { o0 = (f32x4){bflo(b.x), bfhi(b.x), bflo(b.y), bfhi(b.y)}; o1 = (f32x4){bflo(b.z), bfhi(b.z), bflo(b.w), bfhi(b.w)}; }
template <bool GLU> struct EpiRes {
    bf16_t* xb; u64* ss; int zrows;
    __device__ __forceinline__ void operator()(EPI_ARGS) const {
        const int row0 = u.z * zrows + u.pm * 256 + wr * 64 + fr;
#pragma unroll
        for (int ai = 0; ai < 2; ++ai) {
            u32x4 pre[4][2];
#pragma unroll
            for (int m = 0; m < 4; ++m) { const int row = row0 + ai * 128 + m * 16;
                if (GLU) pre[m][0] = *(const u32x4*)(xb + (size_t)row * D + u.pn * 128 + wc * 32 + 8 * fq);
                else {
#pragma unroll
                    for (int bj = 0; bj < 2; ++bj) pre[m][bj] = *(const u32x4*)(xb + (size_t)row * D + u.pn * 256 + bj * 128 + wc * 32 + 8 * fq); } }
#pragma unroll
            for (int m = 0; m < 4; ++m) for (int once_ = efence(); once_; once_ = 0) { const int row = row0 + ai * 128 + m * 16; float q = 0.f;
                if (GLU) { const size_t off = (size_t)row * D + u.pn * 128 + wc * 32 + 8 * fq;
                    f32x4 o0, o1; unpack8(pre[m][0], o0, o1);
#pragma unroll
                    for (int e = 0; e < 4; ++e) { o0[e] += acc[ai][0][m][0][e] * sigmoid_f(acc[ai][1][m][0][e]); o1[e] += acc[ai][0][m][1][e] * sigmoid_f(acc[ai][1][m][1][e]);
                        q += o0[e] * o0[e] + o1[e] * o1[e]; }
                    *(u32x4*)(xb + off) = pack8(o0, o1);
                } else {
#pragma unroll
                    for (int bj = 0; bj < 2; ++bj) { const size_t off = (size_t)row * D + u.pn * 256 + bj * 128 + wc * 32 + 8 * fq;
                        f32x4 o0, o1; unpack8(pre[m][bj], o0, o1); o0 += acc[ai][bj][m][0]; o1 += acc[ai][bj][m][1];
#pragma unroll
                        for (int e = 0; e < 4; ++e) q += o0[e] * o0[e] + o1[e] * o1[e];
                        *(u32x4*)(xb + off) = pack8(o0, o1); }
                }
                q += __shfl_xor(q, 16); q += __shfl_xor(q, 32);
                if (fq == 0) fx_add(ss + row, q);
            }
        }
    }
};
struct EpiResFinal {
    const bf16_t* xb; u64* ss; unsigned* cnt; const float* gain; float* out;
    __device__ __forceinline__ void operator()(EPI_ARGS) const {
        const int row0 = u.pm * 256 + wr * 64 + fr, cofs = u.pn * 256 + wc * 32 + 8 * fq, wid = wr * 4 + wc;
#pragma unroll
        for (int ai = 0; ai < 2; ++ai) {
            u32x4 pre[4][2];
#pragma unroll
            for (int m = 0; m < 4; ++m)
#pragma unroll
                for (int bj = 0; bj < 2; ++bj) pre[m][bj] = *(const u32x4*)(xb + (size_t)(row0 + ai * 128 + m * 16) * D + cofs + bj * 128);
#pragma unroll
            for (int m = 0; m < 4; ++m) for (int once_ = efence(); once_; once_ = 0) { const int row = row0 + ai * 128 + m * 16; float q = 0.f;
#pragma unroll
                for (int bj = 0; bj < 2; ++bj) { f32x4 o0, o1; unpack8(pre[m][bj], o0, o1); o0 += acc[ai][bj][m][0]; o1 += acc[ai][bj][m][1];
#pragma unroll
                    for (int e = 0; e < 4; ++e) q += o0[e] * o0[e] + o1[e] * o1[e];
                    acc[ai][bj][m][0] = o0; acc[ai][bj][m][1] = o1; }
                q += __shfl_xor(q, 16); q += __shfl_xor(q, 32);
                if (fq == 0) fx_add(ss + row, q); }
        }
        asm volatile("s_waitcnt vmcnt(0)" ::: "memory");
        unsigned* c = cnt + 64 * u.pm;
        if (fr == 0 && fq == 0) __hip_atomic_fetch_add(c, 1u, __ATOMIC_RELAXED, __HIP_MEMORY_SCOPE_AGENT);
        if (wid == 0) { unsigned sp = 0;
            while (__hip_atomic_load(c, __ATOMIC_RELAXED, __HIP_MEMORY_SCOPE_AGENT) < 32u) { __builtin_amdgcn_s_sleep(1); if (++sp > (1u << 22)) break; } }
        asm volatile("s_waitcnt vmcnt(0) lgkmcnt(0)" ::: "memory"); __builtin_amdgcn_s_barrier(); asm volatile("" ::: "memory");
        float rs8[2][4];
#pragma unroll
        for (int ai = 0; ai < 2; ++ai)
#pragma unroll
            for (int m = 0; m < 4; ++m) { const u64 raw = __hip_atomic_load(ss + row0 + ai * 128 + m * 16, __ATOMIC_RELAXED, __HIP_MEMORY_SCOPE_AGENT);
                rs8[ai][m] = rsqrtf((float)(long long)raw * (1.0f / 16777216.0f) * (1.0f / D) + EPS); }
        f32x4 gv[2][2];
#pragma unroll
        for (int bj = 0; bj < 2; ++bj) { gv[bj][0] = *(const f32x4*)(gain + cofs + bj * 128); gv[bj][1] = *(const f32x4*)(gain + cofs + bj * 128 + 4); }
        ROWLOOP { float* orow = out + (size_t)(row0 + ai * 128 + m * 16) * D + cofs; const float rs = rs8[ai][m];
#pragma unroll
            for (int bj = 0; bj < 2; ++bj) { *(f32x4*)(orow + bj * 128) = acc[ai][bj][m][0] * rs * gv[bj][0]; *(f32x4*)(orow + bj * 128 + 4) = acc[ai][bj][m][1] * rs * gv[bj][1]; } }
    }
};
struct EpiStore {
    bf16_t* O; int ldc, nz0; long sz0, sz1; const u64* ss; float scale;
    __device__ __forceinline__ void operator()(EPI_ARGS) const {
        bf16_t* base = O + (size_t)(u.z % nz0) * sz0 + (size_t)(u.z / nz0) * sz1; const int row0 = u.pm * 256 + wr * 64 + fr, col0 = u.pn * 256 + wc * 32 + 8 * fq;
        float rs8[2][4];
        if (ss) { LOAD_RS8(t8, ss, row0);
#pragma unroll
            for (int ai = 0; ai < 2; ++ai)
#pragma unroll
                for (int m = 0; m < 4; ++m) rs8[ai][m] = t8[ai][m] * scale; }
        else {
#pragma unroll
            for (int ai = 0; ai < 2; ++ai)
#pragma unroll
                for (int m = 0; m < 4; ++m) rs8[ai][m] = scale; }
        ROWLOOP { const int row = row0 + ai * 128 + m * 16; const float rs = rs8[ai][m];
#pragma unroll
            for (int bj = 0; bj < 2; ++bj) *(u32x4*)(base + (size_t)row * ldc + col0 + bj * 128) = pack8(acc[ai][bj][m][0] * rs, acc[ai][bj][m][1] * rs); }
    }
};
struct EpiSoftmax {
    bf16_t* P; const u64* ss;
    __device__ __forceinline__ void operator()(EPI_ARGS) const {
        LAS float* X = (LAS float*)(lds + XCH_OFF); LAS float* Y = X + 1024;
        const int grow0 = u.z * SEQ + u.pm * 256 + wr * 64 + fr;
        LOAD_RS8(rs8, ss, grow0);
        ROWLOOP { const int r = ai * 128 + wr * 64 + m * 16 + fr; const float sc = rs8[ai][m] * 0.0625f; float mx = -3.0e38f;
#pragma unroll
            for (int bj = 0; bj < 2; ++bj)
#pragma unroll
                for (int n = 0; n < 2; ++n) { acc[ai][bj][m][n] = acc[ai][bj][m][n] * sc;
#pragma unroll
                    for (int e = 0; e < 4; ++e) mx = fmaxf(mx, acc[ai][bj][m][n][e]); }
            mx = fmaxf(mx, __shfl_xor(mx, 16)); mx = fmaxf(mx, __shfl_xor(mx, 32));
            if (fq == 0) X[r * 4 + wc] = mx; }
        asm volatile("s_waitcnt lgkmcnt(0)" ::: "memory"); __builtin_amdgcn_s_barrier(); asm volatile("" ::: "memory");
        ROWLOOP { const int r = ai * 128 + wr * 64 + m * 16 + fr; const f32x4 xm = *(const LAS f32x4*)(X + r * 4); const float mx = fmaxf(fmaxf(xm[0], xm[1]), fmaxf(xm[2], xm[3])); float s = 0.f;
#pragma unroll
            for (int bj = 0; bj < 2; ++bj)
#pragma unroll
                for (int n = 0; n < 2; ++n)
#pragma unroll
                    for (int e = 0; e < 4; ++e) { const float p = __expf(acc[ai][bj][m][n][e] - mx); acc[ai][bj][m][n][e] = p; s += p; }
            s += __shfl_xor(s, 16); s += __shfl_xor(s, 32);
            if (fq == 0) Y[r * 4 + wc] = s; }
        asm volatile("s_waitcnt lgkmcnt(0)" ::: "memory"); __builtin_amdgcn_s_barrier(); asm volatile("" ::: "memory");
        ROWLOOP { const int r = ai * 128 + wr * 64 + m * 16 + fr; const f32x4 ys = *(const LAS f32x4*)(Y + r * 4); const float inv = 1.0f / ((ys[0] + ys[1]) + (ys[2] + ys[3]));
#pragma unroll
            for (int bj = 0; bj < 2; ++bj) *(u32x4*)(P + (size_t)(u.z * SEQ + u.pm * 256 + r) * D + u.pn * 256 + bj * 128 + wc * 32 + 8 * fq) = pack8(acc[ai][bj][m][0] * inv, acc[ai][bj][m][1] * inv); }
    }
};
struct EpiFfn1 {
    const u64* ss; bf16_t* HM;
    __device__ __forceinline__ void operator()(EPI_ARGS) const {
        const int row0 = u.pm * 256 + wr * 64 + fr, col0 = u.pn * 128 + wc * 32 + 8 * fq;
        LOAD_RS8(rs8, ss, row0);
        ROWLOOP { const int row = row0 + ai * 128 + m * 16; const float rs = rs8[ai][m]; f32x4 h0, h1;
#pragma unroll
            for (int e = 0; e < 4; ++e) { h0[e] = silu_f(acc[ai][0][m][0][e] * rs) * (acc[ai][1][m][0][e] * rs); h1[e] = silu_f(acc[ai][0][m][1][e] * rs) * (acc[ai][1][m][1][e] * rs); }
            *(u32x4*)(HM + (size_t)row * FH + col0) = pack8(h0, h1); }
    }
};
struct EpiOin {
    const u64* ss; bf16_t* AC;
    __device__ __forceinline__ void operator()(EPI_ARGS) const {
        const int row0 = u.pm * 256 + wr * 64 + fr;
        LOAD_RS8(rs8, ss, row0);
        ROWLOOP { const int row = row0 + ai * 128 + m * 16; const float rs = rs8[ai][m];
#pragma unroll
            for (int bj = 0; bj < 2; ++bj) { const int col = u.pn * 256 + bj * 128 + wc * 32 + 8 * fq;
                *(u32x4*)(AC + (size_t)(col >> 4) * NCH * AK + (size_t)(row / SL) * AK + (row % SL) * 16 + (col & 8)) = pack8(acc[ai][bj][m][0] * rs, acc[ai][bj][m][1] * rs); } }
    }
};
struct EpiS5State {
    float* XL;
    __device__ __forceinline__ void operator()(EPI_ARGS) const {
        const int row0 = u.pm * 256 + wr * 64 + fr, col0 = wc * 32 + 8 * fq;
        ROWLOOP { const int row = row0 + ai * 128 + m * 16; float* p = XL + (size_t)u.z * NCH * 128 + (size_t)row * 128 + col0;
            *(f32x4*)p = acc[ai][0][m][0]; *(f32x4*)(p + 4) = acc[ai][0][m][1]; }
    }
};
struct EpiS5Out {
    const bf16_t* AC; const float* dsk; bf16_t* Y;
    __device__ __forceinline__ void operator()(EPI_ARGS) const {
        const int g = u.z, row0 = u.pm * 256 + wr * 64 + fr;
        f32x4 dv[2][2];
#pragma unroll
        for (int bj = 0; bj < 2; ++bj) { const int ch = g * 16 + ((u.pn * 256 + bj * 128 + wc * 32 + 8 * fq) & 8); dv[bj][0] = *(const f32x4*)(dsk + ch); dv[bj][1] = *(const f32x4*)(dsk + ch + 4); }
#pragma unroll
        for (int ai = 0; ai < 2; ++ai) {
            u32x4 pre[4][2];
#pragma unroll
            for (int m = 0; m < 4; ++m)
#pragma unroll
                for (int bj = 0; bj < 2; ++bj) pre[m][bj] = *(const u32x4*)(AC + (size_t)g * NCH * AK + (size_t)(row0 + ai * 128 + m * 16) * AK + u.pn * 256 + bj * 128 + wc * 32 + 8 * fq);
#pragma unroll
            for (int m = 0; m < 4; ++m) for (int once_ = efence(); once_; once_ = 0) { const int row = row0 + ai * 128 + m * 16;
#pragma unroll
                for (int bj = 0; bj < 2; ++bj) { const int col = u.pn * 256 + bj * 128 + wc * 32 + 8 * fq, k = col >> 4, ch = g * 16 + (col & 8);
                    f32x4 u0, u1; unpack8(pre[m][bj], u0, u1);
                    f32x4 y0 = acc[ai][bj][m][0] + dv[bj][0] * u0, y1 = acc[ai][bj][m][1] + dv[bj][1] * u1;
#pragma unroll
                    for (int e = 0; e < 4; ++e) { y0[e] = gelu_f(y0[e]); y1[e] = gelu_f(y1[e]); }
                    *(u32x4*)(Y + (size_t)(row * SL + k) * 512 + ch) = pack8(y0, y1); } }
        }
    }
};
}

#define XB_TMO      128
#define XB_XCNT(j)  (256  + 64 * (j))
#define XB_XSUB(j)  (1280 + 64 * (j))
#define XB_XGEN(j)  (2304 + 64 * (j))
#define XB_TOP      3328
#define XB_TOPGEN   3392
#define XCD_BAR_WORDS 3456
#define XB_SPIN_CAP (1u << 22)
__device__ __forceinline__ unsigned xb_ld(unsigned* p)              { return __hip_atomic_load(p, __ATOMIC_RELAXED, __HIP_MEMORY_SCOPE_AGENT); }
__device__ __forceinline__ unsigned xb_add(unsigned* p, unsigned v) { return __hip_atomic_fetch_add(p, v, __ATOMIC_RELAXED, __HIP_MEMORY_SCOPE_AGENT); }
__device__ __forceinline__ unsigned xb_xcc_id() { return (unsigned)__builtin_amdgcn_s_getreg((3 << 11) | 20) & 0xFu; }
#define XB_SPIN(cond, bar) do { unsigned _sp = 0; while (cond) { __builtin_amdgcn_s_sleep(1); \
    if ((++_sp & 255u) == 0u) { if (xb_ld(&(bar)[XB_TMO])) break; if (_sp > XB_SPIN_CAP) { atomicAdd(&(bar)[XB_TMO], 1u); break; } } } } while (0)
struct XcdBarrier { unsigned* bar; unsigned x; volatile LAS unsigned* st; };
__device__ __forceinline__ XcdBarrier xcd_barrier_post(unsigned* bar, volatile LAS unsigned* st) {
    XcdBarrier b; b.bar = bar; b.x = xb_xcc_id(); b.st = st;
    if (threadIdx.x == 0) (void)xb_add(&bar[XB_XCNT(b.x)], 1u);
    return b;
}
__device__ __forceinline__ void xcd_barrier_complete(unsigned* bar, unsigned x, unsigned& nloc, unsigned& nx) {
    const unsigned G = gridDim.x * gridDim.y * gridDim.z;
    unsigned sum, cnt, mine, sp = 0u;
    for (;;) {
        sum = 0u; cnt = 0u; mine = 0u;
#pragma unroll
        for (unsigned j = 0; j < 16; ++j) { const unsigned c = xb_ld(&bar[XB_XCNT(j)]); sum += c; cnt += (c > 0u) ? 1u : 0u; mine = (j == x) ? c : mine; }
        if (sum == G) break;
        __builtin_amdgcn_s_sleep(1);
        if ((++sp & 255u) == 0u) { if (xb_ld(&bar[XB_TMO])) break; if (sp > XB_SPIN_CAP) { atomicAdd(&bar[XB_TMO], 1u); break; } }
    }
    nloc = mine > 0u ? mine : 1u; nx = cnt > 0u ? cnt : 1u;
}
__device__ __forceinline__ void xcd_barrier(const XcdBarrier& b) {
    asm volatile("s_waitcnt vmcnt(0)" ::: "memory");
    __syncthreads();
    if (threadIdx.x == 0) {
        unsigned* bar = b.bar;
        __builtin_amdgcn_s_waitcnt(0);
        unsigned nloc = b.st[0], nx = b.st[1];
        if (nloc == 0u) { xcd_barrier_complete(bar, b.x, nloc, nx); b.st[0] = nloc; b.st[1] = nx; }
        const unsigned old = xb_add(&bar[XB_XSUB(b.x)], 1u);
        const unsigned gen = old / nloc;
        if (old + 1u == (gen + 1u) * nloc) {
            __builtin_amdgcn_fence(__ATOMIC_RELEASE, "agent");
            asm volatile("s_waitcnt vmcnt(0)" ::: "memory");
            const unsigned og = xb_add(&bar[XB_TOP], 1u);
            const unsigned tg = og / nx;
            if (og + 1u == (tg + 1u) * nx) xb_add(&bar[XB_TOPGEN], 1u);
            else XB_SPIN(xb_ld(&bar[XB_TOPGEN]) == tg, bar);
            __builtin_amdgcn_fence(__ATOMIC_ACQUIRE, "agent");
            xb_add(&bar[XB_XGEN(b.x)], 1u);
            asm volatile("s_waitcnt vmcnt(0)" ::: "memory");
        } else {
            XB_SPIN(xb_ld(&bar[XB_XGEN(b.x)]) == gen, bar);
            __builtin_amdgcn_fence(__ATOMIC_ACQUIRE, "agent");
            asm volatile("s_waitcnt vmcnt(0)" ::: "memory");
        }
    }
    __syncthreads();
}

struct ConvP { const float* W; bf16_t* WT; const float* gain; int K, ldn, cs, nblk, mode, roff, r; };
__device__ __forceinline__ void conv_load(const ConvP& p, f32x4 (&v)[32], int lane) {
    const int nkb = p.K / 64, kb = p.r % nkb, nb = p.r / nkb; const float* src = p.W + (size_t)(64 * kb + (lane >> 5)) * p.ldn + p.cs + 128 * nb + 4 * (lane & 31);
#pragma unroll
    for (int i = 0; i < 32; ++i) v[i] = *(const f32x4*)(src + (size_t)(2 * i) * p.ldn);
}
__device__ __forceinline__ void conv_store(const ConvP& p, const f32x4 (&v)[32], LAS float* scr, int lane) {
    const int nkb = p.K / 64, kb = p.r % nkb, nb = p.r / nkb, k0 = 64 * kb, c = lane & 7;
    f32x4 g0 = {1.f, 1.f, 1.f, 1.f}, g1 = g0;
    if (p.gain) { g0 = *(const f32x4*)(p.gain + k0 + 8 * c); g1 = *(const f32x4*)(p.gain + k0 + 8 * c + 4); }
#pragma unroll 1
    for (int sb = 0; sb < 4; ++sb) {
        if (((lane & 31) >> 3) == sb) {
#pragma unroll
            for (int i = 0; i < 32; ++i)
#pragma unroll
                for (int e = 0; e < 4; ++e) scr[(2 * i + (lane >> 5)) * 33 + 4 * (lane & 7) + e] = v[i][e]; }
        asm volatile("s_waitcnt lgkmcnt(0)" ::: "memory");
        const int c0 = 128 * nb + 32 * sb, drow = p.roff + (p.mode == 0 ? c0 : ((c0 >> 7) * 256 + (p.mode - 1) * 128 + (c0 & 127)));
#pragma unroll
        for (int j = 0; j < 4; ++j) { const int n = (lane >> 3) + 8 * j; const LAS float* s = scr + (8 * c) * 33 + n;
            u32x4 o; o.x = cvt_pk_bf16(s[0 * 33] * g0[0], s[1 * 33] * g0[1]); o.y = cvt_pk_bf16(s[2 * 33] * g0[2], s[3 * 33] * g0[3]); o.z = cvt_pk_bf16(s[4 * 33] * g1[0], s[5 * 33] * g1[1]); o.w = cvt_pk_bf16(s[6 * 33] * g1[2], s[7 * 33] * g1[3]);
            *(u32x4*)(p.WT + (size_t)(drow + n) * p.K + k0 + 8 * c) = o; }
        asm volatile("s_waitcnt lgkmcnt(0)" ::: "memory");
    }
}
template <bool NORM, int R> __device__ __forceinline__ void rows_to_bf16(const float* x0, bf16_t* o0, u64* ssq, int lane) {
    f32x4 v[R][4]; float s[R];
#pragma unroll
    for (int r = 0; r < R; ++r) { const f32x4* xr = (const f32x4*)(x0 + (size_t)r * D) + lane;
#pragma unroll
        for (int j = 0; j < 4; ++j) v[r][j] = xr[64 * j]; }
#pragma unroll
    for (int r = 0; r < R; ++r) { float a = 0.f;
#pragma unroll
        for (int j = 0; j < 4; ++j) a += (v[r][j][0] * v[r][j][0] + v[r][j][1] * v[r][j][1]) + (v[r][j][2] * v[r][j][2] + v[r][j][3] * v[r][j][3]);
        s[r] = wave_sum(a); }
#pragma unroll
    for (int r = 0; r < R; ++r) { const float rs = NORM ? rsqrtf(s[r] * (1.0f / D) + EPS) : 1.0f; u32x2* o = (u32x2*)(o0 + (size_t)r * D) + lane;
#pragma unroll
        for (int j = 0; j < 4; ++j) { u32x2 w; w.x = cvt_pk_bf16(v[r][j][0] * rs, v[r][j][1] * rs); w.y = cvt_pk_bf16(v[r][j][2] * rs, v[r][j][3] * rs); o[64 * j] = w; }
        if (ssq && lane == 0) ssq[r] = (u64)(long long)(s[r] * 16777216.0f); }
}
__device__ __forceinline__ void cis_f(float ang, float& c, float& s) {
    float rev = ang * 0.15915494309189535f; rev = rev - rintf(rev);
    const float x = rev * 6.283185307179586f;
    const float h = x * 0.25f, h2 = h * h;
    float sh = h * (1.0f + h2 * (-1.6666667e-1f + h2 * (8.3333333e-3f + h2 * (-1.9841270e-4f + h2 * 2.7557319e-6f))));
    float ch = 1.0f + h2 * (-0.5f + h2 * (4.1666667e-2f + h2 * (-1.3888889e-3f + h2 * (2.4801587e-5f + h2 * -2.7557319e-7f))));
    float s2 = 2.f * sh * ch, c2 = 1.f - 2.f * sh * sh;
    s = 2.f * s2 * c2; c = 1.f - 2.f * s2 * s2;
}
__device__ __forceinline__ void s5_setup(int g, LAS unsigned char* lds, const float* lam_re, const float* lam_im, const float* log_dt, const float* b_re, const float* b_im, const float* c_re, const float* c_im,
                                         bf16_t* BT3, bf16_t* GM, float* AL, int tid) {
    LAS float* pwr = (LAS float*)lds; LAS float* pwi = pwr + 33 * 64; LAS float* Bbr = pwi + 33 * 64; LAS float* Bbi = Bbr + 1024; LAS float* Cr = Bbi + 1024; LAS float* Ci = Cr + 1024; LAS float* Kd = Ci + 1024;
    const float dt = __expf(log_dt[g]);
    for (int idx = tid; idx < 33 * 64; idx += 512) { const int d = idx >> 6, p = idx & 63; const float lr = lam_re[g * 64 + p], li = lam_im[g * 64 + p];
        const float mag = __expf(lr * dt * (float)d); float c, s; cis_f(li * dt * (float)d, c, s); pwr[idx] = mag * c; pwi[idx] = mag * s; }
    for (int idx = tid; idx < 1024; idx += 512) { const int p = idx >> 4; const float lr = lam_re[g * 64 + p], li = lam_im[g * 64 + p];
        const float mag = __expf(lr * dt); float c, s; cis_f(li * dt, c, s); const float ar = mag * c, ai = mag * s, den = lr * lr + li * li;
        const float qr = ((ar - 1.0f) * lr + ai * li) / den, qi = (ai * lr - (ar - 1.0f) * li) / den;
        const float br = b_re[g * 1024 + idx], bi = b_im[g * 1024 + idx];
        Bbr[idx] = qr * br - qi * bi; Bbi[idx] = qr * bi + qi * br;
        Cr[idx] = c_re[g * 1024 + idx]; Ci[idx] = c_im[g * 1024 + idx]; }
    __syncthreads();
    for (int idx = tid; idx < 32 * 256; idx += 512) { const int d = idx >> 8, co = (idx >> 4) & 15, ci = idx & 15; float a = 0.f;
        for (int p = 0; p < 64; ++p) { const float cr = Cr[co * 64 + p], cim = Ci[co * 64 + p], pr = pwr[d * 64 + p], pi = pwi[d * 64 + p];
            const float tr = cr * pr - cim * pi, ti = cr * pi + cim * pr; a += tr * Bbr[p * 16 + ci] - ti * Bbi[p * 16 + ci]; }
        Kd[idx] = a; }
    __syncthreads();
    bf16_t* bt = BT3 + (size_t)g * 512 * AK;
    for (int idx = tid; idx < 512 * (AK / 8); idx += 512) { const int n = idx / (AK / 8), q = idx % (AK / 8), kk0 = q * 8, k = n >> 4, co = n & 15; float v[8];
        if (kk0 < 512) { const int j = kk0 >> 4, ci0 = kk0 & 15;
#pragma unroll
            for (int e = 0; e < 8; ++e) v[e] = (j <= k) ? Kd[(k - j) * 256 + co * 16 + ci0 + e] : 0.f;
        } else { const int p0 = kk0 - 512;
#pragma unroll
            for (int e = 0; e < 8; ++e) { const int p = (p0 & 63) + e; const float cr = Cr[co * 64 + p], cim = Ci[co * 64 + p], pr = pwr[(k + 1) * 64 + p], pi = pwi[(k + 1) * 64 + p];
                v[e] = (p0 < 64) ? (cr * pr - cim * pi) : -(cr * pi + cim * pr); } }
        u32x4 w; w.x = cvt_pk_bf16(v[0], v[1]); w.y = cvt_pk_bf16(v[2], v[3]); w.z = cvt_pk_bf16(v[4], v[5]); w.w = cvt_pk_bf16(v[6], v[7]);
        *(u32x4*)(bt + (size_t)n * AK + kk0) = w; }
    bf16_t* gm = GM + (size_t)g * 256 * 512;
    for (int idx = tid; idx < 256 * 64; idx += 512) { const int n = idx >> 6, q = idx & 63, kk0 = q * 8; float v[8];
        if (n < 128) { const int p = n & 63, j = kk0 >> 4, ci0 = kk0 & 15; const float pr = pwr[(SL - 1 - j) * 64 + p], pi = pwi[(SL - 1 - j) * 64 + p];
#pragma unroll
            for (int e = 0; e < 8; ++e) { const float br = Bbr[p * 16 + ci0 + e], bi = Bbi[p * 16 + ci0 + e]; v[e] = (n < 64) ? (pr * br - pi * bi) : (pr * bi + pi * br); }
        } else {
#pragma unroll
            for (int e = 0; e < 8; ++e) v[e] = 0.f; }
        u32x4 w; w.x = cvt_pk_bf16(v[0], v[1]); w.y = cvt_pk_bf16(v[2], v[3]); w.z = cvt_pk_bf16(v[4], v[5]); w.w = cvt_pk_bf16(v[6], v[7]);
        *(u32x4*)(gm + (size_t)n * 512 + kk0) = w; }
    if (tid < 64) { AL[(g * 64 + tid) * 2] = pwr[SL * 64 + tid]; AL[(g * 64 + tid) * 2 + 1] = pwi[SL * 64 + tid]; }
    __syncthreads();
}

__device__ __forceinline__ void gmlp_unit(int unit, LAS unsigned char* lds, const bf16_t* U, const bf16_t* V, const u64* vst, const bf16_t* GW, const float* gb, bf16_t* MIX, int tid) {
    const int g = unit & 3, t0 = (unit >> 2) * 128, lane = tid & 63, wid = tid >> 6;
    LAS bf16_t* vT = (LAS bf16_t*)lds;
    const int il = lane & 15, kq = lane >> 4, i = wid * 16 + il;
    u32x4 raw[4]; u64 st[4][2];
#pragma unroll
    for (int e = 0; e < 4; ++e) { const int q = tid + 512 * e, j = q >> 4, c8 = (q & 15) * 8;
        raw[e] = *(const u32x4*)(V + (size_t)(t0 + j) * 512 + g * 128 + c8); st[e][0] = vst[2 * (t0 + j)]; st[e][1] = vst[2 * (t0 + j) + 1]; }
    bf16x8 wf[4];
#pragma unroll
    for (int ks = 0; ks < 4; ++ks) wf[ks] = *(const bf16x8*)(GW + (size_t)g * 16384 + (size_t)i * 128 + ks * 32 + kq * 8);
    const float bias = gb[g * 128 + i];
    const size_t tok = (size_t)(t0 + i);
    u32x2 uu[8];
#pragma unroll
    for (int nt = 0; nt < 8; ++nt) uu[nt] = *(const u32x2*)(U + tok * 512 + g * 128 + nt * 16 + kq * 4);
#pragma unroll
    for (int e = 0; e < 4; ++e) { const int q = tid + 512 * e, j = q >> 4, c8 = (q & 15) * 8;
        const float s = (float)(long long)st[e][0] * (1.0f / 16777216.0f), ss = (float)(long long)st[e][1] * (1.0f / 16777216.0f), mean = s * (1.0f / 512.0f), var = ss * (1.0f / 512.0f) - mean * mean, rstd = rsqrtf(fmaxf(var, 0.f) + EPS);
        const float v[8] = {bflo(raw[e].x), bfhi(raw[e].x), bflo(raw[e].y), bfhi(raw[e].y), bflo(raw[e].z), bfhi(raw[e].z), bflo(raw[e].w), bfhi(raw[e].w)};
        const int jo = ((((j >> 3) ^ (c8 >> 3)) & 15) << 3) + (j & 7);
#pragma unroll
        for (int k = 0; k < 8; k += 2) { const unsigned pk = cvt_pk_bf16((v[k] - mean) * rstd, (v[k + 1] - mean) * rstd); vT[(c8 + k) * 136 + jo] = (bf16_t)(pk & 0xffffu); vT[(c8 + k + 1) * 136 + jo] = (bf16_t)(pk >> 16); } }
    __syncthreads();
#pragma unroll 2
    for (int nt = 0; nt < 8; ++nt) { f32x4 a = {0.f, 0.f, 0.f, 0.f}; const int c = nt * 16 + il;
#pragma unroll
        for (int ks = 0; ks < 4; ++ks) { const bf16x8 vf = *(const LAS bf16x8*)(vT + c * 136 + ((((ks * 4 + kq) ^ (c >> 3)) & 15) << 3)); a = __builtin_amdgcn_mfma_f32_16x16x32_bf16(vf, wf[ks], a, 0, 0, 0); }
        u32x2 o; o.x = cvt_pk_bf16(bflo(uu[nt].x) * (a[0] + bias), bfhi(uu[nt].x) * (a[1] + bias)); o.y = cvt_pk_bf16(bflo(uu[nt].y) * (a[2] + bias), bfhi(uu[nt].y) * (a[3] + bias));
        *(u32x2*)(MIX + tok * 1024 + g * 128 + nt * 16 + kq * 4) = o; }
    __syncthreads();
}
__device__ __forceinline__ void conv_units(int first, int stride, int nunits, LAS unsigned char* lds, const bf16_t* H, const float* cw, const float* cb, const float* lng, const float* lnb, bf16_t* MIX, int tid) {
    if (first >= nunits) return;
    const int lane = tid & 63, wid = tid >> 6;
    LAS bf16_t* hin = (LAS bf16_t*)lds;
    LAS float* cout = (LAS float*)(lds + 62 * 1024);
    float w[31];
#pragma unroll
    for (int k = 0; k < 31; ++k) w[k] = cw[k * 512 + tid];
    const float bias = cb[tid];
    const f32x4 g0 = *(const f32x4*)(lng + lane * 8), g1 = *(const f32x4*)(lng + lane * 8 + 4), b0 = *(const f32x4*)(lnb + lane * 8), b1 = *(const f32x4*)(lnb + lane * 8 + 4);
    u32x4 pre[8];
#define CONV_PREFETCH(unit_) { const int t0_ = (unit_) * 32, s0_ = t0_ % SEQ; _Pragma("unroll") for (int e = 0; e < 8; ++e) { const int q = tid + 512 * e, r = q >> 6, c8 = (q & 63) * 8; \
        u32x4 v_ = {0u, 0u, 0u, 0u}; if (q < 62 * 64 && s0_ - 30 + r >= 0) v_ = *(const u32x4*)(H + (size_t)(t0_ - 30 + r) * 512 + c8); pre[e] = v_; } }
    CONV_PREFETCH(first);
#pragma unroll 1
    for (int unit = first; unit < nunits; unit += stride) {
        const int t0 = unit * 32;
#pragma unroll
        for (int e = 0; e < 8; ++e) { const int q = tid + 512 * e; if (q < 62 * 64) *(LAS u32x4*)(hin + (q >> 6) * 512 + (q & 63) * 8) = pre[e]; }
        if (unit + stride < nunits) CONV_PREFETCH(unit + stride);
        __syncthreads();
#pragma unroll 1
        for (int tg = 0; tg < 4; ++tg) { float x[38];
#pragma unroll
            for (int r = 0; r < 38; ++r) x[r] = bf2f(hin[(tg * 8 + r) * 512 + tid]);
#pragma unroll
            for (int o = 0; o < 8; ++o) { float a = bias;
#pragma unroll
                for (int k = 0; k < 31; ++k) a += w[k] * x[o + k];
                cout[(tg * 8 + o) * 516 + tid] = a; } }
        __syncthreads();
#pragma unroll 1
        for (int tt = 0; tt < 4; ++tt) { const int row = wid * 4 + tt; const f32x4 v0 = *(const LAS f32x4*)(cout + row * 516 + lane * 8), v1 = *(const LAS f32x4*)(cout + row * 516 + lane * 8 + 4);
            const float mean = wave_sum((v0[0] + v0[1]) + (v0[2] + v0[3]) + (v1[0] + v1[1]) + (v1[2] + v1[3])) * (1.0f / 512.0f);
            const f32x4 d0 = v0 - mean, d1 = v1 - mean;
            const float var = wave_sum((d0[0] * d0[0] + d0[1] * d0[1]) + (d0[2] * d0[2] + d0[3] * d0[3]) + (d1[0] * d1[0] + d1[1] * d1[1]) + (d1[2] * d1[2] + d1[3] * d1[3])) * (1.0f / 512.0f);
            const float rstd = rsqrtf(var + EPS);
            f32x4 y0 = d0 * rstd * g0 + b0, y1 = d1 * rstd * g1 + b1;
#pragma unroll
            for (int e = 0; e < 4; ++e) { y0[e] = silu_f(y0[e]); y1[e] = silu_f(y1[e]); }
            *(u32x4*)(MIX + (size_t)(t0 + row) * 1024 + 512 + lane * 8) = pack8(y0, y1); }
    }
    __syncthreads();
#undef CONV_PREFETCH
}

struct Args { const float* in[33]; float* out; unsigned char* ws; int ph_lo, ph_hi; };
constexpr int NPHASE = 28;

#define CONVJOB(Wp, K_, ldn_, cs_, nc_, WTp, mode_, roff_, gain_) { const int nblk_ = (nc_) / 128, cnt_ = ((K_) / 64) * nblk_; \
            if (r >= 0 && r < cnt_) { cp.W = (Wp); cp.WT = (bf16_t*)(WTp); cp.gain = (gain_); cp.K = (K_); cp.ldn = (ldn_); cp.cs = (cs_); cp.nblk = nblk_; cp.mode = (mode_); cp.roff = (roff_); cp.r = r; } r -= cnt_; }
#define CONVLOOKUP(cp, it_) { int r = (it_); \
            CONVJOB(ap->in[3], 1024, 2048, 0, 1024, ws + WS_WIN0, 0, 0, ap->in[2]); \
            CONVJOB(ap->in[3], 1024, 2048, 1024, 512, ws + WS_WIN0, 1, 1024, ap->in[2]); \
            CONVJOB(ap->in[3], 1024, 2048, 1536, 512, ws + WS_WIN0, 2, 1024, ap->in[2]); \
            CONVJOB(ap->in[10], 1024, 1024, 0, 1024, ws + WS_WOUT0, 0, 0, nullptr); \
            CONVJOB(ap->in[12], 1024, 512, 0, 512, ws + WS_WOIN, 0, 0, ap->in[11]); \
            CONVJOB(ap->in[21], 512, 2048, 0, 1024, ws + WS_WOOUT, 1, 0, nullptr); \
            CONVJOB(ap->in[21], 512, 2048, 1024, 1024, ws + WS_WOOUT, 2, 0, nullptr); \
            _Pragma("unroll") for (int l2 = 0; l2 < 2; ++l2) { \
                CONVJOB(ap->in[25] + (size_t)l2 * D * D, 1024, 1024, 0, 1024, ws + WS_WK + l2 * WSQ_L, 0, 0, ap->in[23] + l2 * D); \
                CONVJOB(ap->in[26] + (size_t)l2 * D * D, 1024, 1024, 0, 1024, ws + WS_WV + l2 * WSQ_L, 0, 0, ap->in[23] + l2 * D); \
                CONVJOB(ap->in[27] + (size_t)l2 * D * D, 1024, 1024, 0, 1024, ws + WS_WO + l2 * WSQ_L, 0, 0, nullptr); } \
            _Pragma("unroll") for (int l2 = 0; l2 < 2; ++l2) { \
                CONVJOB(ap->in[29] + (size_t)l2 * D * FH, 1024, FH, 0, FH, ws + WS_WGU + l2 * WGU_L, 1, 0, ap->in[28] + l2 * D); \
                CONVJOB(ap->in[30] + (size_t)l2 * D * FH, 1024, FH, 0, FH, ws + WS_WGU + l2 * WGU_L, 2, 0, ap->in[28] + l2 * D); \
                CONVJOB(ap->in[31] + (size_t)l2 * FH * D, FH, 1024, 0, 1024, ws + WS_WD + l2 * WD_L, 0, 0, nullptr); } }
constexpr int CONV_N_A = (512 + 256 + 256 + 512 + 256 + 256 + 256 + 2 * 3 * 512) / 4, CONV_N_B = CONV_N_A + 3 * 1408 / 4, CONV_N_C = CONV_N_B + 3 * 1408 / 4;
#define CONV_RANGE(lo_, hi_, wv_, nwv_) { LAS float* scr_ = (LAS float*)(lds + wave * 16384); \
        for (int it = (lo_) + (wv_); it < (hi_); it += (nwv_)) { ConvP c0{}; f32x4 v0[32]; { ConvP cp{}; CONVLOOKUP(cp, it); c0 = cp; } conv_load(c0, v0, lane); conv_store(c0, v0, scr_, lane); } }

typedef const __attribute__((address_space(4))) Args* KArgP;
__device__ __forceinline__ KArgP fresh_args() { KArgP p = (KArgP)__builtin_amdgcn_kernarg_segment_ptr(); asm volatile("" : "+s"(p)); return p; }

__global__ void __launch_bounds__(512, 2) trunk_fwd(Args args_unused) {
    extern __shared__ __attribute__((aligned(16))) unsigned char lds_raw[];
    LAS unsigned char* lds = (LAS unsigned char*)lds_raw;
    cg::grid_group grid = cg::this_grid();
    { volatile LAS unsigned* MISC0 = (volatile LAS unsigned*)(lds + MISC_OFF); if (threadIdx.x < 32) MISC0[threadIdx.x] = 0u; }
    __syncthreads();
    int lo, hi;
    { KArgP ap = fresh_args(); lo = ap->ph_lo; hi = ap->ph_hi; }
#if !MK_MULTI && !MK_CGSYNC
    { KArgP ap = fresh_args(); (void)xcd_barrier_post((unsigned*)(ap->ws + WS_BAR), (volatile LAS unsigned*)(lds + MISC_OFF) + 8); }
#endif
    int nsync = 0;
#if MK_MULTI
#define SEAM(k) do { } while (0)
#elif MK_CGSYNC
#define SEAM(k) do { if (rep_ + 1 == nrep_ && (k) + 1 < hi) grid.sync(); } while (0)
#else
#define SEAM(k) do { if (rep_ + 1 == nrep_ && (k) + 1 < hi) { if (hi > 1000) grid.sync(); else { KArgP ap_ = fresh_args(); XcdBarrier xb_; xb_.bar = (unsigned*)(ap_->ws + WS_BAR); xb_.x = xb_xcc_id(); xb_.st = (volatile LAS unsigned*)(lds + MISC_OFF) + 8; xcd_barrier(xb_); if (BARPROBE) xcd_barrier(xb_); } ++nsync; } } while (0)
#endif
#ifndef ONLY
#define ONLY -1
#endif
#ifndef REPMASK
#define REPMASK 0
#endif
#define PHASE(id, k) if ((ONLY < 0 || ONLY == (id)) && lo <= (k) && (k) < hi) for (int rep_ = 0, nrep_ = (((REPMASK) >> (id)) & 1) ? 2 : 1; rep_ < nrep_; ++rep_)
    (void)nsync;
#define LOCALS KArgP ap = fresh_args(); unsigned char* ws = ap->ws; float* out = ap->out; const float* x_in = ap->in[0]; \
    int tid_ = threadIdx.x, G_ = gridDim.x, bx_ = blockIdx.x; asm volatile("" : "+v"(tid_), "+s"(G_), "+s"(bx_)); \
    const int tid = tid_, lane = tid & 63, wave = __builtin_amdgcn_readfirstlane(tid >> 6), G = G_, bx = bx_, gw = bx * 8 + wave, NGW = G * 8; \
    bf16_t* XB = (bf16_t*)(ws + WS_XB); u64* SS = (u64*)(ws + WS_SS); u64* VST = (u64*)(ws + WS_VST); bf16_t* QO = (bf16_t*)(ws + WS_QO); \
    bf16_t* HM = (bf16_t*)(ws + WS_HM); bf16_t* MEMN = (bf16_t*)(ws + WS_MEMN); bf16_t* KL = (bf16_t*)(ws + WS_KL); bf16_t* VL = (bf16_t*)(ws + WS_VL); \
    bf16_t* U = (bf16_t*)(ws + WS_U); bf16_t* V = (bf16_t*)(ws + WS_V); bf16_t* H = (bf16_t*)(ws + WS_H); bf16_t* MIX = (bf16_t*)(ws + WS_MIX); \
    bf16_t* AC = (bf16_t*)(ws + WS_ACOMB); float* XL = (float*)(ws + WS_XLOC); bf16_t* Y = (bf16_t*)(ws + WS_Y); u64* SSa = SS + (size_t)(3 * l) * T; \
    (void)out; (void)x_in; (void)lane; (void)gw; (void)NGW; (void)XB; (void)VST; (void)QO; (void)HM; (void)MEMN; (void)KL; (void)VL; (void)U; (void)V; (void)H; (void)MIX; (void)AC; (void)XL; (void)Y; (void)SSa; (void)wave;

    PHASE(0, 0) { const int l = 0; LOCALS
        { f32x4* z = (f32x4*)(SS + T); const int n4 = 7 * T * 2 / 4; for (int i = bx * 512 + tid; i < n4; i += G * 512) z[i] = (f32x4){0.f, 0.f, 0.f, 0.f};
          f32x4* z2 = (f32x4*)VST; const int m4 = 2 * T * 2 / 4; for (int i = bx * 512 + tid; i < m4; i += G * 512) z2[i] = (f32x4){0.f, 0.f, 0.f, 0.f}; }
        CONV_RANGE(0, CONV_N_A, gw, NGW);
        { const int nb5 = (G > 64) ? G - 32 : G;
          if (bx < nb5) { const int NW5 = nb5 * 8;
              for (int m = gw * 4; m < T; m += NW5 * 4) rows_to_bf16<false, 4>(x_in + (size_t)m * D, XB + (size_t)m * D, SS + m, lane);
              for (int m = gw * 4; m < MT; m += NW5 * 4) rows_to_bf16<true, 4>(ap->in[1] + (size_t)m * D, MEMN + (size_t)m * D, nullptr, lane); } }
        for (int i = bx * 512 + tid; i < 2 * D * D / 8; i += G * 512) { const int l2 = i / (D * D / 8), e = (i % (D * D / 8)) * 8, k = e >> 10; const float gk = ap->in[22][l2 * D + k];
            const f32x4 a = *(const f32x4*)(ap->in[24] + (size_t)l2 * D * D + e), b = *(const f32x4*)(ap->in[24] + (size_t)l2 * D * D + e + 4);
            *(u32x4*)((bf16_t*)(ws + WS_WQ) + (size_t)l2 * D * D + e) = pack8(a * gk, b * gk); }
        { bf16_t* GW = (bf16_t*)(ws + WS_GW); const float* w = ap->in[4];
          for (int i = bx * 512 + tid; i < 4 * 128 * 128 / 2; i += G * 512) { const int e = 2 * i, ii = (e >> 7) & 127, jj = e & 127; const bool keep = (jj >> 6) <= (ii >> 6);
              ((unsigned*)GW)[i] = keep ? cvt_pk_bf16(w[e], w[e + 1]) : 0u; } }
        __syncthreads();
        for (int g = G - 1 - bx; g < 32; g += G)
            s5_setup(g, lds, ap->in[13], ap->in[14], ap->in[15], ap->in[16], ap->in[17], ap->in[18], ap->in[19], (bf16_t*)(ws + WS_BT3), (bf16_t*)(ws + WS_GM), (float*)(ws + WS_AL), tid);
        SEAM(0);
    }
#pragma unroll 1
    for (int l = 0; l < 2; ++l) {
        const int pb = 3 + 12 * l;
        if (l == 0) {
            PHASE(2, pb + 0) { LOCALS
                pg8::Gemm g{XB, (const bf16_t*)(ws + WS_WIN0), D, D, D, 1, 0, 0, 0, 0}; pg8::Sched S; S.init(T / 256, 2048 / 256, 1, G, bx);
                { pg8::EpiIn0 E{SSa, U, V, H, VST}; pg8::gemm_phase<MK_ALIGN>(lds, g, S, E, tid); }
                { pg8::Gemm g{MEMN, (const bf16_t*)(ws + WS_WK), D, D, D, 2, 0, 0, (long)D * D, 0}; pg8::Sched S; S.init(MT / 256, D / 256, 2, G, bx);
                  pg8::EpiStore E{KL, D, 2, (long)MT * D, 0, nullptr, 1.0f}; pg8::gemm_phase<MK_ALIGN>(lds, g, S, E, tid); }
                { pg8::Gemm g{MEMN, (const bf16_t*)(ws + WS_WV), D, D, D, 2, 0, 0, (long)D * D, 0}; pg8::Sched S; S.init(MT / 256, D / 256, 2, G, (bx + G / 2) % G);
                  pg8::EpiStore E{VL, D, 2, (long)MT * D, 0, nullptr, 1.0f}; pg8::gemm_phase<MK_ALIGN>(lds, g, S, E, tid); }
                if ((G & 3) == 0) { const int hG = G / 2, qG = G / 4; if ((bx % hG) >= qG) { const int ii = (bx / hG) * qG + (bx % hG) - qG; CONV_RANGE(CONV_N_A, CONV_N_B, ii * 8 + wave, hG * 8); } }
                else CONV_RANGE(CONV_N_A, CONV_N_B, gw, NGW);
                SEAM(pb + 0);
            }
            PHASE(3, pb + 1) { LOCALS
                for (int i = bx; i < 1024; i += G) gmlp_unit(i, lds, U, V, VST, (const bf16_t*)(ws + WS_GW), ap->in[5], MIX, tid);
                conv_units(bx, G, 1024, lds, H, ap->in[6], ap->in[7], ap->in[8], ap->in[9], MIX, tid);
#pragma unroll 1
                for (int l2 = 0; l2 < 2; ++l2) {
                    { pg8::Gemm g{KL + (size_t)l2 * MT * D, (const bf16_t*)(ws + WS_WQ) + (size_t)l2 * D * D, D, D, 256, 4, 256, 256L * D, 256, 0}; pg8::Sched S; S.init(1, 4, 32, G, bx);
                      pg8::EpiStore E{(bf16_t*)(ws + WS_WQK) + (size_t)l2 * 8 * D * D, D, 4, 256L * D, (long)D * D, nullptr, 1.0f}; pg8::gemm_phase<MK_ALIGN>(lds, g, S, E, tid); }
                    { pg8::Gemm g{(const bf16_t*)(ws + WS_WO) + (size_t)l2 * D * D, VL + (size_t)l2 * MT * D, D, D, 256, 4, 256, 0, 256, 256L * D}; pg8::Sched S; S.init(4, 1, 32, G, (bx + G / 2) % G);
                      pg8::EpiStore E{(bf16_t*)(ws + WS_WVO) + (size_t)l2 * 8 * D * D, D, 4, 256, (long)D * D, nullptr, 1.0f}; pg8::gemm_phase<MK_ALIGN>(lds, g, S, E, tid); }
                }
                SEAM(pb + 1);
            }
            PHASE(4, pb + 2) { LOCALS
                pg8::Gemm g{MIX, (const bf16_t*)(ws + WS_WOUT0), D, D, D, 1, 0, 0, 0, 0}; pg8::Sched S; S.init(T / 256, D / 256, 1, G, bx);
                pg8::EpiRes<false> E{XB, SSa + T, 0}; pg8::gemm_phase<MK_ALIGN>(lds, g, S, E, tid);
                SEAM(pb + 2);
            }
        } else {
            PHASE(5, pb + 0) { LOCALS
                pg8::Gemm g{XB, (const bf16_t*)(ws + WS_WOIN), D, D, D, 1, 0, 0, 0, 0}; pg8::Sched S; S.init(T / 256, 512 / 256, 1, G, bx);
                pg8::EpiOin E{SSa, AC}; pg8::gemm_phase<MK_ALIGN>(lds, g, S, E, tid);
                SEAM(pb + 0);
            }
            PHASE(6, pb + 1) { LOCALS
                pg8::Gemm g{AC, (const bf16_t*)(ws + WS_GM), AK, 512, 512, 32, (long)NCH * AK, 0, 256L * 512, 0}; pg8::Sched S; S.init(NCH / 256, 1, 32, G, bx);
                pg8::EpiS5State E{XL}; pg8::gemm_phase<MK_ALIGN>(lds, g, S, E, tid);
                if (G > 128) { if (bx >= 128) CONV_RANGE(CONV_N_B, CONV_N_C, (bx - 128) * 8 + wave, (G - 128) * 8); }
                else CONV_RANGE(CONV_N_B, CONV_N_C, gw, NGW);
                SEAM(pb + 1);
            }
            PHASE(7, pb + 2) { LOCALS
                if (wave == 0) {
#pragma unroll 1
                    for (int idx = bx * 64 + lane; idx < NB * 32 * 64; idx += G * 64) { const int p = idx & 63, g = (idx >> 6) & 31, b = idx >> 11;
                        const float* AL = (const float*)(ws + WS_AL); const float ar = AL[(g * 64 + p) * 2], ai = AL[(g * 64 + p) * 2 + 1];
                        const float* xl = XL + (size_t)g * NCH * 128 + (size_t)(b * (SEQ / SL)) * 128; bf16_t* ac = AC + (size_t)g * NCH * AK + (size_t)(b * (SEQ / SL)) * AK + 512;
                        float xr = 0.f, xi = 0.f;
#pragma unroll 1
                        for (int c0 = 0; c0 < SEQ / SL; c0 += 32) { float lr[32], li[32];
#pragma unroll
                            for (int i = 0; i < 32; ++i) { lr[i] = xl[(size_t)(c0 + i) * 128 + p]; li[i] = xl[(size_t)(c0 + i) * 128 + 64 + p]; }
#pragma unroll
                            for (int i = 0; i < 32; ++i) { const unsigned pk = cvt_pk_bf16(xr, xi); ac[(size_t)(c0 + i) * AK + p] = (bf16_t)(pk & 0xffffu); ac[(size_t)(c0 + i) * AK + 64 + p] = (bf16_t)(pk >> 16);
                                const float nr = ar * xr - ai * xi + lr[i], ni = ar * xi + ai * xr + li[i]; xr = nr; xi = ni; } }
                    }
                }
                SEAM(pb + 2);
            }
            PHASE(8, pb + 3) { LOCALS
                pg8::Gemm g{AC, (const bf16_t*)(ws + WS_BT3), AK, AK, AK, 32, (long)NCH * AK, 0, 512L * AK, 0}; pg8::Sched S; S.init(NCH / 256, 2, 32, G, bx);
                pg8::EpiS5Out E{AC, ap->in[20], Y}; pg8::gemm_phase<MK_ALIGN>(lds, g, S, E, tid);
                SEAM(pb + 3);
            }
            PHASE(9, pb + 4) { LOCALS
                pg8::Gemm g{Y, (const bf16_t*)(ws + WS_WOOUT), 512, 512, 512, 1, 0, 0, 0, 0}; pg8::Sched S; S.init(T / 256, 2048 / 256, 1, G, bx);
                pg8::EpiRes<true> E{XB, SSa + T, 0}; pg8::gemm_phase<MK_ALIGN>(lds, g, S, E, tid);
                SEAM(pb + 4);
            }
        }
        PHASE(10, pb + 5) { LOCALS
            pg8::Gemm g{XB, (const bf16_t*)(ws + WS_WQK) + (size_t)l * 8 * D * D, D, D, D, 8, (long)SEQ * D, 0, (long)D * D, 0}; pg8::Sched S; S.init(SEQ / 256, D / 256, 8, G, bx);
            pg8::EpiSoftmax E{QO, SSa + T}; pg8::gemm_phase<true>(lds, g, S, E, tid);
            SEAM(pb + 5);
        }
        PHASE(13, pb + 6) { LOCALS
            pg8::Gemm g{QO, (const bf16_t*)(ws + WS_WVO) + (size_t)l * 8 * D * D, D, D, D, 8, (long)SEQ * D, 0, (long)D * D, 0}; pg8::Sched S; S.init(SEQ / 256, D / 256, 8, G, bx);
            pg8::EpiRes<false> E{XB, SSa + 2 * T, SEQ}; pg8::gemm_phase<MK_ALIGN>(lds, g, S, E, tid);
            SEAM(pb + 6);
        }
        PHASE(14, pb + 9) { LOCALS
            pg8::Gemm g{XB, (const bf16_t*)(ws + WS_WGU + l * WGU_L), D, D, D, 1, 0, 0, 0, 0}; pg8::Sched S; S.init(T / 256, 2 * FH / 256, 1, G, bx);
            pg8::EpiFfn1 E{SSa + 2 * T, HM}; pg8::gemm_phase<MK_ALIGN>(lds, g, S, E, tid);
            SEAM(pb + 9);
        }
        PHASE(15, pb + 10) { LOCALS
            pg8::Gemm g{HM, (const bf16_t*)(ws + WS_WD + l * WD_L), FH, FH, FH, 1, 0, 0, 0, 0}; pg8::Sched S; S.init(T / 256, D / 256, 1, G, bx);
            if (l == 1 && G == 256 && !MK_MULTI) { pg8::EpiResFinal E{XB, SSa + 3 * T, (unsigned*)(ws + WS_PCNT), ap->in[32], out}; pg8::gemm_phase<true>(lds, g, S, E, tid); }
            else { pg8::EpiRes<false> E{XB, SSa + 3 * T, 0}; pg8::gemm_phase<MK_ALIGN>(lds, g, S, E, tid); SEAM(pb + 10); }
        }
    }
    PHASE(16, 27) { const int l = 0; LOCALS
        if (G != 256 || MK_MULTI) {
        const u64* ssf = SS + (size_t)6 * T; const float* gf = ap->in[32];
        const f32x4 ga = *(const f32x4*)(gf + 8 * lane), gb = *(const f32x4*)(gf + 8 * lane + 4), gc = *(const f32x4*)(gf + 512 + 8 * lane), gd = *(const f32x4*)(gf + 512 + 8 * lane + 4);
        for (int m = gw * 4; m < T; m += NGW * 4) { u32x4 v[4][2]; float rs[4];
#pragma unroll
            for (int r = 0; r < 4; ++r) { rs[r] = rsqrtf(fx_get(ssf + m + r) * (1.0f / D) + EPS); const bf16_t* xr = XB + (size_t)(m + r) * D + 8 * lane; v[r][0] = *(const u32x4*)xr; v[r][1] = *(const u32x4*)(xr + 512); }
#pragma unroll
            for (int r = 0; r < 4; ++r) { float* orow = out + (size_t)(m + r) * D + 8 * lane; f32x4 a0, a1, b0, b1; pg8::unpack8(v[r][0], a0, a1); pg8::unpack8(v[r][1], b0, b1);
                *(f32x4*)orow = a0 * rs[r] * ga; *(f32x4*)(orow + 4) = a1 * rs[r] * gb; *(f32x4*)(orow + 512) = b0 * rs[r] * gc; *(f32x4*)(orow + 516) = b1 * rs[r] * gd; } }
        }
    }
}

extern "C" void kernel_launch(void* const* d_in, const int* in_sizes, int n_in, void* d_out, int out_size, void* d_ws, size_t ws_size, hipStream_t stream) {
    static int grid = 0;
    if (grid == 0) {
        if (n_in != 33 || in_sizes[0] != T * D || out_size != T * D || ws_size < WS_END) { fprintf(stderr, "kernel_launch: unexpected shapes (n_in %d, in0 %d, out %d, ws %zu < %zu)\n", n_in, n_in > 0 ? in_sizes[0] : -1, out_size, ws_size, (size_t)WS_END); grid = -1; return; }
        int dev = 0, cus = 0, per_cu = 0;
        hipGetDevice(&dev); hipDeviceGetAttribute(&cus, hipDeviceAttributeMultiprocessorCount, dev);
        if (hipFuncSetAttribute((const void*)trunk_fwd, hipFuncAttributeMaxDynamicSharedMemorySize, LDS_BYTES) != hipSuccess) { fprintf(stderr, "kernel_launch: hipFuncSetAttribute failed\n"); grid = -1; return; }
        if (hipOccupancyMaxActiveBlocksPerMultiprocessor(&per_cu, (const void*)trunk_fwd, 512, LDS_BYTES) != hipSuccess || per_cu < 1) { fprintf(stderr, "kernel_launch: occupancy query says %d\n", per_cu); per_cu = 1; }
        (void)hipGetLastError();
        grid = cus * 1;
        if (grid <= 0) grid = 256;
    }
    if (grid < 0) return;
    Args a{};
    for (int i = 0; i < 33; ++i) a.in[i] = (const float*)d_in[i];
    a.out = (float*)d_out; a.ws = (unsigned char*)d_ws;
#if !MK_MULTI && !MK_CGSYNC
    (void)hipMemsetAsync((char*)d_ws + WS_BAR, 0, 16384 + 128 * 256, stream);
#endif
#if MK_MULTI
    for (int p = 0; p < NPHASE; ++p) {
        if (p == 1 || p == 2 || p == 6 || p == 7 || p == 10 || p == 11 || p == 14 || p == 22 || p == 23 || p == 26) continue;
        a.ph_lo = p; a.ph_hi = p + 1; void* kargs[] = {&a};
        hipError_t e = hipLaunchCooperativeKernel((const void*)trunk_fwd, dim3(grid), dim3(512), kargs, LDS_BYTES, stream);
        if (e != hipSuccess) { fprintf(stderr, "kernel_launch: launch of phase %d failed: %s\n", p, hipGetErrorString(e)); break; }
    }
#else
    a.ph_lo = 0; a.ph_hi = NPHASE; void* kargs[] = {&a};
    hipError_t e = hipLaunchCooperativeKernel((const void*)trunk_fwd, dim3(grid), dim3(512), kargs, LDS_BYTES, stream);
    if (e != hipSuccess) fprintf(stderr, "kernel_launch: cooperative launch failed: %s (grid %d)\n", hipGetErrorString(e), grid);
#endif
}
```

```cpp
#include <hip/hip_runtime.h>
#include <hip/hip_cooperative_groups.h>
#include <cstdio>
#include <cstdint>
namespace cg = cooperative_groups;

#ifndef MK_MULTI
#define MK_MULTI 0
#endif
#ifndef MK_ALIGN
#define MK_ALIGN true
#endif
#ifndef BARPROBE
#define BARPROBE 0
#endif
#ifndef MK_CGSYNC
#define MK_CGSYNC 0
#endif

#define LAS __attribute__((address_space(3)))
typedef unsigned short bf16_t;
typedef short bf16x8 __attribute__((ext_vector_type(8)));
typedef float f32x4 __attribute__((ext_vector_type(4)));
typedef float f32x2 __attribute__((ext_vector_type(2)));
typedef unsigned u32x4 __attribute__((ext_vector_type(4)));
typedef unsigned u32x2 __attribute__((ext_vector_type(2)));

constexpr int T = 32768, D = 1024, SEQ = 4096, NB = 8, MT = 2048, FH = 2816;
constexpr float EPS = 1e-6f;
constexpr int SL = 32;
constexpr int NCH = T / SL;
constexpr int AK = SL * 16 + 128;

constexpr size_t MiB = 1u << 20;
constexpr size_t WS_WIN0 = 0, WS_WOUT0 = 4 * MiB, WS_WOIN = 6 * MiB, WS_WOOUT = 7 * MiB, WS_WQ = 9 * MiB, WS_WK = 13 * MiB, WS_WV = 17 * MiB, WS_WO = 21 * MiB;
constexpr size_t WS_WGU = 25 * MiB, WS_WD = 47 * MiB, WS_GW = 58 * MiB, WS_AL = 59 * MiB, WS_BT3 = 60 * MiB, WS_GM = 80 * MiB, WS_MEMN = 88 * MiB, WS_KL = 92 * MiB, WS_VL = 100 * MiB;
constexpr size_t WS_XB = 110 * MiB, WS_QO = 174 * MiB, WS_P = 238 * MiB, WS_R0 = 302 * MiB;
constexpr size_t WS_WQK = WS_P, WS_WVO = WS_P + 32 * MiB;
constexpr size_t WS_HM = WS_R0, WS_U = WS_R0, WS_V = WS_R0 + 32 * MiB, WS_H = WS_R0 + 64 * MiB, WS_MIX = WS_R0 + 96 * MiB;
constexpr size_t WS_ACOMB = WS_R0, WS_XLOC = WS_R0 + 40 * MiB, WS_Y = WS_R0 + 56 * MiB;
constexpr size_t WS_SS = WS_R0 + 176 * MiB, WS_VST = WS_SS + 2 * MiB, WS_BAR = WS_VST + 1 * MiB, WS_PCNT = WS_BAR + 16384  , WS_END = WS_BAR + 1 * MiB;
constexpr size_t WGU_L = (size_t)2 * FH * D * 2, WD_L = (size_t)D * FH * 2, WSQ_L = (size_t)D * D * 2;

constexpr int RING_BYTES = 131072, XCH_OFF = RING_BYTES, MISC_OFF = RING_BYTES + 8192, LDS_BYTES = 147456;

__device__ __forceinline__ unsigned cvt_pk_bf16(float lo, float hi) { unsigned r; asm volatile("v_cvt_pk_bf16_f32 %0, %1, %2" : "=v"(r) : "v"(lo), "v"(hi)); return r; }
__device__ __forceinline__ float bf2f(unsigned short b) { return __builtin_bit_cast(float, (unsigned)b << 16); }
__device__ __forceinline__ float bflo(unsigned w) { return __builtin_bit_cast(float, w << 16); }
__device__ __forceinline__ float bfhi(unsigned w) { return __builtin_bit_cast(float, w & 0xffff0000u); }
__device__ __forceinline__ float sigmoid_f(float x) { return __builtin_amdgcn_rcpf(1.0f + __expf(-x)); }
__device__ __forceinline__ float silu_f(float x) { return x * sigmoid_f(x); }
__device__ __forceinline__ float gelu_f(float x) { return x * sigmoid_f(1.5957691216f * (x + 0.044715f * x * x * x)); }
typedef unsigned long long u64;
__device__ __forceinline__ void fx_add(u64* p, float q) { atomicAdd(p, (u64)(long long)(q * 16777216.0f)); }
__device__ __forceinline__ float fx_get(const u64* p) { return (float)(long long)(*p) * (1.0f / 16777216.0f); }
__device__ __forceinline__ float wave_sum(float v) {
#pragma unroll
    for (int o = 1; o < 64; o <<= 1) v += __shfl_xor(v, o);
    return v;
}
__device__ __forceinline__ u32x4 pack8(f32x4 a, f32x4 b) { u32x4 w; w.x = cvt_pk_bf16(a[0], a[1]); w.y = cvt_pk_bf16(a[2], a[3]); w.z = cvt_pk_bf16(b[0], b[1]); w.w = cvt_pk_bf16(b[2], b[3]); return w; }

namespace pg8 {
constexpr int BM = 256, BK = 64, HALF = 128, HTB = HALF * BK * 2, NXCD = 8, WGM = 4;
__device__ __forceinline__ int lds_byte(int r, int c) { const int st = (r >> 4) * 2 + (c >> 5), rr = r & 15, cc = c & 31, ob = rr * 64 + cc * 2; return st * 1024 + (ob ^ (((ob >> 9) & 1) << 5)); }
__device__ __forceinline__ void stage_rc(int b, int& R, int& C) { const int st = b / 1024, sb = b % 1024, swz = sb ^ (((sb >> 9) & 1) << 5); R = (st >> 1) * 16 + swz / 64; C = (st & 1) * 32 + (swz % 64) / 2; }
__device__ __forceinline__ int perm32(int rho) { const int n = rho >> 4, i = rho & 15; return 8 * (i >> 2) + 4 * n + (i & 3); }

struct Unit { int pm, pn, z; };
struct Gemm { const bf16_t* A; const bf16_t* Bt; int lda, ldb, K, nz0; long sAz0, sAz1, sBz0, sBz1; };
struct Sched {
    int nM, nN, per, total, G, c;
    __device__ __forceinline__ void init(int nM_, int nN_, int nz, int G_, int c_) { nM = nM_; nN = nN_; per = nM_ * nN_; total = per * nz; G = G_; c = c_; }
    __device__ __forceinline__ bool next(int i, Unit& u) const {
        const long L = (long)i * G + c; if (L >= total) return false;
        const int z = (int)(L / per); int wgid = (int)(L % per);
        { const int q = per / NXCD, r = per % NXCD, xcd = wgid % NXCD, off = wgid / NXCD; wgid = (xcd < r ? xcd * (q + 1) : r * (q + 1) + (xcd - r) * q) + off; }
        const int nig = WGM * nN, gid = wgid / nig, fm = gid * WGM, gsz = (nM - fm) < WGM ? (nM - fm) : WGM;
        u.pm = fm + ((wgid % nig) % gsz); u.pn = (wgid % nig) / gsz; u.z = z; return true;
    }
};

template <bool ALIGN, class Epi>
__device__ __forceinline__ void gemm_phase(LAS unsigned char* lds, const Gemm g, const Sched& S, const Epi& E, const int tid) {
    const int wid = __builtin_amdgcn_readfirstlane(tid >> 6), lane = tid & 63, wr = wid >> 2, wc = wid & 3, fr = lane & 15, fq = lane >> 4;
    const int nt = g.K / BK;
    unsigned voffA[2], voffB[2];
#pragma unroll
    for (int i = 0; i < 2; ++i) { int R, C; stage_rc(tid * 16 + i * 8192, R, C); const int Rb = (R & ~31) + perm32(R & 31);
        voffA[i] = (unsigned)(R * g.lda + C) * 2u; voffB[i] = (unsigned)(Rb * g.ldb + C) * 2u; }
    const size_t kstep = (size_t)(BK * 2);
    const size_t hsA = (size_t)HALF * g.lda * 2, hsB = (size_t)HALF * g.ldb * 2;
    const unsigned ldsw = (unsigned)wid * 1024u;
    const int aoff = lds_byte(wr * 64 + fr, fq * 8), boff = lds_byte(wc * 32 + fr, fq * 8);
#define PG8_SA(b, h) (((b) * 2 + (h)) * HTB)
#define PG8_SB(b, h) ((4 + (b) * 2 + (h)) * HTB)
#define PG8_STAGE(bufoff, gbase, voff) do { _Pragma("unroll") for (int _i = 0; _i < 2; ++_i) \
        __builtin_amdgcn_global_load_lds((const unsigned*)((const char*)(gbase) + (voff)[_i]), (LAS unsigned*)(lds + (bufoff) + ldsw + _i * 8192), 16, 0, 0); } while (0)
#define PG8_LDA(dst, b, h) do { _Pragma("unroll") for (int m = 0; m < 4; ++m) _Pragma("unroll") for (int k = 0; k < 2; ++k) dst[m][k] = *(const LAS bf16x8*)(lds + PG8_SA(b, h) + aoff + m * 2048 + k * 1024); } while (0)
#define PG8_LDB(dst, b, h) do { _Pragma("unroll") for (int n = 0; n < 2; ++n) _Pragma("unroll") for (int k = 0; k < 2; ++k) dst[n][k] = *(const LAS bf16x8*)(lds + PG8_SB(b, h) + boff + n * 2048 + k * 1024); } while (0)
#define PG8_MMA(ai, bj, At, Bt) do { __builtin_amdgcn_s_setprio(1); _Pragma("unroll") for (int m = 0; m < 4; ++m) _Pragma("unroll") for (int n = 0; n < 2; ++n) _Pragma("unroll") for (int k = 0; k < 2; ++k) \
        acc[ai][bj][m][n] = __builtin_amdgcn_mfma_f32_16x16x32_bf16(Bt[n][k], At[m][k], acc[ai][bj][m][n], 0, 0, 0); __builtin_amdgcn_s_setprio(0); } while (0)
#define PG8_WAIT_V(n) asm volatile("s_waitcnt vmcnt(" #n ")" ::: "memory")
#define PG8_WAIT_L(n) asm volatile("s_waitcnt lgkmcnt(" #n ")" ::: "memory")
#define PG8_BAR __builtin_amdgcn_s_barrier()
#define PG8_SCHED __builtin_amdgcn_sched_barrier(0)
#define PG8_UA(u) ((const char*)g.A + 2 * ((size_t)((u).z % g.nz0) * g.sAz0 + (size_t)((u).z / g.nz0) * g.sAz1 + (size_t)(u).pm * BM * g.lda))
#define PG8_UB(u) ((const char*)g.Bt + 2 * ((size_t)((u).z % g.nz0) * g.sBz0 + (size_t)((u).z / g.nz0) * g.sBz1 + (size_t)(u).pn * BM * g.ldb))
    Unit cur, nxt; int ui = 0;
    if (!S.next(0, cur)) return;
    f32x4 acc[2][2][4][2];
#pragma unroll
    for (int a = 0; a < 2; ++a)
#pragma unroll
        for (int b = 0; b < 2; ++b)
#pragma unroll
            for (int m = 0; m < 4; ++m)
#pragma unroll
                for (int n = 0; n < 2; ++n) acc[a][b][m][n] = (f32x4){0.f, 0.f, 0.f, 0.f};
    bf16x8 At[4][2], B0[2][2], B1[2][2];
    const char* cA = PG8_UA(cur); const char* cB = PG8_UB(cur);
    PG8_STAGE(PG8_SB(0, 0), cB, voffB); PG8_STAGE(PG8_SB(0, 1), cB + hsB, voffB); PG8_STAGE(PG8_SA(0, 0), cA, voffA); PG8_STAGE(PG8_SA(0, 1), cA + hsA, voffA);
    if (wr == 1) PG8_BAR;
    PG8_WAIT_V(2); PG8_BAR;
    PG8_STAGE(PG8_SB(1, 0), cB + kstep, voffB); PG8_STAGE(PG8_SA(1, 0), cA + kstep, voffA); PG8_STAGE(PG8_SB(1, 1), cB + hsB + kstep, voffB);
    PG8_WAIT_V(6); PG8_BAR;
    for (;;) {
        const bool has_next = S.next(ui + 1, nxt);
        const char* nA = has_next ? PG8_UA(nxt) : cA; const char* nB = has_next ? PG8_UB(nxt) : cB;
        for (int t = 0; t < nt; t += 2) {
            const bool last = (t == nt - 2);
            const char* a1 = cA + (size_t)(t + 1) * kstep;
            const char* a2 = last ? nA : cA + (size_t)(t + 2) * kstep; const char* b2 = last ? nB : cB + (size_t)(t + 2) * kstep;
            const char* a3 = a2 + kstep; const char* b3 = b2 + kstep;
            PG8_LDB(B0, 0, 0); PG8_LDB(B1, 0, 1); PG8_SCHED; PG8_LDA(At, 0, 0); PG8_STAGE(PG8_SA(1, 1), a1 + hsA, voffA);
            PG8_WAIT_V(8); PG8_WAIT_L(0); PG8_BAR; PG8_MMA(0, 0, At, B0); PG8_MMA(0, 1, At, B1); PG8_BAR; PG8_SCHED;
            PG8_LDA(At, 0, 1); PG8_STAGE(PG8_SB(0, 0), b2, voffB); PG8_STAGE(PG8_SB(0, 1), b2 + hsB, voffB); PG8_STAGE(PG8_SA(0, 0), a2, voffA);
            PG8_WAIT_V(8); PG8_WAIT_L(0); PG8_BAR; PG8_MMA(1, 0, At, B0); PG8_MMA(1, 1, At, B1); PG8_BAR; PG8_SCHED;
            PG8_LDB(B0, 1, 0); PG8_LDB(B1, 1, 1); PG8_SCHED; PG8_LDA(At, 1, 0); PG8_STAGE(PG8_SA(0, 1), a2 + hsA, voffA);
            PG8_WAIT_V(8); PG8_WAIT_L(0); PG8_BAR; PG8_MMA(0, 0, At, B0); PG8_MMA(0, 1, At, B1); PG8_BAR; PG8_SCHED;
            PG8_LDA(At, 1, 1); PG8_STAGE(PG8_SB(1, 0), b3, voffB); PG8_STAGE(PG8_SB(1, 1), b3 + hsB, voffB); PG8_STAGE(PG8_SA(1, 0), a3, voffA);
            PG8_WAIT_V(8); PG8_WAIT_L(0); PG8_BAR; PG8_MMA(1, 0, At, B0); PG8_MMA(1, 1, At, B1); PG8_BAR; PG8_SCHED;
        }
        if (ALIGN) { if (wr == 0) PG8_BAR; }
        E(acc, cur, wr, wc, fr, fq, lds);
        if (!has_next) break;
#pragma unroll
        for (int a = 0; a < 2; ++a)
#pragma unroll
            for (int b = 0; b < 2; ++b)
#pragma unroll
                for (int m = 0; m < 4; ++m)
#pragma unroll
                    for (int n = 0; n < 2; ++n) acc[a][b][m][n] = (f32x4){0.f, 0.f, 0.f, 0.f};
        cur = nxt; cA = nA; cB = nB; ++ui;
        if (ALIGN) { if (wr == 1) PG8_BAR; }
    }
    PG8_WAIT_V(0);
    if (!ALIGN) { if (wr == 0) PG8_BAR; }
    PG8_BAR;
#undef PG8_SA
#undef PG8_SB
#undef PG8_STAGE
#undef PG8_LDA
#undef PG8_LDB
#undef PG8_MMA
#undef PG8_UA
#undef PG8_UB
}

typedef f32x4 Acc[2][2][4][2];
#define EPI_ARGS Acc& acc, const Unit& u, int wr, int wc, int fr, int fq, LAS unsigned char* lds
__device__ __forceinline__ int efence() { asm volatile("" ::: "memory"); return 1; }
#define ROWLOOP _Pragma("unroll") for (int ai = 0; ai < 2; ++ai) _Pragma("unroll") for (int m = 0; m < 4; ++m) for (int once_ = efence(); once_; once_ = 0)

#define LOAD_RS8(rs, ssp, row0) float rs[2][4]; { u64 raw_[2][4]; _Pragma("unroll") for (int ai = 0; ai < 2; ++ai) _Pragma("unroll") for (int m = 0; m < 4; ++m) raw_[ai][m] = (ssp)[(row0) + ai * 128 + m * 16]; \
    _Pragma("unroll") for (int ai = 0; ai < 2; ++ai) _Pragma("unroll") for (int m = 0; m < 4; ++m) rs[ai][m] = rsqrtf((float)(long long)raw_[ai][m] * (1.0f / 16777216.0f) * (1.0f / D) + EPS); }
struct EpiIn0 {
    const u64* ss; bf16_t* U; bf16_t* V; bf16_t* H; u64* vst;
    __device__ __forceinline__ void operator()(EPI_ARGS) const {
        const int row0 = u.pm * 256 + wr * 64 + fr;
        LOAD_RS8(rs8, ss, row0);
        if (u.pn < 4) {
            bf16_t* dst = (u.pn < 2) ? U : V; const int col0 = (u.pn & 1) * 256 + wc * 32 + 8 * fq; const bool st = u.pn >= 2;
            ROWLOOP { const int row = row0 + ai * 128 + m * 16; const float rs = rs8[ai][m]; float s = 0.f, q = 0.f;
#pragma unroll
                for (int bj = 0; bj < 2; ++bj) { f32x4 v0 = acc[ai][bj][m][0] * rs, v1 = acc[ai][bj][m][1] * rs;
#pragma unroll
                    for (int e = 0; e < 4; ++e) { v0[e] = gelu_f(v0[e]); v1[e] = gelu_f(v1[e]); s += v0[e] + v1[e]; q += v0[e] * v0[e] + v1[e] * v1[e]; }
                    *(u32x4*)(dst + (size_t)row * 512 + col0 + bj * 128) = pack8(v0, v1); }
                if (st) { s += __shfl_xor(s, 16); s += __shfl_xor(s, 32); q += __shfl_xor(q, 16); q += __shfl_xor(q, 32);
                    if (fq == 0) { fx_add(vst + 2 * row, s); fx_add(vst + 2 * row + 1, q); } }
            }
        } else {
            const int col0 = (u.pn - 4) * 128 + wc * 32 + 8 * fq;
            ROWLOOP { const int row = row0 + ai * 128 + m * 16; const float rs = rs8[ai][m]; f32x4 h0, h1;
#pragma unroll
                for (int e = 0; e < 4; ++e) { h0[e] = acc[ai][0][m][0][e] * rs * sigmoid_f(acc[ai][1][m][0][e] * rs); h1[e] = acc[ai][0][m][1][e] * rs * sigmoid_f(acc[ai][1][m][1][e] * rs); }
                *(u32x4*)(H + (size_t)row * 512 + col0) = pack8(h0, h1); }
        }
    }
};
__device__ __forceinline__ void unpack8(u32x4 b, f32x4& o0, f32x4& o1) { o0 = (f32x4){bflo(b.x), bfhi(b.x), bflo(b.y), bfhi(b.y)}; o1 = (f32x4){bflo(b.z), bfhi(b.z), bflo(b.w), bfhi(b.w)}; }
template <bool GLU> struct EpiRes {
    bf16_t* xb; u64* ss; int zrows;
    __device__ __forceinline__ void operator()(EPI_ARGS) const {
        const int row0 = u.z * zrows + u.pm * 256 + wr * 64 + fr;
#pragma unroll
        for (int ai = 0; ai < 2; ++ai) {
            u32x4 pre[4][2];
#pragma unroll
            for (int m = 0; m < 4; ++m) { const int row = row0 + ai * 128 + m * 16;
                if (GLU) pre[m][0] = *(const u32x4*)(xb + (size_t)row * D + u.pn * 128 + wc * 32 + 8 * fq);
                else {
#pragma unroll
                    for (int bj = 0; bj < 2; ++bj) pre[m][bj] = *(const u32x4*)(xb + (size_t)row * D + u.pn * 256 + bj * 128 + wc * 32 + 8 * fq); } }
#pragma unroll
            for (int m = 0; m < 4; ++m) for (int once_ = efence(); once_; once_ = 0) { const int row = row0 + ai * 128 + m * 16; float q = 0.f;
                if (GLU) { const size_t off = (size_t)row * D + u.pn * 128 + wc * 32 + 8 * fq;
                    f32x4 o0, o1; unpack8(pre[m][0], o0, o1);
#pragma unroll
                    for (int e = 0; e < 4; ++e) { o0[e] += acc[ai][0][m][0][e] * sigmoid_f(acc[ai][1][m][0][e]); o1[e] += acc[ai][0][m][1][e] * sigmoid_f(acc[ai][1][m][1][e]);
                        q += o0[e] * o0[e] + o1[e] * o1[e]; }
                    *(u32x4*)(xb + off) = pack8(o0, o1);
                } else {
#pragma unroll
                    for (int bj = 0; bj < 2; ++bj) { const size_t off = (size_t)row * D + u.pn * 256 + bj * 128 + wc * 32 + 8 * fq;
                        f32x4 o0, o1; unpack8(pre[m][bj], o0, o1); o0 += acc[ai][bj][m][0]; o1 += acc[ai][bj][m][1];
#pragma unroll
                        for (int e = 0; e < 4; ++e) q += o0[e] * o0[e] + o1[e] * o1[e];
                        *(u32x4*)(xb + off) = pack8(o0, o1); }
                }
                q += __shfl_xor(q, 16); q += __shfl_xor(q, 32);
                if (fq == 0) fx_add(ss + row, q);
            }
        }
    }
};
struct EpiResFinal {
    const bf16_t* xb; u64* ss; unsigned* cnt; const float* gain; float* out;
    __device__ __forceinline__ void operator()(EPI_ARGS) const {
        const int row0 = u.pm * 256 + wr * 64 + fr, cofs = u.pn * 256 + wc * 32 + 8 * fq, wid = wr * 4 + wc;
#pragma unroll
        for (int ai = 0; ai < 2; ++ai) {
            u32x4 pre[4][2];
#pragma unroll
            for (int m = 0; m < 4; ++m)
#pragma unroll
                for (int bj = 0; bj < 2; ++bj) pre[m][bj] = *(const u32x4*)(xb + (size_t)(row0 + ai * 128 + m * 16) * D + cofs + bj * 128);
#pragma unroll
            for (int m = 0; m < 4; ++m) for (int once_ = efence(); once_; once_ = 0) { const int row = row0 + ai * 128 + m * 16; float q = 0.f;
#pragma unroll
                for (int bj = 0; bj < 2; ++bj) { f32x4 o0, o1; unpack8(pre[m][bj], o0, o1); o0 += acc[ai][bj][m][0]; o1 += acc[ai][bj][m][1];
#pragma unroll
                    for (int e = 0; e < 4; ++e) q += o0[e] * o0[e] + o1[e] * o1[e];
                    acc[ai][bj][m][0] = o0; acc[ai][bj][m][1] = o1; }
                q += __shfl_xor(q, 16); q += __shfl_xor(q, 32);
                if (fq == 0) fx_add(ss + row, q); }
        }
        asm volatile("s_waitcnt vmcnt(0)" ::: "memory");
        unsigned* c = cnt + 64 * u.pm;
        if (fr == 0 && fq == 0) __hip_atomic_fetch_add(c, 1u, __ATOMIC_RELAXED, __HIP_MEMORY_SCOPE_AGENT);
        if (wid == 0) { unsigned sp = 0;
            while (__hip_atomic_load(c, __ATOMIC_RELAXED, __HIP_MEMORY_SCOPE_AGENT) < 32u) { __builtin_amdgcn_s_sleep(1); if (++sp > (1u << 22)) break; } }
        asm volatile("s_waitcnt vmcnt(0) lgkmcnt(0)" ::: "memory"); __builtin_amdgcn_s_barrier(); asm volatile("" ::: "memory");
        float rs8[2][4];
#pragma unroll
        for (int ai = 0; ai < 2; ++ai)
#pragma unroll
            for (int m = 0; m < 4; ++m) { const u64 raw = __hip_atomic_load(ss + row0 + ai * 128 + m * 16, __ATOMIC_RELAXED, __HIP_MEMORY_SCOPE_AGENT);
                rs8[ai][m] = rsqrtf((float)(long long)raw * (1.0f / 16777216.0f) * (1.0f / D) + EPS); }
        f32x4 gv[2][2];
#pragma unroll
        for (int bj = 0; bj < 2; ++bj) { gv[bj][0] = *(const f32x4*)(gain + cofs + bj * 128); gv[bj][1] = *(const f32x4*)(gain + cofs + bj * 128 + 4); }
        ROWLOOP { float* orow = out + (size_t)(row0 + ai * 128 + m * 16) * D + cofs; const float rs = rs8[ai][m];
#pragma unroll
            for (int bj = 0; bj < 2; ++bj) { *(f32x4*)(orow + bj * 128) = acc[ai][bj][m][0] * rs * gv[bj][0]; *(f32x4*)(orow + bj * 128 + 4) = acc[ai][bj][m][1] * rs * gv[bj][1]; } }
    }
};
struct EpiStore {
    bf16_t* O; int ldc, nz0; long sz0, sz1; const u64* ss; float scale;
    __device__ __forceinline__ void operator()(EPI_ARGS) const {
        bf16_t* base = O + (size_t)(u.z % nz0) * sz0 + (size_t)(u.z / nz0) * sz1; const int row0 = u.pm * 256 + wr * 64 + fr, col0 = u.pn * 256 + wc * 32 + 8 * fq;
        float rs8[2][4];
        if (ss) { LOAD_RS8(t8, ss, row0);
#pragma unroll
            for (int ai = 0; ai < 2; ++ai)
#pragma unroll
                for (int m = 0; m < 4; ++m) rs8[ai][m] = t8[ai][m] * scale; }
        else {
#pragma unroll
            for (int ai = 0; ai < 2; ++ai)
#pragma unroll
                for (int m = 0; m < 4; ++m) rs8[ai][m] = scale; }
        ROWLOOP { const int row = row0 + ai * 128 + m * 16; const float rs = rs8[ai][m];
#pragma unroll
            for (int bj = 0; bj < 2; ++bj) *(u32x4*)(base + (size_t)row * ldc + col0 + bj * 128) = pack8(acc[ai][bj][m][0] * rs, acc[ai][bj][m][1] * rs); }
    }
};
struct EpiSoftmax {
    bf16_t* P; const u64* ss;
    __device__ __forceinline__ void operator()(EPI_ARGS) const {
        LAS float* X = (LAS float*)(lds + XCH_OFF); LAS float* Y = X + 1024;
        const int grow0 = u.z * SEQ + u.pm * 256 + wr * 64 + fr;
        LOAD_RS8(rs8, ss, grow0);
        ROWLOOP { const int r = ai * 128 + wr * 64 + m * 16 + fr; const float sc = rs8[ai][m] * 0.0625f; float mx = -3.0e38f;
#pragma unroll
            for (int bj = 0; bj < 2; ++bj)
#pragma unroll
                for (int n = 0; n < 2; ++n) { acc[ai][bj][m][n] = acc[ai][bj][m][n] * sc;
#pragma unroll
                    for (int e = 0; e < 4; ++e) mx = fmaxf(mx, acc[ai][bj][m][n][e]); }
            mx = fmaxf(mx, __shfl_xor(mx, 16)); mx = fmaxf(mx, __shfl_xor(mx, 32));
            if (fq == 0) X[r * 4 + wc] = mx; }
        asm volatile("s_waitcnt lgkmcnt(0)" ::: "memory"); __builtin_amdgcn_s_barrier(); asm volatile("" ::: "memory");
        ROWLOOP { const int r = ai * 128 + wr * 64 + m * 16 + fr; const f32x4 xm = *(const LAS f32x4*)(X + r * 4); const float mx = fmaxf(fmaxf(xm[0], xm[1]), fmaxf(xm[2], xm[3])); float s = 0.f;
#pragma unroll
            for (int bj = 0; bj < 2; ++bj)
#pragma unroll
                for (int n = 0; n < 2; ++n)
#pragma unroll
                    for (int e = 0; e < 4; ++e) { const float p = __expf(acc[ai][bj][m][n][e] - mx); acc[ai][bj][m][n][e] = p; s += p; }
            s += __shfl_xor(s, 16); s += __shfl_xor(s, 32);
            if (fq == 0) Y[r * 4 + wc] = s; }
        asm volatile("s_waitcnt lgkmcnt(0)" ::: "memory"); __builtin_amdgcn_s_barrier(); asm volatile("" ::: "memory");
        ROWLOOP { const int r = ai * 128 + wr * 64 + m * 16 + fr; const f32x4 ys = *(const LAS f32x4*)(Y + r * 4); const float inv = 1.0f / ((ys[0] + ys[1]) + (ys[2] + ys[3]));
#pragma unroll
            for (int bj = 0; bj < 2; ++bj) *(u32x4*)(P + (size_t)(u.z * SEQ + u.pm * 256 + r) * D + u.pn * 256 + bj * 128 + wc * 32 + 8 * fq) = pack8(acc[ai][bj][m][0] * inv, acc[ai][bj][m][1] * inv); }
    }
};
struct EpiFfn1 {
    const u64* ss; bf16_t* HM;
    __device__ __forceinline__ void operator()(EPI_ARGS) const {
        const int row0 = u.pm * 256 + wr * 64 + fr, col0 = u.pn * 128 + wc * 32 + 8 * fq;
        LOAD_RS8(rs8, ss, row0);
        ROWLOOP { const int row = row0 + ai * 128 + m * 16; const float rs = rs8[ai][m]; f32x4 h0, h1;
#pragma unroll
            for (int e = 0; e < 4; ++e) { h0[e] = silu_f(acc[ai][0][m][0][e] * rs) * (acc[ai][1][m][0][e] * rs); h1[e] = silu_f(acc[ai][0][m][1][e] * rs) * (acc[ai][1][m][1][e] * rs); }
            *(u32x4*)(HM + (size_t)row * FH + col0) = pack8(h0, h1); }
    }
};
struct EpiOin {
    const u64* ss; bf16_t* AC;
    __device__ __forceinline__ void operator()(EPI_ARGS) const {
        const int row0 = u.pm * 256 + wr * 64 + fr;
        LOAD_RS8(rs8, ss, row0);
        ROWLOOP { const int row = row0 + ai * 128 + m * 16; const float rs = rs8[ai][m];
#pragma unroll
            for (int bj = 0; bj < 2; ++bj) { const int col = u.pn * 256 + bj * 128 + wc * 32 + 8 * fq;
                *(u32x4*)(AC + (size_t)(col >> 4) * NCH * AK + (size_t)(row / SL) * AK + (row % SL) * 16 + (col & 8)) = pack8(acc[ai][bj][m][0] * rs, acc[ai][bj][m][1] * rs); } }
    }
};
struct EpiS5State {
    float* XL;
    __device__ __forceinline__ void operator()(EPI_ARGS) const {
        const int row0 = u.pm * 256 + wr * 64 + fr, col0 = wc * 32 + 8 * fq;
        ROWLOOP { const int row = row0 + ai * 128 + m * 16; float* p = XL + (size_t)u.z * NCH * 128 + (size_t)row * 128 + col0;
            *(f32x4*)p = acc[ai][0][m][0]; *(f32x4*)(p + 4) = acc[ai][0][m][1]; }
    }
};
struct EpiS5Out {
    const bf16_t* AC; const float* dsk; bf16_t* Y;
    __device__ __forceinline__ void operator()(EPI_ARGS) const {
        const int g = u.z, row0 = u.pm * 256 + wr * 64 + fr;
        f32x4 dv[2][2];
#pragma unroll
        for (int bj = 0; bj < 2; ++bj) { const int ch = g * 16 + ((u.pn * 256 + bj * 128 + wc * 32 + 8 * fq) & 8); dv[bj][0] = *(const f32x4*)(dsk + ch); dv[bj][1] = *(const f32x4*)(dsk + ch + 4); }
#pragma unroll
        for (int ai = 0; ai < 2; ++ai) {
            u32x4 pre[4][2];
#pragma unroll
            for (int m = 0; m < 4; ++m)
#pragma unroll
                for (int bj = 0; bj < 2; ++bj) pre[m][bj] = *(const u32x4*)(AC + (size_t)g * NCH * AK + (size_t)(row0 + ai * 128 + m * 16) * AK + u.pn * 256 + bj * 128 + wc * 32 + 8 * fq);
#pragma unroll
            for (int m = 0; m < 4; ++m) for (int once_ = efence(); once_; once_ = 0) { const int row = row0 + ai * 128 + m * 16;
#pragma unroll
                for (int bj = 0; bj < 2; ++bj) { const int col = u.pn * 256 + bj * 128 + wc * 32 + 8 * fq, k = col >> 4, ch = g * 16 + (col & 8);
                    f32x4 u0, u1; unpack8(pre[m][bj], u0, u1);
                    f32x4 y0 = acc[ai][bj][m][0] + dv[bj][0] * u0, y1 = acc[ai][bj][m][1] + dv[bj][1] * u1;
#pragma unroll
                    for (int e = 0; e < 4; ++e) { y0[e] = gelu_f(y0[e]); y1[e] = gelu_f(y1[e]); }
                    *(u32x4*)(Y + (size_t)(row * SL + k) * 512 + ch) = pack8(y0, y1); } }
        }
    }
};
}

#define XB_TMO      128
#define XB_XCNT(j)  (256  + 64 * (j))
#define XB_XSUB(j)  (1280 + 64 * (j))
#define XB_XGEN(j)  (2304 + 64 * (j))
#define XB_TOP      3328
#define XB_TOPGEN   3392
#define XCD_BAR_WORDS 3456
#define XB_SPIN_CAP (1u << 22)
__device__ __forceinline__ unsigned xb_ld(unsigned* p)              { return __hip_atomic_load(p, __ATOMIC_RELAXED, __HIP_MEMORY_SCOPE_AGENT); }
__device__ __forceinline__ unsigned xb_add(unsigned* p, unsigned v) { return __hip_atomic_fetch_add(p, v, __ATOMIC_RELAXED, __HIP_MEMORY_SCOPE_AGENT); }
__device__ __forceinline__ unsigned xb_xcc_id() { return (unsigned)__builtin_amdgcn_s_getreg((3 << 11) | 20) & 0xFu; }
#define XB_SPIN(cond, bar) do { unsigned _sp = 0; while (cond) { __builtin_amdgcn_s_sleep(1); \
    if ((++_sp & 255u) == 0u) { if (xb_ld(&(bar)[XB_TMO])) break; if (_sp > XB_SPIN_CAP) { atomicAdd(&(bar)[XB_TMO], 1u); break; } } } } while (0)
struct XcdBarrier { unsigned* bar; unsigned x; volatile LAS unsigned* st; };
__device__ __forceinline__ XcdBarrier xcd_barrier_post(unsigned* bar, volatile LAS unsigned* st) {
    XcdBarrier b; b.bar = bar; b.x = xb_xcc_id(); b.st = st;
    if (threadIdx.x == 0) (void)xb_add(&bar[XB_XCNT(b.x)], 1u);
    return b;
}
__device__ __forceinline__ void xcd_barrier_complete(unsigned* bar, unsigned x, unsigned& nloc, unsigned& nx) {
    const unsigned G = gridDim.x * gridDim.y * gridDim.z;
    unsigned sum, cnt, mine, sp = 0u;
    for (;;) {
        sum = 0u; cnt = 0u; mine = 0u;
#pragma unroll
        for (unsigned j = 0; j < 16; ++j) { const unsigned c = xb_ld(&bar[XB_XCNT(j)]); sum += c; cnt += (c > 0u) ? 1u : 0u; mine = (j == x) ? c : mine; }
        if (sum == G) break;
        __builtin_amdgcn_s_sleep(1);
        if ((++sp & 255u) == 0u) { if (xb_ld(&bar[XB_TMO])) break; if (sp > XB_SPIN_CAP) { atomicAdd(&bar[XB_TMO], 1u); break; } }
    }
    nloc = mine > 0u ? mine : 1u; nx = cnt > 0u ? cnt : 1u;
}
__device__ __forceinline__ void xcd_barrier(const XcdBarrier& b) {
    asm volatile("s_waitcnt vmcnt(0)" ::: "memory");
    __syncthreads();
    if (threadIdx.x == 0) {
        unsigned* bar = b.bar;
        __builtin_amdgcn_s_waitcnt(0);
        unsigned nloc = b.st[0], nx = b.st[1];
        if (nloc == 0u) { xcd_barrier_complete(bar, b.x, nloc, nx); b.st[0] = nloc; b.st[1] = nx; }
        const unsigned old = xb_add(&bar[XB_XSUB(b.x)], 1u);
        const unsigned gen = old / nloc;
        if (old + 1u == (gen + 1u) * nloc) {
            __builtin_amdgcn_fence(__ATOMIC_RELEASE, "agent");
            asm volatile("s_waitcnt vmcnt(0)" ::: "memory");
            const unsigned og = xb_add(&bar[XB_TOP], 1u);
            const unsigned tg = og / nx;
            if (og + 1u == (tg + 1u) * nx) xb_add(&bar[XB_TOPGEN], 1u);
            else XB_SPIN(xb_ld(&bar[XB_TOPGEN]) == tg, bar);
            __builtin_amdgcn_fence(__ATOMIC_ACQUIRE, "agent");
            xb_add(&bar[XB_XGEN(b.x)], 1u);
            asm volatile("s_waitcnt vmcnt(0)" ::: "memory");
        } else {
            XB_SPIN(xb_ld(&bar[XB_XGEN(b.x)]) == gen, bar);
            __builtin_amdgcn_fence(__ATOMIC_ACQUIRE, "agent");
            asm volatile("s_waitcnt vmcnt(0)" ::: "memory");
        }
    }
    __syncthreads();
}

struct ConvP { const float* W; bf16_t* WT; const float* gain; int K, ldn, cs, nblk, mode, roff, r; };
__device__ __forceinline__ void conv_load(const ConvP& p, f32x4 (&v)[32], int lane) {
    const int nkb = p.K / 64, kb = p.r % nkb, nb = p.r / nkb; const float* src = p.W + (size_t)(64 * kb + (lane >> 5)) * p.ldn + p.cs + 128 * nb + 4 * (lane & 31);
#pragma unroll
    for (int i = 0; i < 32; ++i) v[i] = *(const f32x4*)(src + (size_t)(2 * i) * p.ldn);
}
__device__ __forceinline__ void conv_store(const ConvP& p, const f32x4 (&v)[32], LAS float* scr, int lane) {
    const int nkb = p.K / 64, kb = p.r % nkb, nb = p.r / nkb, k0 = 64 * kb, c = lane & 7;
    f32x4 g0 = {1.f, 1.f, 1.f, 1.f}, g1 = g0;
    if (p.gain) { g0 = *(const f32x4*)(p.gain + k0 + 8 * c); g1 = *(const f32x4*)(p.gain + k0 + 8 * c + 4); }
#pragma unroll 1
    for (int sb = 0; sb < 4; ++sb) {
        if (((lane & 31) >> 3) == sb) {
#pragma unroll
            for (int i = 0; i < 32; ++i)
#pragma unroll
                for (int e = 0; e < 4; ++e) scr[(2 * i + (lane >> 5)) * 33 + 4 * (lane & 7) + e] = v[i][e]; }
        asm volatile("s_waitcnt lgkmcnt(0)" ::: "memory");
        const int c0 = 128 * nb + 32 * sb, drow = p.roff + (p.mode == 0 ? c0 : ((c0 >> 7) * 256 + (p.mode - 1) * 128 + (c0 & 127)));
#pragma unroll
        for (int j = 0; j < 4; ++j) { const int n = (lane >> 3) + 8 * j; const LAS float* s = scr + (8 * c) * 33 + n;
            u32x4 o; o.x = cvt_pk_bf16(s[0 * 33] * g0[0], s[1 * 33] * g0[1]); o.y = cvt_pk_bf16(s[2 * 33] * g0[2], s[3 * 33] * g0[3]); o.z = cvt_pk_bf16(s[4 * 33] * g1[0], s[5 * 33] * g1[1]); o.w = cvt_pk_bf16(s[6 * 33] * g1[2], s[7 * 33] * g1[3]);
            *(u32x4*)(p.WT + (size_t)(drow + n) * p.K + k0 + 8 * c) = o; }
        asm volatile("s_waitcnt lgkmcnt(0)" ::: "memory");
    }
}
template <bool NORM, int R> __device__ __forceinline__ void rows_to_bf16(const float* x0, bf16_t* o0, u64* ssq, int lane) {
    f32x4 v[R][4]; float s[R];
#pragma unroll
    for (int r = 0; r < R; ++r) { const f32x4* xr = (const f32x4*)(x0 + (size_t)r * D) + lane;
#pragma unroll
        for (int j = 0; j < 4; ++j) v[r][j] = xr[64 * j]; }
#pragma unroll
    for (int r = 0; r < R; ++r) { float a = 0.f;
#pragma unroll
        for (int j = 0; j < 4; ++j) a += (v[r][j][0] * v[r][j][0] + v[r][j][1] * v[r][j][1]) + (v[r][j][2] * v[r][j][2] + v[r][j][3] * v[r][j][3]);
        s[r] = wave_sum(a); }
#pragma unroll
    for (int r = 0; r < R; ++r) { const float rs = NORM ? rsqrtf(s[r] * (1.0f / D) + EPS) : 1.0f; u32x2* o = (u32x2*)(o0 + (size_t)r * D) + lane;
#pragma unroll
        for (int j = 0; j < 4; ++j) { u32x2 w; w.x = cvt_pk_bf16(v[r][j][0] * rs, v[r][j][1] * rs); w.y = cvt_pk_bf16(v[r][j][2] * rs, v[r][j][3] * rs); o[64 * j] = w; }
        if (ssq && lane == 0) ssq[r] = (u64)(long long)(s[r] * 16777216.0f); }
}
__device__ __forceinline__ void cis_f(float ang, float& c, float& s) {
    float rev = ang * 0.15915494309189535f; rev = rev - rintf(rev);
    const float x = rev * 6.283185307179586f;
    const float h = x * 0.25f, h2 = h * h;
    float sh = h * (1.0f + h2 * (-1.6666667e-1f + h2 * (8.3333333e-3f + h2 * (-1.9841270e-4f + h2 * 2.7557319e-6f))));
    float ch = 1.0f + h2 * (-0.5f + h2 * (4.1666667e-2f + h2 * (-1.3888889e-3f + h2 * (2.4801587e-5f + h2 * -2.7557319e-7f))));
    float s2 = 2.f * sh * ch, c2 = 1.f - 2.f * sh * sh;
    s = 2.f * s2 * c2; c = 1.f - 2.f * s2 * s2;
}
__device__ __forceinline__ void s5_setup(int g, LAS unsigned char* lds, const float* lam_re, const float* lam_im, const float* log_dt, const float* b_re, const float* b_im, const float* c_re, const float* c_im,
                                         bf16_t* BT3, bf16_t* GM, float* AL, int tid) {
    LAS float* pwr = (LAS float*)lds; LAS float* pwi = pwr + 33 * 64; LAS float* Bbr = pwi + 33 * 64; LAS float* Bbi = Bbr + 1024; LAS float* Cr = Bbi + 1024; LAS float* Ci = Cr + 1024; LAS float* Kd = Ci + 1024;
    const float dt = __expf(log_dt[g]);
    for (int idx = tid; idx < 33 * 64; idx += 512) { const int d = idx >> 6, p = idx & 63; const float lr = lam_re[g * 64 + p], li = lam_im[g * 64 + p];
        const float mag = __expf(lr * dt * (float)d); float c, s; cis_f(li * dt * (float)d, c, s); pwr[idx] = mag * c; pwi[idx] = mag * s; }
    for (int idx = tid; idx < 1024; idx += 512) { const int p = idx >> 4; const float lr = lam_re[g * 64 + p], li = lam_im[g * 64 + p];
        const float mag = __expf(lr * dt); float c, s; cis_f(li * dt, c, s); const float ar = mag * c, ai = mag * s, den = lr * lr + li * li;
        const float qr = ((ar - 1.0f) * lr + ai * li) / den, qi = (ai * lr - (ar - 1.0f) * li) / den;
        const float br = b_re[g * 1024 + idx], bi = b_im[g * 1024 + idx];
        Bbr[idx] = qr * br - qi * bi; Bbi[idx] = qr * bi + qi * br;
        Cr[idx] = c_re[g * 1024 + idx]; Ci[idx] = c_im[g * 1024 + idx]; }
    __syncthreads();
    for (int idx = tid; idx < 32 * 256; idx += 512) { const int d = idx >> 8, co = (idx >> 4) & 15, ci = idx & 15; float a = 0.f;
        for (int p = 0; p < 64; ++p) { const float cr = Cr[co * 64 + p], cim = Ci[co * 64 + p], pr = pwr[d * 64 + p], pi = pwi[d * 64 + p];
            const float tr = cr * pr - cim * pi, ti = cr * pi + cim * pr; a += tr * Bbr[p * 16 + ci] - ti * Bbi[p * 16 + ci]; }
        Kd[idx] = a; }
    __syncthreads();
    bf16_t* bt = BT3 + (size_t)g * 512 * AK;
    for (int idx = tid; idx < 512 * (AK / 8); idx += 512) { const int n = idx / (AK / 8), q = idx % (AK / 8), kk0 = q * 8, k = n >> 4, co = n & 15; float v[8];
        if (kk0 < 512) { const int j = kk0 >> 4, ci0 = kk0 & 15;
#pragma unroll
            for (int e = 0; e < 8; ++e) v[e] = (j <= k) ? Kd[(k - j) * 256 + co * 16 + ci0 + e] : 0.f;
        } else { const int p0 = kk0 - 512;
#pragma unroll
            for (int e = 0; e < 8; ++e) { const int p = (p0 & 63) + e; const float cr = Cr[co * 64 + p], cim = Ci[co * 64 + p], pr = pwr[(k + 1) * 64 + p], pi = pwi[(k + 1) * 64 + p];
                v[e] = (p0 < 64) ? (cr * pr - cim * pi) : -(cr * pi + cim * pr); } }
        u32x4 w; w.x = cvt_pk_bf16(v[0], v[1]); w.y = cvt_pk_bf16(v[2], v[3]); w.z = cvt_pk_bf16(v[4], v[5]); w.w = cvt_pk_bf16(v[6], v[7]);
        *(u32x4*)(bt + (size_t)n * AK + kk0) = w; }
    bf16_t* gm = GM + (size_t)g * 256 * 512;
    for (int idx = tid; idx < 256 * 64; idx += 512) { const int n = idx >> 6, q = idx & 63, kk0 = q * 8; float v[8];
        if (n < 128) { const int p = n & 63, j = kk0 >> 4, ci0 = kk0 & 15; const float pr = pwr[(SL - 1 - j) * 64 + p], pi = pwi[(SL - 1 - j) * 64 + p];
#pragma unroll
            for (int e = 0; e < 8; ++e) { const float br = Bbr[p * 16 + ci0 + e], bi = Bbi[p * 16 + ci0 + e]; v[e] = (n < 64) ? (pr * br - pi * bi) : (pr * bi + pi * br); }
        } else {
#pragma unroll
            for (int e = 0; e < 8; ++e) v[e] = 0.f; }
        u32x4 w; w.x = cvt_pk_bf16(v[0], v[1]); w.y = cvt_pk_bf16(v[2], v[3]); w.z = cvt_pk_bf16(v[4], v[5]); w.w = cvt_pk_bf16(v[6], v[7]);
        *(u32x4*)(gm + (size_t)n * 512 + kk0) = w; }
    if (tid < 64) { AL[(g * 64 + tid) * 2] = pwr[SL * 64 + tid]; AL[(g * 64 + tid) * 2 + 1] = pwi[SL * 64 + tid]; }
    __syncthreads();
}

__device__ __forceinline__ void gmlp_unit(int unit, LAS unsigned char* lds, const bf16_t* U, const bf16_t* V, const u64* vst, const bf16_t* GW, const float* gb, bf16_t* MIX, int tid) {
    const int g = unit & 3, t0 = (unit >> 2) * 128, lane = tid & 63, wid = tid >> 6;
    LAS bf16_t* vT = (LAS bf16_t*)lds;
    const int il = lane & 15, kq = lane >> 4, i = wid * 16 + il;
    u32x4 raw[4]; u64 st[4][2];
#pragma unroll
    for (int e = 0; e < 4; ++e) { const int q = tid + 512 * e, j = q >> 4, c8 = (q & 15) * 8;
        raw[e] = *(const u32x4*)(V + (size_t)(t0 + j) * 512 + g * 128 + c8); st[e][0] = vst[2 * (t0 + j)]; st[e][1] = vst[2 * (t0 + j) + 1]; }
    bf16x8 wf[4];
#pragma unroll
    for (int ks = 0; ks < 4; ++ks) wf[ks] = *(const bf16x8*)(GW + (size_t)g * 16384 + (size_t)i * 128 + ks * 32 + kq * 8);
    const float bias = gb[g * 128 + i];
    const size_t tok = (size_t)(t0 + i);
    u32x2 uu[8];
#pragma unroll
    for (int nt = 0; nt < 8; ++nt) uu[nt] = *(const u32x2*)(U + tok * 512 + g * 128 + nt * 16 + kq * 4);
#pragma unroll
    for (int e = 0; e < 4; ++e) { const int q = tid + 512 * e, j = q >> 4, c8 = (q & 15) * 8;
        const float s = (float)(long long)st[e][0] * (1.0f / 16777216.0f), ss = (float)(long long)st[e][1] * (1.0f / 16777216.0f), mean = s * (1.0f / 512.0f), var = ss * (1.0f / 512.0f) - mean * mean, rstd = rsqrtf(fmaxf(var, 0.f) + EPS);
        const float v[8] = {bflo(raw[e].x), bfhi(raw[e].x), bflo(raw[e].y), bfhi(raw[e].y), bflo(raw[e].z), bfhi(raw[e].z), bflo(raw[e].w), bfhi(raw[e].w)};
        const int jo = ((((j >> 3) ^ (c8 >> 3)) & 15) << 3) + (j & 7);
#pragma unroll
        for (int k = 0; k < 8; k += 2) { const unsigned pk = cvt_pk_bf16((v[k] - mean) * rstd, (v[k + 1] - mean) * rstd); vT[(c8 + k) * 136 + jo] = (bf16_t)(pk & 0xffffu); vT[(c8 + k + 1) * 136 + jo] = (bf16_t)(pk >> 16); } }
    __syncthreads();
#pragma unroll 2
    for (int nt = 0; nt < 8; ++nt) { f32x4 a = {0.f, 0.f, 0.f, 0.f}; const int c = nt * 16 + il;
#pragma unroll
        for (int ks = 0; ks < 4; ++ks) { const bf16x8 vf = *(const LAS bf16x8*)(vT + c * 136 + ((((ks * 4 + kq) ^ (c >> 3)) & 15) << 3)); a = __builtin_amdgcn_mfma_f32_16x16x32_bf16(vf, wf[ks], a, 0, 0, 0); }
        u32x2 o; o.x = cvt_pk_bf16(bflo(uu[nt].x) * (a[0] + bias), bfhi(uu[nt].x) * (a[1] + bias)); o.y = cvt_pk_bf16(bflo(uu[nt].y) * (a[2] + bias), bfhi(uu[nt].y) * (a[3] + bias));
        *(u32x2*)(MIX + tok * 1024 + g * 128 + nt * 16 + kq * 4) = o; }
    __syncthreads();
}
__device__ __forceinline__ void conv_units(int first, int stride, int nunits, LAS unsigned char* lds, const bf16_t* H, const float* cw, const float* cb, const float* lng, const float* lnb, bf16_t* MIX, int tid) {
    if (first >= nunits) return;
    const int lane = tid & 63, wid = tid >> 6;
    LAS bf16_t* hin = (LAS bf16_t*)lds;
    LAS float* cout = (LAS float*)(lds + 62 * 1024);
    float w[31];
#pragma unroll
    for (int k = 0; k < 31; ++k) w[k] = cw[k * 512 + tid];
    const float bias = cb[tid];
    const f32x4 g0 = *(const f32x4*)(lng + lane * 8), g1 = *(const f32x4*)(lng + lane * 8 + 4), b0 = *(const f32x4*)(lnb + lane * 8), b1 = *(const f32x4*)(lnb + lane * 8 + 4);
    u32x4 pre[8];
#define CONV_PREFETCH(unit_) { const int t0_ = (unit_) * 32, s0_ = t0_ % SEQ; _Pragma("unroll") for (int e = 0; e < 8; ++e) { const int q = tid + 512 * e, r = q >> 6, c8 = (q & 63) * 8; \
        u32x4 v_ = {0u, 0u, 0u, 0u}; if (q < 62 * 64 && s0_ - 30 + r >= 0) v_ = *(const u32x4*)(H + (size_t)(t0_ - 30 + r) * 512 + c8); pre[e] = v_; } }
    CONV_PREFETCH(first);
#pragma unroll 1
    for (int unit = first; unit < nunits; unit += stride) {
        const int t0 = unit * 32;
#pragma unroll
        for (int e = 0; e < 8; ++e) { const int q = tid + 512 * e; if (q < 62 * 64) *(LAS u32x4*)(hin + (q >> 6) * 512 + (q & 63) * 8) = pre[e]; }
        if (unit + stride < nunits) CONV_PREFETCH(unit + stride);
        __syncthreads();
#pragma unroll 1
        for (int tg = 0; tg < 4; ++tg) { float x[38];
#pragma unroll
            for (int r = 0; r < 38; ++r) x[r] = bf2f(hin[(tg * 8 + r) * 512 + tid]);
#pragma unroll
            for (int o = 0; o < 8; ++o) { float a = bias;
#pragma unroll
                for (int k = 0; k < 31; ++k) a += w[k] * x[o + k];
                cout[(tg * 8 + o) * 516 + tid] = a; } }
        __syncthreads();
#pragma unroll 1
        for (int tt = 0; tt < 4; ++tt) { const int row = wid * 4 + tt; const f32x4 v0 = *(const LAS f32x4*)(cout + row * 516 + lane * 8), v1 = *(const LAS f32x4*)(cout + row * 516 + lane * 8 + 4);
            const float mean = wave_sum((v0[0] + v0[1]) + (v0[2] + v0[3]) + (v1[0] + v1[1]) + (v1[2] + v1[3])) * (1.0f / 512.0f);
            const f32x4 d0 = v0 - mean, d1 = v1 - mean;
            const float var = wave_sum((d0[0] * d0[0] + d0[1] * d0[1]) + (d0[2] * d0[2] + d0[3] * d0[3]) + (d1[0] * d1[0] + d1[1] * d1[1]) + (d1[2] * d1[2] + d1[3] * d1[3])) * (1.0f / 512.0f);
            const float rstd = rsqrtf(var + EPS);
            f32x4 y0 = d0 * rstd * g0 + b0, y1 = d1 * rstd * g1 + b1;
#pragma unroll
            for (int e = 0; e < 4; ++e) { y0[e] = silu_f(y0[e]); y1[e] = silu_f(y1[e]); }
            *(u32x4*)(MIX + (size_t)(t0 + row) * 1024 + 512 + lane * 8) = pack8(y0, y1); }
    }
    __syncthreads();
#undef CONV_PREFETCH
}

struct Args { const float* in[33]; float* out; unsigned char* ws; int ph_lo, ph_hi; };
constexpr int NPHASE = 28;

#define CONVJOB(Wp, K_, ldn_, cs_, nc_, WTp, mode_, roff_, gain_) { const int nblk_ = (nc_) / 128, cnt_ = ((K_) / 64) * nblk_; \
            if (r >= 0 && r < cnt_) { cp.W = (Wp); cp.WT = (bf16_t*)(WTp); cp.gain = (gain_); cp.K = (K_); cp.ldn = (ldn_); cp.cs = (cs_); cp.nblk = nblk_; cp.mode = (mode_); cp.roff = (roff_); cp.r = r; } r -= cnt_; }
#define CONVLOOKUP(cp, it_) { int r = (it_); \
            CONVJOB(ap->in[3], 1024, 2048, 0, 1024, ws + WS_WIN0, 0, 0, ap->in[2]); \
            CONVJOB(ap->in[3], 1024, 2048, 1024, 512, ws + WS_WIN0, 1, 1024, ap->in[2]); \
            CONVJOB(ap->in[3], 1024, 2048, 1536, 512, ws + WS_WIN0, 2, 1024, ap->in[2]); \
            CONVJOB(ap->in[10], 1024, 1024, 0, 1024, ws + WS_WOUT0, 0, 0, nullptr); \
            CONVJOB(ap->in[12], 1024, 512, 0, 512, ws + WS_WOIN, 0, 0, ap->in[11]); \
            CONVJOB(ap->in[21], 512, 2048, 0, 1024, ws + WS_WOOUT, 1, 0, nullptr); \
            CONVJOB(ap->in[21], 512, 2048, 1024, 1024, ws + WS_WOOUT, 2, 0, nullptr); \
            _Pragma("unroll") for (int l2 = 0; l2 < 2; ++l2) { \
                CONVJOB(ap->in[25] + (size_t)l2 * D * D, 1024, 1024, 0, 1024, ws + WS_WK + l2 * WSQ_L, 0, 0, ap->in[23] + l2 * D); \
                CONVJOB(ap->in[26] + (size_t)l2 * D * D, 1024, 1024, 0, 1024, ws + WS_WV + l2 * WSQ_L, 0, 0, ap->in[23] + l2 * D); \
                CONVJOB(ap->in[27] + (size_t)l2 * D * D, 1024, 1024, 0, 1024, ws + WS_WO + l2 * WSQ_L, 0, 0, nullptr); } \
            _Pragma("unroll") for (int l2 = 0; l2 < 2; ++l2) { \
                CONVJOB(ap->in[29] + (size_t)l2 * D * FH, 1024, FH, 0, FH, ws + WS_WGU + l2 * WGU_L, 1, 0, ap->in[28] + l2 * D); \
                CONVJOB(ap->in[30] + (size_t)l2 * D * FH, 1024, FH, 0, FH, ws + WS_WGU + l2 * WGU_L, 2, 0, ap->in[28] + l2 * D); \
                CONVJOB(ap->in[31] + (size_t)l2 * FH * D, FH, 1024, 0, 1024, ws + WS_WD + l2 * WD_L, 0, 0, nullptr); } }
constexpr int CONV_N_A = (512 + 256 + 256 + 512 + 256 + 256 + 256 + 2 * 3 * 512) / 4, CONV_N_B = CONV_N_A + 3 * 1408 / 4, CONV_N_C = CONV_N_B + 3 * 1408 / 4;
#define CONV_RANGE(lo_, hi_, wv_, nwv_) { LAS float* scr_ = (LAS float*)(lds + wave * 16384); \
        for (int it = (lo_) + (wv_); it < (hi_); it += (nwv_)) { ConvP c0{}; f32x4 v0[32]; { ConvP cp{}; CONVLOOKUP(cp, it); c0 = cp; } conv_load(c0, v0, lane); conv_store(c0, v0, scr_, lane); } }

typedef const __attribute__((address_space(4))) Args* KArgP;
__device__ __forceinline__ KArgP fresh_args() { KArgP p = (KArgP)__builtin_amdgcn_kernarg_segment_ptr(); asm volatile("" : "+s"(p)); return p; }

__global__ void __launch_bounds__(512, 2) trunk_fwd(Args args_unused) {
    extern __shared__ __attribute__((aligned(16))) unsigned char lds_raw[];
    LAS unsigned char* lds = (LAS unsigned char*)lds_raw;
    cg::grid_group grid = cg::this_grid();
    { volatile LAS unsigned* MISC0 = (volatile LAS unsigned*)(lds + MISC_OFF); if (threadIdx.x < 32) MISC0[threadIdx.x] = 0u; }
    __syncthreads();
    int lo, hi;
    { KArgP ap = fresh_args(); lo = ap->ph_lo; hi = ap->ph_hi; }
#if !MK_MULTI && !MK_CGSYNC
    { KArgP ap = fresh_args(); (void)xcd_barrier_post((unsigned*)(ap->ws + WS_BAR), (volatile LAS unsigned*)(lds + MISC_OFF) + 8); }
#endif
    int nsync = 0;
#if MK_MULTI
#define SEAM(k) do { } while (0)
#elif MK_CGSYNC
#define SEAM(k) do { if (rep_ + 1 == nrep_ && (k) + 1 < hi) grid.sync(); } while (0)
#else
#define SEAM(k) do { if (rep_ + 1 == nrep_ && (k) + 1 < hi) { if (hi > 1000) grid.sync(); else { KArgP ap_ = fresh_args(); XcdBarrier xb_; xb_.bar = (unsigned*)(ap_->ws + WS_BAR); xb_.x = xb_xcc_id(); xb_.st = (volatile LAS unsigned*)(lds + MISC_OFF) + 8; xcd_barrier(xb_); if (BARPROBE) xcd_barrier(xb_); } ++nsync; } } while (0)
#endif
#ifndef ONLY
#define ONLY -1
#endif
#ifndef REPMASK
#define REPMASK 0
#endif
#define PHASE(id, k) if ((ONLY < 0 || ONLY == (id)) && lo <= (k) && (k) < hi) for (int rep_ = 0, nrep_ = (((REPMASK) >> (id)) & 1) ? 2 : 1; rep_ < nrep_; ++rep_)
    (void)nsync;
#define LOCALS KArgP ap = fresh_args(); unsigned char* ws = ap->ws; float* out = ap->out; const float* x_in = ap->in[0]; \
    int tid_ = threadIdx.x, G_ = gridDim.x, bx_ = blockIdx.x; asm volatile("" : "+v"(tid_), "+s"(G_), "+s"(bx_)); \
    const int tid = tid_, lane = tid & 63, wave = __builtin_amdgcn_readfirstlane(tid >> 6), G = G_, bx = bx_, gw = bx * 8 + wave, NGW = G * 8; \
    bf16_t* XB = (bf16_t*)(ws + WS_XB); u64* SS = (u64*)(ws + WS_SS); u64* VST = (u64*)(ws + WS_VST); bf16_t* QO = (bf16_t*)(ws + WS_QO); \
    bf16_t* HM = (bf16_t*)(ws + WS_HM); bf16_t* MEMN = (bf16_t*)(ws + WS_MEMN); bf16_t* KL = (bf16_t*)(ws + WS_KL); bf16_t* VL = (bf16_t*)(ws + WS_VL); \
    bf16_t* U = (bf16_t*)(ws + WS_U); bf16_t* V = (bf16_t*)(ws + WS_V); bf16_t* H = (bf16_t*)(ws + WS_H); bf16_t* MIX = (bf16_t*)(ws + WS_MIX); \
    bf16_t* AC = (bf16_t*)(ws + WS_ACOMB); float* XL = (float*)(ws + WS_XLOC); bf16_t* Y = (bf16_t*)(ws + WS_Y); u64* SSa = SS + (size_t)(3 * l) * T; \
    (void)out; (void)x_in; (void)lane; (void)gw; (void)NGW; (void)XB; (void)VST; (void)QO; (void)HM; (void)MEMN; (void)KL; (void)VL; (void)U; (void)V; (void)H; (void)MIX; (void)AC; (void)XL; (void)Y; (void)SSa; (void)wave;

    PHASE(0, 0) { const int l = 0; LOCALS
        { f32x4* z = (f32x4*)(SS + T); const int n4 = 7 * T * 2 / 4; for (int i = bx * 512 + tid; i < n4; i += G * 512) z[i] = (f32x4){0.f, 0.f, 0.f, 0.f};
          f32x4* z2 = (f32x4*)VST; const int m4 = 2 * T * 2 / 4; for (int i = bx * 512 + tid; i < m4; i += G * 512) z2[i] = (f32x4){0.f, 0.f, 0.f, 0.f}; }
        CONV_RANGE(0, CONV_N_A, gw, NGW);
        { const int nb5 = (G > 64) ? G - 32 : G;
          if (bx < nb5) { const int NW5 = nb5 * 8;
              for (int m = gw * 4; m < T; m += NW5 * 4) rows_to_bf16<false, 4>(x_in + (size_t)m * D, XB + (size_t)m * D, SS + m, lane);
              for (int m = gw * 4; m < MT; m += NW5 * 4) rows_to_bf16<true, 4>(ap->in[1] + (size_t)m * D, MEMN + (size_t)m * D, nullptr, lane); } }
        for (int i = bx * 512 + tid; i < 2 * D * D / 8; i += G * 512) { const int l2 = i / (D * D / 8), e = (i % (D * D / 8)) * 8, k = e >> 10; const float gk = ap->in[22][l2 * D + k];
            const f32x4 a = *(const f32x4*)(ap->in[24] + (size_t)l2 * D * D + e), b = *(const f32x4*)(ap->in[24] + (size_t)l2 * D * D + e + 4);
            *(u32x4*)((bf16_t*)(ws + WS_WQ) + (size_t)l2 * D * D + e) = pack8(a * gk, b * gk); }
        { bf16_t* GW = (bf16_t*)(ws + WS_GW); const float* w = ap->in[4];
          for (int i = bx * 512 + tid; i < 4 * 128 * 128 / 2; i += G * 512) { const int e = 2 * i, ii = (e >> 7) & 127, jj = e & 127; const bool keep = (jj >> 6) <= (ii >> 6);
              ((unsigned*)GW)[i] = keep ? cvt_pk_bf16(w[e], w[e + 1]) : 0u; } }
        __syncthreads();
        for (int g = G - 1 - bx; g < 32; g += G)
            s5_setup(g, lds, ap->in[13], ap->in[14], ap->in[15], ap->in[16], ap->in[17], ap->in[18], ap->in[19], (bf16_t*)(ws + WS_BT3), (bf16_t*)(ws + WS_GM), (float*)(ws + WS_AL), tid);
        SEAM(0);
    }
#pragma unroll 1
    for (int l = 0; l < 2; ++l) {
        const int pb = 3 + 12 * l;
        if (l == 0) {
            PHASE(2, pb + 0) { LOCALS
                pg8::Gemm g{XB, (const bf16_t*)(ws + WS_WIN0), D, D, D, 1, 0, 0, 0, 0}; pg8::Sched S; S.init(T / 256, 2048 / 256, 1, G, bx);
                { pg8::EpiIn0 E{SSa, U, V, H, VST}; pg8::gemm_phase<MK_ALIGN>(lds, g, S, E, tid); }
                { pg8::Gemm g{MEMN, (const bf16_t*)(ws + WS_WK), D, D, D, 2, 0, 0, (long)D * D, 0}; pg8::Sched S; S.init(MT / 256, D / 256, 2, G, bx);
                  pg8::EpiStore E{KL, D, 2, (long)MT * D, 0, nullptr, 1.0f}; pg8::gemm_phase<MK_ALIGN>(lds, g, S, E, tid); }
                { pg8::Gemm g{MEMN, (const bf16_t*)(ws + WS_WV), D, D, D, 2, 0, 0, (long)D * D, 0}; pg8::Sched S; S.init(MT / 256, D / 256, 2, G, (bx + G / 2) % G);
                  pg8::EpiStore E{VL, D, 2, (long)MT * D, 0, nullptr, 1.0f}; pg8::gemm_phase<MK_ALIGN>(lds, g, S, E, tid); }
                if ((G & 3) == 0) { const int hG = G / 2, qG = G / 4; if ((bx % hG) >= qG) { const int ii = (bx / hG) * qG + (bx % hG) - qG; CONV_RANGE(CONV_N_A, CONV_N_B, ii * 8 + wave, hG * 8); } }
                else CONV_RANGE(CONV_N_A, CONV_N_B, gw, NGW);
                SEAM(pb + 0);
            }
            PHASE(3, pb + 1) { LOCALS
                for (int i = bx; i < 1024; i += G) gmlp_unit(i, lds, U, V, VST, (const bf16_t*)(ws + WS_GW), ap->in[5], MIX, tid);
                conv_units(bx, G, 1024, lds, H, ap->in[6], ap->in[7], ap->in[8], ap->in[9], MIX, tid);
#pragma unroll 1
                for (int l2 = 0; l2 < 2; ++l2) {
                    { pg8::Gemm g{KL + (size_t)l2 * MT * D, (const bf16_t*)(ws + WS_WQ) + (size_t)l2 * D * D, D, D, 256, 4, 256, 256L * D, 256, 0}; pg8::Sched S; S.init(1, 4, 32, G, bx);
                      pg8::EpiStore E{(bf16_t*)(ws + WS_WQK) + (size_t)l2 * 8 * D * D, D, 4, 256L * D, (long)D * D, nullptr, 1.0f}; pg8::gemm_phase<MK_ALIGN>(lds, g, S, E, tid); }
                    { pg8::Gemm g{(const bf16_t*)(ws + WS_WO) + (size_t)l2 * D * D, VL + (size_t)l2 * MT * D, D, D, 256, 4, 256, 0, 256, 256L * D}; pg8::Sched S; S.init(4, 1, 32, G, (bx + G / 2) % G);
                      pg8::EpiStore E{(bf16_t*)(ws + WS_WVO) + (size_t)l2 * 8 * D * D, D, 4, 256, (long)D * D, nullptr, 1.0f}; pg8::gemm_phase<MK_ALIGN>(lds, g, S, E, tid); }
                }
                SEAM(pb + 1);
            }
            PHASE(4, pb + 2) { LOCALS
                pg8::Gemm g{MIX, (const bf16_t*)(ws + WS_WOUT0), D, D, D, 1, 0, 0, 0, 0}; pg8::Sched S; S.init(T / 256, D / 256, 1, G, bx);
                pg8::EpiRes<false> E{XB, SSa + T, 0}; pg8::gemm_phase<MK_ALIGN>(lds, g, S, E, tid);
                SEAM(pb + 2);
            }
        } else {
            PHASE(5, pb + 0) { LOCALS
                pg8::Gemm g{XB, (const bf16_t*)(ws + WS_WOIN), D, D, D, 1, 0, 0, 0, 0}; pg8::Sched S; S.init(T / 256, 512 / 256, 1, G, bx);
                pg8::EpiOin E{SSa, AC}; pg8::gemm_phase<MK_ALIGN>(lds, g, S, E, tid);
                SEAM(pb + 0);
            }
            PHASE(6, pb + 1) { LOCALS
                pg8::Gemm g{AC, (const bf16_t*)(ws + WS_GM), AK, 512, 512, 32, (long)NCH * AK, 0, 256L * 512, 0}; pg8::Sched S; S.init(NCH / 256, 1, 32, G, bx);
                pg8::EpiS5State E{XL}; pg8::gemm_phase<MK_ALIGN>(lds, g, S, E, tid);
                SEAM(pb + 1);
            }
            PHASE(7, pb + 2) { LOCALS
                if (wave > 0) CONV_RANGE(CONV_N_B, CONV_N_C, bx * 7 + wave - 1, G * 7);
                if (wave == 0) {
#pragma unroll 1
                    for (int idx = bx * 64 + lane; idx < NB * 32 * 64; idx += G * 64) { const int p = idx & 63, g = (idx >> 6) & 31, b = idx >> 11;
                        const float* AL = (const float*)(ws + WS_AL); const float ar = AL[(g * 64 + p) * 2], ai = AL[(g * 64 + p) * 2 + 1];
                        const float* xl = XL + (size_t)g * NCH * 128 + (size_t)(b * (SEQ / SL)) * 128; bf16_t* ac = AC + (size_t)g * NCH * AK + (size_t)(b * (SEQ / SL)) * AK + 512;
                        float xr = 0.f, xi = 0.f;
#pragma unroll 1
                        for (int c0 = 0; c0 < SEQ / SL; c0 += 32) { float lr[32], li[32];
#pragma unroll
                            for (int i = 0; i < 32; ++i) { lr[i] = xl[(size_t)(c0 + i) * 128 + p]; li[i] = xl[(size_t)(c0 + i) * 128 + 64 + p]; }
#pragma unroll
                            for (int i = 0; i < 32; ++i) { const unsigned pk = cvt_pk_bf16(xr, xi); ac[(size_t)(c0 + i) * AK + p] = (bf16_t)(pk & 0xffffu); ac[(size_t)(c0 + i) * AK + 64 + p] = (bf16_t)(pk >> 16);
                                const float nr = ar * xr - ai * xi + lr[i], ni = ar * xi + ai * xr + li[i]; xr = nr; xi = ni; } }
                    }
                }
                SEAM(pb + 2);
            }
            PHASE(8, pb + 3) { LOCALS
                pg8::Gemm g{AC, (const bf16_t*)(ws + WS_BT3), AK, AK, AK, 32, (long)NCH * AK, 0, 512L * AK, 0}; pg8::Sched S; S.init(NCH / 256, 2, 32, G, bx);
                pg8::EpiS5Out E{AC, ap->in[20], Y}; pg8::gemm_phase<MK_ALIGN>(lds, g, S, E, tid);
                SEAM(pb + 3);
            }
            PHASE(9, pb + 4) { LOCALS
                pg8::Gemm g{Y, (const bf16_t*)(ws + WS_WOOUT), 512, 512, 512, 1, 0, 0, 0, 0}; pg8::Sched S; S.init(T / 256, 2048 / 256, 1, G, bx);
                pg8::EpiRes<true> E{XB, SSa + T, 0}; pg8::gemm_phase<MK_ALIGN>(lds, g, S, E, tid);
                SEAM(pb + 4);
            }
        }
        PHASE(10, pb + 5) { LOCALS
            pg8::Gemm g{XB, (const bf16_t*)(ws + WS_WQK) + (size_t)l * 8 * D * D, D, D, D, 8, (long)SEQ * D, 0, (long)D * D, 0}; pg8::Sched S; S.init(SEQ / 256, D / 256, 8, G, bx);
            pg8::EpiSoftmax E{QO, SSa + T}; pg8::gemm_phase<true>(lds, g, S, E, tid);
            SEAM(pb + 5);
        }
        PHASE(13, pb + 6) { LOCALS
            pg8::Gemm g{QO, (const bf16_t*)(ws + WS_WVO) + (size_t)l * 8 * D * D, D, D, D, 8, (long)SEQ * D, 0, (long)D * D, 0}; pg8::Sched S; S.init(SEQ / 256, D / 256, 8, G, bx);
            pg8::EpiRes<false> E{XB, SSa + 2 * T, SEQ}; pg8::gemm_phase<MK_ALIGN>(lds, g, S, E, tid);
            SEAM(pb + 6);
        }
        PHASE(14, pb + 9) { LOCALS
            pg8::Gemm g{XB, (const bf16_t*)(ws + WS_WGU + l * WGU_L), D, D, D, 1, 0, 0, 0, 0}; pg8::Sched S; S.init(T / 256, 2 * FH / 256, 1, G, bx);
            pg8::EpiFfn1 E{SSa + 2 * T, HM}; pg8::gemm_phase<MK_ALIGN>(lds, g, S, E, tid);
            SEAM(pb + 9);
        }
        PHASE(15, pb + 10) { LOCALS
            pg8::Gemm g{HM, (const bf16_t*)(ws + WS_WD + l * WD_L), FH, FH, FH, 1, 0, 0, 0, 0}; pg8::Sched S; S.init(T / 256, D / 256, 1, G, bx);
            if (l == 1 && G == 256 && !MK_MULTI) { pg8::EpiResFinal E{XB, SSa + 3 * T, (unsigned*)(ws + WS_PCNT), ap->in[32], out}; pg8::gemm_phase<true>(lds, g, S, E, tid); }
            else { pg8::EpiRes<false> E{XB, SSa + 3 * T, 0}; pg8::gemm_phase<MK_ALIGN>(lds, g, S, E, tid); SEAM(pb + 10); }
        }
    }
    PHASE(16, 27) { const int l = 0; LOCALS
        if (G != 256 || MK_MULTI) {
        const u64* ssf = SS + (size_t)6 * T; const float* gf = ap->in[32];
        const f32x4 ga = *(const f32x4*)(gf + 8 * lane), gb = *(const f32x4*)(gf + 8 * lane + 4), gc = *(const f32x4*)(gf + 512 + 8 * lane), gd = *(const f32x4*)(gf + 512 + 8 * lane + 4);
        for (int m = gw * 4; m < T; m += NGW * 4) { u32x4 v[4][2]; float rs[4];
#pragma unroll
            for (int r = 0; r < 4; ++r) { rs[r] = rsqrtf(fx_get(ssf + m + r) * (1.0f / D) + EPS); const bf16_t* xr = XB + (size_t)(m + r) * D + 8 * lane; v[r][0] = *(const u32x4*)xr; v[r][1] = *(const u32x4*)(xr + 512); }
#pragma unroll
            for (int r = 0; r < 4; ++r) { float* orow = out + (size_t)(m + r) * D + 8 * lane; f32x4 a0, a1, b0, b1; pg8::unpack8(v[r][0], a0, a1); pg8::unpack8(v[r][1], b0, b1);
                *(f32x4*)orow = a0 * rs[r] * ga; *(f32x4*)(orow + 4) = a1 * rs[r] * gb; *(f32x4*)(orow + 512) = b0 * rs[r] * gc; *(f32x4*)(orow + 516) = b1 * rs[r] * gd; } }
        }
    }
}

extern "C" void kernel_launch(void* const* d_in, const int* in_sizes, int n_in, void* d_out, int out_size, void* d_ws, size_t ws_size, hipStream_t stream) {
    static int grid = 0;
    if (grid == 0) {
        if (n_in != 33 || in_sizes[0] != T * D || out_size != T * D || ws_size < WS_END) { fprintf(stderr, "kernel_launch: unexpected shapes (n_in %d, in0 %d, out %d, ws %zu < %zu)\n", n_in, n_in > 0 ? in_sizes[0] : -1, out_size, ws_size, (size_t)WS_END); grid = -1; return; }
        int dev = 0, cus = 0, per_cu = 0;
        hipGetDevice(&dev); hipDeviceGetAttribute(&cus, hipDeviceAttributeMultiprocessorCount, dev);
        if (hipFuncSetAttribute((const void*)trunk_fwd, hipFuncAttributeMaxDynamicSharedMemorySize, LDS_BYTES) != hipSuccess) { fprintf(stderr, "kernel_launch: hipFuncSetAttribute failed\n"); grid = -1; return; }
        if (hipOccupancyMaxActiveBlocksPerMultiprocessor(&per_cu, (const void*)trunk_fwd, 512, LDS_BYTES) != hipSuccess || per_cu < 1) { fprintf(stderr, "kernel_launch: occupancy query says %d\n", per_cu); per_cu = 1; }
        (void)hipGetLastError();
        grid = cus * 1;
        if (grid <= 0) grid = 256;
    }
    if (grid < 0) return;
    Args a{};
    for (int i = 0; i < 33; ++i) a.in[i] = (const float*)d_in[i];
    a.out = (float*)d_out; a.ws = (unsigned char*)d_ws;
#if !MK_MULTI && !MK_CGSYNC
    (void)hipMemsetAsync((char*)d_ws + WS_BAR, 0, 16384 + 128 * 256, stream);
#endif
#if MK_MULTI
    for (int p = 0; p < NPHASE; ++p) {
        if (p == 1 || p == 2 || p == 6 || p == 7 || p == 10 || p == 11 || p == 14 || p == 22 || p == 23 || p == 26) continue;
        a.ph_lo = p; a.ph_hi = p + 1; void* kargs[] = {&a};
        hipError_t e = hipLaunchCooperativeKernel((const void*)trunk_fwd, dim3(grid), dim3(512), kargs, LDS_BYTES, stream);
        if (e != hipSuccess) { fprintf(stderr, "kernel_launch: launch of phase %d failed: %s\n", p, hipGetErrorString(e)); break; }
    }
#else
    a.ph_lo = 0; a.ph_hi = NPHASE; void* kargs[] = {&a};
    hipError_t e = hipLaunchCooperativeKernel((const void*)trunk_fwd, dim3(grid), dim3(512), kargs, LDS_BYTES, stream);
    if (e != hipSuccess) fprintf(stderr, "kernel_launch: cooperative launch failed: %s (grid %d)\n", hipGetErrorString(e), grid);
#endif
}
```
